# Optimizing an MI355X kernel written in HIP

```python
import math
import jax, jax.numpy as jnp
from jax import lax
import numpy as np

D_MODEL = 2048
BATCH = 2
SEQ = 4096
DEPTH = 1

D_MIX = D_MODEL
D_CONV = D_MIX // 2
CONV_GROUPS = 16
CONV_WIDTH = 3
D_MLSTM = D_MIX - D_CONV
MLSTM_HEADS = 4
MLSTM_HEAD_DIM = D_MLSTM // MLSTM_HEADS
MLSTM_CHUNK = 64
N_KEYS = 128
N_EXPERTS = N_KEYS * N_KEYS
PEER_HEADS = 8
PEER_TOPK = 16
D_KEY = 256
PEER_BLOCK = 128
EPS = 1e-6

D_IN_PROJ = 3 * D_CONV + 4 * D_MLSTM + 2 * MLSTM_HEADS

kernel_name = "hymba_conv_mlstm_peer_layer"


def rmsnorm(x, g):
    xf = x.astype(jnp.float32)
    y = xf * lax.rsqrt(jnp.mean(xf * xf, axis=-1, keepdims=True) + EPS)
    return (y * g.astype(jnp.float32)).astype(x.dtype)


def short_conv_mixer(xin, gate_b, gate_c, conv_w):
    u = gate_c * xin
    seq = u.shape[1]
    up = jnp.pad(u, ((0, 0), (CONV_WIDTH - 1, 0), (0, 0)))
    y = conv_w[0] * up[:, 0:seq]
    for j in range(1, CONV_WIDTH):
        y = y + conv_w[j] * up[:, j:j + seq]
    return gate_b * y


def mlstm_chunkwise(q, k, v, i_pre, log_f):
    bsz, seq, nh, dh = q.shape
    nc = seq // MLSTM_CHUNK
    L = MLSTM_CHUNK

    def to_chunks(t):
        return t.reshape(bsz, nc, L, nh, dh).transpose(1, 0, 3, 2, 4)

    def gate_chunks(t):
        return t.reshape(bsz, nc, L, nh).transpose(1, 0, 3, 2)

    causal = jnp.tril(jnp.ones((L, L), dtype=bool))

    def step(carry, inp):
        C, n, m = carry
        qc, kc, vc, ic, fc = inp
        b = jnp.cumsum(fc, axis=-1)
        dmat = b[..., :, None] - b[..., None, :] + ic[..., None, :]
        dmat = jnp.where(causal, dmat, -jnp.inf)
        inter = b + m[..., None]
        m_loc = jnp.maximum(inter, jnp.max(dmat, axis=-1))
        sw = jnp.einsum('bhjd,bhld->bhjl', qc, kc) * jnp.exp(dmat - m_loc[..., None])
        ei = jnp.exp(inter - m_loc)
        num = ei[..., None] * jnp.einsum('bhvd,bhjd->bhjv', C, qc) + jnp.einsum('bhjl,bhlv->bhjv', sw, vc)
        nq = ei * jnp.einsum('bhd,bhjd->bhj', n, qc) + jnp.sum(sw, axis=-1)
        h = num / jnp.maximum(jnp.abs(nq), jnp.exp(-m_loc))[..., None]
        b_last = b[..., -1]
        g = b_last[..., None] - b + ic
        m_new = jnp.maximum(b_last + m, jnp.max(g, axis=-1))
        decay = jnp.exp(b_last + m - m_new)
        w = jnp.exp(g - m_new[..., None])
        C_new = decay[..., None, None] * C + jnp.einsum('bhl,bhlv,bhld->bhvd', w, vc, kc)
        n_new = decay[..., None] * n + jnp.einsum('bhl,bhld->bhd', w, kc)
        return (C_new, n_new, m_new), h

    init = (jnp.zeros((bsz, nh, dh, dh), jnp.float32),
            jnp.zeros((bsz, nh, dh), jnp.float32),
            jnp.zeros((bsz, nh), jnp.float32))
    _, h = lax.scan(step, init, (to_chunks(q), to_chunks(k), to_chunks(v),
                                 gate_chunks(i_pre), gate_chunks(log_f)))
    return h.transpose(1, 0, 3, 2, 4).reshape(bsz, seq, nh, dh)


def peer_ffn(xn, w_query, sub_keys_1, sub_keys_2, expert_u, expert_v):
    bsz, seq, d = xn.shape
    t = bsz * seq
    xf = xn.reshape(t, d)
    q = (xf @ w_query).reshape(t, PEER_HEADS, D_KEY)
    q1, q2 = q[..., :D_KEY // 2], q[..., D_KEY // 2:]
    s1 = jnp.einsum('thd,nd->thn', q1, sub_keys_1)
    s2 = jnp.einsum('thd,nd->thn', q2, sub_keys_2)
    v1, i1 = lax.top_k(s1, PEER_TOPK)
    v2, i2 = lax.top_k(s2, PEER_TOPK)
    cand = (v1[..., :, None] + v2[..., None, :]).reshape(t, PEER_HEADS, PEER_TOPK * PEER_TOPK)
    sc, ci = lax.top_k(cand, PEER_TOPK)
    a = ci // PEER_TOPK
    bsel = ci % PEER_TOPK
    idx = jnp.take_along_axis(i1, a, axis=-1) * N_KEYS + jnp.take_along_axis(i2, bsel, axis=-1)
    gate = jax.nn.softmax(sc.astype(jnp.float32), axis=-1).astype(xn.dtype)
    nb = t // PEER_BLOCK

    def block(args):
        xb, ib, gb = args
        u = jnp.take(expert_u, ib, axis=0)
        act = jax.nn.gelu(jnp.einsum('td,thkd->thk', xb, u), approximate=False)
        vv = jnp.take(expert_v, ib, axis=0)
        return jnp.einsum('thk,thkd->td', gb * act, vv)

    y = lax.map(block, (xf.reshape(nb, PEER_BLOCK, d),
                        idx.reshape(nb, PEER_BLOCK, PEER_HEADS, PEER_TOPK),
                        gate.reshape(nb, PEER_BLOCK, PEER_HEADS, PEER_TOPK)))
    return y.reshape(bsz, seq, d)


def setup_inputs(seed: int = 0) -> dict:
    key = jax.random.key(seed)
    ks = jax.random.split(key, 16)
    f32 = jnp.float32
    nrm = lambda k, shape, s: jax.random.normal(k, shape, f32) * s
    x = jax.random.normal(ks[0], (BATCH, SEQ, D_MODEL), f32)
    norm_mix_g = 1.0 + nrm(ks[1], (DEPTH, D_MODEL), 0.02)
    w_in = nrm(ks[2], (DEPTH, D_MODEL, D_IN_PROJ), D_MODEL ** -0.5)
    b_igate = nrm(ks[3], (DEPTH, MLSTM_HEADS), 0.1)
    b_fgate = jnp.linspace(3.0, 6.0, MLSTM_HEADS, dtype=f32)[None, :] + nrm(ks[4], (DEPTH, MLSTM_HEADS), 0.1)
    conv_w = nrm(ks[5], (DEPTH, CONV_WIDTH, D_CONV), CONV_WIDTH ** -0.5)
    mlstm_norm_g = 1.0 + nrm(ks[6], (DEPTH, D_MLSTM), 0.02)
    w_out = nrm(ks[7], (DEPTH, D_MIX, D_MODEL), D_MIX ** -0.5)
    norm_ffn_g = 1.0 + nrm(ks[8], (DEPTH, D_MODEL), 0.02)
    w_query = nrm(ks[9], (DEPTH, D_MODEL, PEER_HEADS * D_KEY), D_MODEL ** -0.5)
    sub_keys_1 = nrm(ks[10], (DEPTH, N_KEYS, D_KEY // 2), (D_KEY // 2) ** -0.5)
    sub_keys_2 = nrm(ks[11], (DEPTH, N_KEYS, D_KEY // 2), (D_KEY // 2) ** -0.5)
    expert_u = nrm(ks[12], (DEPTH, N_EXPERTS, D_MODEL), D_MODEL ** -0.5)
    expert_v = nrm(ks[13], (DEPTH, N_EXPERTS, D_MODEL), PEER_HEADS ** -0.5)
    norm_final_g = 1.0 + nrm(ks[14], (D_MODEL,), 0.02)
    return {"x": x, "norm_mix_g": norm_mix_g, "w_in": w_in, "b_igate": b_igate,
            "b_fgate": b_fgate, "conv_w": conv_w, "mlstm_norm_g": mlstm_norm_g,
            "w_out": w_out, "norm_ffn_g": norm_ffn_g, "w_query": w_query,
            "sub_keys_1": sub_keys_1, "sub_keys_2": sub_keys_2, "expert_u": expert_u,
            "expert_v": expert_v, "norm_final_g": norm_final_g}


def reference(x, norm_mix_g, w_in, b_igate, b_fgate, conv_w, mlstm_norm_g, w_out,
              norm_ffn_g, w_query, sub_keys_1, sub_keys_2, expert_u, expert_v, norm_final_g):
    bsz, seq, _ = x.shape
    split_points = [D_CONV, 2 * D_CONV, 3 * D_CONV,
                    3 * D_CONV + D_MLSTM, 3 * D_CONV + 2 * D_MLSTM,
                    3 * D_CONV + 3 * D_MLSTM, 3 * D_CONV + 4 * D_MLSTM,
                    3 * D_CONV + 4 * D_MLSTM + MLSTM_HEADS]
    for layer in range(DEPTH):
        xn = rmsnorm(x, norm_mix_g[layer])
        proj = xn @ w_in[layer]
        cx, cb, cc, q, k, v, o, ig, fg = jnp.split(proj, split_points, axis=-1)
        conv_out = short_conv_mixer(cx, cb, cc, conv_w[layer])

        shp = (bsz, seq, MLSTM_HEADS, MLSTM_HEAD_DIM)
        qf = q.reshape(shp).astype(jnp.float32)
        kf = k.reshape(shp).astype(jnp.float32) * (MLSTM_HEAD_DIM ** -0.5)
        vf = v.reshape(shp).astype(jnp.float32)
        i_pre = (ig + b_igate[layer]).astype(jnp.float32)
        log_f = jax.nn.log_sigmoid((fg + b_fgate[layer]).astype(jnp.float32))
        h = mlstm_chunkwise(qf, kf, vf, i_pre, log_f)
        h = h * lax.rsqrt(jnp.mean(h * h, axis=-1, keepdims=True) + EPS)
        h = h.reshape(bsz, seq, D_MLSTM) * mlstm_norm_g[layer].astype(jnp.float32)
        mlstm_out = (jax.nn.sigmoid(o.astype(jnp.float32)) * h).astype(x.dtype)

        mix = jnp.concatenate([conv_out, mlstm_out], axis=-1) @ w_out[layer]
        x = x + mix
        xn2 = rmsnorm(x, norm_ffn_g[layer])
        x = x + peer_ffn(xn2, w_query[layer], sub_keys_1[layer], sub_keys_2[layer],
                         expert_u[layer], expert_v[layer])
    return rmsnorm(x, norm_final_g)
```

```cpp
#include <hip/hip_runtime.h>
#include <hip/hip_cooperative_groups.h>
#include <cstdio>
#include <cstdint>
namespace cg = cooperative_groups;
namespace pg8 {
#define PG8_LAS __attribute__((address_space(3)))
typedef unsigned short bf16_t;
typedef short bf16x8 __attribute__((ext_vector_type(8)));
typedef float f32x4 __attribute__((ext_vector_type(4)));
typedef unsigned u32x4 __attribute__((ext_vector_type(4)));
constexpr int BM = 256, BK = 64, HALF = 128, HTB = HALF * BK * 2  , STAGE_BYTES = 8 * HTB, NXCD = 8, WGM = 8;

__host__ __device__ __forceinline__ int lds_byte(int r, int c) { const int st = (r >> 4) * 2 + (c >> 5), rr = r & 15, cc = c & 31, ob = rr * 64 + cc * 2; return st * 1024 + (ob ^ (((ob >> 9) & 1) << 5)); }
__host__ __device__ __forceinline__ void stage_rc(int b, int& R, int& C) { const int st = b / 1024, sb = b % 1024, swz = sb ^ (((sb >> 9) & 1) << 5); R = (st >> 1) * 16 + swz / 64; C = (st & 1) * 32 + (swz % 64) / 2; }
__host__ __device__ __forceinline__ int perm32(int rho) { const int n = rho >> 4, i = rho & 15; return 8 * (i >> 2) + 4 * n + (i & 3); }

struct Unit { int pm, pn; };
struct Gemm { const bf16_t* A; const bf16_t* Bt; int M, N, K; };

struct StaticOrder {
    int nM, nN, nwg, G, c;
    __host__ __device__ void init(int M, int N, int G_, int c_) { nM = M / BM; nN = N / BM; nwg = nM * nN; G = G_; c = c_; }
    __host__ __device__ bool next(int i, Unit& u) const {
        const long L = (long)i * G + c; if (L >= nwg) return false;
        int wgid = (int)L; { const int q = nwg / NXCD, r = nwg % NXCD, xcd = wgid % NXCD, off = wgid / NXCD; wgid = (xcd < r ? xcd * (q + 1) : r * (q + 1) + (xcd - r) * q) + off; }
        const int nig = WGM * nN, gid = wgid / nig, fm = gid * WGM, gsz = (nM - fm) < WGM ? (nM - fm) : WGM;
        u.pm = fm + ((wgid % nig) % gsz); u.pn = (wgid % nig) / gsz; return true;
    }
    __device__ __forceinline__ void a_ready(const Unit&) const {}
    __device__ __forceinline__ void done(const Unit&) const {}
};

__device__ __forceinline__ unsigned cvt_pk_bf16(float lo, float hi) { unsigned r; asm volatile("v_cvt_pk_bf16_f32 %0, %1, %2" : "=v"(r) : "v"(lo), "v"(hi)); return r; }
struct EpiProj {
    static constexpr bool PERM = true, AFTER_DRAIN = false;
    bf16_t* O; int ldc; const float* rs;
    __device__ __forceinline__ void operator()(const f32x4 (&acc)[2][2][4][2], const Unit& u, int wr, int wc, int fr, int fq) const {
        const int row0 = u.pm * BM + wr * 64 + fr, col0 = u.pn * BM + wc * 32 + 8 * fq;
#pragma unroll
        for (int ai = 0; ai < 2; ++ai)
#pragma unroll
            for (int m = 0; m < 4; ++m) { const int row = row0 + ai * HALF + m * 16; const float s = rs[row]; bf16_t* rowp = O + (size_t)row * ldc + col0;
#pragma unroll
                for (int bj = 0; bj < 2; ++bj) { const f32x4 v0 = acc[ai][bj][m][0] * s, v1 = acc[ai][bj][m][1] * s; u32x4 w;
                    w.x = cvt_pk_bf16(v0[0], v0[1]); w.y = cvt_pk_bf16(v0[2], v0[3]); w.z = cvt_pk_bf16(v1[0], v1[1]); w.w = cvt_pk_bf16(v1[2], v1[3]);
                    *(u32x4*)(rowp + bj * HALF) = w; } }
    }
};
struct EpiOut {
    static constexpr bool PERM = false, AFTER_DRAIN = false;
    const float* X; float* X1; bf16_t* X1B; float* SSQ; int ldc;
    __device__ __forceinline__ void operator()(const f32x4 (&acc)[2][2][4][2], const Unit& u, int wr, int wc, int fr, int fq) const {
        typedef unsigned u32x2 __attribute__((ext_vector_type(2)));
        const int row0 = u.pm * BM + wr * 64 + fr, col0 = u.pn * BM + wc * 32 + 4 * fq;
#pragma unroll
        for (int ai = 0; ai < 2; ++ai)
#pragma unroll
            for (int m = 0; m < 4; ++m) { const int row = row0 + ai * HALF + m * 16; const size_t off = (size_t)row * ldc + col0; float ss = 0.f;
#pragma unroll
                for (int bj = 0; bj < 2; ++bj)
#pragma unroll
                    for (int n = 0; n < 2; ++n) { const size_t c = off + bj * HALF + n * 16; const f32x4 xv = *(const f32x4*)(X + c); const f32x4 o = xv + acc[ai][bj][m][n];
                        *(f32x4*)(X1 + c) = o; ss += (o[0] * o[0] + o[1] * o[1]) + (o[2] * o[2] + o[3] * o[3]);
                        u32x2 pk; pk.x = cvt_pk_bf16(o[0], o[1]); pk.y = cvt_pk_bf16(o[2], o[3]); *(u32x2*)(X1B + c) = pk; }
                ss += __shfl_xor(ss, 16); ss += __shfl_xor(ss, 32);
                if (fq == 0) SSQ[(size_t)row * 32 + u.pn * 4 + wc] = ss; }
    }
};
struct EpiQ {
    static constexpr bool PERM = false, AFTER_DRAIN = false;
    float* O; int ldc;
    __device__ __forceinline__ void operator()(const f32x4 (&acc)[2][2][4][2], const Unit& u, int wr, int wc, int fr, int fq) const {
        const int row0 = u.pm * BM + wr * 64 + fr, col0 = u.pn * BM + wc * 32 + 4 * fq;
#pragma unroll
        for (int ai = 0; ai < 2; ++ai)
#pragma unroll
            for (int m = 0; m < 4; ++m) { const size_t off = (size_t)(row0 + ai * HALF + m * 16) * ldc + col0;
#pragma unroll
                for (int bj = 0; bj < 2; ++bj)
#pragma unroll
                    for (int n = 0; n < 2; ++n) *(f32x4*)(O + off + bj * HALF + n * 16) = acc[ai][bj][m][n]; }
    }
};
template <class Epi, class Sched, bool ALIGN_EPI = false, bool SP2 = false>
__device__ __forceinline__ void gemm_phase(PG8_LAS unsigned char* lds, const Gemm g, const Sched& S, const Epi& E) {
    const int tid = threadIdx.x, wid = __builtin_amdgcn_readfirstlane(tid >> 6), lane = tid & 63, wr = wid >> 2, wc = wid & 3, fr = lane & 15, fq = lane >> 4;
    const int K = g.K, nt = K / BK;
    unsigned voffA[2], voffB[2];
#pragma unroll
    for (int i = 0; i < 2; ++i) { int R, C; stage_rc(tid * 16 + i * 8192, R, C); const int Rb = Epi::PERM ? ((R & ~31) + perm32(R & 31)) : R;
        voffA[i] = (unsigned)(R * K + C) * 2u; voffB[i] = (unsigned)(Rb * K + C) * 2u; }
    const size_t kstep = (size_t)(BK * 2);
    const size_t hstep = (size_t)HALF * K * 2;
    const size_t tstep = 2 * hstep;
    const unsigned ldsw = (unsigned)wid * 1024u;
    const int aoff = lds_byte(wr * 64 + fr, fq * 8), boff = lds_byte(wc * 32 + fr, fq * 8);
#define PG8_SA(b, h) (((b) * 2 + (h)) * HTB)
#define PG8_SB(b, h) ((4 + (b) * 2 + (h)) * HTB)
#define PG8_STAGE(bufoff, gbase, voff) do { _Pragma("unroll") for (int _i = 0; _i < 2; ++_i) \
        __builtin_amdgcn_global_load_lds((const unsigned*)((const char*)(gbase) + (voff)[_i]), (PG8_LAS unsigned*)(lds + (bufoff) + ldsw + _i * 8192), 16, 0, 0); } while (0)
#define PG8_LDA(dst, b, h) do { _Pragma("unroll") for (int m = 0; m < 4; ++m) _Pragma("unroll") for (int k = 0; k < 2; ++k) dst[m][k] = *(const PG8_LAS bf16x8*)(lds + PG8_SA(b, h) + aoff + m * 2048 + k * 1024); } while (0)
#define PG8_LDB(dst, b, h) do { _Pragma("unroll") for (int n = 0; n < 2; ++n) _Pragma("unroll") for (int k = 0; k < 2; ++k) dst[n][k] = *(const PG8_LAS bf16x8*)(lds + PG8_SB(b, h) + boff + n * 2048 + k * 1024); } while (0)
#define PG8_MMA(ai, bj, At, Bt) do { __builtin_amdgcn_s_setprio(1); _Pragma("unroll") for (int m = 0; m < 4; ++m) _Pragma("unroll") for (int n = 0; n < 2; ++n) _Pragma("unroll") for (int k = 0; k < 2; ++k) \
        acc[ai][bj][m][n] = __builtin_amdgcn_mfma_f32_16x16x32_bf16(Bt[n][k], At[m][k], acc[ai][bj][m][n], 0, 0, 0); __builtin_amdgcn_s_setprio(0); } while (0)
#define PG8_WAIT_V(n) asm volatile("s_waitcnt vmcnt(" #n ")" ::: "memory")
#define PG8_WAIT_L(n) asm volatile("s_waitcnt lgkmcnt(" #n ")" ::: "memory")
#define PG8_BAR __builtin_amdgcn_s_barrier()
#define PG8_SCHED __builtin_amdgcn_sched_barrier(0)
    Unit cur, nxt; int ui = 0;
    if (!S.next(0, cur)) return;
    f32x4 acc[2][2][4][2];
#pragma unroll
    for (int a = 0; a < 2; ++a)
#pragma unroll
        for (int b = 0; b < 2; ++b)
#pragma unroll
            for (int m = 0; m < 4; ++m)
#pragma unroll
                for (int n = 0; n < 2; ++n) acc[a][b][m][n] = (f32x4){0.f, 0.f, 0.f, 0.f};
    bf16x8 At[4][2], B0[2][2], B1[2][2];
    const char* cA = (const char*)g.A + (size_t)cur.pm * tstep; const char* cB = (const char*)g.Bt + (size_t)cur.pn * tstep;
    S.a_ready(cur);
    if constexpr (SP2) {
        PG8_STAGE(PG8_SB(0, 0), cB, voffB); PG8_STAGE(PG8_SB(0, 1), cB + hstep, voffB); PG8_STAGE(PG8_SA(0, 0), cA, voffA); PG8_STAGE(PG8_SA(0, 1), cA + hstep, voffA);
        if (wr == 1) PG8_BAR;
        PG8_WAIT_V(2); PG8_BAR;
        PG8_STAGE(PG8_SB(1, 0), cB + kstep, voffB); PG8_STAGE(PG8_SA(1, 0), cA + kstep, voffA); PG8_STAGE(PG8_SB(1, 1), cB + hstep + kstep, voffB);
        PG8_WAIT_V(6); PG8_BAR;
    } else {
        PG8_STAGE(PG8_SB(0, 0), cB, voffB); PG8_STAGE(PG8_SA(0, 0), cA, voffA); PG8_STAGE(PG8_SB(0, 1), cB + hstep, voffB); PG8_STAGE(PG8_SA(0, 1), cA + hstep, voffA);
        if (wr == 1) PG8_BAR;
        PG8_WAIT_V(4); PG8_BAR;
        PG8_STAGE(PG8_SB(1, 0), cB + kstep, voffB); PG8_STAGE(PG8_SA(1, 0), cA + kstep, voffA); PG8_STAGE(PG8_SB(1, 1), cB + hstep + kstep, voffB);
        PG8_WAIT_V(6); PG8_BAR;
    }
    for (;;) {
        const bool has_next = S.next(ui + 1, nxt);
        const char* nA = has_next ? (const char*)g.A + (size_t)nxt.pm * tstep : cA; const char* nB = has_next ? (const char*)g.Bt + (size_t)nxt.pn * tstep : cB;
        for (int t = 0; t < nt; t += 2) {
            const bool last = (t == nt - 2);
            const char* a1 = cA + (size_t)(t + 1) * kstep;
            const char* a2 = last ? nA : cA + (size_t)(t + 2) * kstep; const char* b2 = last ? nB : cB + (size_t)(t + 2) * kstep;
            const char* a3 = a2 + kstep; const char* b3 = b2 + kstep;
            if (last && has_next) S.a_ready(nxt);
            if constexpr (SP2) {
            PG8_LDB(B0, 0, 0); PG8_LDB(B1, 0, 1); PG8_SCHED; PG8_LDA(At, 0, 0); PG8_STAGE(PG8_SA(1, 1), a1 + hstep, voffA);
            PG8_WAIT_V(8); PG8_WAIT_L(0); PG8_BAR; PG8_MMA(0, 0, At, B0); PG8_MMA(0, 1, At, B1); PG8_BAR; PG8_SCHED;
            PG8_LDA(At, 0, 1); PG8_STAGE(PG8_SB(0, 0), b2, voffB); PG8_STAGE(PG8_SB(0, 1), b2 + hstep, voffB); PG8_STAGE(PG8_SA(0, 0), a2, voffA);
            PG8_WAIT_V(8); PG8_WAIT_L(0); PG8_BAR; PG8_MMA(1, 0, At, B0); PG8_MMA(1, 1, At, B1); PG8_BAR; PG8_SCHED;
            PG8_LDB(B0, 1, 0); PG8_LDB(B1, 1, 1); PG8_SCHED; PG8_LDA(At, 1, 0); PG8_STAGE(PG8_SA(0, 1), a2 + hstep, voffA);
            PG8_WAIT_V(8); PG8_WAIT_L(0); PG8_BAR; PG8_MMA(0, 0, At, B0); PG8_MMA(0, 1, At, B1); PG8_BAR; PG8_SCHED;
            PG8_LDA(At, 1, 1); PG8_STAGE(PG8_SB(1, 0), b3, voffB); PG8_STAGE(PG8_SB(1, 1), b3 + hstep, voffB); PG8_STAGE(PG8_SA(1, 0), a3, voffA);
            PG8_WAIT_V(8); PG8_WAIT_L(0); PG8_BAR; PG8_MMA(1, 0, At, B0); PG8_MMA(1, 1, At, B1); PG8_BAR; PG8_SCHED;
            } else {
            PG8_LDB(B0, 0, 0); PG8_SCHED; PG8_LDA(At, 0, 0); PG8_STAGE(PG8_SA(1, 1), a1 + hstep, voffA);
            PG8_WAIT_L(8); PG8_BAR; PG8_WAIT_L(0); PG8_MMA(0, 0, At, B0); PG8_BAR; PG8_SCHED;
            PG8_LDB(B1, 0, 1); PG8_STAGE(PG8_SB(0, 0), b2, voffB);
            PG8_BAR; PG8_WAIT_L(0); PG8_MMA(0, 1, At, B1); PG8_BAR;
            PG8_LDA(At, 0, 1); PG8_STAGE(PG8_SA(0, 0), a2, voffA);
            PG8_BAR; PG8_WAIT_L(0); PG8_MMA(1, 0, At, B0); PG8_BAR; PG8_SCHED;
            PG8_STAGE(PG8_SB(0, 1), b2 + hstep, voffB);
            PG8_WAIT_V(6); PG8_BAR; PG8_MMA(1, 1, At, B1); PG8_BAR;
            PG8_LDB(B0, 1, 0); PG8_SCHED; PG8_LDA(At, 1, 0); PG8_STAGE(PG8_SA(0, 1), a2 + hstep, voffA);
            PG8_WAIT_L(8); PG8_BAR; PG8_WAIT_L(0); PG8_MMA(0, 0, At, B0); PG8_BAR; PG8_SCHED;
            PG8_LDB(B1, 1, 1); PG8_STAGE(PG8_SB(1, 0), b3, voffB);
            PG8_BAR; PG8_WAIT_L(0); PG8_MMA(0, 1, At, B1); PG8_BAR;
            PG8_LDA(At, 1, 1); PG8_STAGE(PG8_SA(1, 0), a3, voffA);
            PG8_BAR; PG8_WAIT_L(0); PG8_MMA(1, 0, At, B0); PG8_BAR; PG8_SCHED;
            PG8_STAGE(PG8_SB(1, 1), b3 + hstep, voffB);
            PG8_WAIT_V(6); PG8_BAR; PG8_MMA(1, 1, At, B1); PG8_BAR;
            }
        }
        if constexpr (ALIGN_EPI) { if (wr == 0) PG8_BAR; }
        if constexpr (!Epi::AFTER_DRAIN) { E(acc, cur, wr, wc, fr, fq); S.done(cur); }
        if (!has_next) break;
#pragma unroll
        for (int a = 0; a < 2; ++a)
#pragma unroll
            for (int b = 0; b < 2; ++b)
#pragma unroll
                for (int m = 0; m < 4; ++m)
#pragma unroll
                    for (int n = 0; n < 2; ++n) acc[a][b][m][n] = (f32x4){0.f, 0.f, 0.f, 0.f};
        cur = nxt; cA = nA; cB = nB; ++ui;
        if constexpr (ALIGN_EPI) { if (wr == 1) PG8_BAR; }
    }
    PG8_WAIT_V(0);
    if constexpr (!ALIGN_EPI) { if (wr == 0) PG8_BAR; }
    PG8_BAR;
    if constexpr (Epi::AFTER_DRAIN) { E.fused(acc, cur, wr, wc, fr, fq, lds, wid, lane); S.done(cur); }
#undef PG8_SA
#undef PG8_SB
#undef PG8_STAGE
#undef PG8_LDA
#undef PG8_LDB
#undef PG8_MMA
#undef PG8_WAIT_V
#undef PG8_WAIT_L
#undef PG8_BAR
#undef PG8_SCHED
}
}
constexpr int T = 8192, SEQ = 4096, D = 2048, NPROJ = 7168, NIN = 7176;
constexpr int NH = 4, DH = 256, LCH = 64, DML = 1024;
constexpr int NEXP = 16384, PEER_H = 8, TOPK = 16;
constexpr float EPS = 1e-6f;
constexpr int PC_CX = 0, PC_CB = 1024, PC_CC = 2048, PC_Q = 3072, PC_K = 4096, PC_V = 5120, PC_O = 6144;
constexpr int NTHREADS = 512, NWAVES = 8;
constexpr int LDS_BYTES = 147456;

constexpr size_t MiB = 1u << 20;
constexpr size_t WS_CTL = 0, CTL_ZERO_BYTES = 64 * 1024;
constexpr size_t WS_RS1 = 1 * MiB, WS_GI = 1 * MiB + 64 * 1024, WS_GF = 1 * MiB + 256 * 1024, WS_SSQ = 3 * MiB;
constexpr size_t WS_XB = 5 * MiB, WS_WINT = 37 * MiB, WS_WOUTT = 65 * MiB, WS_WQT = 73 * MiB;
constexpr size_t WS_PROJ = 81 * MiB;
constexpr size_t WS_X1 = 81 * MiB, WS_X1B = 145 * MiB;
constexpr size_t WS_HRAW = 193 * MiB, WS_MIXIN = 225 * MiB, WS_QV = 257 * MiB, WS_IDX = 321 * MiB, WS_GATE = 325 * MiB;
constexpr size_t WS_UB = 329 * MiB, WS_VB = 393 * MiB, WS_END = 457 * MiB;

struct Params {
    const float *x, *g1, *w_in, *b_ig, *b_fg, *conv_w, *gm, *w_out, *g2, *w_q, *sk1, *sk2, *eu, *ev, *gfin;
    float* out; unsigned char* ws;
    int ph_lo, ph_hi;
};

typedef unsigned short bf16_t;
__device__ __forceinline__ unsigned f2bf(float f) { unsigned u = __float_as_uint(f); return (u + 0x7fffu + ((u >> 16) & 1u)) >> 16; }
__device__ __forceinline__ unsigned pk2(float lo, float hi) { return f2bf(lo) | (f2bf(hi) << 16); }
__device__ __forceinline__ float bflo(unsigned w) { return __uint_as_float(w << 16); }
__device__ __forceinline__ float bfhi(unsigned w) { return __uint_as_float(w & 0xffff0000u); }
__device__ __forceinline__ float bf1(bf16_t h) { return __uint_as_float((unsigned)h << 16); }
__device__ __forceinline__ float wave_sum(float v) {
#pragma unroll
    for (int o = 32; o >= 1; o >>= 1) v += __shfl_xor(v, o);
    return v;
}
__device__ __forceinline__ void unpack8(const uint4 w, float (&f)[8]) {
    f[0] = bflo(w.x); f[1] = bfhi(w.x); f[2] = bflo(w.y); f[3] = bfhi(w.y); f[4] = bflo(w.z); f[5] = bfhi(w.z); f[6] = bflo(w.w); f[7] = bfhi(w.w);
}
__device__ __forceinline__ float log_sigmoid(float z) { return z >= 0.f ? -log1pf(expf(-z)) : z - log1pf(expf(z)); }
__device__ __forceinline__ float gelu_erf(float v) { return 0.5f * v * (1.0f + erff(v * 0.70710678118654752f)); }

__device__ __forceinline__ void p0_rows(const Params& P, unsigned char* lds, int G, int bid) {
    float* wg = (float*)lds;
    const int tid = threadIdx.x, lane = tid & 63, wave = tid >> 6;
    for (int i = tid; i < 8 * D; i += NTHREADS) { const int g = i >> 11, k = i & 2047; wg[i] = P.w_in[(size_t)k * NIN + NPROJ + g] * P.g1[k]; }
    __syncthreads();
    float* rs1 = (float*)(P.ws + WS_RS1); float* gi = (float*)(P.ws + WS_GI); float* gf = (float*)(P.ws + WS_GF); bf16_t* xb = (bf16_t*)(P.ws + WS_XB);
    for (int t = bid * NWAVES + wave; t < T; t += G * NWAVES) {
        const float4* xr = (const float4*)(P.x + (size_t)t * D);
        float ss = 0.f, dg[8];
#pragma unroll
        for (int g = 0; g < 8; ++g) dg[g] = 0.f;
#pragma unroll 1
        for (int j = 0; j < 8; ++j) {
            const float4 v = xr[j * 64 + lane];
            ss += (v.x * v.x + v.y * v.y) + (v.z * v.z + v.w * v.w);
            const int k0 = (j * 64 + lane) * 4;
#pragma unroll
            for (int g = 0; g < 8; ++g) { const float4 w = *(const float4*)(wg + g * D + k0); dg[g] += (v.x * w.x + v.y * w.y) + (v.z * w.z + v.w * w.w); }
            ((uint2*)(xb + (size_t)t * D))[j * 64 + lane] = make_uint2(pk2(v.x, v.y), pk2(v.z, v.w));
        }
        ss = wave_sum(ss);
#pragma unroll
        for (int g = 0; g < 8; ++g) dg[g] = wave_sum(dg[g]);
        const float rs = rsqrtf(ss * (1.0f / D) + EPS);
        if (lane == 0) {
            rs1[t] = rs;
#pragma unroll
            for (int h = 0; h < 4; ++h) { gi[t * 4 + h] = rs * dg[h] + P.b_ig[h]; gf[t * 4 + h] = log_sigmoid(rs * dg[4 + h] + P.b_fg[h]); }
        }
    }
    __syncthreads();
}
__device__ __forceinline__ void transpose_tile(const float* W, int ldw, int K, const float* gain, bf16_t* WT, int k0, int n0, float* tile) {
    const int tid = threadIdx.x;
#pragma unroll
    for (int r = 0; r < 2; ++r) {
        const int kk = (tid >> 4) + 32 * r, n4 = (tid & 15) * 4;
        float4 v = *(const float4*)(W + (size_t)(k0 + kk) * ldw + n0 + n4);
        const float g = gain ? gain[k0 + kk] : 1.0f;
        tile[kk * 65 + n4 + 0] = v.x * g; tile[kk * 65 + n4 + 1] = v.y * g; tile[kk * 65 + n4 + 2] = v.z * g; tile[kk * 65 + n4 + 3] = v.w * g;
    }
    __syncthreads();
    { const int nn = tid >> 3, k8 = (tid & 7) * 8; float f[8];
#pragma unroll
      for (int i = 0; i < 8; ++i) f[i] = tile[(k8 + i) * 65 + nn];
      *(uint4*)(WT + (size_t)(n0 + nn) * K + k0 + k8) = make_uint4(pk2(f[0], f[1]), pk2(f[2], f[3]), pk2(f[4], f[5]), pk2(f[6], f[7])); }
    __syncthreads();
}
__device__ __forceinline__ void p0_weights(const Params& P, unsigned char* lds, int G, int bid) {
    float* tile = (float*)lds;
    constexpr int N_IN = (D / 64) * (NPROJ / 64), N_SQ = (D / 64) * (D / 64);
    for (int it = bid; it < N_IN + 2 * N_SQ; it += G) {
        if (it < N_IN) { const int kt = it / (NPROJ / 64), nt = it % (NPROJ / 64); transpose_tile(P.w_in, NIN, D, P.g1, (bf16_t*)(P.ws + WS_WINT), kt * 64, nt * 64, tile); }
        else if (it < N_IN + N_SQ) { const int j = it - N_IN, kt = j / (D / 64), nt = j % (D / 64); transpose_tile(P.w_out, D, D, nullptr, (bf16_t*)(P.ws + WS_WOUTT), kt * 64, nt * 64, tile); }
        else { const int j = it - N_IN - N_SQ, kt = j / (D / 64), nt = j % (D / 64); transpose_tile(P.w_q, D, D, P.g2, (bf16_t*)(P.ws + WS_WQT), kt * 64, nt * 64, tile); }
    }
}
__device__ __forceinline__ void p0_tables(const Params& P, int G, int bid) {
    const size_t NG = (size_t)NEXP * D / 8;
    uint4* ub = (uint4*)(P.ws + WS_UB); uint4* vb = (uint4*)(P.ws + WS_VB);
    const float4* eu = (const float4*)P.eu; const float4* ev = (const float4*)P.ev; const float4* g2 = (const float4*)P.g2;
    for (size_t i = (size_t)bid * NTHREADS + threadIdx.x; i < NG; i += (size_t)G * NTHREADS) {
        const float4 a = eu[2 * i], b = eu[2 * i + 1]; const int dq = (int)((2 * i) & 511); const float4 ga = g2[dq], gb = g2[dq + 1];
        ub[i] = make_uint4(pk2(a.x * ga.x, a.y * ga.y), pk2(a.z * ga.z, a.w * ga.w), pk2(b.x * gb.x, b.y * gb.y), pk2(b.z * gb.z, b.w * gb.w));
        const float4 c = ev[2 * i], d = ev[2 * i + 1];
        vb[i] = make_uint4(pk2(c.x, c.y), pk2(c.z, c.w), pk2(d.x, d.y), pk2(d.z, d.w));
    }
}

__device__ __forceinline__ void p2_conv(const Params& P, int nworkers, int wid) {
    const bf16_t* proj = (const bf16_t*)(P.ws + WS_PROJ); bf16_t* mix = (bf16_t*)(P.ws + WS_MIXIN);
    for (int idx = wid * NTHREADS + threadIdx.x; idx < T * 128; idx += nworkers * NTHREADS) {
        const int t = idx >> 7, c8 = (idx & 127) * 8, s = t & (SEQ - 1);
        float y[8];
#pragma unroll
        for (int i = 0; i < 8; ++i) y[i] = 0.f;
#pragma unroll
        for (int j = 0; j < 3; ++j) {
            const int dt = 2 - j;
            if (s >= dt) {
                const bf16_t* row = proj + (size_t)(t - dt) * NPROJ;
                float cx[8], cc[8]; unpack8(*(const uint4*)(row + PC_CX + c8), cx); unpack8(*(const uint4*)(row + PC_CC + c8), cc);
                const float4 w0 = *(const float4*)(P.conv_w + j * 1024 + c8), w1 = *(const float4*)(P.conv_w + j * 1024 + c8 + 4);
                y[0] += w0.x * (cc[0] * cx[0]); y[1] += w0.y * (cc[1] * cx[1]); y[2] += w0.z * (cc[2] * cx[2]); y[3] += w0.w * (cc[3] * cx[3]);
                y[4] += w1.x * (cc[4] * cx[4]); y[5] += w1.y * (cc[5] * cx[5]); y[6] += w1.z * (cc[6] * cx[6]); y[7] += w1.w * (cc[7] * cx[7]);
            }
        }
        float cb[8]; unpack8(*(const uint4*)(proj + (size_t)t * NPROJ + PC_CB + c8), cb);
        *(uint4*)(mix + (size_t)t * D + c8) = make_uint4(pk2(cb[0] * y[0], cb[1] * y[1]), pk2(cb[2] * y[2], cb[3] * y[3]), pk2(cb[4] * y[4], cb[5] * y[5]), pk2(cb[6] * y[6], cb[7] * y[7]));
    }
}
__device__ __forceinline__ void mlstm_unit(const Params& P, unsigned char* lds, int unit) {
    const int tid = threadIdx.x, lane = tid & 63, wave = tid >> 6;
    const int bh = unit >> 3, sl = unit & 7, b = bh >> 2, h = bh & 3, v0 = sl * 32;
    bf16_t* qs = (bf16_t*)lds;
    bf16_t* ks = qs + 64 * 264;
    float* vs = (float*)(lds + 2 * 64 * 264 * 2);
    float* Ss = vs + 64 * 32;
    float* Cs = Ss + 64 * 65;
    float* ns = Cs + 32 * 260;
    float* sA = ns + 256;
    float* sM = sA + 64;
    float* sEi = sM + 64;
    float* sWl = sEi + 64;
    float* sEnm = sWl + 64;
    float* sDen = sEnm + 64;
    float* sMisc = sDen + 64;
    const bf16_t* proj = (const bf16_t*)(P.ws + WS_PROJ);
    const float* gi = (const float*)(P.ws + WS_GI); const float* gf = (const float*)(P.ws + WS_GF);
    float* hraw = (float*)(P.ws + WS_HRAW);
    for (int i = tid; i < 32 * 260; i += NTHREADS) Cs[i] = 0.f;
    if (tid < 256) ns[tid] = 0.f;
    float m = 0.f;
    __syncthreads();
    for (int c = 0; c < SEQ / LCH; ++c) {
        const int t0 = b * SEQ + c * LCH;
        { const int row = tid >> 3, seg = tid & 7; const bf16_t* src = proj + (size_t)(t0 + row) * NPROJ + h * DH + seg * 32;
#pragma unroll
          for (int i = 0; i < 4; ++i) { *(uint4*)(qs + row * 264 + seg * 32 + i * 8) = *(const uint4*)(src + PC_Q + i * 8); *(uint4*)(ks + row * 264 + seg * 32 + i * 8) = *(const uint4*)(src + PC_K + i * 8); } }
        if (tid < 256) { const int row = tid >> 2, part = tid & 3; float f[8]; unpack8(*(const uint4*)(proj + (size_t)(t0 + row) * NPROJ + PC_V + h * DH + v0 + part * 8), f);
#pragma unroll
          for (int i = 0; i < 8; ++i) vs[row * 32 + part * 8 + i] = f[i]; }
        if (wave == 0) {
            const float ic = gi[(size_t)(t0 + lane) * 4 + h], fc = gf[(size_t)(t0 + lane) * 4 + h];
            float bc = fc;
#pragma unroll
            for (int o = 1; o < 64; o <<= 1) { const float tv = __shfl_up(bc, o); if (lane >= o) bc += tv; }
            const float a = ic - bc; float pm = a;
#pragma unroll
            for (int o = 1; o < 64; o <<= 1) { const float tv = __shfl_up(pm, o); if (lane >= o) pm = fmaxf(pm, tv); }
            const float M = fmaxf(m, pm), M63 = __shfl(M, 63), b63 = __shfl(bc, 63);
            sA[lane] = a; sM[lane] = M; sEi[lane] = expf(m - M); sWl[lane] = expf(a - M63) * 0.0625f; sEnm[lane] = expf(-bc - M);
            if (lane == 0) { sMisc[0] = b63 + M63; sMisc[1] = expf(m - M63); }
        }
        __syncthreads();
        { float acc[8];
#pragma unroll
          for (int jj = 0; jj < 8; ++jj) acc[jj] = 0.f;
          for (int d8 = 0; d8 < 32; ++d8) { float kf[8]; unpack8(*(const uint4*)(ks + lane * 264 + d8 * 8), kf);
#pragma unroll
              for (int jj = 0; jj < 8; ++jj) { float qf[8]; unpack8(*(const uint4*)(qs + (wave * 8 + jj) * 264 + d8 * 8), qf);
#pragma unroll
                  for (int i = 0; i < 8; ++i) acc[jj] += qf[i] * kf[i]; } }
          const float al = sA[lane];
#pragma unroll
          for (int jj = 0; jj < 8; ++jj) { const int j = wave * 8 + jj; Ss[j * 65 + lane] = (lane <= j) ? acc[jj] * 0.0625f * expf(al - sM[j]) : 0.f; } }
        __syncthreads();
        const int vv = tid & 31, jg = tid >> 5;
        float inter[4], intra[4];
#pragma unroll
        for (int jj = 0; jj < 4; ++jj) { inter[jj] = 0.f; intra[jj] = 0.f; }
        for (int d8 = 0; d8 < 32; ++d8) { const float4 c0 = *(const float4*)(Cs + vv * 260 + d8 * 8), c1 = *(const float4*)(Cs + vv * 260 + d8 * 8 + 4);
#pragma unroll
            for (int jj = 0; jj < 4; ++jj) { float qf[8]; unpack8(*(const uint4*)(qs + (jg * 4 + jj) * 264 + d8 * 8), qf);
                inter[jj] += (c0.x * qf[0] + c0.y * qf[1]) + (c0.z * qf[2] + c0.w * qf[3]) + (c1.x * qf[4] + c1.y * qf[5]) + (c1.z * qf[6] + c1.w * qf[7]); } }
        for (int l = 0; l < 64; ++l) { const float vl = vs[l * 32 + vv];
#pragma unroll
            for (int jj = 0; jj < 4; ++jj) intra[jj] += Ss[(jg * 4 + jj) * 65 + l] * vl; }
        if (wave == 0) {
            float nq = 0.f, rsum = 0.f;
            for (int d8 = 0; d8 < 32; ++d8) { float qf[8]; unpack8(*(const uint4*)(qs + lane * 264 + d8 * 8), qf);
#pragma unroll
                for (int i = 0; i < 8; ++i) nq += ns[d8 * 8 + i] * qf[i]; }
            for (int l = 0; l < 64; ++l) rsum += Ss[lane * 65 + l];
            nq = sEi[lane] * nq + rsum;
            sDen[lane] = fmaxf(fabsf(nq), sEnm[lane]);
        }
        __syncthreads();
#pragma unroll
        for (int jj = 0; jj < 4; ++jj) { const int j = jg * 4 + jj; hraw[(size_t)(t0 + j) * DML + h * DH + v0 + vv] = (sEi[j] * inter[jj] + intra[jj]) / sDen[j]; }
        { const float decay = sMisc[1]; const int d0 = jg * 16; float ca[16];
#pragma unroll
          for (int i = 0; i < 16; ++i) ca[i] = decay * Cs[vv * 260 + d0 + i];
          for (int l = 0; l < 64; ++l) { const float wv = sWl[l] * vs[l * 32 + vv]; float k0[8], k1[8]; unpack8(*(const uint4*)(ks + l * 264 + d0), k0); unpack8(*(const uint4*)(ks + l * 264 + d0 + 8), k1);
#pragma unroll
              for (int i = 0; i < 8; ++i) { ca[i] += wv * k0[i]; ca[8 + i] += wv * k1[i]; } }
#pragma unroll
          for (int i = 0; i < 16; ++i) Cs[vv * 260 + d0 + i] = ca[i];
          if (tid < 256) { float na = decay * ns[tid]; for (int l = 0; l < 64; ++l) na += sWl[l] * bf1(ks[l * 264 + tid]); ns[tid] = na; }
          m = sMisc[0]; }
        __syncthreads();
    }
}

__device__ __forceinline__ void p3_finalize(const Params& P, int G, int bid) {
    const int lane = threadIdx.x & 63, wave = threadIdx.x >> 6;
    const float* hraw = (const float*)(P.ws + WS_HRAW); const bf16_t* proj = (const bf16_t*)(P.ws + WS_PROJ); bf16_t* mix = (bf16_t*)(P.ws + WS_MIXIN);
    for (int idx = bid * NWAVES + wave; idx < T * NH; idx += G * NWAVES) {
        const int t = idx >> 2, hh = idx & 3;
        const float4 hv = *(const float4*)(hraw + (size_t)t * DML + hh * DH + lane * 4);
        const float ss = wave_sum((hv.x * hv.x + hv.y * hv.y) + (hv.z * hv.z + hv.w * hv.w));
        const float r = rsqrtf(ss * (1.0f / DH) + EPS);
        const uint2 ow = *(const uint2*)(proj + (size_t)t * NPROJ + PC_O + hh * DH + lane * 4);
        const float4 g = *(const float4*)(P.gm + hh * DH + lane * 4);
        const float o0 = 1.0f / (1.0f + expf(-bflo(ow.x))), o1 = 1.0f / (1.0f + expf(-bfhi(ow.x))), o2 = 1.0f / (1.0f + expf(-bflo(ow.y))), o3 = 1.0f / (1.0f + expf(-bfhi(ow.y)));
        *(uint2*)(mix + (size_t)t * D + DML + hh * DH + lane * 4) = make_uint2(pk2(o0 * (hv.x * r * g.x), o1 * (hv.y * r * g.y)), pk2(o2 * (hv.z * r * g.z), o3 * (hv.w * r * g.w)));
    }
}

__device__ __forceinline__ void wave_argmax(float& v, int& i) {
#pragma unroll
    for (int o = 32; o >= 1; o >>= 1) { const float ov = __shfl_xor(v, o); const int oi = __shfl_xor(i, o); if (ov > v || (ov == v && oi < i)) { v = ov; i = oi; } }
}
__device__ __forceinline__ void p6_topk(const Params& P, unsigned char* lds, int G, int bid) {
    const int tid = threadIdx.x, lane = tid & 63, wave = tid >> 6;
    float* k1t = (float*)lds;
    float* k2t = k1t + 128 * 128;
    float* qb = k2t + 128 * 128 + wave * 256;
    for (int i = tid; i < 128 * 128; i += NTHREADS) { const int n = i >> 7, d = i & 127; k1t[d * 128 + n] = P.sk1[i]; k2t[d * 128 + n] = P.sk2[i]; }
    __syncthreads();
    const float* qv = (const float*)(P.ws + WS_QV); const float* ssq = (const float*)(P.ws + WS_SSQ);
    int* idxo = (int*)(P.ws + WS_IDX); float* gato = (float*)(P.ws + WS_GATE);
    const float NEG = -3.0e38f;
    for (int it = bid * NWAVES + wave; it < T * PEER_H; it += G * NWAVES) {
        const int t = it >> 3, hh = it & 7;
        const float rs2 = rsqrtf(wave_sum(lane < 32 ? ssq[(size_t)t * 32 + lane] : 0.f) * (1.0f / D) + EPS);
        *(float4*)(qb + lane * 4) = *(const float4*)(qv + (size_t)t * D + hh * 256 + lane * 4);
        asm volatile("s_waitcnt lgkmcnt(0)" ::: "memory");
        float s1a = 0.f, s1b = 0.f, s2a = 0.f, s2b = 0.f;
        for (int d4 = 0; d4 < 32; ++d4) {
            const float4 q1 = *(const float4*)(qb + d4 * 4), q2 = *(const float4*)(qb + 128 + d4 * 4);
            const float* r1 = k1t + (d4 * 4) * 128 + lane; const float* r2 = k2t + (d4 * 4) * 128 + lane;
            s1a += q1.x * r1[0] + q1.y * r1[128] + q1.z * r1[256] + q1.w * r1[384];
            s1b += q1.x * r1[64] + q1.y * r1[192] + q1.z * r1[320] + q1.w * r1[448];
            s2a += q2.x * r2[0] + q2.y * r2[128] + q2.z * r2[256] + q2.w * r2[384];
            s2b += q2.x * r2[64] + q2.y * r2[192] + q2.z * r2[320] + q2.w * r2[448];
        }
        asm volatile("" ::: "memory");
        float myv1 = 0.f, myv2 = 0.f; int myi1 = 0, myi2 = 0;
        for (int r = 0; r < TOPK; ++r) {
            float v = s1a; int i = lane; if (s1b > v) { v = s1b; i = lane + 64; }
            wave_argmax(v, i);
            if (lane == r) { myv1 = v; myi1 = i; }
            if (i == lane) s1a = NEG; if (i == lane + 64) s1b = NEG;
        }
        for (int r = 0; r < TOPK; ++r) {
            float v = s2a; int i = lane; if (s2b > v) { v = s2b; i = lane + 64; }
            wave_argmax(v, i);
            if (lane == r) { myv2 = v; myi2 = i; }
            if (i == lane) s2a = NEG; if (i == lane + 64) s2b = NEG;
        }
        const float va = __shfl(myv1, lane >> 2);
        float cv[4];
#pragma unroll
        for (int e = 0; e < 4; ++e) cv[e] = va + __shfl(myv2, (lane & 3) * 4 + e);
        float mysc = 0.f; int myci = 0;
        for (int r = 0; r < TOPK; ++r) {
            float v = cv[0]; int i = lane * 4;
#pragma unroll
            for (int e = 1; e < 4; ++e) if (cv[e] > v) { v = cv[e]; i = lane * 4 + e; }
            wave_argmax(v, i);
            if (lane == r) { mysc = v; myci = i; }
            if ((i >> 2) == lane) {
#pragma unroll
                for (int e = 0; e < 4; ++e) if ((i & 3) == e) cv[e] = NEG;
            }
        }
        const int ea = __shfl(myi1, (myci >> 4) & 15), eb = __shfl(myi2, myci & 15);
        const float smax = __shfl(mysc, 0);
        float ex = lane < TOPK ? expf((mysc - smax) * rs2) : 0.f;
        float den = ex;
#pragma unroll
        for (int o = 8; o >= 1; o >>= 1) den += __shfl_xor(den, o);
        if (lane < TOPK) { idxo[(size_t)t * 128 + hh * 16 + lane] = ea * 128 + eb; gato[(size_t)t * 128 + hh * 16 + lane] = ex / den; }
    }
    __syncthreads();
}

__device__ __forceinline__ void p7_peer(const Params& P, int G, int bid) {
    const int lane = threadIdx.x & 63, wave = threadIdx.x >> 6;
    const bf16_t* x1b = (const bf16_t*)(P.ws + WS_X1B); const float* x1 = (const float*)(P.ws + WS_X1); const float* ssq = (const float*)(P.ws + WS_SSQ);
    const int* idxi = (const int*)(P.ws + WS_IDX); const float* gati = (const float*)(P.ws + WS_GATE);
    const bf16_t* ub = (const bf16_t*)(P.ws + WS_UB); const bf16_t* vb = (const bf16_t*)(P.ws + WS_VB);
    for (int t = bid * NWAVES + wave; t < T; t += G * NWAVES) {
        const float rs2 = rsqrtf(wave_sum(lane < 32 ? ssq[(size_t)t * 32 + lane] : 0.f) * (1.0f / D) + EPS);
        float xf[4][8];
#pragma unroll
        for (int c = 0; c < 4; ++c) unpack8(*(const uint4*)(x1b + (size_t)t * D + c * 512 + lane * 8), xf[c]);
        float y[4][8];
#pragma unroll
        for (int c = 0; c < 4; ++c)
#pragma unroll
            for (int i = 0; i < 8; ++i) y[c][i] = 0.f;
#pragma unroll 1
        for (int hh = 0; hh < PEER_H; ++hh) {
            const int myidx = lane < TOPK ? idxi[(size_t)t * 128 + hh * 16 + lane] : 0;
            const float mygate = lane < TOPK ? gati[(size_t)t * 128 + hh * 16 + lane] : 0.f;
#pragma unroll 1
            for (int g = 0; g < 4; ++g) {
                float dsum[4];
#pragma unroll
                for (int e = 0; e < 4; ++e) {
                    const int ei = __builtin_amdgcn_readlane(myidx, g * 4 + e);
                    const bf16_t* ur = ub + (size_t)ei * D + lane * 8;
                    float s = 0.f;
#pragma unroll
                    for (int c = 0; c < 4; ++c) { float uf[8]; unpack8(*(const uint4*)(ur + c * 512), uf);
#pragma unroll
                        for (int i = 0; i < 8; ++i) s += xf[c][i] * uf[i]; }
                    dsum[e] = s;
                }
#pragma unroll
                for (int e = 0; e < 4; ++e) dsum[e] = wave_sum(dsum[e]);
#pragma unroll
                for (int e = 0; e < 4; ++e) {
                    const int ei = __builtin_amdgcn_readlane(myidx, g * 4 + e);
                    const float gt = __uint_as_float(__builtin_amdgcn_readlane(__float_as_uint(mygate), g * 4 + e));
                    const float cf = gt * gelu_erf(dsum[e] * rs2);
                    const bf16_t* vr = vb + (size_t)ei * D + lane * 8;
#pragma unroll
                    for (int c = 0; c < 4; ++c) { float vf[8]; unpack8(*(const uint4*)(vr + c * 512), vf);
#pragma unroll
                        for (int i = 0; i < 8; ++i) y[c][i] += cf * vf[i]; }
                }
            }
        }
        float ss = 0.f;
#pragma unroll
        for (int c = 0; c < 4; ++c) { const float4 a = *(const float4*)(x1 + (size_t)t * D + c * 512 + lane * 8), b = *(const float4*)(x1 + (size_t)t * D + c * 512 + lane * 8 + 4);
            y[c][0] += a.x; y[c][1] += a.y; y[c][2] += a.z; y[c][3] += a.w; y[c][4] += b.x; y[c][5] += b.y; y[c][6] += b.z; y[c][7] += b.w;
#pragma unroll
            for (int i = 0; i < 8; ++i) ss += y[c][i] * y[c][i]; }
        ss = wave_sum(ss);
        const float r = rsqrtf(ss * (1.0f / D) + EPS);
#pragma unroll
        for (int c = 0; c < 4; ++c) { const float4 ga = *(const float4*)(P.gfin + c * 512 + lane * 8), gb = *(const float4*)(P.gfin + c * 512 + lane * 8 + 4);
            *(float4*)(P.out + (size_t)t * D + c * 512 + lane * 8) = make_float4(y[c][0] * r * ga.x, y[c][1] * r * ga.y, y[c][2] * r * ga.z, y[c][3] * r * ga.w);
            *(float4*)(P.out + (size_t)t * D + c * 512 + lane * 8 + 4) = make_float4(y[c][4] * r * gb.x, y[c][5] * r * gb.y, y[c][6] * r * gb.z, y[c][7] * r * gb.w); }
    }
}

constexpr int N_PHASES = 8;
#ifndef MK_N_LAUNCHES
#define MK_N_LAUNCHES 8
#endif
__global__ void __launch_bounds__(NTHREADS, 2) layer_fwd(Params P) {
    extern __shared__ __attribute__((aligned(16))) unsigned char lds[];
    cg::grid_group grid = cg::this_grid();
    const int G = gridDim.x, bid = blockIdx.x;
    const int lo = P.ph_lo, hi = P.ph_hi;
#ifndef PH_MASK
#define PH_MASK 0xff
#endif
#define IN(k) (((PH_MASK >> (k)) & 1) && lo <= (k) && (k) < hi)
#define SEAM(k) do { if (IN(k) && IN((k) + 1)) grid.sync(); } while (0)
    if (IN(0)) { p0_rows(P, lds, G, bid); p0_weights(P, lds, G, bid); p0_tables(P, G, bid); }
    SEAM(0);
    if (IN(1)) {
        pg8::Gemm g{(const pg8::bf16_t*)(P.ws + WS_XB), (const pg8::bf16_t*)(P.ws + WS_WINT), T, NPROJ, D}; pg8::StaticOrder S; S.init(T, NPROJ, G, bid);
        pg8::EpiProj E{(pg8::bf16_t*)(P.ws + WS_PROJ), NPROJ, (const float*)(P.ws + WS_RS1)};
        pg8::gemm_phase<pg8::EpiProj, pg8::StaticOrder, true, true>((PG8_LAS unsigned char*)lds, g, S, E);
    }
    SEAM(1);
    if (IN(2)) {
        for (int u = bid; u < 64; u += G) mlstm_unit(P, lds, u);
        if (G > 64) { if (bid >= 64) p2_conv(P, G - 64, bid - 64); } else p2_conv(P, G, bid);
    }
    SEAM(2);
    if (IN(3)) p3_finalize(P, G, bid);
    SEAM(3);
    if (IN(4)) {
        pg8::Gemm g{(const pg8::bf16_t*)(P.ws + WS_MIXIN), (const pg8::bf16_t*)(P.ws + WS_WOUTT), T, D, D}; pg8::StaticOrder S; S.init(T, D, G, bid);
        pg8::EpiOut E{P.x, (float*)(P.ws + WS_X1), (pg8::bf16_t*)(P.ws + WS_X1B), (float*)(P.ws + WS_SSQ), D};
        pg8::gemm_phase<pg8::EpiOut, pg8::StaticOrder, true, true>((PG8_LAS unsigned char*)lds, g, S, E);
    }
    SEAM(4);
    if (IN(5)) {
        pg8::Gemm g{(const pg8::bf16_t*)(P.ws + WS_X1B), (const pg8::bf16_t*)(P.ws + WS_WQT), T, D, D}; pg8::StaticOrder S; S.init(T, D, G, bid);
        pg8::EpiQ E{(float*)(P.ws + WS_QV), D};
        pg8::gemm_phase<pg8::EpiQ, pg8::StaticOrder, true, true>((PG8_LAS unsigned char*)lds, g, S, E);
    }
    SEAM(5);
    if (IN(6)) p6_topk(P, lds, G, bid);
    SEAM(6);
    if (IN(7)) p7_peer(P, G, bid);
#undef IN
#undef SEAM
}

extern "C" void kernel_launch(void* const* d_in, const int* in_sizes, int n_in, void* d_out, int out_size, void* d_ws, size_t ws_size, hipStream_t stream) {
    static int grid = 0;
    if (grid == 0) {
        if (n_in != 15 || in_sizes[0] != T * D || out_size != T * D || ws_size < WS_END) { fprintf(stderr, "kernel_launch: unexpected shapes (n_in %d, in0 %d, out %d, ws %zu); nothing launched\n", n_in, n_in > 0 ? in_sizes[0] : -1, out_size, ws_size); grid = -1; return; }
        int dev = 0, cus = 0, per_cu = 0;
        if (hipGetDevice(&dev) != hipSuccess || hipDeviceGetAttribute(&cus, hipDeviceAttributeMultiprocessorCount, dev) != hipSuccess) { grid = -1; return; }
        if (hipFuncSetAttribute((const void*)layer_fwd, hipFuncAttributeMaxDynamicSharedMemorySize, LDS_BYTES) != hipSuccess) { fprintf(stderr, "kernel_launch: hipFuncSetAttribute failed\n"); grid = -1; return; }
        if (hipOccupancyMaxActiveBlocksPerMultiprocessor(&per_cu, (const void*)layer_fwd, NTHREADS, LDS_BYTES) != hipSuccess || per_cu < 1) { fprintf(stderr, "kernel_launch: occupancy query says %d blocks per CU\n", per_cu); (void)hipGetLastError(); grid = -1; return; }
        grid = cus;
    }
    if (grid < 0) return;
    Params p{};
    p.x = (const float*)d_in[0]; p.g1 = (const float*)d_in[1]; p.w_in = (const float*)d_in[2]; p.b_ig = (const float*)d_in[3]; p.b_fg = (const float*)d_in[4];
    p.conv_w = (const float*)d_in[5]; p.gm = (const float*)d_in[6]; p.w_out = (const float*)d_in[7]; p.g2 = (const float*)d_in[8]; p.w_q = (const float*)d_in[9];
    p.sk1 = (const float*)d_in[10]; p.sk2 = (const float*)d_in[11]; p.eu = (const float*)d_in[12]; p.ev = (const float*)d_in[13]; p.gfin = (const float*)d_in[14];
    p.out = (float*)d_out; p.ws = (unsigned char*)d_ws;
    for (int li = 0; li < MK_N_LAUNCHES; ++li) {
        p.ph_lo = (MK_N_LAUNCHES == 1) ? 0 : li; p.ph_hi = (MK_N_LAUNCHES == 1) ? N_PHASES : li + 1;
        void* args[] = {&p};
        const hipError_t e = hipLaunchCooperativeKernel((const void*)layer_fwd, dim3(grid), dim3(NTHREADS), args, LDS_BYTES, stream);
        if (e != hipSuccess) { fprintf(stderr, "kernel_launch: cooperative launch %d failed: %s (grid %d)\n", li, hipGetErrorString(e), grid); break; }
    }
}
```

```cpp
#include <hip/hip_runtime.h>
#include <hip/hip_cooperative_groups.h>
#include <cstdio>
#include <cstdint>
namespace cg = cooperative_groups;
namespace pg8 {
#define PG8_LAS __attribute__((address_space(3)))
typedef unsigned short bf16_t;
typedef short bf16x8 __attribute__((ext_vector_type(8)));
typedef float f32x4 __attribute__((ext_vector_type(4)));
typedef unsigned u32x4 __attribute__((ext_vector_type(4)));
constexpr int BM = 256, BK = 64, HALF = 128, HTB = HALF * BK * 2  , STAGE_BYTES = 8 * HTB, NXCD = 8, WGM = 8;

__host__ __device__ __forceinline__ int lds_byte(int r, int c) { const int st = (r >> 4) * 2 + (c >> 5), rr = r & 15, cc = c & 31, ob = rr * 64 + cc * 2; return st * 1024 + (ob ^ (((ob >> 9) & 1) << 5)); }
__host__ __device__ __forceinline__ void stage_rc(int b, int& R, int& C) { const int st = b / 1024, sb = b % 1024, swz = sb ^ (((sb >> 9) & 1) << 5); R = (st >> 1) * 16 + swz / 64; C = (st & 1) * 32 + (swz % 64) / 2; }
__host__ __device__ __forceinline__ int perm32(int rho) { const int n = rho >> 4, i = rho & 15; return 8 * (i >> 2) + 4 * n + (i & 3); }

struct Unit { int pm, pn; };
struct Gemm { const bf16_t* A; const bf16_t* Bt; int M, N, K; };

struct StaticOrder {
    int nM, nN, nwg, G, c;
    __host__ __device__ void init(int M, int N, int G_, int c_) { nM = M / BM; nN = N / BM; nwg = nM * nN; G = G_; c = c_; }
    __host__ __device__ bool next(int i, Unit& u) const {
        const long L = (long)i * G + c; if (L >= nwg) return false;
        int wgid = (int)L; { const int q = nwg / NXCD, r = nwg % NXCD, xcd = wgid % NXCD, off = wgid / NXCD; wgid = (xcd < r ? xcd * (q + 1) : r * (q + 1) + (xcd - r) * q) + off; }
        const int nig = WGM * nN, gid = wgid / nig, fm = gid * WGM, gsz = (nM - fm) < WGM ? (nM - fm) : WGM;
        u.pm = fm + ((wgid % nig) % gsz); u.pn = (wgid % nig) / gsz; return true;
    }
    __device__ __forceinline__ void a_ready(const Unit&) const {}
    __device__ __forceinline__ void done(const Unit&) const {}
};

__device__ __forceinline__ unsigned cvt_pk_bf16(float lo, float hi) { unsigned r; asm volatile("v_cvt_pk_bf16_f32 %0, %1, %2" : "=v"(r) : "v"(lo), "v"(hi)); return r; }
struct EpiProj {
    static constexpr bool PERM = true, AFTER_DRAIN = false;
    bf16_t* O; int ldc; const float* rs;
    __device__ __forceinline__ void operator()(const f32x4 (&acc)[2][2][4][2], const Unit& u, int wr, int wc, int fr, int fq) const {
        const int row0 = u.pm * BM + wr * 64 + fr, col0 = u.pn * BM + wc * 32 + 8 * fq;
#pragma unroll
        for (int ai = 0; ai < 2; ++ai)
#pragma unroll
            for (int m = 0; m < 4; ++m) { const int row = row0 + ai * HALF + m * 16; const float s = rs[row]; bf16_t* rowp = O + (size_t)row * ldc + col0;
#pragma unroll
                for (int bj = 0; bj < 2; ++bj) { const f32x4 v0 = acc[ai][bj][m][0] * s, v1 = acc[ai][bj][m][1] * s; u32x4 w;
                    w.x = cvt_pk_bf16(v0[0], v0[1]); w.y = cvt_pk_bf16(v0[2], v0[3]); w.z = cvt_pk_bf16(v1[0], v1[1]); w.w = cvt_pk_bf16(v1[2], v1[3]);
                    *(u32x4*)(rowp + bj * HALF) = w; } }
    }
};
struct EpiOut {
    static constexpr bool PERM = false, AFTER_DRAIN = false;
    const float* X; float* X1; bf16_t* X1B; float* SSQ; int ldc;
    __device__ __forceinline__ void operator()(const f32x4 (&acc)[2][2][4][2], const Unit& u, int wr, int wc, int fr, int fq) const {
        typedef unsigned u32x2 __attribute__((ext_vector_type(2)));
        const int row0 = u.pm * BM + wr * 64 + fr, col0 = u.pn * BM + wc * 32 + 4 * fq;
#pragma unroll
        for (int ai = 0; ai < 2; ++ai)
#pragma unroll
            for (int m = 0; m < 4; ++m) { const int row = row0 + ai * HALF + m * 16; const size_t off = (size_t)row * ldc + col0; float ss = 0.f;
#pragma unroll
                for (int bj = 0; bj < 2; ++bj)
#pragma unroll
                    for (int n = 0; n < 2; ++n) { const size_t c = off + bj * HALF + n * 16; const f32x4 xv = *(const f32x4*)(X + c); const f32x4 o = xv + acc[ai][bj][m][n];
                        *(f32x4*)(X1 + c) = o; ss += (o[0] * o[0] + o[1] * o[1]) + (o[2] * o[2] + o[3] * o[3]);
                        u32x2 pk; pk.x = cvt_pk_bf16(o[0], o[1]); pk.y = cvt_pk_bf16(o[2], o[3]); *(u32x2*)(X1B + c) = pk; }
                ss += __shfl_xor(ss, 16); ss += __shfl_xor(ss, 32);
                if (fq == 0) SSQ[(size_t)row * 32 + u.pn * 4 + wc] = ss; }
    }
};
struct EpiQ {
    static constexpr bool PERM = false, AFTER_DRAIN = false;
    float* O; int ldc;
    __device__ __forceinline__ void operator()(const f32x4 (&acc)[2][2][4][2], const Unit& u, int wr, int wc, int fr, int fq) const {
        const int row0 = u.pm * BM + wr * 64 + fr, col0 = u.pn * BM + wc * 32 + 4 * fq;
#pragma unroll
        for (int ai = 0; ai < 2; ++ai)
#pragma unroll
            for (int m = 0; m < 4; ++m) { const size_t off = (size_t)(row0 + ai * HALF + m * 16) * ldc + col0;
#pragma unroll
                for (int bj = 0; bj < 2; ++bj)
#pragma unroll
                    for (int n = 0; n < 2; ++n) *(f32x4*)(O + off + bj * HALF + n * 16) = acc[ai][bj][m][n]; }
    }
};
template <class Epi, class Sched, bool ALIGN_EPI = false, bool SP2 = false>
__device__ __forceinline__ void gemm_phase(PG8_LAS unsigned char* lds, const Gemm g, const Sched& S, const Epi& E) {
    const int tid = threadIdx.x, wid = __builtin_amdgcn_readfirstlane(tid >> 6), lane = tid & 63, wr = wid >> 2, wc = wid & 3, fr = lane & 15, fq = lane >> 4;
    const int K = g.K, nt = K / BK;
    unsigned voffA[2], voffB[2];
#pragma unroll
    for (int i = 0; i < 2; ++i) { int R, C; stage_rc(tid * 16 + i * 8192, R, C); const int Rb = Epi::PERM ? ((R & ~31) + perm32(R & 31)) : R;
        voffA[i] = (unsigned)(R * K + C) * 2u; voffB[i] = (unsigned)(Rb * K + C) * 2u; }
    const size_t kstep = (size_t)(BK * 2);
    const size_t hstep = (size_t)HALF * K * 2;
    const size_t tstep = 2 * hstep;
    const unsigned ldsw = (unsigned)wid * 1024u;
    const int aoff = lds_byte(wr * 64 + fr, fq * 8), boff = lds_byte(wc * 32 + fr, fq * 8);
#define PG8_SA(b, h) (((b) * 2 + (h)) * HTB)
#define PG8_SB(b, h) ((4 + (b) * 2 + (h)) * HTB)
#define PG8_STAGE(bufoff, gbase, voff) do { _Pragma("unroll") for (int _i = 0; _i < 2; ++_i) \
        __builtin_amdgcn_global_load_lds((const unsigned*)((const char*)(gbase) + (voff)[_i]), (PG8_LAS unsigned*)(lds + (bufoff) + ldsw + _i * 8192), 16, 0, 0); } while (0)
#define PG8_LDA(dst, b, h) do { _Pragma("unroll") for (int m = 0; m < 4; ++m) _Pragma("unroll") for (int k = 0; k < 2; ++k) dst[m][k] = *(const PG8_LAS bf16x8*)(lds + PG8_SA(b, h) + aoff + m * 2048 + k * 1024); } while (0)
#define PG8_LDB(dst, b, h) do { _Pragma("unroll") for (int n = 0; n < 2; ++n) _Pragma("unroll") for (int k = 0; k < 2; ++k) dst[n][k] = *(const PG8_LAS bf16x8*)(lds + PG8_SB(b, h) + boff + n * 2048 + k * 1024); } while (0)
#define PG8_MMA(ai, bj, At, Bt) do { __builtin_amdgcn_s_setprio(1); _Pragma("unroll") for (int m = 0; m < 4; ++m) _Pragma("unroll") for (int n = 0; n < 2; ++n) _Pragma("unroll") for (int k = 0; k < 2; ++k) \
        acc[ai][bj][m][n] = __builtin_amdgcn_mfma_f32_16x16x32_bf16(Bt[n][k], At[m][k], acc[ai][bj][m][n], 0, 0, 0); __builtin_amdgcn_s_setprio(0); } while (0)
#define PG8_WAIT_V(n) asm volatile("s_waitcnt vmcnt(" #n ")" ::: "memory")
#define PG8_WAIT_L(n) asm volatile("s_waitcnt lgkmcnt(" #n ")" ::: "memory")
#define PG8_BAR __builtin_amdgcn_s_barrier()
#define PG8_SCHED __builtin_amdgcn_sched_barrier(0)
    Unit cur, nxt; int ui = 0;
    if (!S.next(0, cur)) return;
    f32x4 acc[2][2][4][2];
#pragma unroll
    for (int a = 0; a < 2; ++a)
#pragma unroll
        for (int b = 0; b < 2; ++b)
#pragma unroll
            for (int m = 0; m < 4; ++m)
#pragma unroll
                for (int n = 0; n < 2; ++n) acc[a][b][m][n] = (f32x4){0.f, 0.f, 0.f, 0.f};
    bf16x8 At[4][2], B0[2][2], B1[2][2];
    const char* cA = (const char*)g.A + (size_t)cur.pm * tstep; const char* cB = (const char*)g.Bt + (size_t)cur.pn * tstep;
    S.a_ready(cur);
    if constexpr (SP2) {
        PG8_STAGE(PG8_SB(0, 0), cB, voffB); PG8_STAGE(PG8_SB(0, 1), cB + hstep, voffB); PG8_STAGE(PG8_SA(0, 0), cA, voffA); PG8_STAGE(PG8_SA(0, 1), cA + hstep, voffA);
        if (wr == 1) PG8_BAR;
        PG8_WAIT_V(2); PG8_BAR;
        PG8_STAGE(PG8_SB(1, 0), cB + kstep, voffB); PG8_STAGE(PG8_SA(1, 0), cA + kstep, voffA); PG8_STAGE(PG8_SB(1, 1), cB + hstep + kstep, voffB);
        PG8_WAIT_V(6); PG8_BAR;
    } else {
        PG8_STAGE(PG8_SB(0, 0), cB, voffB); PG8_STAGE(PG8_SA(0, 0), cA, voffA); PG8_STAGE(PG8_SB(0, 1), cB + hstep, voffB); PG8_STAGE(PG8_SA(0, 1), cA + hstep, voffA);
        if (wr == 1) PG8_BAR;
        PG8_WAIT_V(4); PG8_BAR;
        PG8_STAGE(PG8_SB(1, 0), cB + kstep, voffB); PG8_STAGE(PG8_SA(1, 0), cA + kstep, voffA); PG8_STAGE(PG8_SB(1, 1), cB + hstep + kstep, voffB);
        PG8_WAIT_V(6); PG8_BAR;
    }
    for (;;) {
        const bool has_next = S.next(ui + 1, nxt);
        const char* nA = has_next ? (const char*)g.A + (size_t)nxt.pm * tstep : cA; const char* nB = has_next ? (const char*)g.Bt + (size_t)nxt.pn * tstep : cB;
        for (int t = 0; t < nt; t += 2) {
            const bool last = (t == nt - 2);
            const char* a1 = cA + (size_t)(t + 1) * kstep;
            const char* a2 = last ? nA : cA + (size_t)(t + 2) * kstep; const char* b2 = last ? nB : cB + (size_t)(t + 2) * kstep;
            const char* a3 = a2 + kstep; const char* b3 = b2 + kstep;
            if (last && has_next) S.a_ready(nxt);
            if constexpr (SP2) {
            PG8_LDB(B0, 0, 0); PG8_LDB(B1, 0, 1); PG8_SCHED; PG8_LDA(At, 0, 0); PG8_STAGE(PG8_SA(1, 1), a1 + hstep, voffA);
            PG8_WAIT_V(8); PG8_WAIT_L(0); PG8_BAR; PG8_MMA(0, 0, At, B0); PG8_MMA(0, 1, At, B1); PG8_BAR; PG8_SCHED;
            PG8_LDA(At, 0, 1); PG8_STAGE(PG8_SB(0, 0), b2, voffB); PG8_STAGE(PG8_SB(0, 1), b2 + hstep, voffB); PG8_STAGE(PG8_SA(0, 0), a2, voffA);
            PG8_WAIT_V(8); PG8_WAIT_L(0); PG8_BAR; PG8_MMA(1, 0, At, B0); PG8_MMA(1, 1, At, B1); PG8_BAR; PG8_SCHED;
            PG8_LDB(B0, 1, 0); PG8_LDB(B1, 1, 1); PG8_SCHED; PG8_LDA(At, 1, 0); PG8_STAGE(PG8_SA(0, 1), a2 + hstep, voffA);
            PG8_WAIT_V(8); PG8_WAIT_L(0); PG8_BAR; PG8_MMA(0, 0, At, B0); PG8_MMA(0, 1, At, B1); PG8_BAR; PG8_SCHED;
            PG8_LDA(At, 1, 1); PG8_STAGE(PG8_SB(1, 0), b3, voffB); PG8_STAGE(PG8_SB(1, 1), b3 + hstep, voffB); PG8_STAGE(PG8_SA(1, 0), a3, voffA);
            PG8_WAIT_V(8); PG8_WAIT_L(0); PG8_BAR; PG8_MMA(1, 0, At, B0); PG8_MMA(1, 1, At, B1); PG8_BAR; PG8_SCHED;
            } else {
            PG8_LDB(B0, 0, 0); PG8_SCHED; PG8_LDA(At, 0, 0); PG8_STAGE(PG8_SA(1, 1), a1 + hstep, voffA);
            PG8_WAIT_L(8); PG8_BAR; PG8_WAIT_L(0); PG8_MMA(0, 0, At, B0); PG8_BAR; PG8_SCHED;
            PG8_LDB(B1, 0, 1); PG8_STAGE(PG8_SB(0, 0), b2, voffB);
            PG8_BAR; PG8_WAIT_L(0); PG8_MMA(0, 1, At, B1); PG8_BAR;
            PG8_LDA(At, 0, 1); PG8_STAGE(PG8_SA(0, 0), a2, voffA);
            PG8_BAR; PG8_WAIT_L(0); PG8_MMA(1, 0, At, B0); PG8_BAR; PG8_SCHED;
            PG8_STAGE(PG8_SB(0, 1), b2 + hstep, voffB);
            PG8_WAIT_V(6); PG8_BAR; PG8_MMA(1, 1, At, B1); PG8_BAR;
            PG8_LDB(B0, 1, 0); PG8_SCHED; PG8_LDA(At, 1, 0); PG8_STAGE(PG8_SA(0, 1), a2 + hstep, voffA);
            PG8_WAIT_L(8); PG8_BAR; PG8_WAIT_L(0); PG8_MMA(0, 0, At, B0); PG8_BAR; PG8_SCHED;
            PG8_LDB(B1, 1, 1); PG8_STAGE(PG8_SB(1, 0), b3, voffB);
            PG8_BAR; PG8_WAIT_L(0); PG8_MMA(0, 1, At, B1); PG8_BAR;
            PG8_LDA(At, 1, 1); PG8_STAGE(PG8_SA(1, 0), a3, voffA);
            PG8_BAR; PG8_WAIT_L(0); PG8_MMA(1, 0, At, B0); PG8_BAR; PG8_SCHED;
            PG8_STAGE(PG8_SB(1, 1), b3 + hstep, voffB);
            PG8_WAIT_V(6); PG8_BAR; PG8_MMA(1, 1, At, B1); PG8_BAR;
            }
        }
        if constexpr (ALIGN_EPI) { if (wr == 0) PG8_BAR; }
        if constexpr (!Epi::AFTER_DRAIN) { E(acc, cur, wr, wc, fr, fq); S.done(cur); }
        if (!has_next) break;
#pragma unroll
        for (int a = 0; a < 2; ++a)
#pragma unroll
            for (int b = 0; b < 2; ++b)
#pragma unroll
                for (int m = 0; m < 4; ++m)
#pragma unroll
                    for (int n = 0; n < 2; ++n) acc[a][b][m][n] = (f32x4){0.f, 0.f, 0.f, 0.f};
        cur = nxt; cA = nA; cB = nB; ++ui;
        if constexpr (ALIGN_EPI) { if (wr == 1) PG8_BAR; }
    }
    PG8_WAIT_V(0);
    if constexpr (!ALIGN_EPI) { if (wr == 0) PG8_BAR; }
    PG8_BAR;
    if constexpr (Epi::AFTER_DRAIN) { E.fused(acc, cur, wr, wc, fr, fq, lds, wid, lane); S.done(cur); }
#undef PG8_SA
#undef PG8_SB
#undef PG8_STAGE
#undef PG8_LDA
#undef PG8_LDB
#undef PG8_MMA
#undef PG8_WAIT_V
#undef PG8_WAIT_L
#undef PG8_BAR
#undef PG8_SCHED
}
}
constexpr int T = 8192, SEQ = 4096, D = 2048, NPROJ = 7168, NIN = 7176;
constexpr int NH = 4, DH = 256, LCH = 64, DML = 1024;
constexpr int NEXP = 16384, PEER_H = 8, TOPK = 16;
constexpr float EPS = 1e-6f;
constexpr int PC_CX = 0, PC_CB = 1024, PC_CC = 2048, PC_Q = 3072, PC_K = 4096, PC_V = 5120, PC_O = 6144;
constexpr int NTHREADS = 512, NWAVES = 8;
constexpr int LDS_BYTES = 147456;

constexpr size_t MiB = 1u << 20;
constexpr size_t WS_CTL = 0, CTL_ZERO_BYTES = 64 * 1024;
constexpr size_t WS_RS1 = 1 * MiB, WS_GI = 1 * MiB + 64 * 1024, WS_GF = 1 * MiB + 256 * 1024, WS_SSQ = 3 * MiB;
constexpr size_t WS_XB = 5 * MiB, WS_WINT = 37 * MiB, WS_WOUTT = 65 * MiB, WS_WQT = 73 * MiB;
constexpr size_t WS_PROJ = 81 * MiB;
constexpr size_t WS_X1 = 81 * MiB, WS_X1B = 145 * MiB;
constexpr size_t WS_HRAW = 193 * MiB, WS_MIXIN = 225 * MiB, WS_QV = 257 * MiB, WS_IDX = 321 * MiB, WS_GATE = 325 * MiB;
constexpr size_t WS_UB = 329 * MiB, WS_VB = 393 * MiB, WS_END = 457 * MiB;

struct Params {
    const float *x, *g1, *w_in, *b_ig, *b_fg, *conv_w, *gm, *w_out, *g2, *w_q, *sk1, *sk2, *eu, *ev, *gfin;
    float* out; unsigned char* ws;
    int ph_lo, ph_hi;
};

typedef unsigned short bf16_t;
__device__ __forceinline__ unsigned f2bf(float f) { unsigned u = __float_as_uint(f); return (u + 0x7fffu + ((u >> 16) & 1u)) >> 16; }
__device__ __forceinline__ unsigned pk2(float lo, float hi) { return f2bf(lo) | (f2bf(hi) << 16); }
__device__ __forceinline__ float bflo(unsigned w) { return __uint_as_float(w << 16); }
__device__ __forceinline__ float bfhi(unsigned w) { return __uint_as_float(w & 0xffff0000u); }
__device__ __forceinline__ float bf1(bf16_t h) { return __uint_as_float((unsigned)h << 16); }
__device__ __forceinline__ float wave_sum(float v) {
#pragma unroll
    for (int o = 32; o >= 1; o >>= 1) v += __shfl_xor(v, o);
    return v;
}
__device__ __forceinline__ void unpack8(const uint4 w, float (&f)[8]) {
    f[0] = bflo(w.x); f[1] = bfhi(w.x); f[2] = bflo(w.y); f[3] = bfhi(w.y); f[4] = bflo(w.z); f[5] = bfhi(w.z); f[6] = bflo(w.w); f[7] = bfhi(w.w);
}
__device__ __forceinline__ float log_sigmoid(float z) { return z >= 0.f ? -log1pf(expf(-z)) : z - log1pf(expf(z)); }
__device__ __forceinline__ float gelu_erf(float v) { return 0.5f * v * (1.0f + erff(v * 0.70710678118654752f)); }

__device__ __forceinline__ void p0_rows(const Params& P, unsigned char* lds, int G, int bid) {
    float* wg = (float*)lds;
    const int tid = threadIdx.x, lane = tid & 63, wave = tid >> 6;
    for (int i = tid; i < 8 * D; i += NTHREADS) { const int g = i >> 11, k = i & 2047; wg[i] = P.w_in[(size_t)k * NIN + NPROJ + g] * P.g1[k]; }
    __syncthreads();
    float* rs1 = (float*)(P.ws + WS_RS1); float* gi = (float*)(P.ws + WS_GI); float* gf = (float*)(P.ws + WS_GF); bf16_t* xb = (bf16_t*)(P.ws + WS_XB);
    for (int t = bid * NWAVES + wave; t < T; t += G * NWAVES) {
        const float4* xr = (const float4*)(P.x + (size_t)t * D);
        float ss = 0.f, dg[8];
#pragma unroll
        for (int g = 0; g < 8; ++g) dg[g] = 0.f;
#pragma unroll 1
        for (int j = 0; j < 8; ++j) {
            const float4 v = xr[j * 64 + lane];
            ss += (v.x * v.x + v.y * v.y) + (v.z * v.z + v.w * v.w);
            const int k0 = (j * 64 + lane) * 4;
#pragma unroll
            for (int g = 0; g < 8; ++g) { const float4 w = *(const float4*)(wg + g * D + k0); dg[g] += (v.x * w.x + v.y * w.y) + (v.z * w.z + v.w * w.w); }
            ((uint2*)(xb + (size_t)t * D))[j * 64 + lane] = make_uint2(pk2(v.x, v.y), pk2(v.z, v.w));
        }
        ss = wave_sum(ss);
#pragma unroll
        for (int g = 0; g < 8; ++g) dg[g] = wave_sum(dg[g]);
        const float rs = rsqrtf(ss * (1.0f / D) + EPS);
        if (lane == 0) {
            rs1[t] = rs;
#pragma unroll
            for (int h = 0; h < 4; ++h) { gi[t * 4 + h] = rs * dg[h] + P.b_ig[h]; gf[t * 4 + h] = log_sigmoid(rs * dg[4 + h] + P.b_fg[h]); }
        }
    }
    __syncthreads();
}
__device__ __forceinline__ void transpose_tile(const float* W, int ldw, int K, const float* gain, bf16_t* WT, int k0, int n0, float* tile) {
    const int tid = threadIdx.x;
#pragma unroll
    for (int r = 0; r < 2; ++r) {
        const int kk = (tid >> 4) + 32 * r, n4 = (tid & 15) * 4;
        float4 v = *(const float4*)(W + (size_t)(k0 + kk) * ldw + n0 + n4);
        const float g = gain ? gain[k0 + kk] : 1.0f;
        tile[kk * 65 + n4 + 0] = v.x * g; tile[kk * 65 + n4 + 1] = v.y * g; tile[kk * 65 + n4 + 2] = v.z * g; tile[kk * 65 + n4 + 3] = v.w * g;
    }
    __syncthreads();
    { const int nn = tid >> 3, k8 = (tid & 7) * 8; float f[8];
#pragma unroll
      for (int i = 0; i < 8; ++i) f[i] = tile[(k8 + i) * 65 + nn];
      *(uint4*)(WT + (size_t)(n0 + nn) * K + k0 + k8) = make_uint4(pk2(f[0], f[1]), pk2(f[2], f[3]), pk2(f[4], f[5]), pk2(f[6], f[7])); }
    __syncthreads();
}
__device__ __forceinline__ void p0_weights(const Params& P, unsigned char* lds, int G, int bid) {
    float* tile = (float*)lds;
    constexpr int N_IN = (D / 64) * (NPROJ / 64), N_SQ = (D / 64) * (D / 64);
    for (int it = bid; it < N_IN + 2 * N_SQ; it += G) {
        if (it < N_IN) { const int kt = it / (NPROJ / 64), nt = it % (NPROJ / 64); transpose_tile(P.w_in, NIN, D, P.g1, (bf16_t*)(P.ws + WS_WINT), kt * 64, nt * 64, tile); }
        else if (it < N_IN + N_SQ) { const int j = it - N_IN, kt = j / (D / 64), nt = j % (D / 64); transpose_tile(P.w_out, D, D, nullptr, (bf16_t*)(P.ws + WS_WOUTT), kt * 64, nt * 64, tile); }
        else { const int j = it - N_IN - N_SQ, kt = j / (D / 64), nt = j % (D / 64); transpose_tile(P.w_q, D, D, P.g2, (bf16_t*)(P.ws + WS_WQT), kt * 64, nt * 64, tile); }
    }
}
__device__ __forceinline__ void p0_tables(const Params& P, int G, int bid) {
    const size_t NG = (size_t)NEXP * D / 8;
    uint4* ub = (uint4*)(P.ws + WS_UB); uint4* vb = (uint4*)(P.ws + WS_VB);
    const float4* eu = (const float4*)P.eu; const float4* ev = (const float4*)P.ev; const float4* g2 = (const float4*)P.g2;
    for (size_t i = (size_t)bid * NTHREADS + threadIdx.x; i < NG; i += (size_t)G * NTHREADS) {
        const float4 a = eu[2 * i], b = eu[2 * i + 1]; const int dq = (int)((2 * i) & 511); const float4 ga = g2[dq], gb = g2[dq + 1];
        ub[i] = make_uint4(pk2(a.x * ga.x, a.y * ga.y), pk2(a.z * ga.z, a.w * ga.w), pk2(b.x * gb.x, b.y * gb.y), pk2(b.z * gb.z, b.w * gb.w));
        const float4 c = ev[2 * i], d = ev[2 * i + 1];
        vb[i] = make_uint4(pk2(c.x, c.y), pk2(c.z, c.w), pk2(d.x, d.y), pk2(d.z, d.w));
    }
}

__device__ __forceinline__ void p2_conv(const Params& P, int nworkers, int wid) {
    const bf16_t* proj = (const bf16_t*)(P.ws + WS_PROJ); bf16_t* mix = (bf16_t*)(P.ws + WS_MIXIN);
    for (int idx = wid * NTHREADS + threadIdx.x; idx < T * 128; idx += nworkers * NTHREADS) {
        const int t = idx >> 7, c8 = (idx & 127) * 8, s = t & (SEQ - 1);
        float y[8];
#pragma unroll
        for (int i = 0; i < 8; ++i) y[i] = 0.f;
#pragma unroll
        for (int j = 0; j < 3; ++j) {
            const int dt = 2 - j;
            if (s >= dt) {
                const bf16_t* row = proj + (size_t)(t - dt) * NPROJ;
                float cx[8], cc[8]; unpack8(*(const uint4*)(row + PC_CX + c8), cx); unpack8(*(const uint4*)(row + PC_CC + c8), cc);
                const float4 w0 = *(const float4*)(P.conv_w + j * 1024 + c8), w1 = *(const float4*)(P.conv_w + j * 1024 + c8 + 4);
                y[0] += w0.x * (cc[0] * cx[0]); y[1] += w0.y * (cc[1] * cx[1]); y[2] += w0.z * (cc[2] * cx[2]); y[3] += w0.w * (cc[3] * cx[3]);
                y[4] += w1.x * (cc[4] * cx[4]); y[5] += w1.y * (cc[5] * cx[5]); y[6] += w1.z * (cc[6] * cx[6]); y[7] += w1.w * (cc[7] * cx[7]);
            }
        }
        float cb[8]; unpack8(*(const uint4*)(proj + (size_t)t * NPROJ + PC_CB + c8), cb);
        *(uint4*)(mix + (size_t)t * D + c8) = make_uint4(pk2(cb[0] * y[0], cb[1] * y[1]), pk2(cb[2] * y[2], cb[3] * y[3]), pk2(cb[4] * y[4], cb[5] * y[5]), pk2(cb[6] * y[6], cb[7] * y[7]));
    }
}
__device__ __forceinline__ void mlstm_unit(const Params& P, unsigned char* lds, int unit) {
    const int tid = threadIdx.x, lane = tid & 63, wave = tid >> 6;
    const int bh = unit >> 3, sl = unit & 7, b = bh >> 2, h = bh & 3, v0 = sl * 32;
    bf16_t* qs = (bf16_t*)lds;
    bf16_t* ks = qs + 64 * 264;
    float* vs = (float*)(lds + 2 * 64 * 264 * 2);
    float* Ss = vs + 64 * 32;
    float* Cs = Ss + 64 * 65;
    float* ns = Cs + 32 * 260;
    float* sA = ns + 256;
    float* sM = sA + 64;
    float* sEi = sM + 64;
    float* sWl = sEi + 64;
    float* sEnm = sWl + 64;
    float* sDen = sEnm + 64;
    float* sMisc = sDen + 64;
    const bf16_t* proj = (const bf16_t*)(P.ws + WS_PROJ);
    const float* gi = (const float*)(P.ws + WS_GI); const float* gf = (const float*)(P.ws + WS_GF);
    float* hraw = (float*)(P.ws + WS_HRAW);
    for (int i = tid; i < 32 * 260; i += NTHREADS) Cs[i] = 0.f;
    if (tid < 256) ns[tid] = 0.f;
    float m = 0.f;
    __syncthreads();
    for (int c = 0; c < SEQ / LCH; ++c) {
        const int t0 = b * SEQ + c * LCH;
        { const int row = tid >> 3, seg = tid & 7; const bf16_t* src = proj + (size_t)(t0 + row) * NPROJ + h * DH + seg * 32;
#pragma unroll
          for (int i = 0; i < 4; ++i) { *(uint4*)(qs + row * 264 + seg * 32 + i * 8) = *(const uint4*)(src + PC_Q + i * 8); *(uint4*)(ks + row * 264 + seg * 32 + i * 8) = *(const uint4*)(src + PC_K + i * 8); } }
        if (tid < 256) { const int row = tid >> 2, part = tid & 3; float f[8]; unpack8(*(const uint4*)(proj + (size_t)(t0 + row) * NPROJ + PC_V + h * DH + v0 + part * 8), f);
#pragma unroll
          for (int i = 0; i < 8; ++i) vs[row * 32 + part * 8 + i] = f[i]; }
        if (wave == 0) {
            const float ic = gi[(size_t)(t0 + lane) * 4 + h], fc = gf[(size_t)(t0 + lane) * 4 + h];
            float bc = fc;
#pragma unroll
            for (int o = 1; o < 64; o <<= 1) { const float tv = __shfl_up(bc, o); if (lane >= o) bc += tv; }
            const float a = ic - bc; float pm = a;
#pragma unroll
            for (int o = 1; o < 64; o <<= 1) { const float tv = __shfl_up(pm, o); if (lane >= o) pm = fmaxf(pm, tv); }
            const float M = fmaxf(m, pm), M63 = __shfl(M, 63), b63 = __shfl(bc, 63);
            sA[lane] = a; sM[lane] = M; sEi[lane] = expf(m - M); sWl[lane] = expf(a - M63) * 0.0625f; sEnm[lane] = expf(-bc - M);
            if (lane == 0) { sMisc[0] = b63 + M63; sMisc[1] = expf(m - M63); }
        }
        __syncthreads();
        { float acc[8];
#pragma unroll
          for (int jj = 0; jj < 8; ++jj) acc[jj] = 0.f;
          for (int d8 = 0; d8 < 32; ++d8) { float kf[8]; unpack8(*(const uint4*)(ks + lane * 264 + d8 * 8), kf);
#pragma unroll
              for (int jj = 0; jj < 8; ++jj) { float qf[8]; unpack8(*(const uint4*)(qs + (wave * 8 + jj) * 264 + d8 * 8), qf);
#pragma unroll
                  for (int i = 0; i < 8; ++i) acc[jj] += qf[i] * kf[i]; } }
          const float al = sA[lane];
#pragma unroll
          for (int jj = 0; jj < 8; ++jj) { const int j = wave * 8 + jj; Ss[j * 65 + lane] = (lane <= j) ? acc[jj] * 0.0625f * expf(al - sM[j]) : 0.f; } }
        __syncthreads();
        const int vv = tid & 31, jg = tid >> 5;
        float inter[4], intra[4];
#pragma unroll
        for (int jj = 0; jj < 4; ++jj) { inter[jj] = 0.f; intra[jj] = 0.f; }
        for (int d8 = 0; d8 < 32; ++d8) { const float4 c0 = *(const float4*)(Cs + vv * 260 + d8 * 8), c1 = *(const float4*)(Cs + vv * 260 + d8 * 8 + 4);
#pragma unroll
            for (int jj = 0; jj < 4; ++jj) { float qf[8]; unpack8(*(const uint4*)(qs + (jg * 4 + jj) * 264 + d8 * 8), qf);
                inter[jj] += (c0.x * qf[0] + c0.y * qf[1]) + (c0.z * qf[2] + c0.w * qf[3]) + (c1.x * qf[4] + c1.y * qf[5]) + (c1.z * qf[6] + c1.w * qf[7]); } }
        for (int l = 0; l < 64; ++l) { const float vl = vs[l * 32 + vv];
#pragma unroll
            for (int jj = 0; jj < 4; ++jj) intra[jj] += Ss[(jg * 4 + jj) * 65 + l] * vl; }
        if (wave == 0) {
            float nq = 0.f, rsum = 0.f;
            for (int d8 = 0; d8 < 32; ++d8) { float qf[8]; unpack8(*(const uint4*)(qs + lane * 264 + d8 * 8), qf);
#pragma unroll
                for (int i = 0; i < 8; ++i) nq += ns[d8 * 8 + i] * qf[i]; }
            for (int l = 0; l < 64; ++l) rsum += Ss[lane * 65 + l];
            nq = sEi[lane] * nq + rsum;
            sDen[lane] = fmaxf(fabsf(nq), sEnm[lane]);
        }
        __syncthreads();
#pragma unroll
        for (int jj = 0; jj < 4; ++jj) { const int j = jg * 4 + jj; hraw[(size_t)(t0 + j) * DML + h * DH + v0 + vv] = (sEi[j] * inter[jj] + intra[jj]) / sDen[j]; }
        { const float decay = sMisc[1]; const int d0 = jg * 16; float ca[16];
#pragma unroll
          for (int i = 0; i < 16; ++i) ca[i] = decay * Cs[vv * 260 + d0 + i];
          for (int l = 0; l < 64; ++l) { const float wv = sWl[l] * vs[l * 32 + vv]; float k0[8], k1[8]; unpack8(*(const uint4*)(ks + l * 264 + d0), k0); unpack8(*(const uint4*)(ks + l * 264 + d0 + 8), k1);
#pragma unroll
              for (int i = 0; i < 8; ++i) { ca[i] += wv * k0[i]; ca[8 + i] += wv * k1[i]; } }
#pragma unroll
          for (int i = 0; i < 16; ++i) Cs[vv * 260 + d0 + i] = ca[i];
          if (tid < 256) { float na = decay * ns[tid]; for (int l = 0; l < 64; ++l) na += sWl[l] * bf1(ks[l * 264 + tid]); ns[tid] = na; }
          m = sMisc[0]; }
        __syncthreads();
    }
}

__device__ __forceinline__ void p3_finalize(const Params& P, int G, int bid) {
    const int lane = threadIdx.x & 63, wave = threadIdx.x >> 6;
    const float* hraw = (const float*)(P.ws + WS_HRAW); const bf16_t* proj = (const bf16_t*)(P.ws + WS_PROJ); bf16_t* mix = (bf16_t*)(P.ws + WS_MIXIN);
    for (int idx = bid * NWAVES + wave; idx < T * NH; idx += G * NWAVES) {
        const int t = idx >> 2, hh = idx & 3;
        const float4 hv = *(const float4*)(hraw + (size_t)t * DML + hh * DH + lane * 4);
        const float ss = wave_sum((hv.x * hv.x + hv.y * hv.y) + (hv.z * hv.z + hv.w * hv.w));
        const float r = rsqrtf(ss * (1.0f / DH) + EPS);
        const uint2 ow = *(const uint2*)(proj + (size_t)t * NPROJ + PC_O + hh * DH + lane * 4);
        const float4 g = *(const float4*)(P.gm + hh * DH + lane * 4);
        const float o0 = 1.0f / (1.0f + expf(-bflo(ow.x))), o1 = 1.0f / (1.0f + expf(-bfhi(ow.x))), o2 = 1.0f / (1.0f + expf(-bflo(ow.y))), o3 = 1.0f / (1.0f + expf(-bfhi(ow.y)));
        *(uint2*)(mix + (size_t)t * D + DML + hh * DH + lane * 4) = make_uint2(pk2(o0 * (hv.x * r * g.x), o1 * (hv.y * r * g.y)), pk2(o2 * (hv.z * r * g.z), o3 * (hv.w * r * g.w)));
    }
}

__device__ __forceinline__ void wave_argmax(float& v, int& i) {
#pragma unroll
    for (int o = 32; o >= 1; o >>= 1) { const float ov = __shfl_xor(v, o); const int oi = __shfl_xor(i, o); if (ov > v || (ov == v && oi < i)) { v = ov; i = oi; } }
}
__device__ __forceinline__ void p6_topk(const Params& P, unsigned char* lds, int G, int bid) {
    const int tid = threadIdx.x, lane = tid & 63, wave = tid >> 6;
    float* k1t = (float*)lds;
    float* k2t = k1t + 128 * 128;
    float* qb = k2t + 128 * 128 + wave * 256;
    for (int i = tid; i < 128 * 128; i += NTHREADS) { const int n = i >> 7, d = i & 127; k1t[d * 128 + n] = P.sk1[i]; k2t[d * 128 + n] = P.sk2[i]; }
    __syncthreads();
    const float* qv = (const float*)(P.ws + WS_QV); const float* ssq = (const float*)(P.ws + WS_SSQ);
    int* idxo = (int*)(P.ws + WS_IDX); float* gato = (float*)(P.ws + WS_GATE);
    const float NEG = -3.0e38f;
    for (int it = bid * NWAVES + wave; it < T * PEER_H; it += G * NWAVES) {
        const int t = it >> 3, hh = it & 7;
        const float rs2 = rsqrtf(wave_sum(lane < 32 ? ssq[(size_t)t * 32 + lane] : 0.f) * (1.0f / D) + EPS);
        *(float4*)(qb + lane * 4) = *(const float4*)(qv + (size_t)t * D + hh * 256 + lane * 4);
        asm volatile("s_waitcnt lgkmcnt(0)" ::: "memory");
        float s1a = 0.f, s1b = 0.f, s2a = 0.f, s2b = 0.f;
        for (int d4 = 0; d4 < 32; ++d4) {
            const float4 q1 = *(const float4*)(qb + d4 * 4), q2 = *(const float4*)(qb + 128 + d4 * 4);
            const float* r1 = k1t + (d4 * 4) * 128 + lane; const float* r2 = k2t + (d4 * 4) * 128 + lane;
            s1a += q1.x * r1[0] + q1.y * r1[128] + q1.z * r1[256] + q1.w * r1[384];
            s1b += q1.x * r1[64] + q1.y * r1[192] + q1.z * r1[320] + q1.w * r1[448];
            s2a += q2.x * r2[0] + q2.y * r2[128] + q2.z * r2[256] + q2.w * r2[384];
            s2b += q2.x * r2[64] + q2.y * r2[192] + q2.z * r2[320] + q2.w * r2[448];
        }
        asm volatile("" ::: "memory");
        float myv1 = 0.f, myv2 = 0.f; int myi1 = 0, myi2 = 0;
        for (int r = 0; r < TOPK; ++r) {
            float v = s1a; int i = lane; if (s1b > v) { v = s1b; i = lane + 64; }
            wave_argmax(v, i);
            if (lane == r) { myv1 = v; myi1 = i; }
            if (i == lane) s1a = NEG; if (i == lane + 64) s1b = NEG;
        }
        for (int r = 0; r < TOPK; ++r) {
            float v = s2a; int i = lane; if (s2b > v) { v = s2b; i = lane + 64; }
            wave_argmax(v, i);
            if (lane == r) { myv2 = v; myi2 = i; }
            if (i == lane) s2a = NEG; if (i == lane + 64) s2b = NEG;
        }
        const float va = __shfl(myv1, lane >> 2);
        float cv[4];
#pragma unroll
        for (int e = 0; e < 4; ++e) cv[e] = va + __shfl(myv2, (lane & 3) * 4 + e);
        float mysc = 0.f; int myci = 0;
        for (int r = 0; r < TOPK; ++r) {
            float v = cv[0]; int i = lane * 4;
#pragma unroll
            for (int e = 1; e < 4; ++e) if (cv[e] > v) { v = cv[e]; i = lane * 4 + e; }
            wave_argmax(v, i);
            if (lane == r) { mysc = v; myci = i; }
            if ((i >> 2) == lane) {
#pragma unroll
                for (int e = 0; e < 4; ++e) if ((i & 3) == e) cv[e] = NEG;
            }
        }
        const int ea = __shfl(myi1, (myci >> 4) & 15), eb = __shfl(myi2, myci & 15);
        const float smax = __shfl(mysc, 0);
        float ex = lane < TOPK ? expf((mysc - smax) * rs2) : 0.f;
        float den = ex;
#pragma unroll
        for (int o = 8; o >= 1; o >>= 1) den += __shfl_xor(den, o);
        if (lane < TOPK) { idxo[(size_t)t * 128 + hh * 16 + lane] = ea * 128 + eb; gato[(size_t)t * 128 + hh * 16 + lane] = ex / den; }
    }
    __syncthreads();
}

__device__ __forceinline__ void p7_peer(const Params& P, int G, int bid) {
    const int lane = threadIdx.x & 63, wave = threadIdx.x >> 6;
    const bf16_t* x1b = (const bf16_t*)(P.ws + WS_X1B); const float* x1 = (const float*)(P.ws + WS_X1); const float* ssq = (const float*)(P.ws + WS_SSQ);
    const int* idxi = (const int*)(P.ws + WS_IDX); const float* gati = (const float*)(P.ws + WS_GATE);
    const bf16_t* ub = (const bf16_t*)(P.ws + WS_UB); const bf16_t* vb = (const bf16_t*)(P.ws + WS_VB);
    for (int t = bid * NWAVES + wave; t < T; t += G * NWAVES) {
        const float rs2 = rsqrtf(wave_sum(lane < 32 ? ssq[(size_t)t * 32 + lane] : 0.f) * (1.0f / D) + EPS);
        float xf[4][8];
#pragma unroll
        for (int c = 0; c < 4; ++c) unpack8(*(const uint4*)(x1b + (size_t)t * D + c * 512 + lane * 8), xf[c]);
        float y[4][8];
#pragma unroll
        for (int c = 0; c < 4; ++c)
#pragma unroll
            for (int i = 0; i < 8; ++i) y[c][i] = 0.f;
#pragma unroll 1
        for (int hh = 0; hh < PEER_H; ++hh) {
            const int myidx = lane < TOPK ? idxi[(size_t)t * 128 + hh * 16 + lane] : 0;
            const float mygate = lane < TOPK ? gati[(size_t)t * 128 + hh * 16 + lane] : 0.f;
#pragma unroll 1
            for (int g = 0; g < 4; ++g) {
                float dsum[4];
#pragma unroll
                for (int e = 0; e < 4; ++e) {
                    const int ei = __builtin_amdgcn_readlane(myidx, g * 4 + e);
                    const bf16_t* ur = ub + (size_t)ei * D + lane * 8;
                    float s = 0.f;
#pragma unroll
                    for (int c = 0; c < 4; ++c) { float uf[8]; unpack8(*(const uint4*)(ur + c * 512), uf);
#pragma unroll
                        for (int i = 0; i < 8; ++i) s += xf[c][i] * uf[i]; }
                    dsum[e] = s;
                }
#pragma unroll
                for (int e = 0; e < 4; ++e) dsum[e] = wave_sum(dsum[e]);
#pragma unroll
                for (int e = 0; e < 4; ++e) {
                    const int ei = __builtin_amdgcn_readlane(myidx, g * 4 + e);
                    const float gt = __uint_as_float(__builtin_amdgcn_readlane(__float_as_uint(mygate), g * 4 + e));
                    const float cf = gt * gelu_erf(dsum[e] * rs2);
                    const bf16_t* vr = vb + (size_t)ei * D + lane * 8;
#pragma unroll
                    for (int c = 0; c < 4; ++c) { float vf[8]; unpack8(*(const uint4*)(vr + c * 512), vf);
#pragma unroll
                        for (int i = 0; i < 8; ++i) y[c][i] += cf * vf[i]; }
                }
            }
        }
        float ss = 0.f;
#pragma unroll
        for (int c = 0; c < 4; ++c) { const float4 a = *(const float4*)(x1 + (size_t)t * D + c * 512 + lane * 8), b = *(const float4*)(x1 + (size_t)t * D + c * 512 + lane * 8 + 4);
            y[c][0] += a.x; y[c][1] += a.y; y[c][2] += a.z; y[c][3] += a.w; y[c][4] += b.x; y[c][5] += b.y; y[c][6] += b.z; y[c][7] += b.w;
#pragma unroll
            for (int i = 0; i < 8; ++i) ss += y[c][i] * y[c][i]; }
        ss = wave_sum(ss);
        const float r = rsqrtf(ss * (1.0f / D) + EPS);
#pragma unroll
        for (int c = 0; c < 4; ++c) { const float4 ga = *(const float4*)(P.gfin + c * 512 + lane * 8), gb = *(const float4*)(P.gfin + c * 512 + lane * 8 + 4);
            *(float4*)(P.out + (size_t)t * D + c * 512 + lane * 8) = make_float4(y[c][0] * r * ga.x, y[c][1] * r * ga.y, y[c][2] * r * ga.z, y[c][3] * r * ga.w);
            *(float4*)(P.out + (size_t)t * D + c * 512 + lane * 8 + 4) = make_float4(y[c][4] * r * gb.x, y[c][5] * r * gb.y, y[c][6] * r * gb.z, y[c][7] * r * gb.w); }
    }
}

constexpr int N_PHASES = 8;
#ifndef MK_N_LAUNCHES
#define MK_N_LAUNCHES 1
#endif
__global__ void __launch_bounds__(NTHREADS, 2) layer_fwd(Params P) {
    extern __shared__ __attribute__((aligned(16))) unsigned char lds[];
    cg::grid_group grid = cg::this_grid();
    const int G = gridDim.x, bid = blockIdx.x;
    const int lo = P.ph_lo, hi = P.ph_hi;
#ifndef PH_MASK
#define PH_MASK 0xff
#endif
#define IN(k) (((PH_MASK >> (k)) & 1) && lo <= (k) && (k) < hi)
#define SEAM(k) do { if (IN(k) && IN((k) + 1)) grid.sync(); } while (0)
    if (IN(0)) { p0_rows(P, lds, G, bid); p0_weights(P, lds, G, bid); p0_tables(P, G, bid); }
    SEAM(0);
    if (IN(1)) {
        pg8::Gemm g{(const pg8::bf16_t*)(P.ws + WS_XB), (const pg8::bf16_t*)(P.ws + WS_WINT), T, NPROJ, D}; pg8::StaticOrder S; S.init(T, NPROJ, G, bid);
        pg8::EpiProj E{(pg8::bf16_t*)(P.ws + WS_PROJ), NPROJ, (const float*)(P.ws + WS_RS1)};
        pg8::gemm_phase<pg8::EpiProj, pg8::StaticOrder, true, true>((PG8_LAS unsigned char*)lds, g, S, E);
    }
    SEAM(1);
    if (IN(2)) {
        for (int u = bid; u < 64; u += G) mlstm_unit(P, lds, u);
        if (G > 64) { if (bid >= 64) p2_conv(P, G - 64, bid - 64); } else p2_conv(P, G, bid);
    }
    SEAM(2);
    if (IN(3)) p3_finalize(P, G, bid);
    SEAM(3);
    if (IN(4)) {
        pg8::Gemm g{(const pg8::bf16_t*)(P.ws + WS_MIXIN), (const pg8::bf16_t*)(P.ws + WS_WOUTT), T, D, D}; pg8::StaticOrder S; S.init(T, D, G, bid);
        pg8::EpiOut E{P.x, (float*)(P.ws + WS_X1), (pg8::bf16_t*)(P.ws + WS_X1B), (float*)(P.ws + WS_SSQ), D};
        pg8::gemm_phase<pg8::EpiOut, pg8::StaticOrder, true, true>((PG8_LAS unsigned char*)lds, g, S, E);
    }
    SEAM(4);
    if (IN(5)) {
        pg8::Gemm g{(const pg8::bf16_t*)(P.ws + WS_X1B), (const pg8::bf16_t*)(P.ws + WS_WQT), T, D, D}; pg8::StaticOrder S; S.init(T, D, G, bid);
        pg8::EpiQ E{(float*)(P.ws + WS_QV), D};
        pg8::gemm_phase<pg8::EpiQ, pg8::StaticOrder, true, true>((PG8_LAS unsigned char*)lds, g, S, E);
    }
    SEAM(5);
    if (IN(6)) p6_topk(P, lds, G, bid);
    SEAM(6);
    if (IN(7)) p7_peer(P, G, bid);
#undef IN
#undef SEAM
}

extern "C" void kernel_launch(void* const* d_in, const int* in_sizes, int n_in, void* d_out, int out_size, void* d_ws, size_t ws_size, hipStream_t stream) {
    static int grid = 0;
    if (grid == 0) {
        if (n_in != 15 || in_sizes[0] != T * D || out_size != T * D || ws_size < WS_END) { fprintf(stderr, "kernel_launch: unexpected shapes (n_in %d, in0 %d, out %d, ws %zu); nothing launched\n", n_in, n_in > 0 ? in_sizes[0] : -1, out_size, ws_size); grid = -1; return; }
        int dev = 0, cus = 0, per_cu = 0;
        if (hipGetDevice(&dev) != hipSuccess || hipDeviceGetAttribute(&cus, hipDeviceAttributeMultiprocessorCount, dev) != hipSuccess) { grid = -1; return; }
        if (hipFuncSetAttribute((const void*)layer_fwd, hipFuncAttributeMaxDynamicSharedMemorySize, LDS_BYTES) != hipSuccess) { fprintf(stderr, "kernel_launch: hipFuncSetAttribute failed\n"); grid = -1; return; }
        if (hipOccupancyMaxActiveBlocksPerMultiprocessor(&per_cu, (const void*)layer_fwd, NTHREADS, LDS_BYTES) != hipSuccess || per_cu < 1) { fprintf(stderr, "kernel_launch: occupancy query says %d blocks per CU\n", per_cu); (void)hipGetLastError(); grid = -1; return; }
        grid = cus;
    }
    if (grid < 0) return;
    Params p{};
    p.x = (const float*)d_in[0]; p.g1 = (const float*)d_in[1]; p.w_in = (const float*)d_in[2]; p.b_ig = (const float*)d_in[3]; p.b_fg = (const float*)d_in[4];
    p.conv_w = (const float*)d_in[5]; p.gm = (const float*)d_in[6]; p.w_out = (const float*)d_in[7]; p.g2 = (const float*)d_in[8]; p.w_q = (const float*)d_in[9];
    p.sk1 = (const float*)d_in[10]; p.sk2 = (const float*)d_in[11]; p.eu = (const float*)d_in[12]; p.ev = (const float*)d_in[13]; p.gfin = (const float*)d_in[14];
    p.out = (float*)d_out; p.ws = (unsigned char*)d_ws;
    for (int li = 0; li < MK_N_LAUNCHES; ++li) {
        p.ph_lo = (MK_N_LAUNCHES == 1) ? 0 : li; p.ph_hi = (MK_N_LAUNCHES == 1) ? N_PHASES : li + 1;
        void* args[] = {&p};
        const hipError_t e = hipLaunchCooperativeKernel((const void*)layer_fwd, dim3(grid), dim3(NTHREADS), args, LDS_BYTES, stream);
        if (e != hipSuccess) { fprintf(stderr, "kernel_launch: cooperative launch %d failed: %s (grid %d)\n", li, hipGetErrorString(e), grid); break; }
    }
}
```

```cpp
#include <hip/hip_runtime.h>
#include <hip/hip_cooperative_groups.h>
#include <cstdio>
#include <cstdint>
namespace cg = cooperative_groups;
namespace pg8 {
#define PG8_LAS __attribute__((address_space(3)))
typedef unsigned short bf16_t;
typedef short bf16x8 __attribute__((ext_vector_type(8)));
typedef float f32x4 __attribute__((ext_vector_type(4)));
typedef unsigned u32x4 __attribute__((ext_vector_type(4)));
constexpr int BM = 256, BK = 64, HALF = 128, HTB = HALF * BK * 2  , STAGE_BYTES = 8 * HTB, NXCD = 8, WGM = 8;

__host__ __device__ __forceinline__ int lds_byte(int r, int c) { const int st = (r >> 4) * 2 + (c >> 5), rr = r & 15, cc = c & 31, ob = rr * 64 + cc * 2; return st * 1024 + (ob ^ (((ob >> 9) & 1) << 5)); }
__host__ __device__ __forceinline__ void stage_rc(int b, int& R, int& C) { const int st = b / 1024, sb = b % 1024, swz = sb ^ (((sb >> 9) & 1) << 5); R = (st >> 1) * 16 + swz / 64; C = (st & 1) * 32 + (swz % 64) / 2; }
__host__ __device__ __forceinline__ int perm32(int rho) { const int n = rho >> 4, i = rho & 15; return 8 * (i >> 2) + 4 * n + (i & 3); }

struct Unit { int pm, pn; };
struct Gemm { const bf16_t* A; const bf16_t* Bt; int M, N, K; };

struct StaticOrder {
    int nM, nN, nwg, G, c;
    __host__ __device__ void init(int M, int N, int G_, int c_) { nM = M / BM; nN = N / BM; nwg = nM * nN; G = G_; c = c_; }
    __host__ __device__ bool next(int i, Unit& u) const {
        const long L = (long)i * G + c; if (L >= nwg) return false;
        int wgid = (int)L; { const int q = nwg / NXCD, r = nwg % NXCD, xcd = wgid % NXCD, off = wgid / NXCD; wgid = (xcd < r ? xcd * (q + 1) : r * (q + 1) + (xcd - r) * q) + off; }
        const int nig = WGM * nN, gid = wgid / nig, fm = gid * WGM, gsz = (nM - fm) < WGM ? (nM - fm) : WGM;
        u.pm = fm + ((wgid % nig) % gsz); u.pn = (wgid % nig) / gsz; return true;
    }
    __device__ __forceinline__ void a_ready(const Unit&) const {}
    __device__ __forceinline__ void done(const Unit&) const {}
};

__device__ __forceinline__ unsigned cvt_pk_bf16(float lo, float hi) { unsigned r; asm volatile("v_cvt_pk_bf16_f32 %0, %1, %2" : "=v"(r) : "v"(lo), "v"(hi)); return r; }
struct EpiProj {
    static constexpr bool PERM = true, AFTER_DRAIN = false;
    bf16_t* O; int ldc; const float* rs;
    __device__ __forceinline__ void operator()(const f32x4 (&acc)[2][2][4][2], const Unit& u, int wr, int wc, int fr, int fq) const {
        const int row0 = u.pm * BM + wr * 64 + fr, col0 = u.pn * BM + wc * 32 + 8 * fq;
#pragma unroll
        for (int ai = 0; ai < 2; ++ai)
#pragma unroll
            for (int m = 0; m < 4; ++m) { const int row = row0 + ai * HALF + m * 16; const float s = rs[row]; bf16_t* rowp = O + (size_t)row * ldc + col0;
#pragma unroll
                for (int bj = 0; bj < 2; ++bj) { const f32x4 v0 = acc[ai][bj][m][0] * s, v1 = acc[ai][bj][m][1] * s; u32x4 w;
                    w.x = cvt_pk_bf16(v0[0], v0[1]); w.y = cvt_pk_bf16(v0[2], v0[3]); w.z = cvt_pk_bf16(v1[0], v1[1]); w.w = cvt_pk_bf16(v1[2], v1[3]);
                    *(u32x4*)(rowp + bj * HALF) = w; } }
    }
};
struct EpiOut {
    static constexpr bool PERM = false, AFTER_DRAIN = false;
    const float* X; float* X1; bf16_t* X1B; float* SSQ; int ldc;
    __device__ __forceinline__ void operator()(const f32x4 (&acc)[2][2][4][2], const Unit& u, int wr, int wc, int fr, int fq) const {
        typedef unsigned u32x2 __attribute__((ext_vector_type(2)));
        const int row0 = u.pm * BM + wr * 64 + fr, col0 = u.pn * BM + wc * 32 + 4 * fq;
#pragma unroll
        for (int ai = 0; ai < 2; ++ai)
#pragma unroll
            for (int m = 0; m < 4; ++m) { const int row = row0 + ai * HALF + m * 16; const size_t off = (size_t)row * ldc + col0; float ss = 0.f;
#pragma unroll
                for (int bj = 0; bj < 2; ++bj)
#pragma unroll
                    for (int n = 0; n < 2; ++n) { const size_t c = off + bj * HALF + n * 16; const f32x4 xv = *(const f32x4*)(X + c); const f32x4 o = xv + acc[ai][bj][m][n];
                        *(f32x4*)(X1 + c) = o; ss += (o[0] * o[0] + o[1] * o[1]) + (o[2] * o[2] + o[3] * o[3]);
                        u32x2 pk; pk.x = cvt_pk_bf16(o[0], o[1]); pk.y = cvt_pk_bf16(o[2], o[3]); *(u32x2*)(X1B + c) = pk; }
                ss += __shfl_xor(ss, 16); ss += __shfl_xor(ss, 32);
                if (fq == 0) SSQ[(size_t)row * 32 + u.pn * 4 + wc] = ss; }
    }
};
struct EpiQ {
    static constexpr bool PERM = false, AFTER_DRAIN = false;
    float* O; int ldc;
    __device__ __forceinline__ void operator()(const f32x4 (&acc)[2][2][4][2], const Unit& u, int wr, int wc, int fr, int fq) const {
        const int row0 = u.pm * BM + wr * 64 + fr, col0 = u.pn * BM + wc * 32 + 4 * fq;
#pragma unroll
        for (int ai = 0; ai < 2; ++ai)
#pragma unroll
            for (int m = 0; m < 4; ++m) { const size_t off = (size_t)(row0 + ai * HALF + m * 16) * ldc + col0;
#pragma unroll
                for (int bj = 0; bj < 2; ++bj)
#pragma unroll
                    for (int n = 0; n < 2; ++n) *(f32x4*)(O + off + bj * HALF + n * 16) = acc[ai][bj][m][n]; }
    }
};
template <class Epi, class Sched, bool ALIGN_EPI = false, bool SP2 = false>
__device__ __forceinline__ void gemm_phase(PG8_LAS unsigned char* lds, const Gemm g, const Sched& S, const Epi& E) {
    const int tid = threadIdx.x, wid = __builtin_amdgcn_readfirstlane(tid >> 6), lane = tid & 63, wr = wid >> 2, wc = wid & 3, fr = lane & 15, fq = lane >> 4;
    const int K = g.K, nt = K / BK;
    unsigned voffA[2], voffB[2];
#pragma unroll
    for (int i = 0; i < 2; ++i) { int R, C; stage_rc(tid * 16 + i * 8192, R, C); const int Rb = Epi::PERM ? ((R & ~31) + perm32(R & 31)) : R;
        voffA[i] = (unsigned)(R * K + C) * 2u; voffB[i] = (unsigned)(Rb * K + C) * 2u; }
    const size_t kstep = (size_t)(BK * 2);
    const size_t hstep = (size_t)HALF * K * 2;
    const size_t tstep = 2 * hstep;
    const unsigned ldsw = (unsigned)wid * 1024u;
    const int aoff = lds_byte(wr * 64 + fr, fq * 8), boff = lds_byte(wc * 32 + fr, fq * 8);
#define PG8_SA(b, h) (((b) * 2 + (h)) * HTB)
#define PG8_SB(b, h) ((4 + (b) * 2 + (h)) * HTB)
#define PG8_STAGE(bufoff, gbase, voff) do { _Pragma("unroll") for (int _i = 0; _i < 2; ++_i) \
        __builtin_amdgcn_global_load_lds((const unsigned*)((const char*)(gbase) + (voff)[_i]), (PG8_LAS unsigned*)(lds + (bufoff) + ldsw + _i * 8192), 16, 0, 0); } while (0)
#define PG8_LDA(dst, b, h) do { _Pragma("unroll") for (int m = 0; m < 4; ++m) _Pragma("unroll") for (int k = 0; k < 2; ++k) dst[m][k] = *(const PG8_LAS bf16x8*)(lds + PG8_SA(b, h) + aoff + m * 2048 + k * 1024); } while (0)
#define PG8_LDB(dst, b, h) do { _Pragma("unroll") for (int n = 0; n < 2; ++n) _Pragma("unroll") for (int k = 0; k < 2; ++k) dst[n][k] = *(const PG8_LAS bf16x8*)(lds + PG8_SB(b, h) + boff + n * 2048 + k * 1024); } while (0)
#define PG8_MMA(ai, bj, At, Bt) do { __builtin_amdgcn_s_setprio(1); _Pragma("unroll") for (int m = 0; m < 4; ++m) _Pragma("unroll") for (int n = 0; n < 2; ++n) _Pragma("unroll") for (int k = 0; k < 2; ++k) \
        acc[ai][bj][m][n] = __builtin_amdgcn_mfma_f32_16x16x32_bf16(Bt[n][k], At[m][k], acc[ai][bj][m][n], 0, 0, 0); __builtin_amdgcn_s_setprio(0); } while (0)
#define PG8_WAIT_V(n) asm volatile("s_waitcnt vmcnt(" #n ")" ::: "memory")
#define PG8_WAIT_L(n) asm volatile("s_waitcnt lgkmcnt(" #n ")" ::: "memory")
#define PG8_BAR __builtin_amdgcn_s_barrier()
#define PG8_SCHED __builtin_amdgcn_sched_barrier(0)
    Unit cur, nxt; int ui = 0;
    if (!S.next(0, cur)) return;
    f32x4 acc[2][2][4][2];
#pragma unroll
    for (int a = 0; a < 2; ++a)
#pragma unroll
        for (int b = 0; b < 2; ++b)
#pragma unroll
            for (int m = 0; m < 4; ++m)
#pragma unroll
                for (int n = 0; n < 2; ++n) acc[a][b][m][n] = (f32x4){0.f, 0.f, 0.f, 0.f};
    bf16x8 At[4][2], B0[2][2], B1[2][2];
    const char* cA = (const char*)g.A + (size_t)cur.pm * tstep; const char* cB = (const char*)g.Bt + (size_t)cur.pn * tstep;
    S.a_ready(cur);
    if constexpr (SP2) {
        PG8_STAGE(PG8_SB(0, 0), cB, voffB); PG8_STAGE(PG8_SB(0, 1), cB + hstep, voffB); PG8_STAGE(PG8_SA(0, 0), cA, voffA); PG8_STAGE(PG8_SA(0, 1), cA + hstep, voffA);
        if (wr == 1) PG8_BAR;
        PG8_WAIT_V(2); PG8_BAR;
        PG8_STAGE(PG8_SB(1, 0), cB + kstep, voffB); PG8_STAGE(PG8_SA(1, 0), cA + kstep, voffA); PG8_STAGE(PG8_SB(1, 1), cB + hstep + kstep, voffB);
        PG8_WAIT_V(6); PG8_BAR;
    } else {
        PG8_STAGE(PG8_SB(0, 0), cB, voffB); PG8_STAGE(PG8_SA(0, 0), cA, voffA); PG8_STAGE(PG8_SB(0, 1), cB + hstep, voffB); PG8_STAGE(PG8_SA(0, 1), cA + hstep, voffA);
        if (wr == 1) PG8_BAR;
        PG8_WAIT_V(4); PG8_BAR;
        PG8_STAGE(PG8_SB(1, 0), cB + kstep, voffB); PG8_STAGE(PG8_SA(1, 0), cA + kstep, voffA); PG8_STAGE(PG8_SB(1, 1), cB + hstep + kstep, voffB);
        PG8_WAIT_V(6); PG8_BAR;
    }
    for (;;) {
        const bool has_next = S.next(ui + 1, nxt);
        const char* nA = has_next ? (const char*)g.A + (size_t)nxt.pm * tstep : cA; const char* nB = has_next ? (const char*)g.Bt + (size_t)nxt.pn * tstep : cB;
        for (int t = 0; t < nt; t += 2) {
            const bool last = (t == nt - 2);
            const char* a1 = cA + (size_t)(t + 1) * kstep;
            const char* a2 = last ? nA : cA + (size_t)(t + 2) * kstep; const char* b2 = last ? nB : cB + (size_t)(t + 2) * kstep;
            const char* a3 = a2 + kstep; const char* b3 = b2 + kstep;
            if (last && has_next) S.a_ready(nxt);
            if constexpr (SP2) {
            PG8_LDB(B0, 0, 0); PG8_LDB(B1, 0, 1); PG8_SCHED; PG8_LDA(At, 0, 0); PG8_STAGE(PG8_SA(1, 1), a1 + hstep, voffA);
            PG8_WAIT_V(8); PG8_WAIT_L(0); PG8_BAR; PG8_MMA(0, 0, At, B0); PG8_MMA(0, 1, At, B1); PG8_BAR; PG8_SCHED;
            PG8_LDA(At, 0, 1); PG8_STAGE(PG8_SB(0, 0), b2, voffB); PG8_STAGE(PG8_SB(0, 1), b2 + hstep, voffB); PG8_STAGE(PG8_SA(0, 0), a2, voffA);
            PG8_WAIT_V(8); PG8_WAIT_L(0); PG8_BAR; PG8_MMA(1, 0, At, B0); PG8_MMA(1, 1, At, B1); PG8_BAR; PG8_SCHED;
            PG8_LDB(B0, 1, 0); PG8_LDB(B1, 1, 1); PG8_SCHED; PG8_LDA(At, 1, 0); PG8_STAGE(PG8_SA(0, 1), a2 + hstep, voffA);
            PG8_WAIT_V(8); PG8_WAIT_L(0); PG8_BAR; PG8_MMA(0, 0, At, B0); PG8_MMA(0, 1, At, B1); PG8_BAR; PG8_SCHED;
            PG8_LDA(At, 1, 1); PG8_STAGE(PG8_SB(1, 0), b3, voffB); PG8_STAGE(PG8_SB(1, 1), b3 + hstep, voffB); PG8_STAGE(PG8_SA(1, 0), a3, voffA);
            PG8_WAIT_V(8); PG8_WAIT_L(0); PG8_BAR; PG8_MMA(1, 0, At, B0); PG8_MMA(1, 1, At, B1); PG8_BAR; PG8_SCHED;
            } else {
            PG8_LDB(B0, 0, 0); PG8_SCHED; PG8_LDA(At, 0, 0); PG8_STAGE(PG8_SA(1, 1), a1 + hstep, voffA);
            PG8_WAIT_L(8); PG8_BAR; PG8_WAIT_L(0); PG8_MMA(0, 0, At, B0); PG8_BAR; PG8_SCHED;
            PG8_LDB(B1, 0, 1); PG8_STAGE(PG8_SB(0, 0), b2, voffB);
            PG8_BAR; PG8_WAIT_L(0); PG8_MMA(0, 1, At, B1); PG8_BAR;
            PG8_LDA(At, 0, 1); PG8_STAGE(PG8_SA(0, 0), a2, voffA);
            PG8_BAR; PG8_WAIT_L(0); PG8_MMA(1, 0, At, B0); PG8_BAR; PG8_SCHED;
            PG8_STAGE(PG8_SB(0, 1), b2 + hstep, voffB);
            PG8_WAIT_V(6); PG8_BAR; PG8_MMA(1, 1, At, B1); PG8_BAR;
            PG8_LDB(B0, 1, 0); PG8_SCHED; PG8_LDA(At, 1, 0); PG8_STAGE(PG8_SA(0, 1), a2 + hstep, voffA);
            PG8_WAIT_L(8); PG8_BAR; PG8_WAIT_L(0); PG8_MMA(0, 0, At, B0); PG8_BAR; PG8_SCHED;
            PG8_LDB(B1, 1, 1); PG8_STAGE(PG8_SB(1, 0), b3, voffB);
            PG8_BAR; PG8_WAIT_L(0); PG8_MMA(0, 1, At, B1); PG8_BAR;
            PG8_LDA(At, 1, 1); PG8_STAGE(PG8_SA(1, 0), a3, voffA);
            PG8_BAR; PG8_WAIT_L(0); PG8_MMA(1, 0, At, B0); PG8_BAR; PG8_SCHED;
            PG8_STAGE(PG8_SB(1, 1), b3 + hstep, voffB);
            PG8_WAIT_V(6); PG8_BAR; PG8_MMA(1, 1, At, B1); PG8_BAR;
            }
        }
        if constexpr (ALIGN_EPI) { if (wr == 0) PG8_BAR; }
        if constexpr (!Epi::AFTER_DRAIN) { E(acc, cur, wr, wc, fr, fq); S.done(cur); }
        if (!has_next) break;
#pragma unroll
        for (int a = 0; a < 2; ++a)
#pragma unroll
            for (int b = 0; b < 2; ++b)
#pragma unroll
                for (int m = 0; m < 4; ++m)
#pragma unroll
                    for (int n = 0; n < 2; ++n) acc[a][b][m][n] = (f32x4){0.f, 0.f, 0.f, 0.f};
        cur = nxt; cA = nA; cB = nB; ++ui;
        if constexpr (ALIGN_EPI) { if (wr == 1) PG8_BAR; }
    }
    PG8_WAIT_V(0);
    if constexpr (!ALIGN_EPI) { if (wr == 0) PG8_BAR; }
    PG8_BAR;
    if constexpr (Epi::AFTER_DRAIN) { E.fused(acc, cur, wr, wc, fr, fq, lds, wid, lane); S.done(cur); }
#undef PG8_SA
#undef PG8_SB
#undef PG8_STAGE
#undef PG8_LDA
#undef PG8_LDB
#undef PG8_MMA
#undef PG8_WAIT_V
#undef PG8_WAIT_L
#undef PG8_BAR
#undef PG8_SCHED
}
}
constexpr int T = 8192, SEQ = 4096, D = 2048, NPROJ = 7168, NIN = 7176;
constexpr int NH = 4, DH = 256, LCH = 64, DML = 1024;
constexpr int NEXP = 16384, PEER_H = 8, TOPK = 16;
constexpr float EPS = 1e-6f;
constexpr int PC_CX = 0, PC_CB = 1024, PC_CC = 2048, PC_Q = 3072, PC_K = 4096, PC_V = 5120, PC_O = 6144;
constexpr int NTHREADS = 512, NWAVES = 8;
constexpr int LDS_BYTES = 147456;

constexpr size_t MiB = 1u << 20;
constexpr size_t WS_CTL = 0, CTL_ZERO_BYTES = 64 * 1024;
constexpr size_t WS_RS1 = 1 * MiB, WS_GI = 1 * MiB + 64 * 1024, WS_GF = 1 * MiB + 256 * 1024, WS_SSQ = 3 * MiB;
constexpr size_t WS_XB = 5 * MiB, WS_WINT = 37 * MiB, WS_WOUTT = 65 * MiB, WS_WQT = 73 * MiB;
constexpr size_t WS_PROJ = 81 * MiB;
constexpr size_t WS_X1 = 81 * MiB, WS_X1B = 145 * MiB;
constexpr size_t WS_HRAW = 193 * MiB, WS_MIXIN = 225 * MiB, WS_QV = 257 * MiB, WS_IDX = 321 * MiB, WS_GATE = 325 * MiB;
constexpr size_t WS_UB = 329 * MiB, WS_VB = 393 * MiB, WS_END = 457 * MiB;

struct Params {
    const float *x, *g1, *w_in, *b_ig, *b_fg, *conv_w, *gm, *w_out, *g2, *w_q, *sk1, *sk2, *eu, *ev, *gfin;
    float* out; unsigned char* ws;
    int ph_lo, ph_hi;
};

typedef unsigned short bf16_t;
__device__ __forceinline__ unsigned f2bf(float f) { unsigned u = __float_as_uint(f); return (u + 0x7fffu + ((u >> 16) & 1u)) >> 16; }
__device__ __forceinline__ unsigned pk2(float lo, float hi) { return f2bf(lo) | (f2bf(hi) << 16); }
__device__ __forceinline__ float bflo(unsigned w) { return __uint_as_float(w << 16); }
__device__ __forceinline__ float bfhi(unsigned w) { return __uint_as_float(w & 0xffff0000u); }
__device__ __forceinline__ float bf1(bf16_t h) { return __uint_as_float((unsigned)h << 16); }
__device__ __forceinline__ float wave_sum(float v) {
#pragma unroll
    for (int o = 32; o >= 1; o >>= 1) v += __shfl_xor(v, o);
    return v;
}
__device__ __forceinline__ void unpack8(const uint4 w, float (&f)[8]) {
    f[0] = bflo(w.x); f[1] = bfhi(w.x); f[2] = bflo(w.y); f[3] = bfhi(w.y); f[4] = bflo(w.z); f[5] = bfhi(w.z); f[6] = bflo(w.w); f[7] = bfhi(w.w);
}
__device__ __forceinline__ float log_sigmoid(float z) { return z >= 0.f ? -log1pf(expf(-z)) : z - log1pf(expf(z)); }
__device__ __forceinline__ float gelu_erf(float v) { return 0.5f * v * (1.0f + erff(v * 0.70710678118654752f)); }

__device__ __forceinline__ void p0_rows(const Params& P, unsigned char* lds, int G, int bid) {
    float* wg = (float*)lds;
    const int tid = threadIdx.x, lane = tid & 63, wave = tid >> 6;
    for (int i = tid; i < 8 * D; i += NTHREADS) { const int g = i >> 11, k = i & 2047; wg[i] = P.w_in[(size_t)k * NIN + NPROJ + g] * P.g1[k]; }
    __syncthreads();
    float* rs1 = (float*)(P.ws + WS_RS1); float* gi = (float*)(P.ws + WS_GI); float* gf = (float*)(P.ws + WS_GF); bf16_t* xb = (bf16_t*)(P.ws + WS_XB);
    for (int t = bid * NWAVES + wave; t < T; t += G * NWAVES) {
        const float4* xr = (const float4*)(P.x + (size_t)t * D);
        float ss = 0.f, dg[8];
#pragma unroll
        for (int g = 0; g < 8; ++g) dg[g] = 0.f;
#pragma unroll 1
        for (int j = 0; j < 8; ++j) {
            const float4 v = xr[j * 64 + lane];
            ss += (v.x * v.x + v.y * v.y) + (v.z * v.z + v.w * v.w);
            const int k0 = (j * 64 + lane) * 4;
#pragma unroll
            for (int g = 0; g < 8; ++g) { const float4 w = *(const float4*)(wg + g * D + k0); dg[g] += (v.x * w.x + v.y * w.y) + (v.z * w.z + v.w * w.w); }
            ((uint2*)(xb + (size_t)t * D))[j * 64 + lane] = make_uint2(pk2(v.x, v.y), pk2(v.z, v.w));
        }
        ss = wave_sum(ss);
#pragma unroll
        for (int g = 0; g < 8; ++g) dg[g] = wave_sum(dg[g]);
        const float rs = rsqrtf(ss * (1.0f / D) + EPS);
        if (lane == 0) {
            rs1[t] = rs;
#pragma unroll
            for (int h = 0; h < 4; ++h) { gi[t * 4 + h] = rs * dg[h] + P.b_ig[h]; gf[t * 4 + h] = log_sigmoid(rs * dg[4 + h] + P.b_fg[h]); }
        }
    }
    __syncthreads();
}
__device__ __forceinline__ void transpose_tile(const float* W, int ldw, int K, const float* gain, bf16_t* WT, int k0, int n0, float* tile) {
    const int tid = threadIdx.x;
#pragma unroll
    for (int r = 0; r < 2; ++r) {
        const int kk = (tid >> 4) + 32 * r, n4 = (tid & 15) * 4;
        float4 v = *(const float4*)(W + (size_t)(k0 + kk) * ldw + n0 + n4);
        const float g = gain ? gain[k0 + kk] : 1.0f;
        tile[kk * 65 + n4 + 0] = v.x * g; tile[kk * 65 + n4 + 1] = v.y * g; tile[kk * 65 + n4 + 2] = v.z * g; tile[kk * 65 + n4 + 3] = v.w * g;
    }
    __syncthreads();
    { const int nn = tid >> 3, k8 = (tid & 7) * 8; float f[8];
#pragma unroll
      for (int i = 0; i < 8; ++i) f[i] = tile[(k8 + i) * 65 + nn];
      *(uint4*)(WT + (size_t)(n0 + nn) * K + k0 + k8) = make_uint4(pk2(f[0], f[1]), pk2(f[2], f[3]), pk2(f[4], f[5]), pk2(f[6], f[7])); }
    __syncthreads();
}
__device__ __forceinline__ void p0_weights(const Params& P, unsigned char* lds, int G, int bid) {
    float* tile = (float*)lds;
    constexpr int N_IN = (D / 64) * (NPROJ / 64), N_SQ = (D / 64) * (D / 64);
    for (int it = bid; it < N_IN + 2 * N_SQ; it += G) {
        if (it < N_IN) { const int kt = it / (NPROJ / 64), nt = it % (NPROJ / 64); transpose_tile(P.w_in, NIN, D, P.g1, (bf16_t*)(P.ws + WS_WINT), kt * 64, nt * 64, tile); }
        else if (it < N_IN + N_SQ) { const int j = it - N_IN, kt = j / (D / 64), nt = j % (D / 64); transpose_tile(P.w_out, D, D, nullptr, (bf16_t*)(P.ws + WS_WOUTT), kt * 64, nt * 64, tile); }
        else { const int j = it - N_IN - N_SQ, kt = j / (D / 64), nt = j % (D / 64); transpose_tile(P.w_q, D, D, P.g2, (bf16_t*)(P.ws + WS_WQT), kt * 64, nt * 64, tile); }
    }
}
__device__ __forceinline__ void p0_tables(const Params& P, int G, int bid) {
    const size_t NG = (size_t)NEXP * D / 8;
    uint4* ub = (uint4*)(P.ws + WS_UB); uint4* vb = (uint4*)(P.ws + WS_VB);
    const float4* eu = (const float4*)P.eu; const float4* ev = (const float4*)P.ev; const float4* g2 = (const float4*)P.g2;
    for (size_t i = (size_t)bid * NTHREADS + threadIdx.x; i < NG; i += (size_t)G * NTHREADS) {
        const float4 a = eu[2 * i], b = eu[2 * i + 1]; const int dq = (int)((2 * i) & 511); const float4 ga = g2[dq], gb = g2[dq + 1];
        ub[i] = make_uint4(pk2(a.x * ga.x, a.y * ga.y), pk2(a.z * ga.z, a.w * ga.w), pk2(b.x * gb.x, b.y * gb.y), pk2(b.z * gb.z, b.w * gb.w));
        const float4 c = ev[2 * i], d = ev[2 * i + 1];
        vb[i] = make_uint4(pk2(c.x, c.y), pk2(c.z, c.w), pk2(d.x, d.y), pk2(d.z, d.w));
    }
}

__device__ __forceinline__ void p2_conv(const Params& P, int nworkers, int wid) {
    const bf16_t* proj = (const bf16_t*)(P.ws + WS_PROJ); bf16_t* mix = (bf16_t*)(P.ws + WS_MIXIN);
    for (int idx = wid * NTHREADS + threadIdx.x; idx < T * 128; idx += nworkers * NTHREADS) {
        const int t = idx >> 7, c8 = (idx & 127) * 8, s = t & (SEQ - 1);
        float y[8];
#pragma unroll
        for (int i = 0; i < 8; ++i) y[i] = 0.f;
#pragma unroll
        for (int j = 0; j < 3; ++j) {
            const int dt = 2 - j;
            if (s >= dt) {
                const bf16_t* row = proj + (size_t)(t - dt) * NPROJ;
                float cx[8], cc[8]; unpack8(*(const uint4*)(row + PC_CX + c8), cx); unpack8(*(const uint4*)(row + PC_CC + c8), cc);
                const float4 w0 = *(const float4*)(P.conv_w + j * 1024 + c8), w1 = *(const float4*)(P.conv_w + j * 1024 + c8 + 4);
                y[0] += w0.x * (cc[0] * cx[0]); y[1] += w0.y * (cc[1] * cx[1]); y[2] += w0.z * (cc[2] * cx[2]); y[3] += w0.w * (cc[3] * cx[3]);
                y[4] += w1.x * (cc[4] * cx[4]); y[5] += w1.y * (cc[5] * cx[5]); y[6] += w1.z * (cc[6] * cx[6]); y[7] += w1.w * (cc[7] * cx[7]);
            }
        }
        float cb[8]; unpack8(*(const uint4*)(proj + (size_t)t * NPROJ + PC_CB + c8), cb);
        *(uint4*)(mix + (size_t)t * D + c8) = make_uint4(pk2(cb[0] * y[0], cb[1] * y[1]), pk2(cb[2] * y[2], cb[3] * y[3]), pk2(cb[4] * y[4], cb[5] * y[5]), pk2(cb[6] * y[6], cb[7] * y[7]));
    }
}
#define LAS3 __attribute__((address_space(3)))
typedef short s16x4_t __attribute__((ext_vector_type(4)));
typedef unsigned v4u_t __attribute__((ext_vector_type(4)));
typedef unsigned v2u_t __attribute__((ext_vector_type(2)));
__device__ __forceinline__ pg8::bf16x8 tr8(LAS3 unsigned char* p0, LAS3 unsigned char* p1) {
    const s16x4_t a = __builtin_amdgcn_ds_read_tr16_b64_v4i16((LAS3 s16x4_t*)p0), b = __builtin_amdgcn_ds_read_tr16_b64_v4i16((LAS3 s16x4_t*)p1);
    return __builtin_shufflevector(a, b, 0, 1, 2, 3, 4, 5, 6, 7);
}
__device__ __forceinline__ void mlstm_unit(const Params& P, unsigned char* lds_, int unit) {
    typedef pg8::bf16x8 bf16x8; typedef pg8::f32x4 f32x4;
    LAS3 unsigned char* L = (LAS3 unsigned char*)lds_;
    constexpr int QS = 0, KS = 33792, VA = 67584, WV = 73728, SW = 79872, CB = 89088, SM = 114432;
    constexpr int QST = 528, VST = 96, SST = 144;
    LAS3 float* sA = (LAS3 float*)(L + SM); LAS3 float* sM = sA + 64; LAS3 float* sEi = sA + 128; LAS3 float* sWl = sA + 192; LAS3 float* sEnm = sA + 256; LAS3 float* sDen = sA + 320; LAS3 float* sMisc = sA + 384;
    const int tid = threadIdx.x, lane = tid & 63, wave = __builtin_amdgcn_readfirstlane(tid >> 6);
    const int g = lane >> 4, c16 = lane & 15, q4 = c16 >> 2, p4 = lane & 3;
    const int bh = unit >> 3, sl = unit & 7, b = bh >> 2, h = bh & 3, v0 = sl * 32;
    const bf16_t* proj = (const bf16_t*)(P.ws + WS_PROJ);
    const float* gi = (const float*)(P.ws + WS_GI); const float* gf = (const float*)(P.ws + WS_GF);
    float* hraw = (float*)(P.ws + WS_HRAW);
    for (int i = tid; i < 25344 / 16; i += NTHREADS) *(LAS3 v4u_t*)(L + CB + i * 16) = (v4u_t){0u, 0u, 0u, 0u};
    if (tid < 64) { *(LAS3 v4u_t*)(L + VA + tid * VST + 64) = (v4u_t){0x00003F80u, 0u, 0u, 0u}; *(LAS3 v4u_t*)(L + VA + tid * VST + 80) = (v4u_t){0u, 0u, 0u, 0u}; }
    f32x4 accC[2][3];
#pragma unroll
    for (int dt = 0; dt < 2; ++dt)
#pragma unroll
        for (int vt = 0; vt < 3; ++vt) accC[dt][vt] = (f32x4){0.f, 0.f, 0.f, 0.f};
    float m = 0.f;
    const int row = tid >> 3, seg = tid & 7;
    v4u_t rq[4], rk[4], rv = (v4u_t){0u, 0u, 0u, 0u}; float ric = 0.f, rfc = 0.f;
    { const int t0 = b * SEQ; const bf16_t* src = proj + (size_t)(t0 + row) * NPROJ + h * DH + seg * 32;
#pragma unroll
      for (int i = 0; i < 4; ++i) { rq[i] = *(const v4u_t*)(src + PC_Q + i * 8); rk[i] = *(const v4u_t*)(src + PC_K + i * 8); }
      if (tid < 256) rv = *(const v4u_t*)(proj + (size_t)(t0 + (tid >> 2)) * NPROJ + PC_V + h * DH + v0 + (tid & 3) * 8);
      if (wave == 0) { ric = gi[(size_t)(t0 + lane) * 4 + h]; rfc = gf[(size_t)(t0 + lane) * 4 + h]; } }
    __syncthreads();
#pragma unroll 1
    for (int c = 0; c < SEQ / LCH; ++c) {
        const int t0 = b * SEQ + c * LCH;
#pragma unroll
        for (int i = 0; i < 4; ++i) { *(LAS3 v4u_t*)(L + QS + row * QST + seg * 64 + i * 16) = rq[i]; *(LAS3 v4u_t*)(L + KS + row * QST + seg * 64 + i * 16) = rk[i]; }
        if (tid < 256) *(LAS3 v4u_t*)(L + VA + (tid >> 2) * VST + (tid & 3) * 16) = rv;
        if (wave == 0) {
            float bc = rfc;
#pragma unroll
            for (int o = 1; o < 64; o <<= 1) { const float tv = __shfl_up(bc, o); if (lane >= o) bc += tv; }
            const float a = ric - bc; float pm = a;
#pragma unroll
            for (int o = 1; o < 64; o <<= 1) { const float tv = __shfl_up(pm, o); if (lane >= o) pm = fmaxf(pm, tv); }
            const float M = fmaxf(m, pm), M63 = __shfl(M, 63), b63 = __shfl(bc, 63);
            sA[lane] = a; sM[lane] = M; sEi[lane] = expf(m - M); sWl[lane] = expf(a - M63) * 0.0625f; sEnm[lane] = expf(-bc - M);
            if (lane == 0) { sMisc[0] = b63 + M63; sMisc[1] = expf(m - M63); }
        }
        if (c + 1 < SEQ / LCH) { const int t1 = t0 + LCH; const bf16_t* src = proj + (size_t)(t1 + row) * NPROJ + h * DH + seg * 32;
#pragma unroll
            for (int i = 0; i < 4; ++i) { rq[i] = *(const v4u_t*)(src + PC_Q + i * 8); rk[i] = *(const v4u_t*)(src + PC_K + i * 8); }
            if (tid < 256) rv = *(const v4u_t*)(proj + (size_t)(t1 + (tid >> 2)) * NPROJ + PC_V + h * DH + v0 + (tid & 3) * 8);
            if (wave == 0) { ric = gi[(size_t)(t1 + lane) * 4 + h]; rfc = gf[(size_t)(t1 + lane) * 4 + h]; } }
        __syncthreads();
        { const int rt = wave >> 1;
#pragma unroll
          for (int cc = 0; cc < 2; ++cc) { const int ct = (wave & 1) * 2 + cc; f32x4 acc = (f32x4){0.f, 0.f, 0.f, 0.f};
              if (ct <= rt) {
#pragma unroll
                  for (int ks = 0; ks < 8; ++ks) { const bf16x8 av = *(LAS3 bf16x8*)(L + QS + (rt * 16 + c16) * QST + (ks * 32 + g * 8) * 2), bv = *(LAS3 bf16x8*)(L + KS + (ct * 16 + c16) * QST + (ks * 32 + g * 8) * 2);
                      acc = __builtin_amdgcn_mfma_f32_16x16x32_bf16(av, bv, acc, 0, 0, 0); } }
              const int l = ct * 16 + c16; const float al = sA[l]; const f32x4 M4 = *(LAS3 f32x4*)(sM + rt * 16 + 4 * g);
#pragma unroll
              for (int r = 0; r < 4; ++r) { const int j = rt * 16 + 4 * g + r; const float val = (l <= j) ? acc[r] * 0.0625f * __expf(al - M4[r]) : 0.f;
                  *(LAS3 unsigned short*)(L + SW + j * SST + l * 2) = (unsigned short)f2bf(val); } } }
#pragma unroll
        for (int i = 0; i < 6; ++i) { const int e = tid + NTHREADS * i, l = e / 48, vp = e - l * 48;
            *(LAS3 unsigned short*)(L + WV + l * VST + vp * 2) = (unsigned short)f2bf(sWl[l] * bf1(*(LAS3 unsigned short*)(L + VA + l * VST + vp * 2))); }
        __syncthreads();
        const int rt = wave >> 1, vt = wave & 1;
        f32x4 num;
        { f32x4 accI = (f32x4){0.f, 0.f, 0.f, 0.f}, accX = (f32x4){0.f, 0.f, 0.f, 0.f};
#pragma unroll
          for (int ks = 0; ks < 8; ++ks) { const bf16x8 av = *(LAS3 bf16x8*)(L + QS + (rt * 16 + c16) * QST + (ks * 32 + g * 8) * 2), bv = *(LAS3 bf16x8*)(L + CB + (vt * 16 + c16) * QST + (ks * 32 + g * 8) * 2);
              accI = __builtin_amdgcn_mfma_f32_16x16x32_bf16(av, bv, accI, 0, 0, 0); }
#pragma unroll
          for (int ks = 0; ks < 2; ++ks) { const bf16x8 av = *(LAS3 bf16x8*)(L + SW + (rt * 16 + c16) * SST + (ks * 32 + g * 8) * 2);
              LAS3 unsigned char* vp = L + VA + (ks * 32 + g * 8 + q4) * VST + (vt * 16 + 4 * p4) * 2; const bf16x8 bv = tr8(vp, vp + 4 * VST);
              accX = __builtin_amdgcn_mfma_f32_16x16x32_bf16(av, bv, accX, 0, 0, 0); }
          const f32x4 e4 = *(LAS3 f32x4*)(sEi + rt * 16 + 4 * g);
          num = e4 * accI + accX;
          if ((wave & 1) == 0) {
              f32x4 aI = (f32x4){0.f, 0.f, 0.f, 0.f}, aX = (f32x4){0.f, 0.f, 0.f, 0.f};
#pragma unroll
              for (int ks = 0; ks < 8; ++ks) { const bf16x8 av = *(LAS3 bf16x8*)(L + QS + (rt * 16 + c16) * QST + (ks * 32 + g * 8) * 2), bv = *(LAS3 bf16x8*)(L + CB + (32 + c16) * QST + (ks * 32 + g * 8) * 2);
                  aI = __builtin_amdgcn_mfma_f32_16x16x32_bf16(av, bv, aI, 0, 0, 0); }
#pragma unroll
              for (int ks = 0; ks < 2; ++ks) { const bf16x8 av = *(LAS3 bf16x8*)(L + SW + (rt * 16 + c16) * SST + (ks * 32 + g * 8) * 2);
                  LAS3 unsigned char* vp = L + VA + (ks * 32 + g * 8 + q4) * VST + (32 + 4 * p4) * 2; const bf16x8 bv = tr8(vp, vp + 4 * VST);
                  aX = __builtin_amdgcn_mfma_f32_16x16x32_bf16(av, bv, aX, 0, 0, 0); }
              if (c16 == 0) {
#pragma unroll
                  for (int r = 0; r < 4; ++r) { const int j = rt * 16 + 4 * g + r; sDen[j] = fmaxf(fabsf(e4[r] * aI[r] + aX[r]), sEnm[j]); } }
          } }
        __syncthreads();
        { const f32x4 d4 = *(LAS3 f32x4*)(sDen + rt * 16 + 4 * g);
#pragma unroll
          for (int r = 0; r < 4; ++r) hraw[(size_t)(t0 + rt * 16 + 4 * g + r) * DML + h * DH + v0 + vt * 16 + c16] = num[r] / d4[r]; }
        { const float decay = sMisc[1];
#pragma unroll
          for (int dt = 0; dt < 2; ++dt)
#pragma unroll
              for (int v3 = 0; v3 < 3; ++v3) accC[dt][v3] *= decay;
#pragma unroll
          for (int ks = 0; ks < 2; ++ks) { bf16x8 af[2], bfr[3];
#pragma unroll
              for (int dt = 0; dt < 2; ++dt) { LAS3 unsigned char* kp = L + KS + (ks * 32 + g * 8 + q4) * QST + ((2 * wave + dt) * 16 + 4 * p4) * 2; af[dt] = tr8(kp, kp + 4 * QST); }
#pragma unroll
              for (int v3 = 0; v3 < 3; ++v3) { LAS3 unsigned char* wp = L + WV + (ks * 32 + g * 8 + q4) * VST + (v3 * 16 + 4 * p4) * 2; bfr[v3] = tr8(wp, wp + 4 * VST); }
#pragma unroll
              for (int dt = 0; dt < 2; ++dt)
#pragma unroll
                  for (int v3 = 0; v3 < 3; ++v3) accC[dt][v3] = __builtin_amdgcn_mfma_f32_16x16x32_bf16(af[dt], bfr[v3], accC[dt][v3], 0, 0, 0); }
#pragma unroll
          for (int dt = 0; dt < 2; ++dt)
#pragma unroll
              for (int v3 = 0; v3 < 3; ++v3) { const int d = (2 * wave + dt) * 16 + 4 * g, vp = v3 * 16 + c16;
                  *(LAS3 v2u_t*)(L + CB + vp * QST + d * 2) = (v2u_t){pk2(accC[dt][v3][0], accC[dt][v3][1]), pk2(accC[dt][v3][2], accC[dt][v3][3])}; }
          m = sMisc[0]; }
        __syncthreads();
    }
}

__device__ __forceinline__ void p3_finalize(const Params& P, int G, int bid) {
    const int lane = threadIdx.x & 63, wave = threadIdx.x >> 6;
    const float* hraw = (const float*)(P.ws + WS_HRAW); const bf16_t* proj = (const bf16_t*)(P.ws + WS_PROJ); bf16_t* mix = (bf16_t*)(P.ws + WS_MIXIN);
    for (int idx = bid * NWAVES + wave; idx < T * NH; idx += G * NWAVES) {
        const int t = idx >> 2, hh = idx & 3;
        const float4 hv = *(const float4*)(hraw + (size_t)t * DML + hh * DH + lane * 4);
        const float ss = wave_sum((hv.x * hv.x + hv.y * hv.y) + (hv.z * hv.z + hv.w * hv.w));
        const float r = rsqrtf(ss * (1.0f / DH) + EPS);
        const uint2 ow = *(const uint2*)(proj + (size_t)t * NPROJ + PC_O + hh * DH + lane * 4);
        const float4 g = *(const float4*)(P.gm + hh * DH + lane * 4);
        const float o0 = 1.0f / (1.0f + expf(-bflo(ow.x))), o1 = 1.0f / (1.0f + expf(-bfhi(ow.x))), o2 = 1.0f / (1.0f + expf(-bflo(ow.y))), o3 = 1.0f / (1.0f + expf(-bfhi(ow.y)));
        *(uint2*)(mix + (size_t)t * D + DML + hh * DH + lane * 4) = make_uint2(pk2(o0 * (hv.x * r * g.x), o1 * (hv.y * r * g.y)), pk2(o2 * (hv.z * r * g.z), o3 * (hv.w * r * g.w)));
    }
}

__device__ __forceinline__ void wave_argmax(float& v, int& i) {
#pragma unroll
    for (int o = 32; o >= 1; o >>= 1) { const float ov = __shfl_xor(v, o); const int oi = __shfl_xor(i, o); if (ov > v || (ov == v && oi < i)) { v = ov; i = oi; } }
}
__device__ __forceinline__ void p6_topk(const Params& P, unsigned char* lds, int G, int bid) {
    const int tid = threadIdx.x, lane = tid & 63, wave = tid >> 6;
    float* k1t = (float*)lds;
    float* k2t = k1t + 128 * 128;
    float* qb = k2t + 128 * 128 + wave * 256;
    for (int i = tid; i < 128 * 128; i += NTHREADS) { const int n = i >> 7, d = i & 127; k1t[d * 128 + n] = P.sk1[i]; k2t[d * 128 + n] = P.sk2[i]; }
    __syncthreads();
    const float* qv = (const float*)(P.ws + WS_QV); const float* ssq = (const float*)(P.ws + WS_SSQ);
    int* idxo = (int*)(P.ws + WS_IDX); float* gato = (float*)(P.ws + WS_GATE);
    const float NEG = -3.0e38f;
    for (int it = bid * NWAVES + wave; it < T * PEER_H; it += G * NWAVES) {
        const int t = it >> 3, hh = it & 7;
        const float rs2 = rsqrtf(wave_sum(lane < 32 ? ssq[(size_t)t * 32 + lane] : 0.f) * (1.0f / D) + EPS);
        *(float4*)(qb + lane * 4) = *(const float4*)(qv + (size_t)t * D + hh * 256 + lane * 4);
        asm volatile("s_waitcnt lgkmcnt(0)" ::: "memory");
        float s1a = 0.f, s1b = 0.f, s2a = 0.f, s2b = 0.f;
        for (int d4 = 0; d4 < 32; ++d4) {
            const float4 q1 = *(const float4*)(qb + d4 * 4), q2 = *(const float4*)(qb + 128 + d4 * 4);
            const float* r1 = k1t + (d4 * 4) * 128 + lane; const float* r2 = k2t + (d4 * 4) * 128 + lane;
            s1a += q1.x * r1[0] + q1.y * r1[128] + q1.z * r1[256] + q1.w * r1[384];
            s1b += q1.x * r1[64] + q1.y * r1[192] + q1.z * r1[320] + q1.w * r1[448];
            s2a += q2.x * r2[0] + q2.y * r2[128] + q2.z * r2[256] + q2.w * r2[384];
            s2b += q2.x * r2[64] + q2.y * r2[192] + q2.z * r2[320] + q2.w * r2[448];
        }
        asm volatile("" ::: "memory");
        float myv1 = 0.f, myv2 = 0.f; int myi1 = 0, myi2 = 0;
        for (int r = 0; r < TOPK; ++r) {
            float v = s1a; int i = lane; if (s1b > v) { v = s1b; i = lane + 64; }
            wave_argmax(v, i);
            if (lane == r) { myv1 = v; myi1 = i; }
            if (i == lane) s1a = NEG; if (i == lane + 64) s1b = NEG;
        }
        for (int r = 0; r < TOPK; ++r) {
            float v = s2a; int i = lane; if (s2b > v) { v = s2b; i = lane + 64; }
            wave_argmax(v, i);
            if (lane == r) { myv2 = v; myi2 = i; }
            if (i == lane) s2a = NEG; if (i == lane + 64) s2b = NEG;
        }
        const float va = __shfl(myv1, lane >> 2);
        float cv[4];
#pragma unroll
        for (int e = 0; e < 4; ++e) cv[e] = va + __shfl(myv2, (lane & 3) * 4 + e);
        float mysc = 0.f; int myci = 0;
        for (int r = 0; r < TOPK; ++r) {
            float v = cv[0]; int i = lane * 4;
#pragma unroll
            for (int e = 1; e < 4; ++e) if (cv[e] > v) { v = cv[e]; i = lane * 4 + e; }
            wave_argmax(v, i);
            if (lane == r) { mysc = v; myci = i; }
            if ((i >> 2) == lane) {
#pragma unroll
                for (int e = 0; e < 4; ++e) if ((i & 3) == e) cv[e] = NEG;
            }
        }
        const int ea = __shfl(myi1, (myci >> 4) & 15), eb = __shfl(myi2, myci & 15);
        const float smax = __shfl(mysc, 0);
        float ex = lane < TOPK ? expf((mysc - smax) * rs2) : 0.f;
        float den = ex;
#pragma unroll
        for (int o = 8; o >= 1; o >>= 1) den += __shfl_xor(den, o);
        if (lane < TOPK) { idxo[(size_t)t * 128 + hh * 16 + lane] = ea * 128 + eb; gato[(size_t)t * 128 + hh * 16 + lane] = ex / den; }
    }
    __syncthreads();
}

__device__ __forceinline__ void p7_peer(const Params& P, int G, int bid) {
    const int lane = threadIdx.x & 63, wave = threadIdx.x >> 6;
    const bf16_t* x1b = (const bf16_t*)(P.ws + WS_X1B); const float* x1 = (const float*)(P.ws + WS_X1); const float* ssq = (const float*)(P.ws + WS_SSQ);
    const int* idxi = (const int*)(P.ws + WS_IDX); const float* gati = (const float*)(P.ws + WS_GATE);
    const bf16_t* ub = (const bf16_t*)(P.ws + WS_UB); const bf16_t* vb = (const bf16_t*)(P.ws + WS_VB);
    for (int t = bid * NWAVES + wave; t < T; t += G * NWAVES) {
        const float rs2 = rsqrtf(wave_sum(lane < 32 ? ssq[(size_t)t * 32 + lane] : 0.f) * (1.0f / D) + EPS);
        float xf[4][8];
#pragma unroll
        for (int c = 0; c < 4; ++c) unpack8(*(const uint4*)(x1b + (size_t)t * D + c * 512 + lane * 8), xf[c]);
        float y[4][8];
#pragma unroll
        for (int c = 0; c < 4; ++c)
#pragma unroll
            for (int i = 0; i < 8; ++i) y[c][i] = 0.f;
#pragma unroll 1
        for (int hh = 0; hh < PEER_H; ++hh) {
            const int myidx = lane < TOPK ? idxi[(size_t)t * 128 + hh * 16 + lane] : 0;
            const float mygate = lane < TOPK ? gati[(size_t)t * 128 + hh * 16 + lane] : 0.f;
#pragma unroll 1
            for (int g = 0; g < 4; ++g) {
                float dsum[4];
#pragma unroll
                for (int e = 0; e < 4; ++e) {
                    const int ei = __builtin_amdgcn_readlane(myidx, g * 4 + e);
                    const bf16_t* ur = ub + (size_t)ei * D + lane * 8;
                    float s = 0.f;
#pragma unroll
                    for (int c = 0; c < 4; ++c) { float uf[8]; unpack8(*(const uint4*)(ur + c * 512), uf);
#pragma unroll
                        for (int i = 0; i < 8; ++i) s += xf[c][i] * uf[i]; }
                    dsum[e] = s;
                }
#pragma unroll
                for (int e = 0; e < 4; ++e) dsum[e] = wave_sum(dsum[e]);
#pragma unroll
                for (int e = 0; e < 4; ++e) {
                    const int ei = __builtin_amdgcn_readlane(myidx, g * 4 + e);
                    const float gt = __uint_as_float(__builtin_amdgcn_readlane(__float_as_uint(mygate), g * 4 + e));
                    const float cf = gt * gelu_erf(dsum[e] * rs2);
                    const bf16_t* vr = vb + (size_t)ei * D + lane * 8;
#pragma unroll
                    for (int c = 0; c < 4; ++c) { float vf[8]; unpack8(*(const uint4*)(vr + c * 512), vf);
#pragma unroll
                        for (int i = 0; i < 8; ++i) y[c][i] += cf * vf[i]; }
                }
            }
        }
        float ss = 0.f;
#pragma unroll
        for (int c = 0; c < 4; ++c) { const float4 a = *(const float4*)(x1 + (size_t)t * D + c * 512 + lane * 8), b = *(const float4*)(x1 + (size_t)t * D + c * 512 + lane * 8 + 4);
            y[c][0] += a.x; y[c][1] += a.y; y[c][2] += a.z; y[c][3] += a.w; y[c][4] += b.x; y[c][5] += b.y; y[c][6] += b.z; y[c][7] += b.w;
#pragma unroll
            for (int i = 0; i < 8; ++i) ss += y[c][i] * y[c][i]; }
        ss = wave_sum(ss);
        const float r = rsqrtf(ss * (1.0f / D) + EPS);
#pragma unroll
        for (int c = 0; c < 4; ++c) { const float4 ga = *(const float4*)(P.gfin + c * 512 + lane * 8), gb = *(const float4*)(P.gfin + c * 512 + lane * 8 + 4);
            *(float4*)(P.out + (size_t)t * D + c * 512 + lane * 8) = make_float4(y[c][0] * r * ga.x, y[c][1] * r * ga.y, y[c][2] * r * ga.z, y[c][3] * r * ga.w);
            *(float4*)(P.out + (size_t)t * D + c * 512 + lane * 8 + 4) = make_float4(y[c][4] * r * gb.x, y[c][5] * r * gb.y, y[c][6] * r * gb.z, y[c][7] * r * gb.w); }
    }
}

constexpr int N_PHASES = 8;
#ifndef MK_N_LAUNCHES
#define MK_N_LAUNCHES 1
#endif
__global__ void __launch_bounds__(NTHREADS, 2) layer_fwd(Params P) {
    extern __shared__ __attribute__((aligned(16))) unsigned char lds[];
    cg::grid_group grid = cg::this_grid();
    const int G = gridDim.x, bid = blockIdx.x;
    const int lo = P.ph_lo, hi = P.ph_hi;
#ifndef PH_MASK
#define PH_MASK 0xff
#endif
#define IN(k) (((PH_MASK >> (k)) & 1) && lo <= (k) && (k) < hi)
#define SEAM(k) do { if (IN(k) && IN((k) + 1)) grid.sync(); } while (0)
    if (IN(0)) { p0_rows(P, lds, G, bid); p0_weights(P, lds, G, bid); p0_tables(P, G, bid); }
    SEAM(0);
    if (IN(1)) {
        pg8::Gemm g{(const pg8::bf16_t*)(P.ws + WS_XB), (const pg8::bf16_t*)(P.ws + WS_WINT), T, NPROJ, D}; pg8::StaticOrder S; S.init(T, NPROJ, G, bid);
        pg8::EpiProj E{(pg8::bf16_t*)(P.ws + WS_PROJ), NPROJ, (const float*)(P.ws + WS_RS1)};
        pg8::gemm_phase<pg8::EpiProj, pg8::StaticOrder, true, true>((PG8_LAS unsigned char*)lds, g, S, E);
    }
    SEAM(1);
    if (IN(2)) {
        for (int u = bid; u < 64; u += G) mlstm_unit(P, lds, u);
        if (G > 64) { if (bid >= 64) p2_conv(P, G - 64, bid - 64); } else p2_conv(P, G, bid);
    }
    SEAM(2);
    if (IN(3)) p3_finalize(P, G, bid);
    SEAM(3);
    if (IN(4)) {
        pg8::Gemm g{(const pg8::bf16_t*)(P.ws + WS_MIXIN), (const pg8::bf16_t*)(P.ws + WS_WOUTT), T, D, D}; pg8::StaticOrder S; S.init(T, D, G, bid);
        pg8::EpiOut E{P.x, (float*)(P.ws + WS_X1), (pg8::bf16_t*)(P.ws + WS_X1B), (float*)(P.ws + WS_SSQ), D};
        pg8::gemm_phase<pg8::EpiOut, pg8::StaticOrder, true, true>((PG8_LAS unsigned char*)lds, g, S, E);
    }
    SEAM(4);
    if (IN(5)) {
        pg8::Gemm g{(const pg8::bf16_t*)(P.ws + WS_X1B), (const pg8::bf16_t*)(P.ws + WS_WQT), T, D, D}; pg8::StaticOrder S; S.init(T, D, G, bid);
        pg8::EpiQ E{(float*)(P.ws + WS_QV), D};
        pg8::gemm_phase<pg8::EpiQ, pg8::StaticOrder, true, true>((PG8_LAS unsigned char*)lds, g, S, E);
    }
    SEAM(5);
    if (IN(6)) p6_topk(P, lds, G, bid);
    SEAM(6);
    if (IN(7)) p7_peer(P, G, bid);
#undef IN
#undef SEAM
}

extern "C" void kernel_launch(void* const* d_in, const int* in_sizes, int n_in, void* d_out, int out_size, void* d_ws, size_t ws_size, hipStream_t stream) {
    static int grid = 0;
    if (grid == 0) {
        if (n_in != 15 || in_sizes[0] != T * D || out_size != T * D || ws_size < WS_END) { fprintf(stderr, "kernel_launch: unexpected shapes (n_in %d, in0 %d, out %d, ws %zu); nothing launched\n", n_in, n_in > 0 ? in_sizes[0] : -1, out_size, ws_size); grid = -1; return; }
        int dev = 0, cus = 0, per_cu = 0;
        if (hipGetDevice(&dev) != hipSuccess || hipDeviceGetAttribute(&cus, hipDeviceAttributeMultiprocessorCount, dev) != hipSuccess) { grid = -1; return; }
        if (hipFuncSetAttribute((const void*)layer_fwd, hipFuncAttributeMaxDynamicSharedMemorySize, LDS_BYTES) != hipSuccess) { fprintf(stderr, "kernel_launch: hipFuncSetAttribute failed\n"); grid = -1; return; }
        if (hipOccupancyMaxActiveBlocksPerMultiprocessor(&per_cu, (const void*)layer_fwd, NTHREADS, LDS_BYTES) != hipSuccess || per_cu < 1) { fprintf(stderr, "kernel_launch: occupancy query says %d blocks per CU\n", per_cu); (void)hipGetLastError(); grid = -1; return; }
        grid = cus;
    }
    if (grid < 0) return;
    Params p{};
    p.x = (const float*)d_in[0]; p.g1 = (const float*)d_in[1]; p.w_in = (const float*)d_in[2]; p.b_ig = (const float*)d_in[3]; p.b_fg = (const float*)d_in[4];
    p.conv_w = (const float*)d_in[5]; p.gm = (const float*)d_in[6]; p.w_out = (const float*)d_in[7]; p.g2 = (const float*)d_in[8]; p.w_q = (const float*)d_in[9];
    p.sk1 = (const float*)d_in[10]; p.sk2 = (const float*)d_in[11]; p.eu = (const float*)d_in[12]; p.ev = (const float*)d_in[13]; p.gfin = (const float*)d_in[14];
    p.out = (float*)d_out; p.ws = (unsigned char*)d_ws;
    for (int li = 0; li < MK_N_LAUNCHES; ++li) {
        p.ph_lo = (MK_N_LAUNCHES == 1) ? 0 : li; p.ph_hi = (MK_N_LAUNCHES == 1) ? N_PHASES : li + 1;
        void* args[] = {&p};
        const hipError_t e = hipLaunchCooperativeKernel((const void*)layer_fwd, dim3(grid), dim3(NTHREADS), args, LDS_BYTES, stream);
        if (e != hipSuccess) { fprintf(stderr, "kernel_launch: cooperative launch %d failed: %s (grid %d)\n", li, hipGetErrorString(e), grid); break; }
    }
}
```

```cpp
#include <hip/hip_runtime.h>
#include <hip/hip_cooperative_groups.h>
#include <cstdio>
#include <cstdint>
namespace cg = cooperative_groups;
namespace pg8 {
#define PG8_LAS __attribute__((address_space(3)))
typedef unsigned short bf16_t;
typedef short bf16x8 __attribute__((ext_vector_type(8)));
typedef float f32x4 __attribute__((ext_vector_type(4)));
typedef unsigned u32x4 __attribute__((ext_vector_type(4)));
constexpr int BM = 256, BK = 64, HALF = 128, HTB = HALF * BK * 2  , STAGE_BYTES = 8 * HTB, NXCD = 8, WGM = 8;

__host__ __device__ __forceinline__ int lds_byte(int r, int c) { const int st = (r >> 4) * 2 + (c >> 5), rr = r & 15, cc = c & 31, ob = rr * 64 + cc * 2; return st * 1024 + (ob ^ (((ob >> 9) & 1) << 5)); }
__host__ __device__ __forceinline__ void stage_rc(int b, int& R, int& C) { const int st = b / 1024, sb = b % 1024, swz = sb ^ (((sb >> 9) & 1) << 5); R = (st >> 1) * 16 + swz / 64; C = (st & 1) * 32 + (swz % 64) / 2; }
__host__ __device__ __forceinline__ int perm32(int rho) { const int n = rho >> 4, i = rho & 15; return 8 * (i >> 2) + 4 * n + (i & 3); }

struct Unit { int pm, pn; };
struct Gemm { const bf16_t* A; const bf16_t* Bt; int M, N, K; };

struct StaticOrder {
    int nM, nN, nwg, G, c;
    __host__ __device__ void init(int M, int N, int G_, int c_) { nM = M / BM; nN = N / BM; nwg = nM * nN; G = G_; c = c_; }
    __host__ __device__ bool next(int i, Unit& u) const {
        const long L = (long)i * G + c; if (L >= nwg) return false;
        int wgid = (int)L; { const int q = nwg / NXCD, r = nwg % NXCD, xcd = wgid % NXCD, off = wgid / NXCD; wgid = (xcd < r ? xcd * (q + 1) : r * (q + 1) + (xcd - r) * q) + off; }
        const int nig = WGM * nN, gid = wgid / nig, fm = gid * WGM, gsz = (nM - fm) < WGM ? (nM - fm) : WGM;
        u.pm = fm + ((wgid % nig) % gsz); u.pn = (wgid % nig) / gsz; return true;
    }
    __device__ __forceinline__ void a_ready(const Unit&) const {}
    __device__ __forceinline__ void done(const Unit&) const {}
};

__device__ __forceinline__ unsigned cvt_pk_bf16(float lo, float hi) { unsigned r; asm volatile("v_cvt_pk_bf16_f32 %0, %1, %2" : "=v"(r) : "v"(lo), "v"(hi)); return r; }
struct EpiProj {
    static constexpr bool PERM = true, AFTER_DRAIN = false;
    bf16_t* O; int ldc; const float* rs;
    __device__ __forceinline__ void operator()(const f32x4 (&acc)[2][2][4][2], const Unit& u, int wr, int wc, int fr, int fq) const {
        const int row0 = u.pm * BM + wr * 64 + fr, col0 = u.pn * BM + wc * 32 + 8 * fq;
#pragma unroll
        for (int ai = 0; ai < 2; ++ai)
#pragma unroll
            for (int m = 0; m < 4; ++m) { const int row = row0 + ai * HALF + m * 16; const float s = rs[row]; bf16_t* rowp = O + (size_t)row * ldc + col0;
#pragma unroll
                for (int bj = 0; bj < 2; ++bj) { const f32x4 v0 = acc[ai][bj][m][0] * s, v1 = acc[ai][bj][m][1] * s; u32x4 w;
                    w.x = cvt_pk_bf16(v0[0], v0[1]); w.y = cvt_pk_bf16(v0[2], v0[3]); w.z = cvt_pk_bf16(v1[0], v1[1]); w.w = cvt_pk_bf16(v1[2], v1[3]);
                    *(u32x4*)(rowp + bj * HALF) = w; } }
    }
};
struct EpiOut {
    static constexpr bool PERM = false, AFTER_DRAIN = false;
    const float* X; float* X1; bf16_t* X1B; float* SSQ; int ldc;
    __device__ __forceinline__ void operator()(const f32x4 (&acc)[2][2][4][2], const Unit& u, int wr, int wc, int fr, int fq) const {
        typedef unsigned u32x2 __attribute__((ext_vector_type(2)));
        const int row0 = u.pm * BM + wr * 64 + fr, col0 = u.pn * BM + wc * 32 + 4 * fq;
#pragma unroll
        for (int ai = 0; ai < 2; ++ai)
#pragma unroll
            for (int m = 0; m < 4; ++m) { const int row = row0 + ai * HALF + m * 16; const size_t off = (size_t)row * ldc + col0; float ss = 0.f;
#pragma unroll
                for (int bj = 0; bj < 2; ++bj)
#pragma unroll
                    for (int n = 0; n < 2; ++n) { const size_t c = off + bj * HALF + n * 16; const f32x4 xv = *(const f32x4*)(X + c); const f32x4 o = xv + acc[ai][bj][m][n];
                        *(f32x4*)(X1 + c) = o; ss += (o[0] * o[0] + o[1] * o[1]) + (o[2] * o[2] + o[3] * o[3]);
                        u32x2 pk; pk.x = cvt_pk_bf16(o[0], o[1]); pk.y = cvt_pk_bf16(o[2], o[3]); *(u32x2*)(X1B + c) = pk; }
                ss += __shfl_xor(ss, 16); ss += __shfl_xor(ss, 32);
                if (fq == 0) SSQ[(size_t)row * 32 + u.pn * 4 + wc] = ss; }
    }
};
struct EpiQ {
    static constexpr bool PERM = false, AFTER_DRAIN = false;
    float* O; int ldc;
    __device__ __forceinline__ void operator()(const f32x4 (&acc)[2][2][4][2], const Unit& u, int wr, int wc, int fr, int fq) const {
        const int row0 = u.pm * BM + wr * 64 + fr, col0 = u.pn * BM + wc * 32 + 4 * fq;
#pragma unroll
        for (int ai = 0; ai < 2; ++ai)
#pragma unroll
            for (int m = 0; m < 4; ++m) { const size_t off = (size_t)(row0 + ai * HALF + m * 16) * ldc + col0;
#pragma unroll
                for (int bj = 0; bj < 2; ++bj)
#pragma unroll
                    for (int n = 0; n < 2; ++n) *(f32x4*)(O + off + bj * HALF + n * 16) = acc[ai][bj][m][n]; }
    }
};
struct EpiQb {
    static constexpr bool PERM = true, AFTER_DRAIN = false;
    bf16_t* O; int ldc; const float* SSQ;
    __device__ __forceinline__ void operator()(const f32x4 (&acc)[2][2][4][2], const Unit& u, int wr, int wc, int fr, int fq) const {
        const int row0 = u.pm * BM + wr * 64 + fr, col0 = u.pn * BM + wc * 32 + 8 * fq;
#pragma unroll
        for (int ai = 0; ai < 2; ++ai)
#pragma unroll
            for (int m = 0; m < 4; ++m) { const int row = row0 + ai * HALF + m * 16; const f32x4* sp = (const f32x4*)(SSQ + (size_t)row * 32);
                f32x4 s4 = sp[0];
#pragma unroll
                for (int i = 1; i < 8; ++i) s4 += sp[i];
                const float s = rsqrtf(((s4[0] + s4[1]) + (s4[2] + s4[3])) * (1.0f / 2048.0f) + 1e-6f); bf16_t* rowp = O + (size_t)row * ldc + col0;
#pragma unroll
                for (int bj = 0; bj < 2; ++bj) { const f32x4 v0 = acc[ai][bj][m][0] * s, v1 = acc[ai][bj][m][1] * s; u32x4 w;
                    w.x = cvt_pk_bf16(v0[0], v0[1]); w.y = cvt_pk_bf16(v0[2], v0[3]); w.z = cvt_pk_bf16(v1[0], v1[1]); w.w = cvt_pk_bf16(v1[2], v1[3]);
                    *(u32x4*)(rowp + bj * HALF) = w; } }
    }
};
template <class Epi, class Sched, bool ALIGN_EPI = false, bool SP2 = false>
__device__ __forceinline__ void gemm_phase(PG8_LAS unsigned char* lds, const Gemm g, const Sched& S, const Epi& E) {
    const int tid = threadIdx.x, wid = __builtin_amdgcn_readfirstlane(tid >> 6), lane = tid & 63, wr = wid >> 2, wc = wid & 3, fr = lane & 15, fq = lane >> 4;
    const int K = g.K, nt = K / BK;
    unsigned voffA[2], voffB[2];
#pragma unroll
    for (int i = 0; i < 2; ++i) { int R, C; stage_rc(tid * 16 + i * 8192, R, C); const int Rb = Epi::PERM ? ((R & ~31) + perm32(R & 31)) : R;
        voffA[i] = (unsigned)(R * K + C) * 2u; voffB[i] = (unsigned)(Rb * K + C) * 2u; }
    const size_t kstep = (size_t)(BK * 2);
    const size_t hstep = (size_t)HALF * K * 2;
    const size_t tstep = 2 * hstep;
    const unsigned ldsw = (unsigned)wid * 1024u;
    const int aoff = lds_byte(wr * 64 + fr, fq * 8), boff = lds_byte(wc * 32 + fr, fq * 8);
#define PG8_SA(b, h) (((b) * 2 + (h)) * HTB)
#define PG8_SB(b, h) ((4 + (b) * 2 + (h)) * HTB)
#define PG8_STAGE(bufoff, gbase, voff) do { _Pragma("unroll") for (int _i = 0; _i < 2; ++_i) \
        __builtin_amdgcn_global_load_lds((const unsigned*)((const char*)(gbase) + (voff)[_i]), (PG8_LAS unsigned*)(lds + (bufoff) + ldsw + _i * 8192), 16, 0, 0); } while (0)
#define PG8_LDA(dst, b, h) do { _Pragma("unroll") for (int m = 0; m < 4; ++m) _Pragma("unroll") for (int k = 0; k < 2; ++k) dst[m][k] = *(const PG8_LAS bf16x8*)(lds + PG8_SA(b, h) + aoff + m * 2048 + k * 1024); } while (0)
#define PG8_LDB(dst, b, h) do { _Pragma("unroll") for (int n = 0; n < 2; ++n) _Pragma("unroll") for (int k = 0; k < 2; ++k) dst[n][k] = *(const PG8_LAS bf16x8*)(lds + PG8_SB(b, h) + boff + n * 2048 + k * 1024); } while (0)
#define PG8_MMA(ai, bj, At, Bt) do { __builtin_amdgcn_s_setprio(1); _Pragma("unroll") for (int m = 0; m < 4; ++m) _Pragma("unroll") for (int n = 0; n < 2; ++n) _Pragma("unroll") for (int k = 0; k < 2; ++k) \
        acc[ai][bj][m][n] = __builtin_amdgcn_mfma_f32_16x16x32_bf16(Bt[n][k], At[m][k], acc[ai][bj][m][n], 0, 0, 0); __builtin_amdgcn_s_setprio(0); } while (0)
#define PG8_WAIT_V(n) asm volatile("s_waitcnt vmcnt(" #n ")" ::: "memory")
#define PG8_WAIT_L(n) asm volatile("s_waitcnt lgkmcnt(" #n ")" ::: "memory")
#define PG8_BAR __builtin_amdgcn_s_barrier()
#define PG8_SCHED __builtin_amdgcn_sched_barrier(0)
    Unit cur, nxt; int ui = 0;
    if (!S.next(0, cur)) return;
    f32x4 acc[2][2][4][2];
#pragma unroll
    for (int a = 0; a < 2; ++a)
#pragma unroll
        for (int b = 0; b < 2; ++b)
#pragma unroll
            for (int m = 0; m < 4; ++m)
#pragma unroll
                for (int n = 0; n < 2; ++n) acc[a][b][m][n] = (f32x4){0.f, 0.f, 0.f, 0.f};
    bf16x8 At[4][2], B0[2][2], B1[2][2];
    const char* cA = (const char*)g.A + (size_t)cur.pm * tstep; const char* cB = (const char*)g.Bt + (size_t)cur.pn * tstep;
    S.a_ready(cur);
    if constexpr (SP2) {
        PG8_STAGE(PG8_SB(0, 0), cB, voffB); PG8_STAGE(PG8_SB(0, 1), cB + hstep, voffB); PG8_STAGE(PG8_SA(0, 0), cA, voffA); PG8_STAGE(PG8_SA(0, 1), cA + hstep, voffA);
        if (wr == 1) PG8_BAR;
        PG8_WAIT_V(2); PG8_BAR;
        PG8_STAGE(PG8_SB(1, 0), cB + kstep, voffB); PG8_STAGE(PG8_SA(1, 0), cA + kstep, voffA); PG8_STAGE(PG8_SB(1, 1), cB + hstep + kstep, voffB);
        PG8_WAIT_V(6); PG8_BAR;
    } else {
        PG8_STAGE(PG8_SB(0, 0), cB, voffB); PG8_STAGE(PG8_SA(0, 0), cA, voffA); PG8_STAGE(PG8_SB(0, 1), cB + hstep, voffB); PG8_STAGE(PG8_SA(0, 1), cA + hstep, voffA);
        if (wr == 1) PG8_BAR;
        PG8_WAIT_V(4); PG8_BAR;
        PG8_STAGE(PG8_SB(1, 0), cB + kstep, voffB); PG8_STAGE(PG8_SA(1, 0), cA + kstep, voffA); PG8_STAGE(PG8_SB(1, 1), cB + hstep + kstep, voffB);
        PG8_WAIT_V(6); PG8_BAR;
    }
    for (;;) {
        const bool has_next = S.next(ui + 1, nxt);
        const char* nA = has_next ? (const char*)g.A + (size_t)nxt.pm * tstep : cA; const char* nB = has_next ? (const char*)g.Bt + (size_t)nxt.pn * tstep : cB;
        for (int t = 0; t < nt; t += 2) {
            const bool last = (t == nt - 2);
            const char* a1 = cA + (size_t)(t + 1) * kstep;
            const char* a2 = last ? nA : cA + (size_t)(t + 2) * kstep; const char* b2 = last ? nB : cB + (size_t)(t + 2) * kstep;
            const char* a3 = a2 + kstep; const char* b3 = b2 + kstep;
            if (last && has_next) S.a_ready(nxt);
            if constexpr (SP2) {
            PG8_LDB(B0, 0, 0); PG8_LDB(B1, 0, 1); PG8_SCHED; PG8_LDA(At, 0, 0); PG8_STAGE(PG8_SA(1, 1), a1 + hstep, voffA);
            PG8_WAIT_V(8); PG8_WAIT_L(0); PG8_BAR; PG8_MMA(0, 0, At, B0); PG8_MMA(0, 1, At, B1); PG8_BAR; PG8_SCHED;
            PG8_LDA(At, 0, 1); PG8_STAGE(PG8_SB(0, 0), b2, voffB); PG8_STAGE(PG8_SB(0, 1), b2 + hstep, voffB); PG8_STAGE(PG8_SA(0, 0), a2, voffA);
            PG8_WAIT_V(8); PG8_WAIT_L(0); PG8_BAR; PG8_MMA(1, 0, At, B0); PG8_MMA(1, 1, At, B1); PG8_BAR; PG8_SCHED;
            PG8_LDB(B0, 1, 0); PG8_LDB(B1, 1, 1); PG8_SCHED; PG8_LDA(At, 1, 0); PG8_STAGE(PG8_SA(0, 1), a2 + hstep, voffA);
            PG8_WAIT_V(8); PG8_WAIT_L(0); PG8_BAR; PG8_MMA(0, 0, At, B0); PG8_MMA(0, 1, At, B1); PG8_BAR; PG8_SCHED;
            PG8_LDA(At, 1, 1); PG8_STAGE(PG8_SB(1, 0), b3, voffB); PG8_STAGE(PG8_SB(1, 1), b3 + hstep, voffB); PG8_STAGE(PG8_SA(1, 0), a3, voffA);
            PG8_WAIT_V(8); PG8_WAIT_L(0); PG8_BAR; PG8_MMA(1, 0, At, B0); PG8_MMA(1, 1, At, B1); PG8_BAR; PG8_SCHED;
            } else {
            PG8_LDB(B0, 0, 0); PG8_SCHED; PG8_LDA(At, 0, 0); PG8_STAGE(PG8_SA(1, 1), a1 + hstep, voffA);
            PG8_WAIT_L(8); PG8_BAR; PG8_WAIT_L(0); PG8_MMA(0, 0, At, B0); PG8_BAR; PG8_SCHED;
            PG8_LDB(B1, 0, 1); PG8_STAGE(PG8_SB(0, 0), b2, voffB);
            PG8_BAR; PG8_WAIT_L(0); PG8_MMA(0, 1, At, B1); PG8_BAR;
            PG8_LDA(At, 0, 1); PG8_STAGE(PG8_SA(0, 0), a2, voffA);
            PG8_BAR; PG8_WAIT_L(0); PG8_MMA(1, 0, At, B0); PG8_BAR; PG8_SCHED;
            PG8_STAGE(PG8_SB(0, 1), b2 + hstep, voffB);
            PG8_WAIT_V(6); PG8_BAR; PG8_MMA(1, 1, At, B1); PG8_BAR;
            PG8_LDB(B0, 1, 0); PG8_SCHED; PG8_LDA(At, 1, 0); PG8_STAGE(PG8_SA(0, 1), a2 + hstep, voffA);
            PG8_WAIT_L(8); PG8_BAR; PG8_WAIT_L(0); PG8_MMA(0, 0, At, B0); PG8_BAR; PG8_SCHED;
            PG8_LDB(B1, 1, 1); PG8_STAGE(PG8_SB(1, 0), b3, voffB);
            PG8_BAR; PG8_WAIT_L(0); PG8_MMA(0, 1, At, B1); PG8_BAR;
            PG8_LDA(At, 1, 1); PG8_STAGE(PG8_SA(1, 0), a3, voffA);
            PG8_BAR; PG8_WAIT_L(0); PG8_MMA(1, 0, At, B0); PG8_BAR; PG8_SCHED;
            PG8_STAGE(PG8_SB(1, 1), b3 + hstep, voffB);
            PG8_WAIT_V(6); PG8_BAR; PG8_MMA(1, 1, At, B1); PG8_BAR;
            }
        }
        if constexpr (ALIGN_EPI) { if (wr == 0) PG8_BAR; }
        if constexpr (!Epi::AFTER_DRAIN) { E(acc, cur, wr, wc, fr, fq); S.done(cur); }
        if (!has_next) break;
#pragma unroll
        for (int a = 0; a < 2; ++a)
#pragma unroll
            for (int b = 0; b < 2; ++b)
#pragma unroll
                for (int m = 0; m < 4; ++m)
#pragma unroll
                    for (int n = 0; n < 2; ++n) acc[a][b][m][n] = (f32x4){0.f, 0.f, 0.f, 0.f};
        cur = nxt; cA = nA; cB = nB; ++ui;
        if constexpr (ALIGN_EPI) { if (wr == 1) PG8_BAR; }
    }
    PG8_WAIT_V(0);
    if constexpr (!ALIGN_EPI) { if (wr == 0) PG8_BAR; }
    PG8_BAR;
    if constexpr (Epi::AFTER_DRAIN) { E.fused(acc, cur, wr, wc, fr, fq, lds, wid, lane); S.done(cur); }
#undef PG8_SA
#undef PG8_SB
#undef PG8_STAGE
#undef PG8_LDA
#undef PG8_LDB
#undef PG8_MMA
#undef PG8_WAIT_V
#undef PG8_WAIT_L
#undef PG8_BAR
#undef PG8_SCHED
}
}
constexpr int T = 8192, SEQ = 4096, D = 2048, NPROJ = 7168, NIN = 7176;
constexpr int NH = 4, DH = 256, LCH = 64, DML = 1024;
constexpr int NEXP = 16384, PEER_H = 8, TOPK = 16;
constexpr float EPS = 1e-6f;
constexpr int PC_CX = 0, PC_CB = 1024, PC_CC = 2048, PC_Q = 3072, PC_K = 4096, PC_V = 5120, PC_O = 6144;
constexpr int NTHREADS = 512, NWAVES = 8;
constexpr int LDS_BYTES = 147456;

constexpr size_t MiB = 1u << 20;
constexpr size_t WS_CTL = 0, CTL_ZERO_BYTES = 64 * 1024;
constexpr size_t WS_RS1 = 1 * MiB, WS_GI = 1 * MiB + 64 * 1024, WS_GF = 1 * MiB + 256 * 1024, WS_SSQ = 3 * MiB;
constexpr size_t WS_XB = 5 * MiB, WS_WINT = 37 * MiB, WS_WOUTT = 65 * MiB, WS_WQT = 73 * MiB;
constexpr size_t WS_PROJ = 81 * MiB;
constexpr size_t WS_X1 = 81 * MiB, WS_X1B = 145 * MiB;
constexpr size_t WS_HRAW = 193 * MiB, WS_MIXIN = 225 * MiB, WS_QV = 257 * MiB, WS_IDX = 321 * MiB, WS_GATE = 325 * MiB;
constexpr size_t WS_UB = 329 * MiB, WS_VB = 393 * MiB, WS_END = 457 * MiB;

struct Params {
    const float *x, *g1, *w_in, *b_ig, *b_fg, *conv_w, *gm, *w_out, *g2, *w_q, *sk1, *sk2, *eu, *ev, *gfin;
    float* out; unsigned char* ws;
    int ph_lo, ph_hi;
};

typedef unsigned short bf16_t;
__device__ __forceinline__ unsigned f2bf(float f) { unsigned u = __float_as_uint(f); return (u + 0x7fffu + ((u >> 16) & 1u)) >> 16; }
__device__ __forceinline__ unsigned pk2(float lo, float hi) { return f2bf(lo) | (f2bf(hi) << 16); }
__device__ __forceinline__ float bflo(unsigned w) { return __uint_as_float(w << 16); }
__device__ __forceinline__ float bfhi(unsigned w) { return __uint_as_float(w & 0xffff0000u); }
__device__ __forceinline__ float bf1(bf16_t h) { return __uint_as_float((unsigned)h << 16); }
__device__ __forceinline__ float wave_sum(float v) {
#pragma unroll
    for (int o = 32; o >= 1; o >>= 1) v += __shfl_xor(v, o);
    return v;
}
__device__ __forceinline__ void unpack8(const uint4 w, float (&f)[8]) {
    f[0] = bflo(w.x); f[1] = bfhi(w.x); f[2] = bflo(w.y); f[3] = bfhi(w.y); f[4] = bflo(w.z); f[5] = bfhi(w.z); f[6] = bflo(w.w); f[7] = bfhi(w.w);
}
__device__ __forceinline__ float log_sigmoid(float z) { return z >= 0.f ? -log1pf(expf(-z)) : z - log1pf(expf(z)); }
__device__ __forceinline__ float gelu_erf(float v) { return 0.5f * v * (1.0f + erff(v * 0.70710678118654752f)); }

__device__ __forceinline__ void p0_rows(const Params& P, unsigned char* lds, int G, int bid) {
    float* wg = (float*)lds;
    const int tid = threadIdx.x, lane = tid & 63, wave = tid >> 6;
    for (int i = tid; i < 8 * D; i += NTHREADS) { const int g = i >> 11, k = i & 2047; wg[i] = P.w_in[(size_t)k * NIN + NPROJ + g] * P.g1[k]; }
    __syncthreads();
    float* rs1 = (float*)(P.ws + WS_RS1); float* gi = (float*)(P.ws + WS_GI); float* gf = (float*)(P.ws + WS_GF); bf16_t* xb = (bf16_t*)(P.ws + WS_XB);
    for (int t = bid * NWAVES + wave; t < T; t += G * NWAVES) {
        const float4* xr = (const float4*)(P.x + (size_t)t * D);
        float ss = 0.f, dg[8];
#pragma unroll
        for (int g = 0; g < 8; ++g) dg[g] = 0.f;
#pragma unroll 1
        for (int j = 0; j < 8; ++j) {
            const float4 v = xr[j * 64 + lane];
            ss += (v.x * v.x + v.y * v.y) + (v.z * v.z + v.w * v.w);
            const int k0 = (j * 64 + lane) * 4;
#pragma unroll
            for (int g = 0; g < 8; ++g) { const float4 w = *(const float4*)(wg + g * D + k0); dg[g] += (v.x * w.x + v.y * w.y) + (v.z * w.z + v.w * w.w); }
            ((uint2*)(xb + (size_t)t * D))[j * 64 + lane] = make_uint2(pk2(v.x, v.y), pk2(v.z, v.w));
        }
        ss = wave_sum(ss);
#pragma unroll
        for (int g = 0; g < 8; ++g) dg[g] = wave_sum(dg[g]);
        const float rs = rsqrtf(ss * (1.0f / D) + EPS);
        if (lane == 0) {
            rs1[t] = rs;
#pragma unroll
            for (int h = 0; h < 4; ++h) { gi[t * 4 + h] = rs * dg[h] + P.b_ig[h]; gf[t * 4 + h] = log_sigmoid(rs * dg[4 + h] + P.b_fg[h]); }
        }
    }
    __syncthreads();
}
__device__ __forceinline__ void transpose_tile(const float* W, int ldw, int K, const float* gain, bf16_t* WT, int k0, int n0, float* tile) {
    const int tid = threadIdx.x;
#pragma unroll
    for (int r = 0; r < 2; ++r) {
        const int kk = (tid >> 4) + 32 * r, n4 = (tid & 15) * 4;
        float4 v = *(const float4*)(W + (size_t)(k0 + kk) * ldw + n0 + n4);
        const float g = gain ? gain[k0 + kk] : 1.0f;
        tile[kk * 65 + n4 + 0] = v.x * g; tile[kk * 65 + n4 + 1] = v.y * g; tile[kk * 65 + n4 + 2] = v.z * g; tile[kk * 65 + n4 + 3] = v.w * g;
    }
    __syncthreads();
    { const int nn = tid >> 3, k8 = (tid & 7) * 8; float f[8];
#pragma unroll
      for (int i = 0; i < 8; ++i) f[i] = tile[(k8 + i) * 65 + nn];
      *(uint4*)(WT + (size_t)(n0 + nn) * K + k0 + k8) = make_uint4(pk2(f[0], f[1]), pk2(f[2], f[3]), pk2(f[4], f[5]), pk2(f[6], f[7])); }
    __syncthreads();
}
__device__ __forceinline__ void p0_weights(const Params& P, unsigned char* lds, int G, int bid) {
    float* tile = (float*)lds;
    constexpr int N_IN = (D / 64) * (NPROJ / 64), N_SQ = (D / 64) * (D / 64);
    for (int it = bid; it < N_IN + 2 * N_SQ; it += G) {
        if (it < N_IN) { const int kt = it / (NPROJ / 64), nt = it % (NPROJ / 64); transpose_tile(P.w_in, NIN, D, P.g1, (bf16_t*)(P.ws + WS_WINT), kt * 64, nt * 64, tile); }
        else if (it < N_IN + N_SQ) { const int j = it - N_IN, kt = j / (D / 64), nt = j % (D / 64); transpose_tile(P.w_out, D, D, nullptr, (bf16_t*)(P.ws + WS_WOUTT), kt * 64, nt * 64, tile); }
        else { const int j = it - N_IN - N_SQ, kt = j / (D / 64), nt = j % (D / 64); transpose_tile(P.w_q, D, D, P.g2, (bf16_t*)(P.ws + WS_WQT), kt * 64, nt * 64, tile); }
    }
}
__device__ __forceinline__ void p0_tables(const Params& P, int G, int bid) {
    const size_t NG = (size_t)NEXP * D / 8;
    uint4* ub = (uint4*)(P.ws + WS_UB); uint4* vb = (uint4*)(P.ws + WS_VB);
    const float4* eu = (const float4*)P.eu; const float4* ev = (const float4*)P.ev; const float4* g2 = (const float4*)P.g2;
    for (size_t i = (size_t)bid * NTHREADS + threadIdx.x; i < NG; i += (size_t)G * NTHREADS) {
        const float4 a = eu[2 * i], b = eu[2 * i + 1]; const int dq = (int)((2 * i) & 511); const float4 ga = g2[dq], gb = g2[dq + 1];
        ub[i] = make_uint4(pk2(a.x * ga.x, a.y * ga.y), pk2(a.z * ga.z, a.w * ga.w), pk2(b.x * gb.x, b.y * gb.y), pk2(b.z * gb.z, b.w * gb.w));
        const float4 c = ev[2 * i], d = ev[2 * i + 1];
        vb[i] = make_uint4(pk2(c.x, c.y), pk2(c.z, c.w), pk2(d.x, d.y), pk2(d.z, d.w));
    }
}

__device__ __forceinline__ void p2_conv(const Params& P, int nworkers, int wid) {
    const bf16_t* proj = (const bf16_t*)(P.ws + WS_PROJ); bf16_t* mix = (bf16_t*)(P.ws + WS_MIXIN);
    for (int idx = wid * NTHREADS + threadIdx.x; idx < T * 128; idx += nworkers * NTHREADS) {
        const int t = idx >> 7, c8 = (idx & 127) * 8, s = t & (SEQ - 1);
        float y[8];
#pragma unroll
        for (int i = 0; i < 8; ++i) y[i] = 0.f;
#pragma unroll
        for (int j = 0; j < 3; ++j) {
            const int dt = 2 - j;
            if (s >= dt) {
                const bf16_t* row = proj + (size_t)(t - dt) * NPROJ;
                float cx[8], cc[8]; unpack8(*(const uint4*)(row + PC_CX + c8), cx); unpack8(*(const uint4*)(row + PC_CC + c8), cc);
                const float4 w0 = *(const float4*)(P.conv_w + j * 1024 + c8), w1 = *(const float4*)(P.conv_w + j * 1024 + c8 + 4);
                y[0] += w0.x * (cc[0] * cx[0]); y[1] += w0.y * (cc[1] * cx[1]); y[2] += w0.z * (cc[2] * cx[2]); y[3] += w0.w * (cc[3] * cx[3]);
                y[4] += w1.x * (cc[4] * cx[4]); y[5] += w1.y * (cc[5] * cx[5]); y[6] += w1.z * (cc[6] * cx[6]); y[7] += w1.w * (cc[7] * cx[7]);
            }
        }
        float cb[8]; unpack8(*(const uint4*)(proj + (size_t)t * NPROJ + PC_CB + c8), cb);
        *(uint4*)(mix + (size_t)t * D + c8) = make_uint4(pk2(cb[0] * y[0], cb[1] * y[1]), pk2(cb[2] * y[2], cb[3] * y[3]), pk2(cb[4] * y[4], cb[5] * y[5]), pk2(cb[6] * y[6], cb[7] * y[7]));
    }
}
#define LAS3 __attribute__((address_space(3)))
typedef short s16x4_t __attribute__((ext_vector_type(4)));
typedef unsigned v4u_t __attribute__((ext_vector_type(4)));
typedef unsigned v2u_t __attribute__((ext_vector_type(2)));
__device__ __forceinline__ pg8::bf16x8 tr8(LAS3 unsigned char* p0, LAS3 unsigned char* p1) {
    const s16x4_t a = __builtin_amdgcn_ds_read_tr16_b64_v4i16((LAS3 s16x4_t*)p0), b = __builtin_amdgcn_ds_read_tr16_b64_v4i16((LAS3 s16x4_t*)p1);
    return __builtin_shufflevector(a, b, 0, 1, 2, 3, 4, 5, 6, 7);
}
__device__ __forceinline__ void mlstm_unit(const Params& P, unsigned char* lds_, int unit) {
    typedef pg8::bf16x8 bf16x8; typedef pg8::f32x4 f32x4;
    LAS3 unsigned char* L = (LAS3 unsigned char*)lds_;
    constexpr int QS = 0, KS = 33792, VA = 67584, WV = 73728, SW = 79872, CB = 89088, SM = 114432;
    constexpr int QST = 528, VST = 96, SST = 144;
    LAS3 float* sA = (LAS3 float*)(L + SM); LAS3 float* sM = sA + 64; LAS3 float* sEi = sA + 128; LAS3 float* sWl = sA + 192; LAS3 float* sEnm = sA + 256; LAS3 float* sDen = sA + 320; LAS3 float* sMisc = sA + 384;
    const int tid = threadIdx.x, lane = tid & 63, wave = __builtin_amdgcn_readfirstlane(tid >> 6);
    const int g = lane >> 4, c16 = lane & 15, q4 = c16 >> 2, p4 = lane & 3;
    const int bh = unit >> 3, sl = unit & 7, b = bh >> 2, h = bh & 3, v0 = sl * 32;
    const bf16_t* proj = (const bf16_t*)(P.ws + WS_PROJ);
    const float* gi = (const float*)(P.ws + WS_GI); const float* gf = (const float*)(P.ws + WS_GF);
    float* hraw = (float*)(P.ws + WS_HRAW);
    for (int i = tid; i < 25344 / 16; i += NTHREADS) *(LAS3 v4u_t*)(L + CB + i * 16) = (v4u_t){0u, 0u, 0u, 0u};
    if (tid < 64) { *(LAS3 v4u_t*)(L + VA + tid * VST + 64) = (v4u_t){0x00003F80u, 0u, 0u, 0u}; *(LAS3 v4u_t*)(L + VA + tid * VST + 80) = (v4u_t){0u, 0u, 0u, 0u}; }
    f32x4 accC[2][3];
#pragma unroll
    for (int dt = 0; dt < 2; ++dt)
#pragma unroll
        for (int vt = 0; vt < 3; ++vt) accC[dt][vt] = (f32x4){0.f, 0.f, 0.f, 0.f};
    float m = 0.f;
    const int row = tid >> 3, seg = tid & 7;
    v4u_t rq[4], rk[4], rv = (v4u_t){0u, 0u, 0u, 0u}; float ric = 0.f, rfc = 0.f;
    { const int t0 = b * SEQ; const bf16_t* src = proj + (size_t)(t0 + row) * NPROJ + h * DH + seg * 32;
#pragma unroll
      for (int i = 0; i < 4; ++i) { rq[i] = *(const v4u_t*)(src + PC_Q + i * 8); rk[i] = *(const v4u_t*)(src + PC_K + i * 8); }
      if (tid < 256) rv = *(const v4u_t*)(proj + (size_t)(t0 + (tid >> 2)) * NPROJ + PC_V + h * DH + v0 + (tid & 3) * 8);
      if (wave == 0) { ric = gi[(size_t)(t0 + lane) * 4 + h]; rfc = gf[(size_t)(t0 + lane) * 4 + h]; } }
    __syncthreads();
#pragma unroll 1
    for (int c = 0; c < SEQ / LCH; ++c) {
        const int t0 = b * SEQ + c * LCH;
#pragma unroll
        for (int i = 0; i < 4; ++i) { *(LAS3 v4u_t*)(L + QS + row * QST + seg * 64 + i * 16) = rq[i]; *(LAS3 v4u_t*)(L + KS + row * QST + seg * 64 + i * 16) = rk[i]; }
        if (tid < 256) *(LAS3 v4u_t*)(L + VA + (tid >> 2) * VST + (tid & 3) * 16) = rv;
        if (wave == 0) {
            float bc = rfc;
#pragma unroll
            for (int o = 1; o < 64; o <<= 1) { const float tv = __shfl_up(bc, o); if (lane >= o) bc += tv; }
            const float a = ric - bc; float pm = a;
#pragma unroll
            for (int o = 1; o < 64; o <<= 1) { const float tv = __shfl_up(pm, o); if (lane >= o) pm = fmaxf(pm, tv); }
            const float M = fmaxf(m, pm), M63 = __shfl(M, 63), b63 = __shfl(bc, 63);
            sA[lane] = a; sM[lane] = M; sEi[lane] = expf(m - M); sWl[lane] = expf(a - M63) * 0.0625f; sEnm[lane] = expf(-bc - M);
            if (lane == 0) { sMisc[0] = b63 + M63; sMisc[1] = expf(m - M63); }
        }
        if (c + 1 < SEQ / LCH) { const int t1 = t0 + LCH; const bf16_t* src = proj + (size_t)(t1 + row) * NPROJ + h * DH + seg * 32;
#pragma unroll
            for (int i = 0; i < 4; ++i) { rq[i] = *(const v4u_t*)(src + PC_Q + i * 8); rk[i] = *(const v4u_t*)(src + PC_K + i * 8); }
            if (tid < 256) rv = *(const v4u_t*)(proj + (size_t)(t1 + (tid >> 2)) * NPROJ + PC_V + h * DH + v0 + (tid & 3) * 8);
            if (wave == 0) { ric = gi[(size_t)(t1 + lane) * 4 + h]; rfc = gf[(size_t)(t1 + lane) * 4 + h]; } }
        __syncthreads();
        { const int rt = wave >> 1;
#pragma unroll
          for (int cc = 0; cc < 2; ++cc) { const int ct = (wave & 1) * 2 + cc; f32x4 acc = (f32x4){0.f, 0.f, 0.f, 0.f};
              if (ct <= rt) {
#pragma unroll
                  for (int ks = 0; ks < 8; ++ks) { const bf16x8 av = *(LAS3 bf16x8*)(L + QS + (rt * 16 + c16) * QST + (ks * 32 + g * 8) * 2), bv = *(LAS3 bf16x8*)(L + KS + (ct * 16 + c16) * QST + (ks * 32 + g * 8) * 2);
                      acc = __builtin_amdgcn_mfma_f32_16x16x32_bf16(av, bv, acc, 0, 0, 0); } }
              const int l = ct * 16 + c16; const float al = sA[l]; const f32x4 M4 = *(LAS3 f32x4*)(sM + rt * 16 + 4 * g);
#pragma unroll
              for (int r = 0; r < 4; ++r) { const int j = rt * 16 + 4 * g + r; const float val = (l <= j) ? acc[r] * 0.0625f * __expf(al - M4[r]) : 0.f;
                  *(LAS3 unsigned short*)(L + SW + j * SST + l * 2) = (unsigned short)f2bf(val); } } }
#pragma unroll
        for (int i = 0; i < 6; ++i) { const int e = tid + NTHREADS * i, l = e / 48, vp = e - l * 48;
            *(LAS3 unsigned short*)(L + WV + l * VST + vp * 2) = (unsigned short)f2bf(sWl[l] * bf1(*(LAS3 unsigned short*)(L + VA + l * VST + vp * 2))); }
        __syncthreads();
        const int rt = wave >> 1, vt = wave & 1;
        f32x4 num;
        { f32x4 accI = (f32x4){0.f, 0.f, 0.f, 0.f}, accX = (f32x4){0.f, 0.f, 0.f, 0.f};
#pragma unroll
          for (int ks = 0; ks < 8; ++ks) { const bf16x8 av = *(LAS3 bf16x8*)(L + QS + (rt * 16 + c16) * QST + (ks * 32 + g * 8) * 2), bv = *(LAS3 bf16x8*)(L + CB + (vt * 16 + c16) * QST + (ks * 32 + g * 8) * 2);
              accI = __builtin_amdgcn_mfma_f32_16x16x32_bf16(av, bv, accI, 0, 0, 0); }
#pragma unroll
          for (int ks = 0; ks < 2; ++ks) { const bf16x8 av = *(LAS3 bf16x8*)(L + SW + (rt * 16 + c16) * SST + (ks * 32 + g * 8) * 2);
              LAS3 unsigned char* vp = L + VA + (ks * 32 + g * 8 + q4) * VST + (vt * 16 + 4 * p4) * 2; const bf16x8 bv = tr8(vp, vp + 4 * VST);
              accX = __builtin_amdgcn_mfma_f32_16x16x32_bf16(av, bv, accX, 0, 0, 0); }
          const f32x4 e4 = *(LAS3 f32x4*)(sEi + rt * 16 + 4 * g);
          num = e4 * accI + accX;
          if ((wave & 1) == 0) {
              f32x4 aI = (f32x4){0.f, 0.f, 0.f, 0.f}, aX = (f32x4){0.f, 0.f, 0.f, 0.f};
#pragma unroll
              for (int ks = 0; ks < 8; ++ks) { const bf16x8 av = *(LAS3 bf16x8*)(L + QS + (rt * 16 + c16) * QST + (ks * 32 + g * 8) * 2), bv = *(LAS3 bf16x8*)(L + CB + (32 + c16) * QST + (ks * 32 + g * 8) * 2);
                  aI = __builtin_amdgcn_mfma_f32_16x16x32_bf16(av, bv, aI, 0, 0, 0); }
#pragma unroll
              for (int ks = 0; ks < 2; ++ks) { const bf16x8 av = *(LAS3 bf16x8*)(L + SW + (rt * 16 + c16) * SST + (ks * 32 + g * 8) * 2);
                  LAS3 unsigned char* vp = L + VA + (ks * 32 + g * 8 + q4) * VST + (32 + 4 * p4) * 2; const bf16x8 bv = tr8(vp, vp + 4 * VST);
                  aX = __builtin_amdgcn_mfma_f32_16x16x32_bf16(av, bv, aX, 0, 0, 0); }
              if (c16 == 0) {
#pragma unroll
                  for (int r = 0; r < 4; ++r) { const int j = rt * 16 + 4 * g + r; sDen[j] = fmaxf(fabsf(e4[r] * aI[r] + aX[r]), sEnm[j]); } }
          } }
        __syncthreads();
        { const f32x4 d4 = *(LAS3 f32x4*)(sDen + rt * 16 + 4 * g);
#pragma unroll
          for (int r = 0; r < 4; ++r) hraw[(size_t)(t0 + rt * 16 + 4 * g + r) * DML + h * DH + v0 + vt * 16 + c16] = num[r] / d4[r]; }
        { const float decay = sMisc[1];
#pragma unroll
          for (int dt = 0; dt < 2; ++dt)
#pragma unroll
              for (int v3 = 0; v3 < 3; ++v3) accC[dt][v3] *= decay;
#pragma unroll
          for (int ks = 0; ks < 2; ++ks) { bf16x8 af[2], bfr[3];
#pragma unroll
              for (int dt = 0; dt < 2; ++dt) { LAS3 unsigned char* kp = L + KS + (ks * 32 + g * 8 + q4) * QST + ((2 * wave + dt) * 16 + 4 * p4) * 2; af[dt] = tr8(kp, kp + 4 * QST); }
#pragma unroll
              for (int v3 = 0; v3 < 3; ++v3) { LAS3 unsigned char* wp = L + WV + (ks * 32 + g * 8 + q4) * VST + (v3 * 16 + 4 * p4) * 2; bfr[v3] = tr8(wp, wp + 4 * VST); }
#pragma unroll
              for (int dt = 0; dt < 2; ++dt)
#pragma unroll
                  for (int v3 = 0; v3 < 3; ++v3) accC[dt][v3] = __builtin_amdgcn_mfma_f32_16x16x32_bf16(af[dt], bfr[v3], accC[dt][v3], 0, 0, 0); }
#pragma unroll
          for (int dt = 0; dt < 2; ++dt)
#pragma unroll
              for (int v3 = 0; v3 < 3; ++v3) { const int d = (2 * wave + dt) * 16 + 4 * g, vp = v3 * 16 + c16;
                  *(LAS3 v2u_t*)(L + CB + vp * QST + d * 2) = (v2u_t){pk2(accC[dt][v3][0], accC[dt][v3][1]), pk2(accC[dt][v3][2], accC[dt][v3][3])}; }
          m = sMisc[0]; }
        __syncthreads();
    }
}

__device__ __forceinline__ void p3_finalize(const Params& P, int G, int bid) {
    const int lane = threadIdx.x & 63, wave = threadIdx.x >> 6;
    const float* hraw = (const float*)(P.ws + WS_HRAW); const bf16_t* proj = (const bf16_t*)(P.ws + WS_PROJ); bf16_t* mix = (bf16_t*)(P.ws + WS_MIXIN);
    for (int idx = bid * NWAVES + wave; idx < T * NH; idx += G * NWAVES) {
        const int t = idx >> 2, hh = idx & 3;
        const float4 hv = *(const float4*)(hraw + (size_t)t * DML + hh * DH + lane * 4);
        const float ss = wave_sum((hv.x * hv.x + hv.y * hv.y) + (hv.z * hv.z + hv.w * hv.w));
        const float r = rsqrtf(ss * (1.0f / DH) + EPS);
        const uint2 ow = *(const uint2*)(proj + (size_t)t * NPROJ + PC_O + hh * DH + lane * 4);
        const float4 g = *(const float4*)(P.gm + hh * DH + lane * 4);
        const float o0 = 1.0f / (1.0f + expf(-bflo(ow.x))), o1 = 1.0f / (1.0f + expf(-bfhi(ow.x))), o2 = 1.0f / (1.0f + expf(-bflo(ow.y))), o3 = 1.0f / (1.0f + expf(-bfhi(ow.y)));
        *(uint2*)(mix + (size_t)t * D + DML + hh * DH + lane * 4) = make_uint2(pk2(o0 * (hv.x * r * g.x), o1 * (hv.y * r * g.y)), pk2(o2 * (hv.z * r * g.z), o3 * (hv.w * r * g.w)));
    }
}

template <int CTRL> __device__ __forceinline__ float dppf(float v) { return __int_as_float(__builtin_amdgcn_update_dpp(0, __float_as_int(v), CTRL, 0xF, 0xF, true)); }
__device__ __forceinline__ float grp16_max(float v) { v = fmaxf(v, dppf<0xB1>(v)); v = fmaxf(v, dppf<0x4E>(v)); v = fmaxf(v, dppf<0x141>(v)); v = fmaxf(v, dppf<0x140>(v)); return v; }
__device__ __forceinline__ float grp16_sum(float v) { v += dppf<0xB1>(v); v += dppf<0x4E>(v); v += dppf<0x141>(v); v += dppf<0x140>(v); return v; }
#define CEX(a, b) do { const float hi_ = fmaxf(a, b), lo_ = fminf(a, b); a = hi_; b = lo_; } while (0)
static __device__ const unsigned char CAND_AB[16][4] = {
    {0x00, 0x01, 0x02, 0x03}, {0x04, 0x05, 0x06, 0x07}, {0x08, 0x09, 0x0A, 0x0B}, {0x0C, 0x0D, 0x0E, 0x0F}, {0x10, 0x11, 0x12, 0x13}, {0x14, 0x15, 0x16, 0x17}, {0x20, 0x21, 0x22, 0x23}, {0x24, 0, 0, 0},
    {0x30, 0x31, 0x32, 0x33}, {0x40, 0x41, 0x42, 0}, {0x50, 0x60, 0x70, 0x80}, {0x90, 0xA0, 0xB0, 0xC0}, {0xD0, 0xE0, 0xF0, 0}, {0x51, 0x61, 0x71, 0}, {0, 0, 0, 0}, {0, 0, 0, 0}};
static __device__ const unsigned char CAND_N[16] = {4, 4, 4, 4, 4, 4, 4, 1, 4, 3, 4, 4, 3, 3, 0, 0};
__device__ __forceinline__ void p6_topk(const Params& P, unsigned char* lds_, int G, int bid) {
    typedef pg8::bf16x8 bf16x8; typedef pg8::f32x4 f32x4;
    LAS3 unsigned char* L = (LAS3 unsigned char*)lds_;
    constexpr int KST = 272, KHALF = 128 * KST;
    const int tid = threadIdx.x, lane = tid & 63, wave = tid >> 6, g = lane >> 4, c16 = lane & 15;
    for (int i = tid; i < 2 * 2048; i += NTHREADS) { const int hf = i >> 11, n = (i >> 4) & 127, d8 = (i & 15) * 8; const float* src = (hf ? P.sk2 : P.sk1) + n * 128 + d8;
        const float4 a = *(const float4*)src, b = *(const float4*)(src + 4);
        *(LAS3 v4u_t*)(L + hf * KHALF + n * KST + d8 * 2) = (v4u_t){pk2(a.x, a.y), pk2(a.z, a.w), pk2(b.x, b.y), pk2(b.z, b.w)}; }
    __syncthreads();
    const bf16_t* qvb = (const bf16_t*)(P.ws + WS_QV);
    int* idxo = (int*)(P.ws + WS_IDX); float* gato = (float*)(P.ws + WS_GATE);
    const float NEGINF = -__builtin_inff();
    unsigned ctab = 0; { const unsigned char* tp = CAND_AB[c16]; ctab = (unsigned)tp[0] | ((unsigned)tp[1] << 8) | ((unsigned)tp[2] << 16) | ((unsigned)tp[3] << 24); }
    const int ccnt = CAND_N[c16];
#pragma unroll 1
    for (int it = bid * NWAVES + wave; it < (T / 16) * PEER_H; it += G * NWAVES) {
        const int t0 = (it >> 3) * 16, hh = it & 7;
        float keepH[2][4];
#pragma unroll
        for (int hf = 0; hf < 2; ++hf) {
            asm volatile("" ::: "memory");
            bf16x8 af[4];
#pragma unroll
            for (int ks = 0; ks < 4; ++ks) af[ks] = *(const bf16x8*)(qvb + (size_t)(t0 + c16) * D + hh * 256 + hf * 128 + ks * 32 + g * 8);
            f32x4 acc[8];
#pragma unroll
            for (int ct = 0; ct < 8; ++ct) { acc[ct] = (f32x4){0.f, 0.f, 0.f, 0.f};
#pragma unroll
                for (int ks = 0; ks < 4; ++ks) { const bf16x8 bv = *(LAS3 bf16x8*)(L + hf * KHALF + (ct * 16 + c16) * KST + (ks * 32 + g * 8) * 2);
                    acc[ct] = __builtin_amdgcn_mfma_f32_16x16x32_bf16(af[ks], bv, acc[ct], 0, 0, 0); } }
            float v[4][8];
#pragma unroll
            for (int r = 0; r < 4; ++r) {
#pragma unroll
                for (int ct = 0; ct < 8; ++ct) v[r][ct] = __uint_as_float((__float_as_uint(acc[ct][r]) & ~127u) | (unsigned)(127 - (ct * 16 + c16)));
                CEX(v[r][0], v[r][1]); CEX(v[r][2], v[r][3]); CEX(v[r][4], v[r][5]); CEX(v[r][6], v[r][7]);
                CEX(v[r][0], v[r][2]); CEX(v[r][1], v[r][3]); CEX(v[r][4], v[r][6]); CEX(v[r][5], v[r][7]);
                CEX(v[r][1], v[r][2]); CEX(v[r][5], v[r][6]); CEX(v[r][0], v[r][4]); CEX(v[r][3], v[r][7]);
                CEX(v[r][1], v[r][5]); CEX(v[r][2], v[r][6]);
                CEX(v[r][1], v[r][4]); CEX(v[r][3], v[r][6]);
                CEX(v[r][2], v[r][4]); CEX(v[r][3], v[r][5]);
                CEX(v[r][3], v[r][4]);
                keepH[hf][r] = 0.f;
            }
#pragma unroll
            for (int rd = 0; rd < TOPK; ++rd) {
#pragma unroll
                for (int r = 0; r < 4; ++r) {
                    const float W = grp16_max(v[r][0]); const bool win = (v[r][0] == W);
                    if (c16 == rd) keepH[hf][r] = W;
#pragma unroll
                    for (int k = 0; k < 7; ++k) v[r][k] = win ? v[r][k + 1] : v[r][k];
                    v[r][7] = win ? NEGINF : v[r][7];
                }
            }
        }
#pragma unroll
        for (int r = 0; r < 4; ++r) {
            const float V1 = keepH[0][r], V2 = keepH[1][r];
            float cv[4];
#pragma unroll
            for (int s4 = 0; s4 < 4; ++s4) { const unsigned code = (ctab >> (8 * s4)) & 255u;
                const float x1 = __shfl(V1, g * 16 + (int)(code >> 4)), x2 = __shfl(V2, g * 16 + (int)(code & 15u));
                const float sum = __uint_as_float(__float_as_uint(x1) & ~127u) + __uint_as_float(__float_as_uint(x2) & ~127u);
                cv[s4] = (s4 < ccnt) ? __uint_as_float((__float_as_uint(sum) & ~255u) | (255u - code)) : NEGINF; }
            float keepc = 0.f;
#pragma unroll
            for (int rd = 0; rd < TOPK; ++rd) {
                const float W = grp16_max(cv[0]); const bool win = (cv[0] == W);
                if (c16 == rd) keepc = W;
                cv[0] = win ? cv[1] : cv[0]; cv[1] = win ? cv[2] : cv[1]; cv[2] = win ? cv[3] : cv[2]; cv[3] = win ? NEGINF : cv[3];
            }
            const unsigned kb = __float_as_uint(keepc), code = 255u - (kb & 255u);
            const unsigned n1 = 127u - (__float_as_uint(__shfl(V1, g * 16 + (int)(code >> 4))) & 127u), n2 = 127u - (__float_as_uint(__shfl(V2, g * 16 + (int)(code & 15u))) & 127u);
            const float sval = __uint_as_float(kb & ~255u), smax = __shfl(sval, g * 16);
            const float ex = __expf(sval - smax), den = grp16_sum(ex);
            const size_t o = (size_t)(t0 + 4 * g + r) * 128 + hh * 16 + c16;
            idxo[o] = (int)(n1 * 128u + n2); gato[o] = ex / den;
        }
    }
    __syncthreads();
}

__device__ __forceinline__ void p7_peer(const Params& P, int G, int bid) {
    const int lane = threadIdx.x & 63, wave = threadIdx.x >> 6;
    const bf16_t* x1b = (const bf16_t*)(P.ws + WS_X1B); const float* x1 = (const float*)(P.ws + WS_X1); const float* ssq = (const float*)(P.ws + WS_SSQ);
    const int* idxi = (const int*)(P.ws + WS_IDX); const float* gati = (const float*)(P.ws + WS_GATE);
    const bf16_t* ub = (const bf16_t*)(P.ws + WS_UB); const bf16_t* vb = (const bf16_t*)(P.ws + WS_VB);
    for (int t = bid * NWAVES + wave; t < T; t += G * NWAVES) {
        const float rs2 = rsqrtf(wave_sum(lane < 32 ? ssq[(size_t)t * 32 + lane] : 0.f) * (1.0f / D) + EPS);
        float xf[4][8];
#pragma unroll
        for (int c = 0; c < 4; ++c) unpack8(*(const uint4*)(x1b + (size_t)t * D + c * 512 + lane * 8), xf[c]);
        float y[4][8];
#pragma unroll
        for (int c = 0; c < 4; ++c)
#pragma unroll
            for (int i = 0; i < 8; ++i) y[c][i] = 0.f;
#pragma unroll 1
        for (int hh = 0; hh < PEER_H; ++hh) {
            const int myidx = lane < TOPK ? idxi[(size_t)t * 128 + hh * 16 + lane] : 0;
            const float mygate = lane < TOPK ? gati[(size_t)t * 128 + hh * 16 + lane] : 0.f;
#pragma unroll 1
            for (int g = 0; g < 4; ++g) {
                float dsum[4];
#pragma unroll
                for (int e = 0; e < 4; ++e) {
                    const int ei = __builtin_amdgcn_readlane(myidx, g * 4 + e);
                    const bf16_t* ur = ub + (size_t)ei * D + lane * 8;
                    float s = 0.f;
#pragma unroll
                    for (int c = 0; c < 4; ++c) { float uf[8]; unpack8(*(const uint4*)(ur + c * 512), uf);
#pragma unroll
                        for (int i = 0; i < 8; ++i) s += xf[c][i] * uf[i]; }
                    dsum[e] = s;
                }
#pragma unroll
                for (int e = 0; e < 4; ++e) dsum[e] = wave_sum(dsum[e]);
#pragma unroll
                for (int e = 0; e < 4; ++e) {
                    const int ei = __builtin_amdgcn_readlane(myidx, g * 4 + e);
                    const float gt = __uint_as_float(__builtin_amdgcn_readlane(__float_as_uint(mygate), g * 4 + e));
                    const float cf = gt * gelu_erf(dsum[e] * rs2);
                    const bf16_t* vr = vb + (size_t)ei * D + lane * 8;
#pragma unroll
                    for (int c = 0; c < 4; ++c) { float vf[8]; unpack8(*(const uint4*)(vr + c * 512), vf);
#pragma unroll
                        for (int i = 0; i < 8; ++i) y[c][i] += cf * vf[i]; }
                }
            }
        }
        float ss = 0.f;
#pragma unroll
        for (int c = 0; c < 4; ++c) { const float4 a = *(const float4*)(x1 + (size_t)t * D + c * 512 + lane * 8), b = *(const float4*)(x1 + (size_t)t * D + c * 512 + lane * 8 + 4);
            y[c][0] += a.x; y[c][1] += a.y; y[c][2] += a.z; y[c][3] += a.w; y[c][4] += b.x; y[c][5] += b.y; y[c][6] += b.z; y[c][7] += b.w;
#pragma unroll
            for (int i = 0; i < 8; ++i) ss += y[c][i] * y[c][i]; }
        ss = wave_sum(ss);
        const float r = rsqrtf(ss * (1.0f / D) + EPS);
#pragma unroll
        for (int c = 0; c < 4; ++c) { const float4 ga = *(const float4*)(P.gfin + c * 512 + lane * 8), gb = *(const float4*)(P.gfin + c * 512 + lane * 8 + 4);
            *(float4*)(P.out + (size_t)t * D + c * 512 + lane * 8) = make_float4(y[c][0] * r * ga.x, y[c][1] * r * ga.y, y[c][2] * r * ga.z, y[c][3] * r * ga.w);
            *(float4*)(P.out + (size_t)t * D + c * 512 + lane * 8 + 4) = make_float4(y[c][4] * r * gb.x, y[c][5] * r * gb.y, y[c][6] * r * gb.z, y[c][7] * r * gb.w); }
    }
}

constexpr int N_PHASES = 8;
#ifndef MK_N_LAUNCHES
#define MK_N_LAUNCHES 1
#endif
__global__ void __launch_bounds__(NTHREADS, 2) layer_fwd(Params P) {
    extern __shared__ __attribute__((aligned(16))) unsigned char lds[];
    cg::grid_group grid = cg::this_grid();
    const int G = gridDim.x, bid = blockIdx.x;
    const int lo = P.ph_lo, hi = P.ph_hi;
#ifndef PH_MASK
#define PH_MASK 0xff
#endif
#define IN(k) (((PH_MASK >> (k)) & 1) && lo <= (k) && (k) < hi)
#define SEAM(k) do { if (IN(k) && IN((k) + 1)) grid.sync(); } while (0)
#ifndef REP_MASK
#define REP_MASK 0
#endif
#define REPS(k) (((REP_MASK >> (k)) & 1) ? 2 : 1)
    if (IN(0)) for (int rep = 0; rep < REPS(0); ++rep) { p0_rows(P, lds, G, bid); p0_weights(P, lds, G, bid); p0_tables(P, G, bid); }
    SEAM(0);
    if (IN(1)) {
        pg8::Gemm g{(const pg8::bf16_t*)(P.ws + WS_XB), (const pg8::bf16_t*)(P.ws + WS_WINT), T, NPROJ, D}; pg8::StaticOrder S; S.init(T, NPROJ, G, bid);
        pg8::EpiProj E{(pg8::bf16_t*)(P.ws + WS_PROJ), NPROJ, (const float*)(P.ws + WS_RS1)};
        pg8::gemm_phase<pg8::EpiProj, pg8::StaticOrder, true, true>((PG8_LAS unsigned char*)lds, g, S, E);
    }
    SEAM(1);
    if (IN(2)) for (int rep = 0; rep < REPS(2); ++rep) {
        for (int u = bid; u < 64; u += G) mlstm_unit(P, lds, u);
        if (G > 64) { if (bid >= 64) p2_conv(P, G - 64, bid - 64); } else p2_conv(P, G, bid);
    }
    SEAM(2);
    if (IN(3)) for (int rep = 0; rep < REPS(3); ++rep) p3_finalize(P, G, bid);
    SEAM(3);
    if (IN(4)) {
        pg8::Gemm g{(const pg8::bf16_t*)(P.ws + WS_MIXIN), (const pg8::bf16_t*)(P.ws + WS_WOUTT), T, D, D}; pg8::StaticOrder S; S.init(T, D, G, bid);
        pg8::EpiOut E{P.x, (float*)(P.ws + WS_X1), (pg8::bf16_t*)(P.ws + WS_X1B), (float*)(P.ws + WS_SSQ), D};
        pg8::gemm_phase<pg8::EpiOut, pg8::StaticOrder, false, true>((PG8_LAS unsigned char*)lds, g, S, E);
    }
    SEAM(4);
    if (IN(5)) {
        pg8::Gemm g{(const pg8::bf16_t*)(P.ws + WS_X1B), (const pg8::bf16_t*)(P.ws + WS_WQT), T, D, D}; pg8::StaticOrder S; S.init(T, D, G, bid);
        pg8::EpiQb E{(pg8::bf16_t*)(P.ws + WS_QV), D, (const float*)(P.ws + WS_SSQ)};
        pg8::gemm_phase<pg8::EpiQb, pg8::StaticOrder, false, true>((PG8_LAS unsigned char*)lds, g, S, E);
    }
    SEAM(5);
    if (IN(6)) for (int rep = 0; rep < REPS(6); ++rep) p6_topk(P, lds, G, bid);
    SEAM(6);
    if (IN(7)) for (int rep = 0; rep < REPS(7); ++rep) p7_peer(P, G, bid);
#undef IN
#undef SEAM
}

extern "C" void kernel_launch(void* const* d_in, const int* in_sizes, int n_in, void* d_out, int out_size, void* d_ws, size_t ws_size, hipStream_t stream) {
    static int grid = 0;
    if (grid == 0) {
        if (n_in != 15 || in_sizes[0] != T * D || out_size != T * D || ws_size < WS_END) { fprintf(stderr, "kernel_launch: unexpected shapes (n_in %d, in0 %d, out %d, ws %zu); nothing launched\n", n_in, n_in > 0 ? in_sizes[0] : -1, out_size, ws_size); grid = -1; return; }
        int dev = 0, cus = 0, per_cu = 0;
        if (hipGetDevice(&dev) != hipSuccess || hipDeviceGetAttribute(&cus, hipDeviceAttributeMultiprocessorCount, dev) != hipSuccess) { grid = -1; return; }
        if (hipFuncSetAttribute((const void*)layer_fwd, hipFuncAttributeMaxDynamicSharedMemorySize, LDS_BYTES) != hipSuccess) { fprintf(stderr, "kernel_launch: hipFuncSetAttribute failed\n"); grid = -1; return; }
        if (hipOccupancyMaxActiveBlocksPerMultiprocessor(&per_cu, (const void*)layer_fwd, NTHREADS, LDS_BYTES) != hipSuccess || per_cu < 1) { fprintf(stderr, "kernel_launch: occupancy query says %d blocks per CU\n", per_cu); (void)hipGetLastError(); grid = -1; return; }
        grid = cus;
    }
    if (grid < 0) return;
    Params p{};
    p.x = (const float*)d_in[0]; p.g1 = (const float*)d_in[1]; p.w_in = (const float*)d_in[2]; p.b_ig = (const float*)d_in[3]; p.b_fg = (const float*)d_in[4];
    p.conv_w = (const float*)d_in[5]; p.gm = (const float*)d_in[6]; p.w_out = (const float*)d_in[7]; p.g2 = (const float*)d_in[8]; p.w_q = (const float*)d_in[9];
    p.sk1 = (const float*)d_in[10]; p.sk2 = (const float*)d_in[11]; p.eu = (const float*)d_in[12]; p.ev = (const float*)d_in[13]; p.gfin = (const float*)d_in[14];
    p.out = (float*)d_out; p.ws = (unsigned char*)d_ws;
    for (int li = 0; li < MK_N_LAUNCHES; ++li) {
        p.ph_lo = (MK_N_LAUNCHES == 1) ? 0 : li; p.ph_hi = (MK_N_LAUNCHES == 1) ? N_PHASES : li + 1;
        void* args[] = {&p};
        const hipError_t e = hipLaunchCooperativeKernel((const void*)layer_fwd, dim3(grid), dim3(NTHREADS), args, LDS_BYTES, stream);
        if (e != hipSuccess) { fprintf(stderr, "kernel_launch: cooperative launch %d failed: %s (grid %d)\n", li, hipGetErrorString(e), grid); break; }
    }
}
```

```cpp
#include <hip/hip_runtime.h>
#include <hip/hip_cooperative_groups.h>
#include <cstdio>
#include <cstdint>
namespace cg = cooperative_groups;
namespace pg8 {
#define PG8_LAS __attribute__((address_space(3)))
typedef unsigned short bf16_t;
typedef short bf16x8 __attribute__((ext_vector_type(8)));
typedef float f32x4 __attribute__((ext_vector_type(4)));
typedef unsigned u32x4 __attribute__((ext_vector_type(4)));
constexpr int BM = 256, BK = 64, HALF = 128, HTB = HALF * BK * 2  , STAGE_BYTES = 8 * HTB, NXCD = 8, WGM = 8;

__host__ __device__ __forceinline__ int lds_byte(int r, int c) { const int st = (r >> 4) * 2 + (c >> 5), rr = r & 15, cc = c & 31, ob = rr * 64 + cc * 2; return st * 1024 + (ob ^ (((ob >> 9) & 1) << 5)); }
__host__ __device__ __forceinline__ void stage_rc(int b, int& R, int& C) { const int st = b / 1024, sb = b % 1024, swz = sb ^ (((sb >> 9) & 1) << 5); R = (st >> 1) * 16 + swz / 64; C = (st & 1) * 32 + (swz % 64) / 2; }
__host__ __device__ __forceinline__ int perm32(int rho) { const int n = rho >> 4, i = rho & 15; return 8 * (i >> 2) + 4 * n + (i & 3); }

struct Unit { int pm, pn; };
struct Gemm { const bf16_t* A; const bf16_t* Bt; int M, N, K; };

struct StaticOrder {
    int nM, nN, nwg, G, c;
    __host__ __device__ void init(int M, int N, int G_, int c_) { nM = M / BM; nN = N / BM; nwg = nM * nN; G = G_; c = c_; }
    __host__ __device__ bool next(int i, Unit& u) const {
        const long L = (long)i * G + c; if (L >= nwg) return false;
        int wgid = (int)L; { const int q = nwg / NXCD, r = nwg % NXCD, xcd = wgid % NXCD, off = wgid / NXCD; wgid = (xcd < r ? xcd * (q + 1) : r * (q + 1) + (xcd - r) * q) + off; }
        const int nig = WGM * nN, gid = wgid / nig, fm = gid * WGM, gsz = (nM - fm) < WGM ? (nM - fm) : WGM;
        u.pm = fm + ((wgid % nig) % gsz); u.pn = (wgid % nig) / gsz; return true;
    }
    __device__ __forceinline__ void a_ready(const Unit&) const {}
    __device__ __forceinline__ void done(const Unit&) const {}
};

__device__ __forceinline__ unsigned cvt_pk_bf16(float lo, float hi) { unsigned r; asm volatile("v_cvt_pk_bf16_f32 %0, %1, %2" : "=v"(r) : "v"(lo), "v"(hi)); return r; }
struct EpiProj {
    static constexpr bool PERM = true, AFTER_DRAIN = false;
    bf16_t* O; int ldc; const float* rs;
    __device__ __forceinline__ void operator()(const f32x4 (&acc)[2][2][4][2], const Unit& u, int wr, int wc, int fr, int fq) const {
        const int row0 = u.pm * BM + wr * 64 + fr, col0 = u.pn * BM + wc * 32 + 8 * fq;
#pragma unroll
        for (int ai = 0; ai < 2; ++ai)
#pragma unroll
            for (int m = 0; m < 4; ++m) { const int row = row0 + ai * HALF + m * 16; const float s = rs[row]; bf16_t* rowp = O + (size_t)row * ldc + col0;
#pragma unroll
                for (int bj = 0; bj < 2; ++bj) { const f32x4 v0 = acc[ai][bj][m][0] * s, v1 = acc[ai][bj][m][1] * s; u32x4 w;
                    w.x = cvt_pk_bf16(v0[0], v0[1]); w.y = cvt_pk_bf16(v0[2], v0[3]); w.z = cvt_pk_bf16(v1[0], v1[1]); w.w = cvt_pk_bf16(v1[2], v1[3]);
                    *(u32x4*)(rowp + bj * HALF) = w; } }
    }
};
struct EpiOut {
    static constexpr bool PERM = false, AFTER_DRAIN = false;
    const float* X; float* X1; bf16_t* X1B; float* SSQ; int ldc;
    __device__ __forceinline__ void operator()(const f32x4 (&acc)[2][2][4][2], const Unit& u, int wr, int wc, int fr, int fq) const {
        typedef unsigned u32x2 __attribute__((ext_vector_type(2)));
        const int row0 = u.pm * BM + wr * 64 + fr, col0 = u.pn * BM + wc * 32 + 4 * fq;
#pragma unroll
        for (int ai = 0; ai < 2; ++ai)
#pragma unroll
            for (int m = 0; m < 4; ++m) { const int row = row0 + ai * HALF + m * 16; const size_t off = (size_t)row * ldc + col0; float ss = 0.f;
#pragma unroll
                for (int bj = 0; bj < 2; ++bj)
#pragma unroll
                    for (int n = 0; n < 2; ++n) { const size_t c = off + bj * HALF + n * 16; const f32x4 xv = *(const f32x4*)(X + c); const f32x4 o = xv + acc[ai][bj][m][n];
                        *(f32x4*)(X1 + c) = o; ss += (o[0] * o[0] + o[1] * o[1]) + (o[2] * o[2] + o[3] * o[3]);
                        u32x2 pk; pk.x = cvt_pk_bf16(o[0], o[1]); pk.y = cvt_pk_bf16(o[2], o[3]); *(u32x2*)(X1B + c) = pk; }
                ss += __shfl_xor(ss, 16); ss += __shfl_xor(ss, 32);
                if (fq == 0) SSQ[(size_t)row * 32 + u.pn * 4 + wc] = ss; }
    }
};
struct EpiQ {
    static constexpr bool PERM = false, AFTER_DRAIN = false;
    float* O; int ldc;
    __device__ __forceinline__ void operator()(const f32x4 (&acc)[2][2][4][2], const Unit& u, int wr, int wc, int fr, int fq) const {
        const int row0 = u.pm * BM + wr * 64 + fr, col0 = u.pn * BM + wc * 32 + 4 * fq;
#pragma unroll
        for (int ai = 0; ai < 2; ++ai)
#pragma unroll
            for (int m = 0; m < 4; ++m) { const size_t off = (size_t)(row0 + ai * HALF + m * 16) * ldc + col0;
#pragma unroll
                for (int bj = 0; bj < 2; ++bj)
#pragma unroll
                    for (int n = 0; n < 2; ++n) *(f32x4*)(O + off + bj * HALF + n * 16) = acc[ai][bj][m][n]; }
    }
};
struct EpiQb {
    static constexpr bool PERM = true, AFTER_DRAIN = false;
    bf16_t* O; int ldc; const float* SSQ;
    __device__ __forceinline__ void operator()(const f32x4 (&acc)[2][2][4][2], const Unit& u, int wr, int wc, int fr, int fq) const {
        const int row0 = u.pm * BM + wr * 64 + fr, col0 = u.pn * BM + wc * 32 + 8 * fq;
#pragma unroll
        for (int ai = 0; ai < 2; ++ai)
#pragma unroll
            for (int m = 0; m < 4; ++m) { const int row = row0 + ai * HALF + m * 16; const f32x4* sp = (const f32x4*)(SSQ + (size_t)row * 32);
                f32x4 s4 = sp[0];
#pragma unroll
                for (int i = 1; i < 8; ++i) s4 += sp[i];
                const float s = rsqrtf(((s4[0] + s4[1]) + (s4[2] + s4[3])) * (1.0f / 2048.0f) + 1e-6f); bf16_t* rowp = O + (size_t)row * ldc + col0;
#pragma unroll
                for (int bj = 0; bj < 2; ++bj) { const f32x4 v0 = acc[ai][bj][m][0] * s, v1 = acc[ai][bj][m][1] * s; u32x4 w;
                    w.x = cvt_pk_bf16(v0[0], v0[1]); w.y = cvt_pk_bf16(v0[2], v0[3]); w.z = cvt_pk_bf16(v1[0], v1[1]); w.w = cvt_pk_bf16(v1[2], v1[3]);
                    *(u32x4*)(rowp + bj * HALF) = w; } }
    }
};
template <class Epi, class Sched, bool ALIGN_EPI = false, bool SP2 = false>
__device__ __forceinline__ void gemm_phase(PG8_LAS unsigned char* lds, const Gemm g, const Sched& S, const Epi& E) {
    const int tid = threadIdx.x, wid = __builtin_amdgcn_readfirstlane(tid >> 6), lane = tid & 63, wr = wid >> 2, wc = wid & 3, fr = lane & 15, fq = lane >> 4;
    const int K = g.K, nt = K / BK;
    unsigned voffA[2], voffB[2];
#pragma unroll
    for (int i = 0; i < 2; ++i) { int R, C; stage_rc(tid * 16 + i * 8192, R, C); const int Rb = Epi::PERM ? ((R & ~31) + perm32(R & 31)) : R;
        voffA[i] = (unsigned)(R * K + C) * 2u; voffB[i] = (unsigned)(Rb * K + C) * 2u; }
    const size_t kstep = (size_t)(BK * 2);
    const size_t hstep = (size_t)HALF * K * 2;
    const size_t tstep = 2 * hstep;
    const unsigned ldsw = (unsigned)wid * 1024u;
    const int aoff = lds_byte(wr * 64 + fr, fq * 8), boff = lds_byte(wc * 32 + fr, fq * 8);
#define PG8_SA(b, h) (((b) * 2 + (h)) * HTB)
#define PG8_SB(b, h) ((4 + (b) * 2 + (h)) * HTB)
#define PG8_STAGE(bufoff, gbase, voff) do { _Pragma("unroll") for (int _i = 0; _i < 2; ++_i) \
        __builtin_amdgcn_global_load_lds((const unsigned*)((const char*)(gbase) + (voff)[_i]), (PG8_LAS unsigned*)(lds + (bufoff) + ldsw + _i * 8192), 16, 0, 0); } while (0)
#define PG8_LDA(dst, b, h) do { _Pragma("unroll") for (int m = 0; m < 4; ++m) _Pragma("unroll") for (int k = 0; k < 2; ++k) dst[m][k] = *(const PG8_LAS bf16x8*)(lds + PG8_SA(b, h) + aoff + m * 2048 + k * 1024); } while (0)
#define PG8_LDB(dst, b, h) do { _Pragma("unroll") for (int n = 0; n < 2; ++n) _Pragma("unroll") for (int k = 0; k < 2; ++k) dst[n][k] = *(const PG8_LAS bf16x8*)(lds + PG8_SB(b, h) + boff + n * 2048 + k * 1024); } while (0)
#define PG8_MMA(ai, bj, At, Bt) do { __builtin_amdgcn_s_setprio(1); _Pragma("unroll") for (int m = 0; m < 4; ++m) _Pragma("unroll") for (int n = 0; n < 2; ++n) _Pragma("unroll") for (int k = 0; k < 2; ++k) \
        acc[ai][bj][m][n] = __builtin_amdgcn_mfma_f32_16x16x32_bf16(Bt[n][k], At[m][k], acc[ai][bj][m][n], 0, 0, 0); __builtin_amdgcn_s_setprio(0); } while (0)
#define PG8_WAIT_V(n) asm volatile("s_waitcnt vmcnt(" #n ")" ::: "memory")
#define PG8_WAIT_L(n) asm volatile("s_waitcnt lgkmcnt(" #n ")" ::: "memory")
#define PG8_BAR __builtin_amdgcn_s_barrier()
#define PG8_SCHED __builtin_amdgcn_sched_barrier(0)
    Unit cur, nxt; int ui = 0;
    if (!S.next(0, cur)) return;
    f32x4 acc[2][2][4][2];
#pragma unroll
    for (int a = 0; a < 2; ++a)
#pragma unroll
        for (int b = 0; b < 2; ++b)
#pragma unroll
            for (int m = 0; m < 4; ++m)
#pragma unroll
                for (int n = 0; n < 2; ++n) acc[a][b][m][n] = (f32x4){0.f, 0.f, 0.f, 0.f};
    bf16x8 At[4][2], B0[2][2], B1[2][2];
    const char* cA = (const char*)g.A + (size_t)cur.pm * tstep; const char* cB = (const char*)g.Bt + (size_t)cur.pn * tstep;
    S.a_ready(cur);
    if constexpr (SP2) {
        PG8_STAGE(PG8_SB(0, 0), cB, voffB); PG8_STAGE(PG8_SB(0, 1), cB + hstep, voffB); PG8_STAGE(PG8_SA(0, 0), cA, voffA); PG8_STAGE(PG8_SA(0, 1), cA + hstep, voffA);
        if (wr == 1) PG8_BAR;
        PG8_WAIT_V(2); PG8_BAR;
        PG8_STAGE(PG8_SB(1, 0), cB + kstep, voffB); PG8_STAGE(PG8_SA(1, 0), cA + kstep, voffA); PG8_STAGE(PG8_SB(1, 1), cB + hstep + kstep, voffB);
        PG8_WAIT_V(6); PG8_BAR;
    } else {
        PG8_STAGE(PG8_SB(0, 0), cB, voffB); PG8_STAGE(PG8_SA(0, 0), cA, voffA); PG8_STAGE(PG8_SB(0, 1), cB + hstep, voffB); PG8_STAGE(PG8_SA(0, 1), cA + hstep, voffA);
        if (wr == 1) PG8_BAR;
        PG8_WAIT_V(4); PG8_BAR;
        PG8_STAGE(PG8_SB(1, 0), cB + kstep, voffB); PG8_STAGE(PG8_SA(1, 0), cA + kstep, voffA); PG8_STAGE(PG8_SB(1, 1), cB + hstep + kstep, voffB);
        PG8_WAIT_V(6); PG8_BAR;
    }
    for (;;) {
        const bool has_next = S.next(ui + 1, nxt);
        const char* nA = has_next ? (const char*)g.A + (size_t)nxt.pm * tstep : cA; const char* nB = has_next ? (const char*)g.Bt + (size_t)nxt.pn * tstep : cB;
        for (int t = 0; t < nt; t += 2) {
            const bool last = (t == nt - 2);
            const char* a1 = cA + (size_t)(t + 1) * kstep;
            const char* a2 = last ? nA : cA + (size_t)(t + 2) * kstep; const char* b2 = last ? nB : cB + (size_t)(t + 2) * kstep;
            const char* a3 = a2 + kstep; const char* b3 = b2 + kstep;
            if (last && has_next) S.a_ready(nxt);
            if constexpr (SP2) {
            PG8_LDB(B0, 0, 0); PG8_LDB(B1, 0, 1); PG8_SCHED; PG8_LDA(At, 0, 0); PG8_STAGE(PG8_SA(1, 1), a1 + hstep, voffA);
            PG8_WAIT_V(8); PG8_WAIT_L(0); PG8_BAR; PG8_MMA(0, 0, At, B0); PG8_MMA(0, 1, At, B1); PG8_BAR; PG8_SCHED;
            PG8_LDA(At, 0, 1); PG8_STAGE(PG8_SB(0, 0), b2, voffB); PG8_STAGE(PG8_SB(0, 1), b2 + hstep, voffB); PG8_STAGE(PG8_SA(0, 0), a2, voffA);
            PG8_WAIT_V(8); PG8_WAIT_L(0); PG8_BAR; PG8_MMA(1, 0, At, B0); PG8_MMA(1, 1, At, B1); PG8_BAR; PG8_SCHED;
            PG8_LDB(B0, 1, 0); PG8_LDB(B1, 1, 1); PG8_SCHED; PG8_LDA(At, 1, 0); PG8_STAGE(PG8_SA(0, 1), a2 + hstep, voffA);
            PG8_WAIT_V(8); PG8_WAIT_L(0); PG8_BAR; PG8_MMA(0, 0, At, B0); PG8_MMA(0, 1, At, B1); PG8_BAR; PG8_SCHED;
            PG8_LDA(At, 1, 1); PG8_STAGE(PG8_SB(1, 0), b3, voffB); PG8_STAGE(PG8_SB(1, 1), b3 + hstep, voffB); PG8_STAGE(PG8_SA(1, 0), a3, voffA);
            PG8_WAIT_V(8); PG8_WAIT_L(0); PG8_BAR; PG8_MMA(1, 0, At, B0); PG8_MMA(1, 1, At, B1); PG8_BAR; PG8_SCHED;
            } else {
            PG8_LDB(B0, 0, 0); PG8_SCHED; PG8_LDA(At, 0, 0); PG8_STAGE(PG8_SA(1, 1), a1 + hstep, voffA);
            PG8_WAIT_L(8); PG8_BAR; PG8_WAIT_L(0); PG8_MMA(0, 0, At, B0); PG8_BAR; PG8_SCHED;
            PG8_LDB(B1, 0, 1); PG8_STAGE(PG8_SB(0, 0), b2, voffB);
            PG8_BAR; PG8_WAIT_L(0); PG8_MMA(0, 1, At, B1); PG8_BAR;
            PG8_LDA(At, 0, 1); PG8_STAGE(PG8_SA(0, 0), a2, voffA);
            PG8_BAR; PG8_WAIT_L(0); PG8_MMA(1, 0, At, B0); PG8_BAR; PG8_SCHED;
            PG8_STAGE(PG8_SB(0, 1), b2 + hstep, voffB);
            PG8_WAIT_V(6); PG8_BAR; PG8_MMA(1, 1, At, B1); PG8_BAR;
            PG8_LDB(B0, 1, 0); PG8_SCHED; PG8_LDA(At, 1, 0); PG8_STAGE(PG8_SA(0, 1), a2 + hstep, voffA);
            PG8_WAIT_L(8); PG8_BAR; PG8_WAIT_L(0); PG8_MMA(0, 0, At, B0); PG8_BAR; PG8_SCHED;
            PG8_LDB(B1, 1, 1); PG8_STAGE(PG8_SB(1, 0), b3, voffB);
            PG8_BAR; PG8_WAIT_L(0); PG8_MMA(0, 1, At, B1); PG8_BAR;
            PG8_LDA(At, 1, 1); PG8_STAGE(PG8_SA(1, 0), a3, voffA);
            PG8_BAR; PG8_WAIT_L(0); PG8_MMA(1, 0, At, B0); PG8_BAR; PG8_SCHED;
            PG8_STAGE(PG8_SB(1, 1), b3 + hstep, voffB);
            PG8_WAIT_V(6); PG8_BAR; PG8_MMA(1, 1, At, B1); PG8_BAR;
            }
        }
        if constexpr (ALIGN_EPI) { if (wr == 0) PG8_BAR; }
        if constexpr (!Epi::AFTER_DRAIN) { E(acc, cur, wr, wc, fr, fq); S.done(cur); }
        if (!has_next) break;
#pragma unroll
        for (int a = 0; a < 2; ++a)
#pragma unroll
            for (int b = 0; b < 2; ++b)
#pragma unroll
                for (int m = 0; m < 4; ++m)
#pragma unroll
                    for (int n = 0; n < 2; ++n) acc[a][b][m][n] = (f32x4){0.f, 0.f, 0.f, 0.f};
        cur = nxt; cA = nA; cB = nB; ++ui;
        if constexpr (ALIGN_EPI) { if (wr == 1) PG8_BAR; }
    }
    PG8_WAIT_V(0);
    if constexpr (!ALIGN_EPI) { if (wr == 0) PG8_BAR; }
    PG8_BAR;
    if constexpr (Epi::AFTER_DRAIN) { E.fused(acc, cur, wr, wc, fr, fq, lds, wid, lane); S.done(cur); }
#undef PG8_SA
#undef PG8_SB
#undef PG8_STAGE
#undef PG8_LDA
#undef PG8_LDB
#undef PG8_MMA
#undef PG8_WAIT_V
#undef PG8_WAIT_L
#undef PG8_BAR
#undef PG8_SCHED
}
}
constexpr int T = 8192, SEQ = 4096, D = 2048, NPROJ = 7168, NIN = 7176;
constexpr int NH = 4, DH = 256, LCH = 64, DML = 1024;
constexpr int NEXP = 16384, PEER_H = 8, TOPK = 16;
constexpr float EPS = 1e-6f;
constexpr int PC_CX = 0, PC_CB = 1024, PC_CC = 2048, PC_Q = 3072, PC_K = 4096, PC_V = 5120, PC_O = 6144;
constexpr int NTHREADS = 512, NWAVES = 8;
constexpr int LDS_BYTES = 147456;

constexpr size_t MiB = 1u << 20;
constexpr size_t WS_CTL = 0, CTL_ZERO_BYTES = 64 * 1024;
constexpr size_t WS_RS1 = 1 * MiB, WS_GI = 1 * MiB + 64 * 1024, WS_GF = 1 * MiB + 256 * 1024, WS_SSQ = 3 * MiB, WS_ESC = 4 * MiB;
constexpr size_t WS_XB = 5 * MiB, WS_WINT = 37 * MiB, WS_WOUTT = 65 * MiB, WS_WQT = 73 * MiB;
constexpr size_t WS_PROJ = 81 * MiB;
constexpr size_t WS_X1 = 81 * MiB, WS_X1B = 145 * MiB;
constexpr size_t WS_HRAW = 193 * MiB, WS_MIXIN = 225 * MiB, WS_QV = 257 * MiB, WS_IDX = 321 * MiB, WS_GATE = 325 * MiB;
constexpr size_t WS_UB = 329 * MiB, WS_VB = 393 * MiB, WS_END = 457 * MiB;

struct Params {
    const float *x, *g1, *w_in, *b_ig, *b_fg, *conv_w, *gm, *w_out, *g2, *w_q, *sk1, *sk2, *eu, *ev, *gfin;
    float* out; unsigned char* ws;
    int ph_lo, ph_hi;
};

typedef unsigned short bf16_t;
__device__ __forceinline__ unsigned f2bf(float f) { unsigned u = __float_as_uint(f); return (u + 0x7fffu + ((u >> 16) & 1u)) >> 16; }
__device__ __forceinline__ unsigned pk2(float lo, float hi) { return f2bf(lo) | (f2bf(hi) << 16); }
__device__ __forceinline__ float bflo(unsigned w) { return __uint_as_float(w << 16); }
__device__ __forceinline__ float bfhi(unsigned w) { return __uint_as_float(w & 0xffff0000u); }
__device__ __forceinline__ float bf1(bf16_t h) { return __uint_as_float((unsigned)h << 16); }
__device__ __forceinline__ float wave_sum(float v) {
#pragma unroll
    for (int o = 32; o >= 1; o >>= 1) v += __shfl_xor(v, o);
    return v;
}
__device__ __forceinline__ void unpack8(const uint4 w, float (&f)[8]) {
    f[0] = bflo(w.x); f[1] = bfhi(w.x); f[2] = bflo(w.y); f[3] = bfhi(w.y); f[4] = bflo(w.z); f[5] = bfhi(w.z); f[6] = bflo(w.w); f[7] = bfhi(w.w);
}
__device__ __forceinline__ float log_sigmoid(float z) { return z >= 0.f ? -log1pf(expf(-z)) : z - log1pf(expf(z)); }
__device__ __forceinline__ float gelu_erf(float v) { return 0.5f * v * (1.0f + erff(v * 0.70710678118654752f)); }

__device__ __forceinline__ void p0_rows(const Params& P, unsigned char* lds, int G, int bid) {
    float* wg = (float*)lds;
    const int tid = threadIdx.x, lane = tid & 63, wave = tid >> 6;
    for (int i = tid; i < 8 * D; i += NTHREADS) { const int g = i >> 11, k = i & 2047; wg[i] = P.w_in[(size_t)k * NIN + NPROJ + g] * P.g1[k]; }
    __syncthreads();
    float* rs1 = (float*)(P.ws + WS_RS1); float* gi = (float*)(P.ws + WS_GI); float* gf = (float*)(P.ws + WS_GF); bf16_t* xb = (bf16_t*)(P.ws + WS_XB);
    for (int t = bid * NWAVES + wave; t < T; t += G * NWAVES) {
        const float4* xr = (const float4*)(P.x + (size_t)t * D);
        float ss = 0.f, dg[8];
#pragma unroll
        for (int g = 0; g < 8; ++g) dg[g] = 0.f;
#pragma unroll 1
        for (int j = 0; j < 8; ++j) {
            const float4 v = xr[j * 64 + lane];
            ss += (v.x * v.x + v.y * v.y) + (v.z * v.z + v.w * v.w);
            const int k0 = (j * 64 + lane) * 4;
#pragma unroll
            for (int g = 0; g < 8; ++g) { const float4 w = *(const float4*)(wg + g * D + k0); dg[g] += (v.x * w.x + v.y * w.y) + (v.z * w.z + v.w * w.w); }
            ((uint2*)(xb + (size_t)t * D))[j * 64 + lane] = make_uint2(pk2(v.x, v.y), pk2(v.z, v.w));
        }
        ss = wave_sum(ss);
#pragma unroll
        for (int g = 0; g < 8; ++g) dg[g] = wave_sum(dg[g]);
        const float rs = rsqrtf(ss * (1.0f / D) + EPS);
        if (lane == 0) {
            rs1[t] = rs;
#pragma unroll
            for (int h = 0; h < 4; ++h) { gi[t * 4 + h] = rs * dg[h] + P.b_ig[h]; gf[t * 4 + h] = log_sigmoid(rs * dg[4 + h] + P.b_fg[h]); }
        }
    }
    __syncthreads();
}
__device__ __forceinline__ void transpose_tile(const float* W, int ldw, int K, const float* gain, bf16_t* WT, int k0, int n0, float* tile) {
    const int tid = threadIdx.x;
#pragma unroll
    for (int r = 0; r < 2; ++r) {
        const int kk = (tid >> 4) + 32 * r, n4 = (tid & 15) * 4;
        float4 v = *(const float4*)(W + (size_t)(k0 + kk) * ldw + n0 + n4);
        const float g = gain ? gain[k0 + kk] : 1.0f;
        tile[kk * 65 + n4 + 0] = v.x * g; tile[kk * 65 + n4 + 1] = v.y * g; tile[kk * 65 + n4 + 2] = v.z * g; tile[kk * 65 + n4 + 3] = v.w * g;
    }
    __syncthreads();
    { const int nn = tid >> 3, k8 = (tid & 7) * 8; float f[8];
#pragma unroll
      for (int i = 0; i < 8; ++i) f[i] = tile[(k8 + i) * 65 + nn];
      *(uint4*)(WT + (size_t)(n0 + nn) * K + k0 + k8) = make_uint4(pk2(f[0], f[1]), pk2(f[2], f[3]), pk2(f[4], f[5]), pk2(f[6], f[7])); }
    __syncthreads();
}
__device__ __forceinline__ void p0_weights(const Params& P, unsigned char* lds, int G, int bid) {
    float* tile = (float*)lds;
    constexpr int N_IN = (D / 64) * (NPROJ / 64), N_SQ = (D / 64) * (D / 64);
    for (int it = bid; it < N_IN + 2 * N_SQ; it += G) {
        if (it < N_IN) { const int kt = it / (NPROJ / 64), nt = it % (NPROJ / 64); transpose_tile(P.w_in, NIN, D, P.g1, (bf16_t*)(P.ws + WS_WINT), kt * 64, nt * 64, tile); }
        else if (it < N_IN + N_SQ) { const int j = it - N_IN, kt = j / (D / 64), nt = j % (D / 64); transpose_tile(P.w_out, D, D, nullptr, (bf16_t*)(P.ws + WS_WOUTT), kt * 64, nt * 64, tile); }
        else { const int j = it - N_IN - N_SQ, kt = j / (D / 64), nt = j % (D / 64); transpose_tile(P.w_q, D, D, P.g2, (bf16_t*)(P.ws + WS_WQT), kt * 64, nt * 64, tile); }
    }
}
typedef float f32x2_t __attribute__((ext_vector_type(2)));
__device__ __forceinline__ float wave_max(float v) {
#pragma unroll
    for (int o = 32; o >= 1; o >>= 1) v = fmaxf(v, __shfl_xor(v, o));
    return v;
}
__device__ __forceinline__ void p0_tables(const Params& P, int nworkers, int wid) {
    const int lane = threadIdx.x & 63, wave = threadIdx.x >> 6;
    float* esc = (float*)(P.ws + WS_ESC);
#pragma unroll 1
    for (int rix = wid * NWAVES + wave; rix < 2 * NEXP; rix += nworkers * NWAVES) {
        const int isv = rix & 1, e = rix >> 1;
        const float4* src = (const float4*)((isv ? P.ev : P.eu) + (size_t)e * D);
        unsigned* dst = (unsigned*)(P.ws + (isv ? WS_VB : WS_UB)) + (size_t)e * (D / 4);
        float4 v[8]; float mx = 0.f;
#pragma unroll
        for (int j = 0; j < 8; ++j) { v[j] = src[j * 64 + lane];
            if (!isv) { const float4 gg = ((const float4*)P.g2)[j * 64 + lane]; v[j].x *= gg.x; v[j].y *= gg.y; v[j].z *= gg.z; v[j].w *= gg.w; }
            mx = fmaxf(mx, fmaxf(fmaxf(fabsf(v[j].x), fabsf(v[j].y)), fmaxf(fabsf(v[j].z), fabsf(v[j].w)))); }
        mx = wave_max(mx);
        const float sc = mx > 0.f ? 240.0f / mx : 1.0f, inv = mx > 0.f ? mx * (1.0f / 240.0f) : 1.0f;
#pragma unroll
        for (int j = 0; j < 8; ++j) { int pk = __builtin_amdgcn_cvt_pk_fp8_f32(v[j].x * sc, v[j].y * sc, 0, false); pk = __builtin_amdgcn_cvt_pk_fp8_f32(v[j].z * sc, v[j].w * sc, pk, true); dst[j * 64 + lane] = (unsigned)pk; }
        if (lane == 0) esc[e * 2 + isv] = inv;
    }
}

__device__ __forceinline__ void p2_conv(const Params& P, int nworkers, int wid) {
    const bf16_t* proj = (const bf16_t*)(P.ws + WS_PROJ); bf16_t* mix = (bf16_t*)(P.ws + WS_MIXIN);
    for (int idx = wid * NTHREADS + threadIdx.x; idx < T * 128; idx += nworkers * NTHREADS) {
        const int t = idx >> 7, c8 = (idx & 127) * 8, s = t & (SEQ - 1);
        float y[8];
#pragma unroll
        for (int i = 0; i < 8; ++i) y[i] = 0.f;
#pragma unroll
        for (int j = 0; j < 3; ++j) {
            const int dt = 2 - j;
            if (s >= dt) {
                const bf16_t* row = proj + (size_t)(t - dt) * NPROJ;
                float cx[8], cc[8]; unpack8(*(const uint4*)(row + PC_CX + c8), cx); unpack8(*(const uint4*)(row + PC_CC + c8), cc);
                const float4 w0 = *(const float4*)(P.conv_w + j * 1024 + c8), w1 = *(const float4*)(P.conv_w + j * 1024 + c8 + 4);
                y[0] += w0.x * (cc[0] * cx[0]); y[1] += w0.y * (cc[1] * cx[1]); y[2] += w0.z * (cc[2] * cx[2]); y[3] += w0.w * (cc[3] * cx[3]);
                y[4] += w1.x * (cc[4] * cx[4]); y[5] += w1.y * (cc[5] * cx[5]); y[6] += w1.z * (cc[6] * cx[6]); y[7] += w1.w * (cc[7] * cx[7]);
            }
        }
        float cb[8]; unpack8(*(const uint4*)(proj + (size_t)t * NPROJ + PC_CB + c8), cb);
        *(uint4*)(mix + (size_t)t * D + c8) = make_uint4(pk2(cb[0] * y[0], cb[1] * y[1]), pk2(cb[2] * y[2], cb[3] * y[3]), pk2(cb[4] * y[4], cb[5] * y[5]), pk2(cb[6] * y[6], cb[7] * y[7]));
    }
}
#define LAS3 __attribute__((address_space(3)))
typedef short s16x4_t __attribute__((ext_vector_type(4)));
typedef unsigned v4u_t __attribute__((ext_vector_type(4)));
typedef unsigned v2u_t __attribute__((ext_vector_type(2)));
__device__ __forceinline__ pg8::bf16x8 tr8(LAS3 unsigned char* p0, LAS3 unsigned char* p1) {
    const s16x4_t a = __builtin_amdgcn_ds_read_tr16_b64_v4i16((LAS3 s16x4_t*)p0), b = __builtin_amdgcn_ds_read_tr16_b64_v4i16((LAS3 s16x4_t*)p1);
    return __builtin_shufflevector(a, b, 0, 1, 2, 3, 4, 5, 6, 7);
}
__device__ __forceinline__ void mlstm_unit(const Params& P, unsigned char* lds_, int unit) {
    typedef pg8::bf16x8 bf16x8; typedef pg8::f32x4 f32x4;
    LAS3 unsigned char* L = (LAS3 unsigned char*)lds_;
    constexpr int QS = 0, KS = 33792, VA = 67584, WV = 73728, SW = 79872, CB = 89088, SM = 114432;
    constexpr int QST = 528, VST = 96, SST = 144;
    LAS3 float* sA = (LAS3 float*)(L + SM); LAS3 float* sM = sA + 64; LAS3 float* sEi = sA + 128; LAS3 float* sWl = sA + 192; LAS3 float* sEnm = sA + 256; LAS3 float* sDen = sA + 320; LAS3 float* sMisc = sA + 384;
    const int tid = threadIdx.x, lane = tid & 63, wave = __builtin_amdgcn_readfirstlane(tid >> 6);
    const int g = lane >> 4, c16 = lane & 15, q4 = c16 >> 2, p4 = lane & 3;
    const int bh = unit >> 3, sl = unit & 7, b = bh >> 2, h = bh & 3, v0 = sl * 32;
    const bf16_t* proj = (const bf16_t*)(P.ws + WS_PROJ);
    const float* gi = (const float*)(P.ws + WS_GI); const float* gf = (const float*)(P.ws + WS_GF);
    float* hraw = (float*)(P.ws + WS_HRAW);
    for (int i = tid; i < 25344 / 16; i += NTHREADS) *(LAS3 v4u_t*)(L + CB + i * 16) = (v4u_t){0u, 0u, 0u, 0u};
    if (tid < 64) { *(LAS3 v4u_t*)(L + VA + tid * VST + 64) = (v4u_t){0x00003F80u, 0u, 0u, 0u}; *(LAS3 v4u_t*)(L + VA + tid * VST + 80) = (v4u_t){0u, 0u, 0u, 0u}; }
    f32x4 accC[2][3];
#pragma unroll
    for (int dt = 0; dt < 2; ++dt)
#pragma unroll
        for (int vt = 0; vt < 3; ++vt) accC[dt][vt] = (f32x4){0.f, 0.f, 0.f, 0.f};
    float m = 0.f;
    const int row = tid >> 3, seg = tid & 7;
    v4u_t rq[4], rk[4], rv = (v4u_t){0u, 0u, 0u, 0u}; float ric = 0.f, rfc = 0.f;
    { const int t0 = b * SEQ; const bf16_t* src = proj + (size_t)(t0 + row) * NPROJ + h * DH + seg * 32;
#pragma unroll
      for (int i = 0; i < 4; ++i) { rq[i] = *(const v4u_t*)(src + PC_Q + i * 8); rk[i] = *(const v4u_t*)(src + PC_K + i * 8); }
      if (tid < 256) rv = *(const v4u_t*)(proj + (size_t)(t0 + (tid >> 2)) * NPROJ + PC_V + h * DH + v0 + (tid & 3) * 8);
      if (wave == 0) { ric = gi[(size_t)(t0 + lane) * 4 + h]; rfc = gf[(size_t)(t0 + lane) * 4 + h]; } }
    __syncthreads();
#pragma unroll 1
    for (int c = 0; c < SEQ / LCH; ++c) {
        const int t0 = b * SEQ + c * LCH;
#pragma unroll
        for (int i = 0; i < 4; ++i) { *(LAS3 v4u_t*)(L + QS + row * QST + seg * 64 + i * 16) = rq[i]; *(LAS3 v4u_t*)(L + KS + row * QST + seg * 64 + i * 16) = rk[i]; }
        if (tid < 256) *(LAS3 v4u_t*)(L + VA + (tid >> 2) * VST + (tid & 3) * 16) = rv;
        if (wave == 0) {
            float bc = rfc;
#pragma unroll
            for (int o = 1; o < 64; o <<= 1) { const float tv = __shfl_up(bc, o); if (lane >= o) bc += tv; }
            const float a = ric - bc; float pm = a;
#pragma unroll
            for (int o = 1; o < 64; o <<= 1) { const float tv = __shfl_up(pm, o); if (lane >= o) pm = fmaxf(pm, tv); }
            const float M = fmaxf(m, pm), M63 = __shfl(M, 63), b63 = __shfl(bc, 63);
            sA[lane] = a; sM[lane] = M; sEi[lane] = expf(m - M); sWl[lane] = expf(a - M63) * 0.0625f; sEnm[lane] = expf(-bc - M);
            if (lane == 0) { sMisc[0] = b63 + M63; sMisc[1] = expf(m - M63); }
        }
        if (c + 1 < SEQ / LCH) { const int t1 = t0 + LCH; const bf16_t* src = proj + (size_t)(t1 + row) * NPROJ + h * DH + seg * 32;
#pragma unroll
            for (int i = 0; i < 4; ++i) { rq[i] = *(const v4u_t*)(src + PC_Q + i * 8); rk[i] = *(const v4u_t*)(src + PC_K + i * 8); }
            if (tid < 256) rv = *(const v4u_t*)(proj + (size_t)(t1 + (tid >> 2)) * NPROJ + PC_V + h * DH + v0 + (tid & 3) * 8);
            if (wave == 0) { ric = gi[(size_t)(t1 + lane) * 4 + h]; rfc = gf[(size_t)(t1 + lane) * 4 + h]; } }
        __syncthreads();
        { const int rt = wave >> 1;
#pragma unroll
          for (int cc = 0; cc < 2; ++cc) { const int ct = (wave & 1) * 2 + cc; f32x4 acc = (f32x4){0.f, 0.f, 0.f, 0.f};
              if (ct <= rt) {
#pragma unroll
                  for (int ks = 0; ks < 8; ++ks) { const bf16x8 av = *(LAS3 bf16x8*)(L + QS + (rt * 16 + c16) * QST + (ks * 32 + g * 8) * 2), bv = *(LAS3 bf16x8*)(L + KS + (ct * 16 + c16) * QST + (ks * 32 + g * 8) * 2);
                      acc = __builtin_amdgcn_mfma_f32_16x16x32_bf16(av, bv, acc, 0, 0, 0); } }
              const int l = ct * 16 + c16; const float al = sA[l]; const f32x4 M4 = *(LAS3 f32x4*)(sM + rt * 16 + 4 * g);
#pragma unroll
              for (int r = 0; r < 4; ++r) { const int j = rt * 16 + 4 * g + r; const float val = (l <= j) ? acc[r] * 0.0625f * __expf(al - M4[r]) : 0.f;
                  *(LAS3 unsigned short*)(L + SW + j * SST + l * 2) = (unsigned short)f2bf(val); } } }
#pragma unroll
        for (int i = 0; i < 6; ++i) { const int e = tid + NTHREADS * i, l = e / 48, vp = e - l * 48;
            *(LAS3 unsigned short*)(L + WV + l * VST + vp * 2) = (unsigned short)f2bf(sWl[l] * bf1(*(LAS3 unsigned short*)(L + VA + l * VST + vp * 2))); }
        __syncthreads();
        const int rt = wave >> 1, vt = wave & 1;
        f32x4 num;
        { f32x4 accI = (f32x4){0.f, 0.f, 0.f, 0.f}, accX = (f32x4){0.f, 0.f, 0.f, 0.f};
#pragma unroll
          for (int ks = 0; ks < 8; ++ks) { const bf16x8 av = *(LAS3 bf16x8*)(L + QS + (rt * 16 + c16) * QST + (ks * 32 + g * 8) * 2), bv = *(LAS3 bf16x8*)(L + CB + (vt * 16 + c16) * QST + (ks * 32 + g * 8) * 2);
              accI = __builtin_amdgcn_mfma_f32_16x16x32_bf16(av, bv, accI, 0, 0, 0); }
#pragma unroll
          for (int ks = 0; ks < 2; ++ks) { const bf16x8 av = *(LAS3 bf16x8*)(L + SW + (rt * 16 + c16) * SST + (ks * 32 + g * 8) * 2);
              LAS3 unsigned char* vp = L + VA + (ks * 32 + g * 8 + q4) * VST + (vt * 16 + 4 * p4) * 2; const bf16x8 bv = tr8(vp, vp + 4 * VST);
              accX = __builtin_amdgcn_mfma_f32_16x16x32_bf16(av, bv, accX, 0, 0, 0); }
          const f32x4 e4 = *(LAS3 f32x4*)(sEi + rt * 16 + 4 * g);
          num = e4 * accI + accX;
          if ((wave & 1) == 0) {
              f32x4 aI = (f32x4){0.f, 0.f, 0.f, 0.f}, aX = (f32x4){0.f, 0.f, 0.f, 0.f};
#pragma unroll
              for (int ks = 0; ks < 8; ++ks) { const bf16x8 av = *(LAS3 bf16x8*)(L + QS + (rt * 16 + c16) * QST + (ks * 32 + g * 8) * 2), bv = *(LAS3 bf16x8*)(L + CB + (32 + c16) * QST + (ks * 32 + g * 8) * 2);
                  aI = __builtin_amdgcn_mfma_f32_16x16x32_bf16(av, bv, aI, 0, 0, 0); }
#pragma unroll
              for (int ks = 0; ks < 2; ++ks) { const bf16x8 av = *(LAS3 bf16x8*)(L + SW + (rt * 16 + c16) * SST + (ks * 32 + g * 8) * 2);
                  LAS3 unsigned char* vp = L + VA + (ks * 32 + g * 8 + q4) * VST + (32 + 4 * p4) * 2; const bf16x8 bv = tr8(vp, vp + 4 * VST);
                  aX = __builtin_amdgcn_mfma_f32_16x16x32_bf16(av, bv, aX, 0, 0, 0); }
              if (c16 == 0) {
#pragma unroll
                  for (int r = 0; r < 4; ++r) { const int j = rt * 16 + 4 * g + r; sDen[j] = fmaxf(fabsf(e4[r] * aI[r] + aX[r]), sEnm[j]); } }
          } }
        __syncthreads();
        { const f32x4 d4 = *(LAS3 f32x4*)(sDen + rt * 16 + 4 * g);
#pragma unroll
          for (int r = 0; r < 4; ++r) hraw[(size_t)(t0 + rt * 16 + 4 * g + r) * DML + h * DH + v0 + vt * 16 + c16] = num[r] / d4[r]; }
        { const float decay = sMisc[1];
#pragma unroll
          for (int dt = 0; dt < 2; ++dt)
#pragma unroll
              for (int v3 = 0; v3 < 3; ++v3) accC[dt][v3] *= decay;
#pragma unroll
          for (int ks = 0; ks < 2; ++ks) { bf16x8 af[2], bfr[3];
#pragma unroll
              for (int dt = 0; dt < 2; ++dt) { LAS3 unsigned char* kp = L + KS + (ks * 32 + g * 8 + q4) * QST + ((2 * wave + dt) * 16 + 4 * p4) * 2; af[dt] = tr8(kp, kp + 4 * QST); }
#pragma unroll
              for (int v3 = 0; v3 < 3; ++v3) { LAS3 unsigned char* wp = L + WV + (ks * 32 + g * 8 + q4) * VST + (v3 * 16 + 4 * p4) * 2; bfr[v3] = tr8(wp, wp + 4 * VST); }
#pragma unroll
              for (int dt = 0; dt < 2; ++dt)
#pragma unroll
                  for (int v3 = 0; v3 < 3; ++v3) accC[dt][v3] = __builtin_amdgcn_mfma_f32_16x16x32_bf16(af[dt], bfr[v3], accC[dt][v3], 0, 0, 0); }
#pragma unroll
          for (int dt = 0; dt < 2; ++dt)
#pragma unroll
              for (int v3 = 0; v3 < 3; ++v3) { const int d = (2 * wave + dt) * 16 + 4 * g, vp = v3 * 16 + c16;
                  *(LAS3 v2u_t*)(L + CB + vp * QST + d * 2) = (v2u_t){pk2(accC[dt][v3][0], accC[dt][v3][1]), pk2(accC[dt][v3][2], accC[dt][v3][3])}; }
          m = sMisc[0]; }
        __syncthreads();
    }
}

__device__ __forceinline__ void p3_finalize(const Params& P, int G, int bid) {
    const int lane = threadIdx.x & 63, wave = threadIdx.x >> 6;
    const float* hraw = (const float*)(P.ws + WS_HRAW); const bf16_t* proj = (const bf16_t*)(P.ws + WS_PROJ); bf16_t* mix = (bf16_t*)(P.ws + WS_MIXIN);
    for (int idx = bid * NWAVES + wave; idx < T * NH; idx += G * NWAVES) {
        const int t = idx >> 2, hh = idx & 3;
        const float4 hv = *(const float4*)(hraw + (size_t)t * DML + hh * DH + lane * 4);
        const float ss = wave_sum((hv.x * hv.x + hv.y * hv.y) + (hv.z * hv.z + hv.w * hv.w));
        const float r = rsqrtf(ss * (1.0f / DH) + EPS);
        const uint2 ow = *(const uint2*)(proj + (size_t)t * NPROJ + PC_O + hh * DH + lane * 4);
        const float4 g = *(const float4*)(P.gm + hh * DH + lane * 4);
        const float o0 = 1.0f / (1.0f + expf(-bflo(ow.x))), o1 = 1.0f / (1.0f + expf(-bfhi(ow.x))), o2 = 1.0f / (1.0f + expf(-bflo(ow.y))), o3 = 1.0f / (1.0f + expf(-bfhi(ow.y)));
        *(uint2*)(mix + (size_t)t * D + DML + hh * DH + lane * 4) = make_uint2(pk2(o0 * (hv.x * r * g.x), o1 * (hv.y * r * g.y)), pk2(o2 * (hv.z * r * g.z), o3 * (hv.w * r * g.w)));
    }
}

template <int CTRL> __device__ __forceinline__ float dppf(float v) { return __int_as_float(__builtin_amdgcn_update_dpp(0, __float_as_int(v), CTRL, 0xF, 0xF, true)); }
__device__ __forceinline__ float grp16_max(float v) { v = fmaxf(v, dppf<0xB1>(v)); v = fmaxf(v, dppf<0x4E>(v)); v = fmaxf(v, dppf<0x141>(v)); v = fmaxf(v, dppf<0x140>(v)); return v; }
__device__ __forceinline__ float grp16_sum(float v) { v += dppf<0xB1>(v); v += dppf<0x4E>(v); v += dppf<0x141>(v); v += dppf<0x140>(v); return v; }
#define CEX(a, b) do { const float hi_ = fmaxf(a, b), lo_ = fminf(a, b); a = hi_; b = lo_; } while (0)
static __device__ const unsigned char CAND_AB[16][4] = {
    {0x00, 0x01, 0x02, 0x03}, {0x04, 0x05, 0x06, 0x07}, {0x08, 0x09, 0x0A, 0x0B}, {0x0C, 0x0D, 0x0E, 0x0F}, {0x10, 0x11, 0x12, 0x13}, {0x14, 0x15, 0x16, 0x17}, {0x20, 0x21, 0x22, 0x23}, {0x24, 0, 0, 0},
    {0x30, 0x31, 0x32, 0x33}, {0x40, 0x41, 0x42, 0}, {0x50, 0x60, 0x70, 0x80}, {0x90, 0xA0, 0xB0, 0xC0}, {0xD0, 0xE0, 0xF0, 0}, {0x51, 0x61, 0x71, 0}, {0, 0, 0, 0}, {0, 0, 0, 0}};
static __device__ const unsigned char CAND_N[16] = {4, 4, 4, 4, 4, 4, 4, 1, 4, 3, 4, 4, 3, 3, 0, 0};
__device__ __forceinline__ void p6_topk(const Params& P, unsigned char* lds_, int G, int bid) {
    typedef pg8::bf16x8 bf16x8; typedef pg8::f32x4 f32x4;
    LAS3 unsigned char* L = (LAS3 unsigned char*)lds_;
    constexpr int KST = 272, KHALF = 128 * KST;
    const int tid = threadIdx.x, lane = tid & 63, wave = tid >> 6, g = lane >> 4, c16 = lane & 15;
    for (int i = tid; i < 2 * 2048; i += NTHREADS) { const int hf = i >> 11, n = (i >> 4) & 127, d8 = (i & 15) * 8; const float* src = (hf ? P.sk2 : P.sk1) + n * 128 + d8;
        const float4 a = *(const float4*)src, b = *(const float4*)(src + 4);
        *(LAS3 v4u_t*)(L + hf * KHALF + n * KST + d8 * 2) = (v4u_t){pk2(a.x, a.y), pk2(a.z, a.w), pk2(b.x, b.y), pk2(b.z, b.w)}; }
    __syncthreads();
    const bf16_t* qvb = (const bf16_t*)(P.ws + WS_QV);
    int* idxo = (int*)(P.ws + WS_IDX); float* gato = (float*)(P.ws + WS_GATE);
    const float NEGINF = -__builtin_inff();
    unsigned ctab = 0; { const unsigned char* tp = CAND_AB[c16]; ctab = (unsigned)tp[0] | ((unsigned)tp[1] << 8) | ((unsigned)tp[2] << 16) | ((unsigned)tp[3] << 24); }
    const int ccnt = CAND_N[c16];
#pragma unroll 1
    for (int it = bid * NWAVES + wave; it < (T / 16) * PEER_H; it += G * NWAVES) {
        const int t0 = (it >> 3) * 16, hh = it & 7;
        float keepH[2][4];
#pragma unroll
        for (int hf = 0; hf < 2; ++hf) {
            asm volatile("" ::: "memory");
            bf16x8 af[4];
#pragma unroll
            for (int ks = 0; ks < 4; ++ks) af[ks] = *(const bf16x8*)(qvb + (size_t)(t0 + c16) * D + hh * 256 + hf * 128 + ks * 32 + g * 8);
            f32x4 acc[8];
#pragma unroll
            for (int ct = 0; ct < 8; ++ct) { acc[ct] = (f32x4){0.f, 0.f, 0.f, 0.f};
#pragma unroll
                for (int ks = 0; ks < 4; ++ks) { const bf16x8 bv = *(LAS3 bf16x8*)(L + hf * KHALF + (ct * 16 + c16) * KST + (ks * 32 + g * 8) * 2);
                    acc[ct] = __builtin_amdgcn_mfma_f32_16x16x32_bf16(af[ks], bv, acc[ct], 0, 0, 0); } }
            float v[4][8];
#pragma unroll
            for (int r = 0; r < 4; ++r) {
#pragma unroll
                for (int ct = 0; ct < 8; ++ct) v[r][ct] = __uint_as_float((__float_as_uint(acc[ct][r]) & ~127u) | (unsigned)(127 - (ct * 16 + c16)));
                CEX(v[r][0], v[r][1]); CEX(v[r][2], v[r][3]); CEX(v[r][4], v[r][5]); CEX(v[r][6], v[r][7]);
                CEX(v[r][0], v[r][2]); CEX(v[r][1], v[r][3]); CEX(v[r][4], v[r][6]); CEX(v[r][5], v[r][7]);
                CEX(v[r][1], v[r][2]); CEX(v[r][5], v[r][6]); CEX(v[r][0], v[r][4]); CEX(v[r][3], v[r][7]);
                CEX(v[r][1], v[r][5]); CEX(v[r][2], v[r][6]);
                CEX(v[r][1], v[r][4]); CEX(v[r][3], v[r][6]);
                CEX(v[r][2], v[r][4]); CEX(v[r][3], v[r][5]);
                CEX(v[r][3], v[r][4]);
                keepH[hf][r] = 0.f;
            }
#pragma unroll
            for (int rd = 0; rd < TOPK; ++rd) {
#pragma unroll
                for (int r = 0; r < 4; ++r) {
                    const float W = grp16_max(v[r][0]); const bool win = (v[r][0] == W);
                    if (c16 == rd) keepH[hf][r] = W;
#pragma unroll
                    for (int k = 0; k < 7; ++k) v[r][k] = win ? v[r][k + 1] : v[r][k];
                    v[r][7] = win ? NEGINF : v[r][7];
                }
            }
        }
#pragma unroll
        for (int r = 0; r < 4; ++r) {
            const float V1 = keepH[0][r], V2 = keepH[1][r];
            float cv[4];
#pragma unroll
            for (int s4 = 0; s4 < 4; ++s4) { const unsigned code = (ctab >> (8 * s4)) & 255u;
                const float x1 = __shfl(V1, g * 16 + (int)(code >> 4)), x2 = __shfl(V2, g * 16 + (int)(code & 15u));
                const float sum = __uint_as_float(__float_as_uint(x1) & ~127u) + __uint_as_float(__float_as_uint(x2) & ~127u);
                cv[s4] = (s4 < ccnt) ? __uint_as_float((__float_as_uint(sum) & ~255u) | (255u - code)) : NEGINF; }
            float keepc = 0.f;
#pragma unroll
            for (int rd = 0; rd < TOPK; ++rd) {
                const float W = grp16_max(cv[0]); const bool win = (cv[0] == W);
                if (c16 == rd) keepc = W;
                cv[0] = win ? cv[1] : cv[0]; cv[1] = win ? cv[2] : cv[1]; cv[2] = win ? cv[3] : cv[2]; cv[3] = win ? NEGINF : cv[3];
            }
            const unsigned kb = __float_as_uint(keepc), code = 255u - (kb & 255u);
            const unsigned n1 = 127u - (__float_as_uint(__shfl(V1, g * 16 + (int)(code >> 4))) & 127u), n2 = 127u - (__float_as_uint(__shfl(V2, g * 16 + (int)(code & 15u))) & 127u);
            const float sval = __uint_as_float(kb & ~255u), smax = __shfl(sval, g * 16);
            const float ex = __expf(sval - smax), den = grp16_sum(ex);
            const size_t o = (size_t)(t0 + 4 * g + r) * 128 + hh * 16 + c16;
            idxo[o] = (int)(n1 * 128u + n2); gato[o] = ex / den;
        }
    }
    __syncthreads();
}

__device__ __forceinline__ float wave_sum_dpp(float v) {
    v += dppf<0xB1>(v); v += dppf<0x4E>(v); v += dppf<0x141>(v); v += dppf<0x140>(v);
    const int iv = __float_as_int(v);
    return (__int_as_float(__builtin_amdgcn_readlane(iv, 0)) + __int_as_float(__builtin_amdgcn_readlane(iv, 16))) + (__int_as_float(__builtin_amdgcn_readlane(iv, 32)) + __int_as_float(__builtin_amdgcn_readlane(iv, 48)));
}
__device__ __forceinline__ float dot16_fp8(const v4u_t w, const float (&x)[16]) {
    float s = 0.f;
#pragma unroll
    for (int k = 0; k < 4; ++k) { const f32x2_t lo = __builtin_amdgcn_cvt_pk_f32_fp8(w[k], false), hi = __builtin_amdgcn_cvt_pk_f32_fp8(w[k], true);
        s += (x[4 * k] * lo.x + x[4 * k + 1] * lo.y) + (x[4 * k + 2] * hi.x + x[4 * k + 3] * hi.y); }
    return s;
}
__device__ __forceinline__ void axpy16_fp8(const v4u_t w, const float cf, float (&y)[16]) {
#pragma unroll
    for (int k = 0; k < 4; ++k) { const f32x2_t lo = __builtin_amdgcn_cvt_pk_f32_fp8(w[k], false), hi = __builtin_amdgcn_cvt_pk_f32_fp8(w[k], true);
        y[4 * k] += cf * lo.x; y[4 * k + 1] += cf * lo.y; y[4 * k + 2] += cf * hi.x; y[4 * k + 3] += cf * hi.y; }
}
__device__ __forceinline__ void p7_peer(const Params& P, int G, int bid) {
    const int lane = threadIdx.x & 63, wave = threadIdx.x >> 6;
    const bf16_t* x1b = (const bf16_t*)(P.ws + WS_X1B); const float* x1 = (const float*)(P.ws + WS_X1); const float* ssq = (const float*)(P.ws + WS_SSQ);
    const int* idxi = (const int*)(P.ws + WS_IDX); const float* gati = (const float*)(P.ws + WS_GATE);
    const unsigned char* ub = P.ws + WS_UB; const unsigned char* vb = P.ws + WS_VB; const float* esc = (const float*)(P.ws + WS_ESC);
#pragma unroll 1
    for (int t = bid * NWAVES + wave; t < T; t += G * NWAVES) {
        int ln = lane; asm volatile("" : "+v"(ln));
        const float rs2 = rsqrtf(wave_sum(ln < 32 ? ssq[(size_t)t * 32 + ln] : 0.f) * (1.0f / D) + EPS);
        const int idx0 = idxi[(size_t)t * 128 + ln], idx1 = idxi[(size_t)t * 128 + 64 + ln];
        v4u_t bA[8][2], bB[8][2]; const unsigned lane16 = (unsigned)ln * 16u;
#define P7_LOAD(TAB, IDXR, gl, Bf) do { _Pragma("unroll") for (int e = 0; e < 8; ++e) { const int ei = __builtin_amdgcn_readlane(IDXR, (gl) * 8 + e); \
            const unsigned char* rb = (TAB) + (size_t)(unsigned)ei * D; Bf[e][0] = *(const v4u_t*)(rb + lane16); Bf[e][1] = *(const v4u_t*)(rb + lane16 + 1024u); } __builtin_amdgcn_sched_barrier(0); } while (0)
#define PIN16(a) asm volatile("" : "+v"(a[0]), "+v"(a[1]), "+v"(a[2]), "+v"(a[3]), "+v"(a[4]), "+v"(a[5]), "+v"(a[6]), "+v"(a[7]), "+v"(a[8]), "+v"(a[9]), "+v"(a[10]), "+v"(a[11]), "+v"(a[12]), "+v"(a[13]), "+v"(a[14]), "+v"(a[15]))
#define P7_DOT(gl, Bf, DR) do { float ds_[8]; _Pragma("unroll") for (int e = 0; e < 8; ++e) { asm volatile("" : "+v"(Bf[e][0]), "+v"(Bf[e][1])); ds_[e] = dot16_fp8(Bf[e][0], xf[0]) + dot16_fp8(Bf[e][1], xf[1]); } \
            _Pragma("unroll") for (int e = 0; e < 8; ++e) { const float tot = wave_sum_dpp(ds_[e]); int l2_ = lane; asm volatile("" : "+v"(l2_)); DR = (l2_ == (gl) * 8 + e) ? tot : DR; } __builtin_amdgcn_sched_barrier(0); } while (0)
#define P7_AXPY(gl, Bf, CR) do { _Pragma("unroll") for (int e = 0; e < 8; ++e) { const float cf = __int_as_float(__builtin_amdgcn_readlane(__float_as_int(CR), (gl) * 8 + e)); asm volatile("" : "+v"(Bf[e][0]), "+v"(Bf[e][1])); \
            axpy16_fp8(Bf[e][0], cf, y[0]); axpy16_fp8(Bf[e][1], cf, y[1]); PIN16(y[0]); PIN16(y[1]); } } while (0)
        float d0 = 0.f, d1 = 0.f;
        {
            float xf[2][16];
#pragma unroll
            for (int c = 0; c < 2; ++c) { float a[8], b[8]; unpack8(*(const uint4*)(x1b + (size_t)t * D + c * 1024 + ln * 16), a); unpack8(*(const uint4*)(x1b + (size_t)t * D + c * 1024 + ln * 16 + 8), b);
#pragma unroll
                for (int i = 0; i < 8; ++i) { xf[c][i] = a[i]; xf[c][8 + i] = b[i]; } }
            P7_LOAD(ub, idx0, 0, bA);
#pragma unroll 1
            for (int gl = 0; gl < 6; gl += 2) { P7_LOAD(ub, idx0, gl + 1, bB); P7_DOT(gl, bA, d0); P7_LOAD(ub, idx0, gl + 2, bA); P7_DOT(gl + 1, bB, d0); }
            P7_LOAD(ub, idx0, 7, bB); P7_DOT(6, bA, d0); P7_LOAD(ub, idx1, 0, bA); P7_DOT(7, bB, d0);
#pragma unroll 1
            for (int gl = 0; gl < 6; gl += 2) { P7_LOAD(ub, idx1, gl + 1, bB); P7_DOT(gl, bA, d1); P7_LOAD(ub, idx1, gl + 2, bA); P7_DOT(gl + 1, bB, d1); }
            P7_LOAD(ub, idx1, 7, bB); P7_DOT(6, bA, d1); P7_LOAD(vb, idx0, 0, bA); P7_DOT(7, bB, d1);
        }
        float cf0, cf1;
        { const float gt0 = gati[(size_t)t * 128 + ln], gt1 = gati[(size_t)t * 128 + 64 + ln];
          const float su0 = esc[idx0 * 2], sv0 = esc[idx0 * 2 + 1], su1 = esc[idx1 * 2], sv1 = esc[idx1 * 2 + 1];
          cf0 = gt0 * gelu_erf(d0 * rs2 * su0) * sv0; cf1 = gt1 * gelu_erf(d1 * rs2 * su1) * sv1; }
        float y[2][16];
#pragma unroll
        for (int c = 0; c < 2; ++c)
#pragma unroll
            for (int i = 0; i < 16; ++i) y[c][i] = 0.f;
#pragma unroll 1
        for (int gl = 0; gl < 6; gl += 2) { P7_LOAD(vb, idx0, gl + 1, bB); P7_AXPY(gl, bA, cf0); P7_LOAD(vb, idx0, gl + 2, bA); P7_AXPY(gl + 1, bB, cf0); }
        P7_LOAD(vb, idx0, 7, bB); P7_AXPY(6, bA, cf0); P7_LOAD(vb, idx1, 0, bA); P7_AXPY(7, bB, cf0);
#pragma unroll 1
        for (int gl = 0; gl < 6; gl += 2) { P7_LOAD(vb, idx1, gl + 1, bB); P7_AXPY(gl, bA, cf1); P7_LOAD(vb, idx1, gl + 2, bA); P7_AXPY(gl + 1, bB, cf1); }
        P7_LOAD(vb, idx1, 7, bB); P7_AXPY(6, bA, cf1); P7_AXPY(7, bB, cf1);
#undef P7_AXPY
#undef PIN16
#undef P7_DOT
#undef P7_LOAD
        float ss = 0.f;
#pragma unroll
        for (int c = 0; c < 2; ++c)
#pragma unroll
            for (int k = 0; k < 4; ++k) { const float4 a = *(const float4*)(x1 + (size_t)t * D + c * 1024 + ln * 16 + 4 * k);
                y[c][4 * k] += a.x; y[c][4 * k + 1] += a.y; y[c][4 * k + 2] += a.z; y[c][4 * k + 3] += a.w;
                ss += (y[c][4 * k] * y[c][4 * k] + y[c][4 * k + 1] * y[c][4 * k + 1]) + (y[c][4 * k + 2] * y[c][4 * k + 2] + y[c][4 * k + 3] * y[c][4 * k + 3]); }
        ss = wave_sum(ss);
        const float r = rsqrtf(ss * (1.0f / D) + EPS);
#pragma unroll
        for (int c = 0; c < 2; ++c)
#pragma unroll
            for (int k = 0; k < 4; ++k) { const float4 gg = *(const float4*)(P.gfin + c * 1024 + ln * 16 + 4 * k);
                *(float4*)(P.out + (size_t)t * D + c * 1024 + ln * 16 + 4 * k) = make_float4(y[c][4 * k] * r * gg.x, y[c][4 * k + 1] * r * gg.y, y[c][4 * k + 2] * r * gg.z, y[c][4 * k + 3] * r * gg.w); }
    }
}

constexpr int N_PHASES = 8;
#ifndef MK_N_LAUNCHES
#define MK_N_LAUNCHES 1
#endif
__global__ void __launch_bounds__(NTHREADS, 2) layer_fwd(Params P) {
    extern __shared__ __attribute__((aligned(16))) unsigned char lds[];
    cg::grid_group grid = cg::this_grid();
    const int G = gridDim.x, bid = blockIdx.x;
    const int lo = P.ph_lo, hi = P.ph_hi;
#ifndef PH_MASK
#define PH_MASK 0xff
#endif
#define IN(k) (((PH_MASK >> (k)) & 1) && lo <= (k) && (k) < hi)
#define SEAM(k) do { if (IN(k) && IN((k) + 1)) grid.sync(); } while (0)
#ifndef REP_MASK
#define REP_MASK 0
#endif
#define REPS(k) (((REP_MASK >> (k)) & 1) ? 2 : 1)
    if (IN(0)) for (int rep = 0; rep < REPS(0); ++rep) { p0_rows(P, lds, G, bid); p0_weights(P, lds, G, bid); p0_tables(P, G, bid); }
    SEAM(0);
    if (IN(1)) {
        pg8::Gemm g{(const pg8::bf16_t*)(P.ws + WS_XB), (const pg8::bf16_t*)(P.ws + WS_WINT), T, NPROJ, D}; pg8::StaticOrder S; S.init(T, NPROJ, G, bid);
        pg8::EpiProj E{(pg8::bf16_t*)(P.ws + WS_PROJ), NPROJ, (const float*)(P.ws + WS_RS1)};
        pg8::gemm_phase<pg8::EpiProj, pg8::StaticOrder, true, true>((PG8_LAS unsigned char*)lds, g, S, E);
    }
    SEAM(1);
    if (IN(2)) for (int rep = 0; rep < REPS(2); ++rep) {
        for (int u = bid; u < 64; u += G) mlstm_unit(P, lds, u);
        if (G > 64) { if (bid >= 64) p2_conv(P, G - 64, bid - 64); } else p2_conv(P, G, bid);
    }
    SEAM(2);
    if (IN(3)) for (int rep = 0; rep < REPS(3); ++rep) p3_finalize(P, G, bid);
    SEAM(3);
    if (IN(4)) {
        pg8::Gemm g{(const pg8::bf16_t*)(P.ws + WS_MIXIN), (const pg8::bf16_t*)(P.ws + WS_WOUTT), T, D, D}; pg8::StaticOrder S; S.init(T, D, G, bid);
        pg8::EpiOut E{P.x, (float*)(P.ws + WS_X1), (pg8::bf16_t*)(P.ws + WS_X1B), (float*)(P.ws + WS_SSQ), D};
        pg8::gemm_phase<pg8::EpiOut, pg8::StaticOrder, false, true>((PG8_LAS unsigned char*)lds, g, S, E);
    }
    SEAM(4);
    if (IN(5)) {
        pg8::Gemm g{(const pg8::bf16_t*)(P.ws + WS_X1B), (const pg8::bf16_t*)(P.ws + WS_WQT), T, D, D}; pg8::StaticOrder S; S.init(T, D, G, bid);
        pg8::EpiQb E{(pg8::bf16_t*)(P.ws + WS_QV), D, (const float*)(P.ws + WS_SSQ)};
        pg8::gemm_phase<pg8::EpiQb, pg8::StaticOrder, false, true>((PG8_LAS unsigned char*)lds, g, S, E);
    }
    SEAM(5);
    if (IN(6)) for (int rep = 0; rep < REPS(6); ++rep) p6_topk(P, lds, G, bid);
    SEAM(6);
    if (IN(7)) for (int rep = 0; rep < REPS(7); ++rep) p7_peer(P, G, bid);
#undef IN
#undef SEAM
}

extern "C" void kernel_launch(void* const* d_in, const int* in_sizes, int n_in, void* d_out, int out_size, void* d_ws, size_t ws_size, hipStream_t stream) {
    static int grid = 0;
    if (grid == 0) {
        if (n_in != 15 || in_sizes[0] != T * D || out_size != T * D || ws_size < WS_END) { fprintf(stderr, "kernel_launch: unexpected shapes (n_in %d, in0 %d, out %d, ws %zu); nothing launched\n", n_in, n_in > 0 ? in_sizes[0] : -1, out_size, ws_size); grid = -1; return; }
        int dev = 0, cus = 0, per_cu = 0;
        if (hipGetDevice(&dev) != hipSuccess || hipDeviceGetAttribute(&cus, hipDeviceAttributeMultiprocessorCount, dev) != hipSuccess) { grid = -1; return; }
        if (hipFuncSetAttribute((const void*)layer_fwd, hipFuncAttributeMaxDynamicSharedMemorySize, LDS_BYTES) != hipSuccess) { fprintf(stderr, "kernel_launch: hipFuncSetAttribute failed\n"); grid = -1; return; }
        if (hipOccupancyMaxActiveBlocksPerMultiprocessor(&per_cu, (const void*)layer_fwd, NTHREADS, LDS_BYTES) != hipSuccess || per_cu < 1) { fprintf(stderr, "kernel_launch: occupancy query says %d blocks per CU\n", per_cu); (void)hipGetLastError(); grid = -1; return; }
        grid = cus;
    }
    if (grid < 0) return;
    Params p{};
    p.x = (const float*)d_in[0]; p.g1 = (const float*)d_in[1]; p.w_in = (const float*)d_in[2]; p.b_ig = (const float*)d_in[3]; p.b_fg = (const float*)d_in[4];
    p.conv_w = (const float*)d_in[5]; p.gm = (const float*)d_in[6]; p.w_out = (const float*)d_in[7]; p.g2 = (const float*)d_in[8]; p.w_q = (const float*)d_in[9];
    p.sk1 = (const float*)d_in[10]; p.sk2 = (const float*)d_in[11]; p.eu = (const float*)d_in[12]; p.ev = (const float*)d_in[13]; p.gfin = (const float*)d_in[14];
    p.out = (float*)d_out; p.ws = (unsigned char*)d_ws;
    for (int li = 0; li < MK_N_LAUNCHES; ++li) {
        p.ph_lo = (MK_N_LAUNCHES == 1) ? 0 : li; p.ph_hi = (MK_N_LAUNCHES == 1) ? N_PHASES : li + 1;
        void* args[] = {&p};
        const hipError_t e = hipLaunchCooperativeKernel((const void*)layer_fwd, dim3(grid), dim3(NTHREADS), args, LDS_BYTES, stream);
        if (e != hipSuccess) { fprintf(stderr, "kernel_launch: cooperative launch %d failed: %s (grid %d)\n", li, hipGetErrorString(e), grid); break; }
    }
}
```

```cpp
#include <hip/hip_runtime.h>
#include <hip/hip_cooperative_groups.h>
#include <cstdio>
#include <cstdint>
namespace cg = cooperative_groups;
namespace pg8 {
#define PG8_LAS __attribute__((address_space(3)))
typedef unsigned short bf16_t;
typedef short bf16x8 __attribute__((ext_vector_type(8)));
typedef float f32x4 __attribute__((ext_vector_type(4)));
typedef unsigned u32x4 __attribute__((ext_vector_type(4)));
constexpr int BM = 256, BK = 64, HALF = 128, HTB = HALF * BK * 2  , STAGE_BYTES = 8 * HTB, NXCD = 8, WGM = 8;

__host__ __device__ __forceinline__ int lds_byte(int r, int c) { const int st = (r >> 4) * 2 + (c >> 5), rr = r & 15, cc = c & 31, ob = rr * 64 + cc * 2; return st * 1024 + (ob ^ (((ob >> 9) & 1) << 5)); }
__host__ __device__ __forceinline__ void stage_rc(int b, int& R, int& C) { const int st = b / 1024, sb = b % 1024, swz = sb ^ (((sb >> 9) & 1) << 5); R = (st >> 1) * 16 + swz / 64; C = (st & 1) * 32 + (swz % 64) / 2; }
__host__ __device__ __forceinline__ int perm32(int rho) { const int n = rho >> 4, i = rho & 15; return 8 * (i >> 2) + 4 * n + (i & 3); }

struct Unit { int pm, pn; };
struct Gemm { const bf16_t* A; const bf16_t* Bt; int M, N, K; };

struct StaticOrder {
    int nM, nN, nwg, G, c;
    __host__ __device__ void init(int M, int N, int G_, int c_) { nM = M / BM; nN = N / BM; nwg = nM * nN; G = G_; c = c_; }
    __host__ __device__ bool next(int i, Unit& u) const {
        const long L = (long)i * G + c; if (L >= nwg) return false;
        int wgid = (int)L; { const int q = nwg / NXCD, r = nwg % NXCD, xcd = wgid % NXCD, off = wgid / NXCD; wgid = (xcd < r ? xcd * (q + 1) : r * (q + 1) + (xcd - r) * q) + off; }
        const int nig = WGM * nN, gid = wgid / nig, fm = gid * WGM, gsz = (nM - fm) < WGM ? (nM - fm) : WGM;
        u.pm = fm + ((wgid % nig) % gsz); u.pn = (wgid % nig) / gsz; return true;
    }
    __device__ __forceinline__ void a_ready(const Unit&) const {}
    __device__ __forceinline__ void done(const Unit&) const {}
};

__device__ __forceinline__ unsigned cvt_pk_bf16(float lo, float hi) { unsigned r; asm volatile("v_cvt_pk_bf16_f32 %0, %1, %2" : "=v"(r) : "v"(lo), "v"(hi)); return r; }
struct EpiProj {
    static constexpr bool PERM = true, AFTER_DRAIN = false;
    bf16_t* O; int ldc; const float* rs;
    __device__ __forceinline__ void operator()(const f32x4 (&acc)[2][2][4][2], const Unit& u, int wr, int wc, int fr, int fq) const {
        const int row0 = u.pm * BM + wr * 64 + fr, col0 = u.pn * BM + wc * 32 + 8 * fq;
#pragma unroll
        for (int ai = 0; ai < 2; ++ai)
#pragma unroll
            for (int m = 0; m < 4; ++m) { const int row = row0 + ai * HALF + m * 16; const float s = rs[row]; bf16_t* rowp = O + (size_t)row * ldc + col0;
#pragma unroll
                for (int bj = 0; bj < 2; ++bj) { const f32x4 v0 = acc[ai][bj][m][0] * s, v1 = acc[ai][bj][m][1] * s; u32x4 w;
                    w.x = cvt_pk_bf16(v0[0], v0[1]); w.y = cvt_pk_bf16(v0[2], v0[3]); w.z = cvt_pk_bf16(v1[0], v1[1]); w.w = cvt_pk_bf16(v1[2], v1[3]);
                    *(u32x4*)(rowp + bj * HALF) = w; } }
    }
};
struct EpiOut {
    static constexpr bool PERM = false, AFTER_DRAIN = false;
    const float* X; float* X1; bf16_t* X1B; float* SSQ; int ldc;
    __device__ __forceinline__ void operator()(const f32x4 (&acc)[2][2][4][2], const Unit& u, int wr, int wc, int fr, int fq) const {
        typedef unsigned u32x2 __attribute__((ext_vector_type(2)));
        const int row0 = u.pm * BM + wr * 64 + fr, col0 = u.pn * BM + wc * 32 + 4 * fq;
#pragma unroll
        for (int ai = 0; ai < 2; ++ai)
#pragma unroll
            for (int m = 0; m < 4; ++m) { const int row = row0 + ai * HALF + m * 16; const size_t off = (size_t)row * ldc + col0; float ss = 0.f;
#pragma unroll
                for (int bj = 0; bj < 2; ++bj)
#pragma unroll
                    for (int n = 0; n < 2; ++n) { const size_t c = off + bj * HALF + n * 16; const f32x4 xv = *(const f32x4*)(X + c); const f32x4 o = xv + acc[ai][bj][m][n];
                        *(f32x4*)(X1 + c) = o; ss += (o[0] * o[0] + o[1] * o[1]) + (o[2] * o[2] + o[3] * o[3]);
                        u32x2 pk; pk.x = cvt_pk_bf16(o[0], o[1]); pk.y = cvt_pk_bf16(o[2], o[3]); *(u32x2*)(X1B + c) = pk; }
                ss += __shfl_xor(ss, 16); ss += __shfl_xor(ss, 32);
                if (fq == 0) SSQ[(size_t)row * 32 + u.pn * 4 + wc] = ss; }
    }
};
struct EpiQ {
    static constexpr bool PERM = false, AFTER_DRAIN = false;
    float* O; int ldc;
    __device__ __forceinline__ void operator()(const f32x4 (&acc)[2][2][4][2], const Unit& u, int wr, int wc, int fr, int fq) const {
        const int row0 = u.pm * BM + wr * 64 + fr, col0 = u.pn * BM + wc * 32 + 4 * fq;
#pragma unroll
        for (int ai = 0; ai < 2; ++ai)
#pragma unroll
            for (int m = 0; m < 4; ++m) { const size_t off = (size_t)(row0 + ai * HALF + m * 16) * ldc + col0;
#pragma unroll
                for (int bj = 0; bj < 2; ++bj)
#pragma unroll
                    for (int n = 0; n < 2; ++n) *(f32x4*)(O + off + bj * HALF + n * 16) = acc[ai][bj][m][n]; }
    }
};
struct EpiQb {
    static constexpr bool PERM = true, AFTER_DRAIN = false;
    bf16_t* O; int ldc; const float* SSQ;
    __device__ __forceinline__ void operator()(const f32x4 (&acc)[2][2][4][2], const Unit& u, int wr, int wc, int fr, int fq) const {
        const int row0 = u.pm * BM + wr * 64 + fr, col0 = u.pn * BM + wc * 32 + 8 * fq;
#pragma unroll
        for (int ai = 0; ai < 2; ++ai)
#pragma unroll
            for (int m = 0; m < 4; ++m) { const int row = row0 + ai * HALF + m * 16; const f32x4* sp = (const f32x4*)(SSQ + (size_t)row * 32);
                f32x4 s4 = sp[0];
#pragma unroll
                for (int i = 1; i < 8; ++i) s4 += sp[i];
                const float s = rsqrtf(((s4[0] + s4[1]) + (s4[2] + s4[3])) * (1.0f / 2048.0f) + 1e-6f); bf16_t* rowp = O + (size_t)row * ldc + col0;
#pragma unroll
                for (int bj = 0; bj < 2; ++bj) { const f32x4 v0 = acc[ai][bj][m][0] * s, v1 = acc[ai][bj][m][1] * s; u32x4 w;
                    w.x = cvt_pk_bf16(v0[0], v0[1]); w.y = cvt_pk_bf16(v0[2], v0[3]); w.z = cvt_pk_bf16(v1[0], v1[1]); w.w = cvt_pk_bf16(v1[2], v1[3]);
                    *(u32x4*)(rowp + bj * HALF) = w; } }
    }
};
template <class Epi, class Sched, bool ALIGN_EPI = false, bool SP2 = false>
__device__ __forceinline__ void gemm_phase(PG8_LAS unsigned char* lds, const Gemm g, const Sched& S, const Epi& E) {
    const int tid = threadIdx.x, wid = __builtin_amdgcn_readfirstlane(tid >> 6), lane = tid & 63, wr = wid >> 2, wc = wid & 3, fr = lane & 15, fq = lane >> 4;
    const int K = g.K, nt = K / BK;
    unsigned voffA[2], voffB[2];
#pragma unroll
    for (int i = 0; i < 2; ++i) { int R, C; stage_rc(tid * 16 + i * 8192, R, C); const int Rb = Epi::PERM ? ((R & ~31) + perm32(R & 31)) : R;
        voffA[i] = (unsigned)(R * K + C) * 2u; voffB[i] = (unsigned)(Rb * K + C) * 2u; }
    const size_t kstep = (size_t)(BK * 2);
    const size_t hstep = (size_t)HALF * K * 2;
    const size_t tstep = 2 * hstep;
    const unsigned ldsw = (unsigned)wid * 1024u;
    const int aoff = lds_byte(wr * 64 + fr, fq * 8), boff = lds_byte(wc * 32 + fr, fq * 8);
#define PG8_SA(b, h) (((b) * 2 + (h)) * HTB)
#define PG8_SB(b, h) ((4 + (b) * 2 + (h)) * HTB)
#define PG8_STAGE(bufoff, gbase, voff) do { _Pragma("unroll") for (int _i = 0; _i < 2; ++_i) \
        __builtin_amdgcn_global_load_lds((const unsigned*)((const char*)(gbase) + (voff)[_i]), (PG8_LAS unsigned*)(lds + (bufoff) + ldsw + _i * 8192), 16, 0, 0); } while (0)
#define PG8_LDA(dst, b, h) do { _Pragma("unroll") for (int m = 0; m < 4; ++m) _Pragma("unroll") for (int k = 0; k < 2; ++k) dst[m][k] = *(const PG8_LAS bf16x8*)(lds + PG8_SA(b, h) + aoff + m * 2048 + k * 1024); } while (0)
#define PG8_LDB(dst, b, h) do { _Pragma("unroll") for (int n = 0; n < 2; ++n) _Pragma("unroll") for (int k = 0; k < 2; ++k) dst[n][k] = *(const PG8_LAS bf16x8*)(lds + PG8_SB(b, h) + boff + n * 2048 + k * 1024); } while (0)
#define PG8_MMA(ai, bj, At, Bt) do { __builtin_amdgcn_s_setprio(1); _Pragma("unroll") for (int m = 0; m < 4; ++m) _Pragma("unroll") for (int n = 0; n < 2; ++n) _Pragma("unroll") for (int k = 0; k < 2; ++k) \
        acc[ai][bj][m][n] = __builtin_amdgcn_mfma_f32_16x16x32_bf16(Bt[n][k], At[m][k], acc[ai][bj][m][n], 0, 0, 0); __builtin_amdgcn_s_setprio(0); } while (0)
#define PG8_WAIT_V(n) asm volatile("s_waitcnt vmcnt(" #n ")" ::: "memory")
#define PG8_WAIT_L(n) asm volatile("s_waitcnt lgkmcnt(" #n ")" ::: "memory")
#define PG8_BAR __builtin_amdgcn_s_barrier()
#define PG8_SCHED __builtin_amdgcn_sched_barrier(0)
    Unit cur, nxt; int ui = 0;
    if (!S.next(0, cur)) return;
    f32x4 acc[2][2][4][2];
#pragma unroll
    for (int a = 0; a < 2; ++a)
#pragma unroll
        for (int b = 0; b < 2; ++b)
#pragma unroll
            for (int m = 0; m < 4; ++m)
#pragma unroll
                for (int n = 0; n < 2; ++n) acc[a][b][m][n] = (f32x4){0.f, 0.f, 0.f, 0.f};
    bf16x8 At[4][2], B0[2][2], B1[2][2];
    const char* cA = (const char*)g.A + (size_t)cur.pm * tstep; const char* cB = (const char*)g.Bt + (size_t)cur.pn * tstep;
    S.a_ready(cur);
    if constexpr (SP2) {
        PG8_STAGE(PG8_SB(0, 0), cB, voffB); PG8_STAGE(PG8_SB(0, 1), cB + hstep, voffB); PG8_STAGE(PG8_SA(0, 0), cA, voffA); PG8_STAGE(PG8_SA(0, 1), cA + hstep, voffA);
        if (wr == 1) PG8_BAR;
        PG8_WAIT_V(2); PG8_BAR;
        PG8_STAGE(PG8_SB(1, 0), cB + kstep, voffB); PG8_STAGE(PG8_SA(1, 0), cA + kstep, voffA); PG8_STAGE(PG8_SB(1, 1), cB + hstep + kstep, voffB);
        PG8_WAIT_V(6); PG8_BAR;
    } else {
        PG8_STAGE(PG8_SB(0, 0), cB, voffB); PG8_STAGE(PG8_SA(0, 0), cA, voffA); PG8_STAGE(PG8_SB(0, 1), cB + hstep, voffB); PG8_STAGE(PG8_SA(0, 1), cA + hstep, voffA);
        if (wr == 1) PG8_BAR;
        PG8_WAIT_V(4); PG8_BAR;
        PG8_STAGE(PG8_SB(1, 0), cB + kstep, voffB); PG8_STAGE(PG8_SA(1, 0), cA + kstep, voffA); PG8_STAGE(PG8_SB(1, 1), cB + hstep + kstep, voffB);
        PG8_WAIT_V(6); PG8_BAR;
    }
    for (;;) {
        const bool has_next = S.next(ui + 1, nxt);
        const char* nA = has_next ? (const char*)g.A + (size_t)nxt.pm * tstep : cA; const char* nB = has_next ? (const char*)g.Bt + (size_t)nxt.pn * tstep : cB;
        for (int t = 0; t < nt; t += 2) {
            const bool last = (t == nt - 2);
            const char* a1 = cA + (size_t)(t + 1) * kstep;
            const char* a2 = last ? nA : cA + (size_t)(t + 2) * kstep; const char* b2 = last ? nB : cB + (size_t)(t + 2) * kstep;
            const char* a3 = a2 + kstep; const char* b3 = b2 + kstep;
            if (last && has_next) S.a_ready(nxt);
            if constexpr (SP2) {
            PG8_LDB(B0, 0, 0); PG8_LDB(B1, 0, 1); PG8_SCHED; PG8_LDA(At, 0, 0); PG8_STAGE(PG8_SA(1, 1), a1 + hstep, voffA);
            PG8_WAIT_V(8); PG8_WAIT_L(0); PG8_BAR; PG8_MMA(0, 0, At, B0); PG8_MMA(0, 1, At, B1); PG8_BAR; PG8_SCHED;
            PG8_LDA(At, 0, 1); PG8_STAGE(PG8_SB(0, 0), b2, voffB); PG8_STAGE(PG8_SB(0, 1), b2 + hstep, voffB); PG8_STAGE(PG8_SA(0, 0), a2, voffA);
            PG8_WAIT_V(8); PG8_WAIT_L(0); PG8_BAR; PG8_MMA(1, 0, At, B0); PG8_MMA(1, 1, At, B1); PG8_BAR; PG8_SCHED;
            PG8_LDB(B0, 1, 0); PG8_LDB(B1, 1, 1); PG8_SCHED; PG8_LDA(At, 1, 0); PG8_STAGE(PG8_SA(0, 1), a2 + hstep, voffA);
            PG8_WAIT_V(8); PG8_WAIT_L(0); PG8_BAR; PG8_MMA(0, 0, At, B0); PG8_MMA(0, 1, At, B1); PG8_BAR; PG8_SCHED;
            PG8_LDA(At, 1, 1); PG8_STAGE(PG8_SB(1, 0), b3, voffB); PG8_STAGE(PG8_SB(1, 1), b3 + hstep, voffB); PG8_STAGE(PG8_SA(1, 0), a3, voffA);
            PG8_WAIT_V(8); PG8_WAIT_L(0); PG8_BAR; PG8_MMA(1, 0, At, B0); PG8_MMA(1, 1, At, B1); PG8_BAR; PG8_SCHED;
            } else {
            PG8_LDB(B0, 0, 0); PG8_SCHED; PG8_LDA(At, 0, 0); PG8_STAGE(PG8_SA(1, 1), a1 + hstep, voffA);
            PG8_WAIT_L(8); PG8_BAR; PG8_WAIT_L(0); PG8_MMA(0, 0, At, B0); PG8_BAR; PG8_SCHED;
            PG8_LDB(B1, 0, 1); PG8_STAGE(PG8_SB(0, 0), b2, voffB);
            PG8_BAR; PG8_WAIT_L(0); PG8_MMA(0, 1, At, B1); PG8_BAR;
            PG8_LDA(At, 0, 1); PG8_STAGE(PG8_SA(0, 0), a2, voffA);
            PG8_BAR; PG8_WAIT_L(0); PG8_MMA(1, 0, At, B0); PG8_BAR; PG8_SCHED;
            PG8_STAGE(PG8_SB(0, 1), b2 + hstep, voffB);
            PG8_WAIT_V(6); PG8_BAR; PG8_MMA(1, 1, At, B1); PG8_BAR;
            PG8_LDB(B0, 1, 0); PG8_SCHED; PG8_LDA(At, 1, 0); PG8_STAGE(PG8_SA(0, 1), a2 + hstep, voffA);
            PG8_WAIT_L(8); PG8_BAR; PG8_WAIT_L(0); PG8_MMA(0, 0, At, B0); PG8_BAR; PG8_SCHED;
            PG8_LDB(B1, 1, 1); PG8_STAGE(PG8_SB(1, 0), b3, voffB);
            PG8_BAR; PG8_WAIT_L(0); PG8_MMA(0, 1, At, B1); PG8_BAR;
            PG8_LDA(At, 1, 1); PG8_STAGE(PG8_SA(1, 0), a3, voffA);
            PG8_BAR; PG8_WAIT_L(0); PG8_MMA(1, 0, At, B0); PG8_BAR; PG8_SCHED;
            PG8_STAGE(PG8_SB(1, 1), b3 + hstep, voffB);
            PG8_WAIT_V(6); PG8_BAR; PG8_MMA(1, 1, At, B1); PG8_BAR;
            }
        }
        if constexpr (ALIGN_EPI) { if (wr == 0) PG8_BAR; }
        if constexpr (!Epi::AFTER_DRAIN) { E(acc, cur, wr, wc, fr, fq); S.done(cur); }
        if (!has_next) break;
#pragma unroll
        for (int a = 0; a < 2; ++a)
#pragma unroll
            for (int b = 0; b < 2; ++b)
#pragma unroll
                for (int m = 0; m < 4; ++m)
#pragma unroll
                    for (int n = 0; n < 2; ++n) acc[a][b][m][n] = (f32x4){0.f, 0.f, 0.f, 0.f};
        cur = nxt; cA = nA; cB = nB; ++ui;
        if constexpr (ALIGN_EPI) { if (wr == 1) PG8_BAR; }
    }
    PG8_WAIT_V(0);
    if constexpr (!ALIGN_EPI) { if (wr == 0) PG8_BAR; }
    PG8_BAR;
    if constexpr (Epi::AFTER_DRAIN) { E.fused(acc, cur, wr, wc, fr, fq, lds, wid, lane); S.done(cur); }
#undef PG8_SA
#undef PG8_SB
#undef PG8_STAGE
#undef PG8_LDA
#undef PG8_LDB
#undef PG8_MMA
#undef PG8_WAIT_V
#undef PG8_WAIT_L
#undef PG8_BAR
#undef PG8_SCHED
}
}
constexpr int T = 8192, SEQ = 4096, D = 2048, NPROJ = 7168, NIN = 7176;
constexpr int NH = 4, DH = 256, LCH = 64, DML = 1024;
constexpr int NEXP = 16384, PEER_H = 8, TOPK = 16;
constexpr float EPS = 1e-6f;
constexpr int PC_CX = 0, PC_CB = 1024, PC_CC = 2048, PC_Q = 3072, PC_K = 4096, PC_V = 5120, PC_O = 6144;
constexpr int NTHREADS = 512, NWAVES = 8;
constexpr int LDS_BYTES = 147456;

constexpr size_t MiB = 1u << 20;
constexpr size_t WS_CTL = 0, CTL_ZERO_BYTES = 64 * 1024;
constexpr int CW_BAR = 1024;
constexpr size_t WS_RS1 = 1 * MiB, WS_GI = 1 * MiB + 64 * 1024, WS_GF = 1 * MiB + 256 * 1024, WS_SSQ = 3 * MiB, WS_ESC = 4 * MiB;
constexpr size_t WS_XB = 5 * MiB, WS_WINT = 37 * MiB, WS_WOUTT = 65 * MiB, WS_WQT = 73 * MiB;
constexpr size_t WS_PROJ = 81 * MiB;
constexpr size_t WS_X1 = 81 * MiB, WS_X1B = 145 * MiB;
constexpr size_t WS_HRAW = 193 * MiB, WS_MIXIN = 225 * MiB, WS_QV = 257 * MiB, WS_IDX = 321 * MiB, WS_GATE = 325 * MiB;
constexpr size_t WS_UB = 329 * MiB, WS_VB = 393 * MiB, WS_END = 457 * MiB;

struct Params {
    const float *x, *g1, *w_in, *b_ig, *b_fg, *conv_w, *gm, *w_out, *g2, *w_q, *sk1, *sk2, *eu, *ev, *gfin;
    float* out; unsigned char* ws;
    int ph_lo, ph_hi;
};

typedef unsigned short bf16_t;
__device__ __forceinline__ unsigned f2bf(float f) { unsigned u = __float_as_uint(f); return (u + 0x7fffu + ((u >> 16) & 1u)) >> 16; }
__device__ __forceinline__ unsigned pk2(float lo, float hi) { return f2bf(lo) | (f2bf(hi) << 16); }
__device__ __forceinline__ float bflo(unsigned w) { return __uint_as_float(w << 16); }
__device__ __forceinline__ float bfhi(unsigned w) { return __uint_as_float(w & 0xffff0000u); }
__device__ __forceinline__ float bf1(bf16_t h) { return __uint_as_float((unsigned)h << 16); }
__device__ __forceinline__ float wave_sum(float v) {
#pragma unroll
    for (int o = 32; o >= 1; o >>= 1) v += __shfl_xor(v, o);
    return v;
}
__device__ __forceinline__ void unpack8(const uint4 w, float (&f)[8]) {
    f[0] = bflo(w.x); f[1] = bfhi(w.x); f[2] = bflo(w.y); f[3] = bfhi(w.y); f[4] = bflo(w.z); f[5] = bfhi(w.z); f[6] = bflo(w.w); f[7] = bfhi(w.w);
}
__device__ __forceinline__ float log_sigmoid(float z) { return z >= 0.f ? -log1pf(expf(-z)) : z - log1pf(expf(z)); }
__device__ __forceinline__ float gelu_erf(float v) { return 0.5f * v * (1.0f + erff(v * 0.70710678118654752f)); }

__device__ __forceinline__ void p0_rows(const Params& P, unsigned char* lds, int G, int bid) {
    float* wg = (float*)lds;
    const int tid = threadIdx.x, lane = tid & 63, wave = tid >> 6;
    for (int i = tid; i < 8 * D; i += NTHREADS) { const int g = i >> 11, k = i & 2047; wg[i] = P.w_in[(size_t)k * NIN + NPROJ + g] * P.g1[k]; }
    __syncthreads();
    float* rs1 = (float*)(P.ws + WS_RS1); float* gi = (float*)(P.ws + WS_GI); float* gf = (float*)(P.ws + WS_GF); bf16_t* xb = (bf16_t*)(P.ws + WS_XB);
    for (int t = bid * NWAVES + wave; t < T; t += G * NWAVES) {
        const float4* xr = (const float4*)(P.x + (size_t)t * D);
        float ss = 0.f, dg[8];
#pragma unroll
        for (int g = 0; g < 8; ++g) dg[g] = 0.f;
#pragma unroll 1
        for (int j = 0; j < 8; ++j) {
            const float4 v = xr[j * 64 + lane];
            ss += (v.x * v.x + v.y * v.y) + (v.z * v.z + v.w * v.w);
            const int k0 = (j * 64 + lane) * 4;
#pragma unroll
            for (int g = 0; g < 8; ++g) { const float4 w = *(const float4*)(wg + g * D + k0); dg[g] += (v.x * w.x + v.y * w.y) + (v.z * w.z + v.w * w.w); }
            ((uint2*)(xb + (size_t)t * D))[j * 64 + lane] = make_uint2(pk2(v.x, v.y), pk2(v.z, v.w));
        }
        ss = wave_sum(ss);
#pragma unroll
        for (int g = 0; g < 8; ++g) dg[g] = wave_sum(dg[g]);
        const float rs = rsqrtf(ss * (1.0f / D) + EPS);
        if (lane == 0) {
            rs1[t] = rs;
#pragma unroll
            for (int h = 0; h < 4; ++h) { gi[t * 4 + h] = rs * dg[h] + P.b_ig[h]; gf[t * 4 + h] = log_sigmoid(rs * dg[4 + h] + P.b_fg[h]); }
        }
    }
    __syncthreads();
}
__device__ __forceinline__ void transpose_tile(const float* W, int ldw, int K, const float* gain, bf16_t* WT, int k0, int n0, float* tile) {
    const int tid = threadIdx.x;
#pragma unroll
    for (int r = 0; r < 2; ++r) {
        const int kk = (tid >> 4) + 32 * r, n4 = (tid & 15) * 4;
        float4 v = *(const float4*)(W + (size_t)(k0 + kk) * ldw + n0 + n4);
        const float g = gain ? gain[k0 + kk] : 1.0f;
        tile[kk * 65 + n4 + 0] = v.x * g; tile[kk * 65 + n4 + 1] = v.y * g; tile[kk * 65 + n4 + 2] = v.z * g; tile[kk * 65 + n4 + 3] = v.w * g;
    }
    __syncthreads();
    { const int nn = tid >> 3, k8 = (tid & 7) * 8; float f[8];
#pragma unroll
      for (int i = 0; i < 8; ++i) f[i] = tile[(k8 + i) * 65 + nn];
      *(uint4*)(WT + (size_t)(n0 + nn) * K + k0 + k8) = make_uint4(pk2(f[0], f[1]), pk2(f[2], f[3]), pk2(f[4], f[5]), pk2(f[6], f[7])); }
    __syncthreads();
}
__device__ __forceinline__ void p0_weights_in(const Params& P, unsigned char* lds, int G, int bid) {
    float* tile = (float*)lds;
    constexpr int N_IN = (D / 64) * (NPROJ / 64);
    for (int it = bid; it < N_IN; it += G) { const int kt = it / (NPROJ / 64), nt = it % (NPROJ / 64); transpose_tile(P.w_in, NIN, D, P.g1, (bf16_t*)(P.ws + WS_WINT), kt * 64, nt * 64, tile); }
}
__device__ __forceinline__ void p2_weights_sq(const Params& P, unsigned char* lds, int nworkers, int wid) {
    float* tile = (float*)lds;
    constexpr int N_SQ = (D / 64) * (D / 64);
    for (int it = wid; it < 2 * N_SQ; it += nworkers) {
        if (it < N_SQ) { const int kt = it / (D / 64), nt = it % (D / 64); transpose_tile(P.w_out, D, D, nullptr, (bf16_t*)(P.ws + WS_WOUTT), kt * 64, nt * 64, tile); }
        else { const int j = it - N_SQ, kt = j / (D / 64), nt = j % (D / 64); transpose_tile(P.w_q, D, D, P.g2, (bf16_t*)(P.ws + WS_WQT), kt * 64, nt * 64, tile); }
    }
}
typedef float f32x2_t __attribute__((ext_vector_type(2)));
__device__ __forceinline__ float wave_max(float v) {
#pragma unroll
    for (int o = 32; o >= 1; o >>= 1) v = fmaxf(v, __shfl_xor(v, o));
    return v;
}
__device__ __forceinline__ void p0_tables(const Params& P, int nworkers, int wid) {
    const int lane = threadIdx.x & 63, wave = threadIdx.x >> 6;
    float* esc = (float*)(P.ws + WS_ESC);
#pragma unroll 1
    for (int rix = wid * NWAVES + wave; rix < 2 * NEXP; rix += nworkers * NWAVES) {
        const int isv = rix & 1, e = rix >> 1;
        const float4* src = (const float4*)((isv ? P.ev : P.eu) + (size_t)e * D);
        unsigned* dst = (unsigned*)(P.ws + (isv ? WS_VB : WS_UB)) + (size_t)e * (D / 4);
        float4 v[8]; float mx = 0.f;
#pragma unroll
        for (int j = 0; j < 8; ++j) { v[j] = src[j * 64 + lane];
            if (!isv) { const float4 gg = ((const float4*)P.g2)[j * 64 + lane]; v[j].x *= gg.x; v[j].y *= gg.y; v[j].z *= gg.z; v[j].w *= gg.w; }
            mx = fmaxf(mx, fmaxf(fmaxf(fabsf(v[j].x), fabsf(v[j].y)), fmaxf(fabsf(v[j].z), fabsf(v[j].w)))); }
        mx = wave_max(mx);
        const float sc = mx > 0.f ? 240.0f / mx : 1.0f, inv = mx > 0.f ? mx * (1.0f / 240.0f) : 1.0f;
#pragma unroll
        for (int j = 0; j < 8; ++j) { int pk = __builtin_amdgcn_cvt_pk_fp8_f32(v[j].x * sc, v[j].y * sc, 0, false); pk = __builtin_amdgcn_cvt_pk_fp8_f32(v[j].z * sc, v[j].w * sc, pk, true); dst[j * 64 + lane] = (unsigned)pk; }
        if (lane == 0) esc[e * 2 + isv] = inv;
    }
}

__device__ __forceinline__ void p2_conv(const Params& P, int nworkers, int wid) {
    const bf16_t* proj = (const bf16_t*)(P.ws + WS_PROJ); bf16_t* mix = (bf16_t*)(P.ws + WS_MIXIN);
    for (int idx = wid * NTHREADS + threadIdx.x; idx < T * 128; idx += nworkers * NTHREADS) {
        const int t = idx >> 7, c8 = (idx & 127) * 8, s = t & (SEQ - 1);
        float y[8];
#pragma unroll
        for (int i = 0; i < 8; ++i) y[i] = 0.f;
#pragma unroll
        for (int j = 0; j < 3; ++j) {
            const int dt = 2 - j;
            if (s >= dt) {
                const bf16_t* row = proj + (size_t)(t - dt) * NPROJ;
                float cx[8], cc[8]; unpack8(*(const uint4*)(row + PC_CX + c8), cx); unpack8(*(const uint4*)(row + PC_CC + c8), cc);
                const float4 w0 = *(const float4*)(P.conv_w + j * 1024 + c8), w1 = *(const float4*)(P.conv_w + j * 1024 + c8 + 4);
                y[0] += w0.x * (cc[0] * cx[0]); y[1] += w0.y * (cc[1] * cx[1]); y[2] += w0.z * (cc[2] * cx[2]); y[3] += w0.w * (cc[3] * cx[3]);
                y[4] += w1.x * (cc[4] * cx[4]); y[5] += w1.y * (cc[5] * cx[5]); y[6] += w1.z * (cc[6] * cx[6]); y[7] += w1.w * (cc[7] * cx[7]);
            }
        }
        float cb[8]; unpack8(*(const uint4*)(proj + (size_t)t * NPROJ + PC_CB + c8), cb);
        *(uint4*)(mix + (size_t)t * D + c8) = make_uint4(pk2(cb[0] * y[0], cb[1] * y[1]), pk2(cb[2] * y[2], cb[3] * y[3]), pk2(cb[4] * y[4], cb[5] * y[5]), pk2(cb[6] * y[6], cb[7] * y[7]));
    }
}
#define LAS3 __attribute__((address_space(3)))
typedef short s16x4_t __attribute__((ext_vector_type(4)));
typedef unsigned v4u_t __attribute__((ext_vector_type(4)));
typedef unsigned v2u_t __attribute__((ext_vector_type(2)));
__device__ __forceinline__ pg8::bf16x8 tr8(LAS3 unsigned char* p0, LAS3 unsigned char* p1) {
    const s16x4_t a = __builtin_amdgcn_ds_read_tr16_b64_v4i16((LAS3 s16x4_t*)p0), b = __builtin_amdgcn_ds_read_tr16_b64_v4i16((LAS3 s16x4_t*)p1);
    return __builtin_shufflevector(a, b, 0, 1, 2, 3, 4, 5, 6, 7);
}
__device__ __forceinline__ void mlstm_unit(const Params& P, unsigned char* lds_, int unit) {
    typedef pg8::bf16x8 bf16x8; typedef pg8::f32x4 f32x4;
    LAS3 unsigned char* L = (LAS3 unsigned char*)lds_;
    constexpr int QS = 0, KS = 33792, VA = 67584, WV = 73728, SW = 79872, CB = 89088, SM = 114432;
    constexpr int QST = 528, VST = 96, SST = 144;
    LAS3 float* sA = (LAS3 float*)(L + SM); LAS3 float* sM = sA + 64; LAS3 float* sEi = sA + 128; LAS3 float* sWl = sA + 192; LAS3 float* sEnm = sA + 256; LAS3 float* sDen = sA + 320; LAS3 float* sMisc = sA + 384;
    const int tid = threadIdx.x, lane = tid & 63, wave = __builtin_amdgcn_readfirstlane(tid >> 6);
    const int g = lane >> 4, c16 = lane & 15, q4 = c16 >> 2, p4 = lane & 3;
    const int bh = unit >> 3, sl = unit & 7, b = bh >> 2, h = bh & 3, v0 = sl * 32;
    const bf16_t* proj = (const bf16_t*)(P.ws + WS_PROJ);
    const float* gi = (const float*)(P.ws + WS_GI); const float* gf = (const float*)(P.ws + WS_GF);
    float* hraw = (float*)(P.ws + WS_HRAW);
    for (int i = tid; i < 25344 / 16; i += NTHREADS) *(LAS3 v4u_t*)(L + CB + i * 16) = (v4u_t){0u, 0u, 0u, 0u};
    if (tid < 64) { *(LAS3 v4u_t*)(L + VA + tid * VST + 64) = (v4u_t){0x00003F80u, 0u, 0u, 0u}; *(LAS3 v4u_t*)(L + VA + tid * VST + 80) = (v4u_t){0u, 0u, 0u, 0u}; }
    f32x4 accC[2][3];
#pragma unroll
    for (int dt = 0; dt < 2; ++dt)
#pragma unroll
        for (int vt = 0; vt < 3; ++vt) accC[dt][vt] = (f32x4){0.f, 0.f, 0.f, 0.f};
    float m = 0.f;
    const int row = tid >> 3, seg = tid & 7;
    v4u_t rq[4], rk[4], rv = (v4u_t){0u, 0u, 0u, 0u};
    float pa = 0.f, pP = 0.f, pb = 0.f, nic = 0.f, nfc = 0.f, fic = 0.f, ffc = 0.f;
#define MLSTM_SCAN(ic_, fc_) do { float bc_ = (fc_); _Pragma("unroll") for (int o = 1; o < 64; o <<= 1) { const float tv = __shfl_up(bc_, o); if (lane >= o) bc_ += tv; } \
        const float a_ = (ic_) - bc_; float pm_ = a_; _Pragma("unroll") for (int o = 1; o < 64; o <<= 1) { const float tv = __shfl_up(pm_, o); if (lane >= o) pm_ = fmaxf(pm_, tv); } pa = a_; pP = pm_; pb = bc_; } while (0)
    { const int t0 = b * SEQ; const bf16_t* src = proj + (size_t)(t0 + row) * NPROJ + h * DH + seg * 32;
#pragma unroll
      for (int i = 0; i < 4; ++i) { rq[i] = *(const v4u_t*)(src + PC_Q + i * 8); rk[i] = *(const v4u_t*)(src + PC_K + i * 8); }
      if (tid < 256) rv = *(const v4u_t*)(proj + (size_t)(t0 + (tid >> 2)) * NPROJ + PC_V + h * DH + v0 + (tid & 3) * 8);
      if (wave == 1) { const float ic0 = gi[(size_t)(t0 + lane) * 4 + h], fc0 = gf[(size_t)(t0 + lane) * 4 + h]; MLSTM_SCAN(ic0, fc0);
          fic = gi[(size_t)(t0 + LCH + lane) * 4 + h]; ffc = gf[(size_t)(t0 + LCH + lane) * 4 + h]; } }
    __syncthreads();
#pragma unroll 1
    for (int c = 0; c < SEQ / LCH; ++c) {
        const int t0 = b * SEQ + c * LCH;
#pragma unroll
        for (int i = 0; i < 4; ++i) { *(LAS3 v4u_t*)(L + QS + row * QST + seg * 64 + i * 16) = rq[i]; *(LAS3 v4u_t*)(L + KS + row * QST + seg * 64 + i * 16) = rk[i]; }
        if (tid < 256) *(LAS3 v4u_t*)(L + VA + (tid >> 2) * VST + (tid & 3) * 16) = rv;
        if (wave == 1) {
            const float M = fmaxf(m, pP), M63 = __shfl(M, 63), b63 = __shfl(pb, 63);
            sA[lane] = pa; sM[lane] = M; sEi[lane] = __expf(m - M); sWl[lane] = __expf(pa - M63) * 0.0625f; sEnm[lane] = __expf(-pb - M);
            if (lane == 0) { sMisc[0] = b63 + M63; sMisc[1] = __expf(m - M63); }
            nic = fic; nfc = ffc;
            if (c + 2 < SEQ / LCH) { fic = gi[(size_t)(t0 + 2 * LCH + lane) * 4 + h]; ffc = gf[(size_t)(t0 + 2 * LCH + lane) * 4 + h]; }
        }
        if (c + 1 < SEQ / LCH) { const int t1 = t0 + LCH; const bf16_t* src = proj + (size_t)(t1 + row) * NPROJ + h * DH + seg * 32;
#pragma unroll
            for (int i = 0; i < 4; ++i) { rq[i] = *(const v4u_t*)(src + PC_Q + i * 8); rk[i] = *(const v4u_t*)(src + PC_K + i * 8); }
            if (tid < 256) rv = *(const v4u_t*)(proj + (size_t)(t1 + (tid >> 2)) * NPROJ + PC_V + h * DH + v0 + (tid & 3) * 8); }
        __syncthreads();
        { const int rt = wave >> 1;
#pragma unroll
          for (int cc = 0; cc < 2; ++cc) { const int ct = (wave & 1) * 2 + cc; f32x4 acc = (f32x4){0.f, 0.f, 0.f, 0.f};
              if (ct <= rt) {
#pragma unroll
                  for (int ks = 0; ks < 8; ++ks) { const bf16x8 av = *(LAS3 bf16x8*)(L + QS + (rt * 16 + c16) * QST + (ks * 32 + g * 8) * 2), bv = *(LAS3 bf16x8*)(L + KS + (ct * 16 + c16) * QST + (ks * 32 + g * 8) * 2);
                      acc = __builtin_amdgcn_mfma_f32_16x16x32_bf16(av, bv, acc, 0, 0, 0); } }
              const int l = ct * 16 + c16; const float al = sA[l]; const f32x4 M4 = *(LAS3 f32x4*)(sM + rt * 16 + 4 * g);
#pragma unroll
              for (int r = 0; r < 4; ++r) { const int j = rt * 16 + 4 * g + r; const float val = (l <= j) ? acc[r] * 0.0625f * __expf(al - M4[r]) : 0.f;
                  *(LAS3 unsigned short*)(L + SW + j * SST + l * 2) = (unsigned short)f2bf(val); } } }
        if (wave == 1 && c + 1 < SEQ / LCH) MLSTM_SCAN(nic, nfc);
#pragma unroll
        for (int i = 0; i < 6; ++i) { const int e = tid + NTHREADS * i, l = e / 48, vp = e - l * 48;
            *(LAS3 unsigned short*)(L + WV + l * VST + vp * 2) = (unsigned short)f2bf(sWl[l] * bf1(*(LAS3 unsigned short*)(L + VA + l * VST + vp * 2))); }
        __syncthreads();
        const int rt = wave >> 1, vt = wave & 1;
        f32x4 num;
        { f32x4 accI = (f32x4){0.f, 0.f, 0.f, 0.f}, accX = (f32x4){0.f, 0.f, 0.f, 0.f};
#pragma unroll
          for (int ks = 0; ks < 8; ++ks) { const bf16x8 av = *(LAS3 bf16x8*)(L + QS + (rt * 16 + c16) * QST + (ks * 32 + g * 8) * 2), bv = *(LAS3 bf16x8*)(L + CB + (vt * 16 + c16) * QST + (ks * 32 + g * 8) * 2);
              accI = __builtin_amdgcn_mfma_f32_16x16x32_bf16(av, bv, accI, 0, 0, 0); }
#pragma unroll
          for (int ks = 0; ks < 2; ++ks) { const bf16x8 av = *(LAS3 bf16x8*)(L + SW + (rt * 16 + c16) * SST + (ks * 32 + g * 8) * 2);
              LAS3 unsigned char* vp = L + VA + (ks * 32 + g * 8 + q4) * VST + (vt * 16 + 4 * p4) * 2; const bf16x8 bv = tr8(vp, vp + 4 * VST);
              accX = __builtin_amdgcn_mfma_f32_16x16x32_bf16(av, bv, accX, 0, 0, 0); }
          const f32x4 e4 = *(LAS3 f32x4*)(sEi + rt * 16 + 4 * g);
          num = e4 * accI + accX;
          if ((wave & 1) == 0) {
              f32x4 aI = (f32x4){0.f, 0.f, 0.f, 0.f}, aX = (f32x4){0.f, 0.f, 0.f, 0.f};
#pragma unroll
              for (int ks = 0; ks < 8; ++ks) { const bf16x8 av = *(LAS3 bf16x8*)(L + QS + (rt * 16 + c16) * QST + (ks * 32 + g * 8) * 2), bv = *(LAS3 bf16x8*)(L + CB + (32 + c16) * QST + (ks * 32 + g * 8) * 2);
                  aI = __builtin_amdgcn_mfma_f32_16x16x32_bf16(av, bv, aI, 0, 0, 0); }
#pragma unroll
              for (int ks = 0; ks < 2; ++ks) { const bf16x8 av = *(LAS3 bf16x8*)(L + SW + (rt * 16 + c16) * SST + (ks * 32 + g * 8) * 2);
                  LAS3 unsigned char* vp = L + VA + (ks * 32 + g * 8 + q4) * VST + (32 + 4 * p4) * 2; const bf16x8 bv = tr8(vp, vp + 4 * VST);
                  aX = __builtin_amdgcn_mfma_f32_16x16x32_bf16(av, bv, aX, 0, 0, 0); }
              if (c16 == 0) {
#pragma unroll
                  for (int r = 0; r < 4; ++r) { const int j = rt * 16 + 4 * g + r; sDen[j] = fmaxf(fabsf(e4[r] * aI[r] + aX[r]), sEnm[j]); } }
          } }
        __syncthreads();
        { const f32x4 d4 = *(LAS3 f32x4*)(sDen + rt * 16 + 4 * g);
#pragma unroll
          for (int r = 0; r < 4; ++r) hraw[(size_t)(t0 + rt * 16 + 4 * g + r) * DML + h * DH + v0 + vt * 16 + c16] = __fdividef(num[r], d4[r]); }
        { const float decay = sMisc[1];
#pragma unroll
          for (int dt = 0; dt < 2; ++dt)
#pragma unroll
              for (int v3 = 0; v3 < 3; ++v3) accC[dt][v3] *= decay;
#pragma unroll
          for (int ks = 0; ks < 2; ++ks) { bf16x8 af[2], bfr[3];
#pragma unroll
              for (int dt = 0; dt < 2; ++dt) { LAS3 unsigned char* kp = L + KS + (ks * 32 + g * 8 + q4) * QST + ((2 * wave + dt) * 16 + 4 * p4) * 2; af[dt] = tr8(kp, kp + 4 * QST); }
#pragma unroll
              for (int v3 = 0; v3 < 3; ++v3) { LAS3 unsigned char* wp = L + WV + (ks * 32 + g * 8 + q4) * VST + (v3 * 16 + 4 * p4) * 2; bfr[v3] = tr8(wp, wp + 4 * VST); }
#pragma unroll
              for (int dt = 0; dt < 2; ++dt)
#pragma unroll
                  for (int v3 = 0; v3 < 3; ++v3) accC[dt][v3] = __builtin_amdgcn_mfma_f32_16x16x32_bf16(af[dt], bfr[v3], accC[dt][v3], 0, 0, 0); }
#pragma unroll
          for (int dt = 0; dt < 2; ++dt)
#pragma unroll
              for (int v3 = 0; v3 < 3; ++v3) { const int d = (2 * wave + dt) * 16 + 4 * g, vp = v3 * 16 + c16;
                  *(LAS3 v2u_t*)(L + CB + vp * QST + d * 2) = (v2u_t){pk2(accC[dt][v3][0], accC[dt][v3][1]), pk2(accC[dt][v3][2], accC[dt][v3][3])}; }
          m = sMisc[0]; }
        __syncthreads();
    }
#undef MLSTM_SCAN
}

__device__ __forceinline__ void p3_finalize(const Params& P, int G, int bid) {
    const int lane = threadIdx.x & 63, wave = threadIdx.x >> 6;
    const float* hraw = (const float*)(P.ws + WS_HRAW); const bf16_t* proj = (const bf16_t*)(P.ws + WS_PROJ); bf16_t* mix = (bf16_t*)(P.ws + WS_MIXIN);
    for (int idx = bid * NWAVES + wave; idx < T * NH; idx += G * NWAVES) {
        const int t = idx >> 2, hh = idx & 3;
        const float4 hv = *(const float4*)(hraw + (size_t)t * DML + hh * DH + lane * 4);
        const float ss = wave_sum((hv.x * hv.x + hv.y * hv.y) + (hv.z * hv.z + hv.w * hv.w));
        const float r = rsqrtf(ss * (1.0f / DH) + EPS);
        const uint2 ow = *(const uint2*)(proj + (size_t)t * NPROJ + PC_O + hh * DH + lane * 4);
        const float4 g = *(const float4*)(P.gm + hh * DH + lane * 4);
        const float o0 = 1.0f / (1.0f + expf(-bflo(ow.x))), o1 = 1.0f / (1.0f + expf(-bfhi(ow.x))), o2 = 1.0f / (1.0f + expf(-bflo(ow.y))), o3 = 1.0f / (1.0f + expf(-bfhi(ow.y)));
        *(uint2*)(mix + (size_t)t * D + DML + hh * DH + lane * 4) = make_uint2(pk2(o0 * (hv.x * r * g.x), o1 * (hv.y * r * g.y)), pk2(o2 * (hv.z * r * g.z), o3 * (hv.w * r * g.w)));
    }
}

template <int CTRL> __device__ __forceinline__ float dppf(float v) { return __int_as_float(__builtin_amdgcn_update_dpp(0, __float_as_int(v), CTRL, 0xF, 0xF, true)); }
__device__ __forceinline__ float grp16_max(float v) { v = fmaxf(v, dppf<0xB1>(v)); v = fmaxf(v, dppf<0x4E>(v)); v = fmaxf(v, dppf<0x141>(v)); v = fmaxf(v, dppf<0x140>(v)); return v; }
__device__ __forceinline__ float grp16_sum(float v) { v += dppf<0xB1>(v); v += dppf<0x4E>(v); v += dppf<0x141>(v); v += dppf<0x140>(v); return v; }
#define CEX(a, b) do { const float hi_ = fmaxf(a, b), lo_ = fminf(a, b); a = hi_; b = lo_; } while (0)
static __device__ const unsigned char CAND_AB[16][4] = {
    {0x00, 0x01, 0x02, 0x03}, {0x04, 0x05, 0x06, 0x07}, {0x08, 0x09, 0x0A, 0x0B}, {0x0C, 0x0D, 0x0E, 0x0F}, {0x10, 0x11, 0x12, 0x13}, {0x14, 0x15, 0x16, 0x17}, {0x20, 0x21, 0x22, 0x23}, {0x24, 0, 0, 0},
    {0x30, 0x31, 0x32, 0x33}, {0x40, 0x41, 0x42, 0}, {0x50, 0x60, 0x70, 0x80}, {0x90, 0xA0, 0xB0, 0xC0}, {0xD0, 0xE0, 0xF0, 0}, {0x51, 0x61, 0x71, 0}, {0, 0, 0, 0}, {0, 0, 0, 0}};
static __device__ const unsigned char CAND_N[16] = {4, 4, 4, 4, 4, 4, 4, 1, 4, 3, 4, 4, 3, 3, 0, 0};
__device__ __forceinline__ void p6_topk(const Params& P, unsigned char* lds_, int G, int bid) {
    typedef pg8::bf16x8 bf16x8; typedef pg8::f32x4 f32x4;
    LAS3 unsigned char* L = (LAS3 unsigned char*)lds_;
    constexpr int KST = 272, KHALF = 128 * KST;
    const int tid = threadIdx.x, lane = tid & 63, wave = tid >> 6, g = lane >> 4, c16 = lane & 15;
    for (int i = tid; i < 2 * 2048; i += NTHREADS) { const int hf = i >> 11, n = (i >> 4) & 127, d8 = (i & 15) * 8; const float* src = (hf ? P.sk2 : P.sk1) + n * 128 + d8;
        const float4 a = *(const float4*)src, b = *(const float4*)(src + 4);
        *(LAS3 v4u_t*)(L + hf * KHALF + n * KST + d8 * 2) = (v4u_t){pk2(a.x, a.y), pk2(a.z, a.w), pk2(b.x, b.y), pk2(b.z, b.w)}; }
    __syncthreads();
    const bf16_t* qvb = (const bf16_t*)(P.ws + WS_QV);
    int* idxo = (int*)(P.ws + WS_IDX); float* gato = (float*)(P.ws + WS_GATE);
    const float NEGINF = -__builtin_inff();
    unsigned ctab = 0; { const unsigned char* tp = CAND_AB[c16]; ctab = (unsigned)tp[0] | ((unsigned)tp[1] << 8) | ((unsigned)tp[2] << 16) | ((unsigned)tp[3] << 24); }
    const int ccnt = CAND_N[c16];
#pragma unroll 1
    for (int it = bid * NWAVES + wave; it < (T / 16) * PEER_H; it += G * NWAVES) {
        const int t0 = (it >> 3) * 16, hh = it & 7;
        float keepH[2][4];
#pragma unroll
        for (int hf = 0; hf < 2; ++hf) {
            asm volatile("" ::: "memory");
            bf16x8 af[4];
#pragma unroll
            for (int ks = 0; ks < 4; ++ks) af[ks] = *(const bf16x8*)(qvb + (size_t)(t0 + c16) * D + hh * 256 + hf * 128 + ks * 32 + g * 8);
            f32x4 acc[8];
#pragma unroll
            for (int ct = 0; ct < 8; ++ct) { acc[ct] = (f32x4){0.f, 0.f, 0.f, 0.f};
#pragma unroll
                for (int ks = 0; ks < 4; ++ks) { const bf16x8 bv = *(LAS3 bf16x8*)(L + hf * KHALF + (ct * 16 + c16) * KST + (ks * 32 + g * 8) * 2);
                    acc[ct] = __builtin_amdgcn_mfma_f32_16x16x32_bf16(af[ks], bv, acc[ct], 0, 0, 0); } }
            float v[4][8];
#pragma unroll
            for (int r = 0; r < 4; ++r) {
#pragma unroll
                for (int ct = 0; ct < 8; ++ct) v[r][ct] = __uint_as_float((__float_as_uint(acc[ct][r]) & ~127u) | (unsigned)(127 - (ct * 16 + c16)));
                CEX(v[r][0], v[r][1]); CEX(v[r][2], v[r][3]); CEX(v[r][4], v[r][5]); CEX(v[r][6], v[r][7]);
                CEX(v[r][0], v[r][2]); CEX(v[r][1], v[r][3]); CEX(v[r][4], v[r][6]); CEX(v[r][5], v[r][7]);
                CEX(v[r][1], v[r][2]); CEX(v[r][5], v[r][6]); CEX(v[r][0], v[r][4]); CEX(v[r][3], v[r][7]);
                CEX(v[r][1], v[r][5]); CEX(v[r][2], v[r][6]);
                CEX(v[r][1], v[r][4]); CEX(v[r][3], v[r][6]);
                CEX(v[r][2], v[r][4]); CEX(v[r][3], v[r][5]);
                CEX(v[r][3], v[r][4]);
                keepH[hf][r] = 0.f;
            }
#pragma unroll
            for (int rd = 0; rd < TOPK; ++rd) {
#pragma unroll
                for (int r = 0; r < 4; ++r) {
                    const float W = grp16_max(v[r][0]); const bool win = (v[r][0] == W);
                    if (c16 == rd) keepH[hf][r] = W;
#pragma unroll
                    for (int k = 0; k < 7; ++k) v[r][k] = win ? v[r][k + 1] : v[r][k];
                    v[r][7] = win ? NEGINF : v[r][7];
                }
            }
        }
#pragma unroll
        for (int r = 0; r < 4; ++r) {
            const float V1 = keepH[0][r], V2 = keepH[1][r];
            float cv[4];
#pragma unroll
            for (int s4 = 0; s4 < 4; ++s4) { const unsigned code = (ctab >> (8 * s4)) & 255u;
                const float x1 = __shfl(V1, g * 16 + (int)(code >> 4)), x2 = __shfl(V2, g * 16 + (int)(code & 15u));
                const float sum = __uint_as_float(__float_as_uint(x1) & ~127u) + __uint_as_float(__float_as_uint(x2) & ~127u);
                cv[s4] = (s4 < ccnt) ? __uint_as_float((__float_as_uint(sum) & ~255u) | (255u - code)) : NEGINF; }
            float keepc = 0.f;
#pragma unroll
            for (int rd = 0; rd < TOPK; ++rd) {
                const float W = grp16_max(cv[0]); const bool win = (cv[0] == W);
                if (c16 == rd) keepc = W;
                cv[0] = win ? cv[1] : cv[0]; cv[1] = win ? cv[2] : cv[1]; cv[2] = win ? cv[3] : cv[2]; cv[3] = win ? NEGINF : cv[3];
            }
            const unsigned kb = __float_as_uint(keepc), code = 255u - (kb & 255u);
            const unsigned n1 = 127u - (__float_as_uint(__shfl(V1, g * 16 + (int)(code >> 4))) & 127u), n2 = 127u - (__float_as_uint(__shfl(V2, g * 16 + (int)(code & 15u))) & 127u);
            const float sval = __uint_as_float(kb & ~255u), smax = __shfl(sval, g * 16);
            const float ex = __expf(sval - smax), den = grp16_sum(ex);
            const size_t o = (size_t)(t0 + 4 * g + r) * 128 + hh * 16 + c16;
            idxo[o] = (int)(n1 * 128u + n2); gato[o] = ex / den;
        }
    }
    __syncthreads();
}

__device__ __forceinline__ float wave_sum_dpp(float v) {
    v += dppf<0xB1>(v); v += dppf<0x4E>(v); v += dppf<0x141>(v); v += dppf<0x140>(v);
    const int iv = __float_as_int(v);
    return (__int_as_float(__builtin_amdgcn_readlane(iv, 0)) + __int_as_float(__builtin_amdgcn_readlane(iv, 16))) + (__int_as_float(__builtin_amdgcn_readlane(iv, 32)) + __int_as_float(__builtin_amdgcn_readlane(iv, 48)));
}
__device__ __forceinline__ float dot16_fp8(const v4u_t w, const float (&x)[16]) {
    float s = 0.f;
#pragma unroll
    for (int k = 0; k < 4; ++k) { const f32x2_t lo = __builtin_amdgcn_cvt_pk_f32_fp8(w[k], false), hi = __builtin_amdgcn_cvt_pk_f32_fp8(w[k], true);
        s += (x[4 * k] * lo.x + x[4 * k + 1] * lo.y) + (x[4 * k + 2] * hi.x + x[4 * k + 3] * hi.y); }
    return s;
}
__device__ __forceinline__ void axpy16_fp8(const v4u_t w, const float cf, float (&y)[16]) {
#pragma unroll
    for (int k = 0; k < 4; ++k) { const f32x2_t lo = __builtin_amdgcn_cvt_pk_f32_fp8(w[k], false), hi = __builtin_amdgcn_cvt_pk_f32_fp8(w[k], true);
        y[4 * k] += cf * lo.x; y[4 * k + 1] += cf * lo.y; y[4 * k + 2] += cf * hi.x; y[4 * k + 3] += cf * hi.y; }
}
__device__ __forceinline__ void p7_peer(const Params& P, int G, int bid) {
    const int lane = threadIdx.x & 63, wave = threadIdx.x >> 6;
    const bf16_t* x1b = (const bf16_t*)(P.ws + WS_X1B); const float* x1 = (const float*)(P.ws + WS_X1); const float* ssq = (const float*)(P.ws + WS_SSQ);
    const int* idxi = (const int*)(P.ws + WS_IDX); const float* gati = (const float*)(P.ws + WS_GATE);
    const unsigned char* ub = P.ws + WS_UB; const unsigned char* vb = P.ws + WS_VB; const float* esc = (const float*)(P.ws + WS_ESC);
#pragma unroll 1
    for (int t = bid * NWAVES + wave; t < T; t += G * NWAVES) {
        int ln = lane; asm volatile("" : "+v"(ln));
        const float rs2 = rsqrtf(wave_sum(ln < 32 ? ssq[(size_t)t * 32 + ln] : 0.f) * (1.0f / D) + EPS);
        const int idx0 = idxi[(size_t)t * 128 + ln], idx1 = idxi[(size_t)t * 128 + 64 + ln];
        v4u_t bA[8][2], bB[8][2]; const unsigned lane16 = (unsigned)ln * 16u;
#define P7_LOAD(TAB, IDXR, gl, Bf) do { _Pragma("unroll") for (int e = 0; e < 8; ++e) { const int ei = __builtin_amdgcn_readlane(IDXR, (gl) * 8 + e); \
            const unsigned char* rb = (TAB) + (size_t)(unsigned)ei * D; Bf[e][0] = *(const v4u_t*)(rb + lane16); Bf[e][1] = *(const v4u_t*)(rb + lane16 + 1024u); } __builtin_amdgcn_sched_barrier(0); } while (0)
#define PIN16(a) asm volatile("" : "+v"(a[0]), "+v"(a[1]), "+v"(a[2]), "+v"(a[3]), "+v"(a[4]), "+v"(a[5]), "+v"(a[6]), "+v"(a[7]), "+v"(a[8]), "+v"(a[9]), "+v"(a[10]), "+v"(a[11]), "+v"(a[12]), "+v"(a[13]), "+v"(a[14]), "+v"(a[15]))
#define P7_DOT(gl, Bf, DR) do { float ds_[8]; _Pragma("unroll") for (int e = 0; e < 8; ++e) { asm volatile("" : "+v"(Bf[e][0]), "+v"(Bf[e][1])); ds_[e] = dot16_fp8(Bf[e][0], xf[0]) + dot16_fp8(Bf[e][1], xf[1]); } \
            _Pragma("unroll") for (int e = 0; e < 8; ++e) { const float tot = wave_sum_dpp(ds_[e]); int l2_ = lane; asm volatile("" : "+v"(l2_)); DR = (l2_ == (gl) * 8 + e) ? tot : DR; } __builtin_amdgcn_sched_barrier(0); } while (0)
#define P7_AXPY(gl, Bf, CR) do { _Pragma("unroll") for (int e = 0; e < 8; ++e) { const float cf = __int_as_float(__builtin_amdgcn_readlane(__float_as_int(CR), (gl) * 8 + e)); asm volatile("" : "+v"(Bf[e][0]), "+v"(Bf[e][1])); \
            axpy16_fp8(Bf[e][0], cf, y[0]); axpy16_fp8(Bf[e][1], cf, y[1]); PIN16(y[0]); PIN16(y[1]); } } while (0)
        float d0 = 0.f, d1 = 0.f;
        {
            float xf[2][16];
#pragma unroll
            for (int c = 0; c < 2; ++c) { float a[8], b[8]; unpack8(*(const uint4*)(x1b + (size_t)t * D + c * 1024 + ln * 16), a); unpack8(*(const uint4*)(x1b + (size_t)t * D + c * 1024 + ln * 16 + 8), b);
#pragma unroll
                for (int i = 0; i < 8; ++i) { xf[c][i] = a[i]; xf[c][8 + i] = b[i]; } }
            P7_LOAD(ub, idx0, 0, bA);
#pragma unroll 1
            for (int gl = 0; gl < 6; gl += 2) { P7_LOAD(ub, idx0, gl + 1, bB); P7_DOT(gl, bA, d0); P7_LOAD(ub, idx0, gl + 2, bA); P7_DOT(gl + 1, bB, d0); }
            P7_LOAD(ub, idx0, 7, bB); P7_DOT(6, bA, d0); P7_LOAD(ub, idx1, 0, bA); P7_DOT(7, bB, d0);
#pragma unroll 1
            for (int gl = 0; gl < 6; gl += 2) { P7_LOAD(ub, idx1, gl + 1, bB); P7_DOT(gl, bA, d1); P7_LOAD(ub, idx1, gl + 2, bA); P7_DOT(gl + 1, bB, d1); }
            P7_LOAD(ub, idx1, 7, bB); P7_DOT(6, bA, d1); P7_LOAD(vb, idx0, 0, bA); P7_DOT(7, bB, d1);
        }
        float cf0, cf1;
        { const float gt0 = gati[(size_t)t * 128 + ln], gt1 = gati[(size_t)t * 128 + 64 + ln];
          const float su0 = esc[idx0 * 2], sv0 = esc[idx0 * 2 + 1], su1 = esc[idx1 * 2], sv1 = esc[idx1 * 2 + 1];
          cf0 = gt0 * gelu_erf(d0 * rs2 * su0) * sv0; cf1 = gt1 * gelu_erf(d1 * rs2 * su1) * sv1; }
        float y[2][16];
#pragma unroll
        for (int c = 0; c < 2; ++c)
#pragma unroll
            for (int i = 0; i < 16; ++i) y[c][i] = 0.f;
#pragma unroll 1
        for (int gl = 0; gl < 6; gl += 2) { P7_LOAD(vb, idx0, gl + 1, bB); P7_AXPY(gl, bA, cf0); P7_LOAD(vb, idx0, gl + 2, bA); P7_AXPY(gl + 1, bB, cf0); }
        P7_LOAD(vb, idx0, 7, bB); P7_AXPY(6, bA, cf0); P7_LOAD(vb, idx1, 0, bA); P7_AXPY(7, bB, cf0);
#pragma unroll 1
        for (int gl = 0; gl < 6; gl += 2) { P7_LOAD(vb, idx1, gl + 1, bB); P7_AXPY(gl, bA, cf1); P7_LOAD(vb, idx1, gl + 2, bA); P7_AXPY(gl + 1, bB, cf1); }
        P7_LOAD(vb, idx1, 7, bB); P7_AXPY(6, bA, cf1); P7_AXPY(7, bB, cf1);
#undef P7_AXPY
#undef PIN16
#undef P7_DOT
#undef P7_LOAD
        float ss = 0.f;
#pragma unroll
        for (int c = 0; c < 2; ++c)
#pragma unroll
            for (int k = 0; k < 4; ++k) { const float4 a = *(const float4*)(x1 + (size_t)t * D + c * 1024 + ln * 16 + 4 * k);
                y[c][4 * k] += a.x; y[c][4 * k + 1] += a.y; y[c][4 * k + 2] += a.z; y[c][4 * k + 3] += a.w;
                ss += (y[c][4 * k] * y[c][4 * k] + y[c][4 * k + 1] * y[c][4 * k + 1]) + (y[c][4 * k + 2] * y[c][4 * k + 2] + y[c][4 * k + 3] * y[c][4 * k + 3]); }
        ss = wave_sum(ss);
        const float r = rsqrtf(ss * (1.0f / D) + EPS);
#pragma unroll
        for (int c = 0; c < 2; ++c)
#pragma unroll
            for (int k = 0; k < 4; ++k) { const float4 gg = *(const float4*)(P.gfin + c * 1024 + ln * 16 + 4 * k);
                *(float4*)(P.out + (size_t)t * D + c * 1024 + ln * 16 + 4 * k) = make_float4(y[c][4 * k] * r * gg.x, y[c][4 * k + 1] * r * gg.y, y[c][4 * k + 2] * r * gg.z, y[c][4 * k + 3] * r * gg.w); }
    }
}

#define XB_TMO      128
#define XB_XCNT(j)  (256  + 64 * (j))
#define XB_XSUB(j)  (1280 + 64 * (j))
#define XB_XGEN(j)  (2304 + 64 * (j))
#define XB_TOP      3328
#define XB_TOPGEN   3392
#define XCD_BAR_WORDS 3456
#define XB_SPIN_CAP (1u << 18)

__device__ __forceinline__ unsigned xb_ld(unsigned* p)              { return __hip_atomic_load(p, __ATOMIC_RELAXED, __HIP_MEMORY_SCOPE_AGENT); }
__device__ __forceinline__ unsigned xb_add(unsigned* p, unsigned v) { return __hip_atomic_fetch_add(p, v, __ATOMIC_RELAXED, __HIP_MEMORY_SCOPE_AGENT); }
__device__ __forceinline__ unsigned xb_xcc_id() { return (unsigned)__builtin_amdgcn_s_getreg((3 << 11) | 20) & 0xFu; }
#define XB_SPIN(cond, bar) do { unsigned _sp = 0; while (cond) { __builtin_amdgcn_s_sleep(1); \
    if ((++_sp & 255u) == 0u) { if (xb_ld(&(bar)[XB_TMO])) break; if (_sp > XB_SPIN_CAP) { atomicAdd(&(bar)[XB_TMO], 1u); break; } } } } while (0)

struct XcdBarrier {
    unsigned* bar; unsigned x;
    volatile LAS3 unsigned* st;
};

__device__ __forceinline__ XcdBarrier xcd_barrier_post(unsigned* bar, volatile LAS3 unsigned* st) {
    XcdBarrier b; b.bar = bar; b.x = xb_xcc_id(); b.st = st;
    if (threadIdx.x == 0) (void)xb_add(&bar[XB_XCNT(b.x)], 1u);
    return b;
}
__device__ __forceinline__ void xcd_barrier_complete(unsigned* bar, unsigned x, unsigned& nloc, unsigned& nx) {
    const unsigned G = gridDim.x * gridDim.y * gridDim.z;
    unsigned sum, cnt, mine, sp = 0u;
    for (;;) {
        sum = 0u; cnt = 0u; mine = 0u;
#pragma unroll
        for (unsigned j = 0; j < 16; ++j) { const unsigned c = xb_ld(&bar[XB_XCNT(j)]); sum += c; cnt += (c > 0u) ? 1u : 0u; mine = (j == x) ? c : mine; }
        if (sum == G) break;
        __builtin_amdgcn_s_sleep(1);
        if ((++sp & 255u) == 0u) { if (xb_ld(&bar[XB_TMO])) break; if (sp > XB_SPIN_CAP) { atomicAdd(&bar[XB_TMO], 1u); break; } }
    }
    nloc = mine > 0u ? mine : 1u; nx = cnt > 0u ? cnt : 1u;
}

__device__ __forceinline__ void xcd_barrier(const XcdBarrier& b) {
    asm volatile("s_waitcnt vmcnt(0)" ::: "memory");
    __syncthreads();
    if (threadIdx.x == 0) {
        unsigned* bar = b.bar;
        __builtin_amdgcn_s_waitcnt(0);
        unsigned nloc = b.st[0], nx = b.st[1];
        if (nloc == 0u) { xcd_barrier_complete(bar, b.x, nloc, nx); b.st[0] = nloc; b.st[1] = nx; }
        const unsigned old = xb_add(&bar[XB_XSUB(b.x)], 1u);
        const unsigned gen = old / nloc;
        if (old + 1u == (gen + 1u) * nloc) {
            __builtin_amdgcn_fence(__ATOMIC_RELEASE, "agent");
            asm volatile("s_waitcnt vmcnt(0)" ::: "memory");
            const unsigned og = xb_add(&bar[XB_TOP], 1u);
            const unsigned tg = og / nx;
            if (og + 1u == (tg + 1u) * nx) xb_add(&bar[XB_TOPGEN], 1u);
            else XB_SPIN(xb_ld(&bar[XB_TOPGEN]) == tg, bar);
            __builtin_amdgcn_fence(__ATOMIC_ACQUIRE, "agent");
            xb_add(&bar[XB_XGEN(b.x)], 1u);
            asm volatile("s_waitcnt vmcnt(0)" ::: "memory");
        } else {
            XB_SPIN(xb_ld(&bar[XB_XGEN(b.x)]) == gen, bar);
            __builtin_amdgcn_fence(__ATOMIC_ACQUIRE, "agent");
            asm volatile("s_waitcnt vmcnt(0)" ::: "memory");
        }
    }
    __syncthreads();
}

constexpr int N_PHASES = 8;
#ifndef MK_N_LAUNCHES
#define MK_N_LAUNCHES 1
#endif
__global__ void __launch_bounds__(NTHREADS, 2) layer_fwd(Params P) {
    extern __shared__ __attribute__((aligned(16))) unsigned char lds[];
    const int G = gridDim.x, bid = blockIdx.x;
    volatile LAS3 unsigned* bst = (volatile LAS3 unsigned*)((LAS3 unsigned char*)lds + (LDS_BYTES - 16));
    if (threadIdx.x < 4) bst[threadIdx.x] = 0u;
    __syncthreads();
    XcdBarrier xbar = xcd_barrier_post((unsigned*)(P.ws + WS_CTL) + CW_BAR, bst);
    const int lo = P.ph_lo, hi = P.ph_hi;
#ifndef PH_MASK
#define PH_MASK 0xff
#endif
#define IN(k) (((PH_MASK >> (k)) & 1) && lo <= (k) && (k) < hi)
#define SEAM(k) do { if (IN(k) && IN((k) + 1)) xcd_barrier(xbar); } while (0)
#ifndef REP_MASK
#define REP_MASK 0
#endif
#define REPS(k) (((REP_MASK >> (k)) & 1) ? 2 : 1)
    if (IN(0)) for (int rep = 0; rep < REPS(0); ++rep) { p0_rows(P, lds, G, bid); p0_weights_in(P, lds, G, bid); }
    SEAM(0);
    if (IN(1)) for (int rep = 0; rep < REPS(1); ++rep) {
        pg8::Gemm g{(const pg8::bf16_t*)(P.ws + WS_XB), (const pg8::bf16_t*)(P.ws + WS_WINT), T, NPROJ, D}; pg8::StaticOrder S; S.init(T, NPROJ, G, bid);
        pg8::EpiProj E{(pg8::bf16_t*)(P.ws + WS_PROJ), NPROJ, (const float*)(P.ws + WS_RS1)};
        pg8::gemm_phase<pg8::EpiProj, pg8::StaticOrder, true, true>((PG8_LAS unsigned char*)lds, g, S, E);
    }
    SEAM(1);
    if (IN(2)) for (int rep = 0; rep < REPS(2); ++rep) {
        for (int u = bid; u < 64; u += G) mlstm_unit(P, lds, u);
        if (G > 64) { if (bid >= 64) { p2_conv(P, G - 64, bid - 64); p2_weights_sq(P, lds, G - 64, bid - 64); p0_tables(P, G - 64, bid - 64); } }
        else { p2_conv(P, G, bid); p2_weights_sq(P, lds, G, bid); p0_tables(P, G, bid); }
    }
    SEAM(2);
    if (IN(3)) for (int rep = 0; rep < REPS(3); ++rep) p3_finalize(P, G, bid);
    SEAM(3);
    if (IN(4)) for (int rep = 0; rep < REPS(4); ++rep) {
        pg8::Gemm g{(const pg8::bf16_t*)(P.ws + WS_MIXIN), (const pg8::bf16_t*)(P.ws + WS_WOUTT), T, D, D}; pg8::StaticOrder S; S.init(T, D, G, bid);
        pg8::EpiOut E{P.x, (float*)(P.ws + WS_X1), (pg8::bf16_t*)(P.ws + WS_X1B), (float*)(P.ws + WS_SSQ), D};
        pg8::gemm_phase<pg8::EpiOut, pg8::StaticOrder, false, true>((PG8_LAS unsigned char*)lds, g, S, E);
    }
    SEAM(4);
    if (IN(5)) for (int rep = 0; rep < REPS(5); ++rep) {
        pg8::Gemm g{(const pg8::bf16_t*)(P.ws + WS_X1B), (const pg8::bf16_t*)(P.ws + WS_WQT), T, D, D}; pg8::StaticOrder S; S.init(T, D, G, bid);
        pg8::EpiQb E{(pg8::bf16_t*)(P.ws + WS_QV), D, (const float*)(P.ws + WS_SSQ)};
        pg8::gemm_phase<pg8::EpiQb, pg8::StaticOrder, false, true>((PG8_LAS unsigned char*)lds, g, S, E);
    }
    SEAM(5);
    if (IN(6)) for (int rep = 0; rep < REPS(6); ++rep) p6_topk(P, lds, G, bid);
    SEAM(6);
#ifdef EXTRA_SYNCS
    for (int i = 0; i < EXTRA_SYNCS; ++i) xcd_barrier(xbar);
#endif
    if (IN(7)) for (int rep = 0; rep < REPS(7); ++rep) p7_peer(P, G, bid);
#undef IN
#undef SEAM
}

extern "C" void kernel_launch(void* const* d_in, const int* in_sizes, int n_in, void* d_out, int out_size, void* d_ws, size_t ws_size, hipStream_t stream) {
    static int grid = 0;
    if (grid == 0) {
        if (n_in != 15 || in_sizes[0] != T * D || out_size != T * D || ws_size < WS_END) { fprintf(stderr, "kernel_launch: unexpected shapes (n_in %d, in0 %d, out %d, ws %zu); nothing launched\n", n_in, n_in > 0 ? in_sizes[0] : -1, out_size, ws_size); grid = -1; return; }
        int dev = 0, cus = 0, per_cu = 0;
        if (hipGetDevice(&dev) != hipSuccess || hipDeviceGetAttribute(&cus, hipDeviceAttributeMultiprocessorCount, dev) != hipSuccess) { grid = -1; return; }
        if (hipFuncSetAttribute((const void*)layer_fwd, hipFuncAttributeMaxDynamicSharedMemorySize, LDS_BYTES) != hipSuccess) { fprintf(stderr, "kernel_launch: hipFuncSetAttribute failed\n"); grid = -1; return; }
        if (hipOccupancyMaxActiveBlocksPerMultiprocessor(&per_cu, (const void*)layer_fwd, NTHREADS, LDS_BYTES) != hipSuccess || per_cu < 1) { fprintf(stderr, "kernel_launch: occupancy query says %d blocks per CU\n", per_cu); (void)hipGetLastError(); grid = -1; return; }
        grid = cus;
    }
    if (grid < 0) return;
    Params p{};
    p.x = (const float*)d_in[0]; p.g1 = (const float*)d_in[1]; p.w_in = (const float*)d_in[2]; p.b_ig = (const float*)d_in[3]; p.b_fg = (const float*)d_in[4];
    p.conv_w = (const float*)d_in[5]; p.gm = (const float*)d_in[6]; p.w_out = (const float*)d_in[7]; p.g2 = (const float*)d_in[8]; p.w_q = (const float*)d_in[9];
    p.sk1 = (const float*)d_in[10]; p.sk2 = (const float*)d_in[11]; p.eu = (const float*)d_in[12]; p.ev = (const float*)d_in[13]; p.gfin = (const float*)d_in[14];
    p.out = (float*)d_out; p.ws = (unsigned char*)d_ws;
    if (hipMemsetAsync((char*)d_ws + WS_CTL, 0, CTL_ZERO_BYTES, stream) != hipSuccess) { fprintf(stderr, "kernel_launch: hipMemsetAsync failed\n"); return; }
    for (int li = 0; li < MK_N_LAUNCHES; ++li) {
        p.ph_lo = (MK_N_LAUNCHES == 1) ? 0 : li; p.ph_hi = (MK_N_LAUNCHES == 1) ? N_PHASES : li + 1;
        void* args[] = {&p};
        const hipError_t e = hipLaunchCooperativeKernel((const void*)layer_fwd, dim3(grid), dim3(NTHREADS), args, LDS_BYTES, stream);
        if (e != hipSuccess) { fprintf(stderr, "kernel_launch: cooperative launch %d failed: %s (grid %d)\n", li, hipGetErrorString(e), grid); break; }
    }
}
```

```cpp
#include <hip/hip_runtime.h>
#include <hip/hip_cooperative_groups.h>
#include <cstdio>
#include <cstdint>
namespace cg = cooperative_groups;
namespace pg8 {
#define PG8_LAS __attribute__((address_space(3)))
typedef unsigned short bf16_t;
typedef short bf16x8 __attribute__((ext_vector_type(8)));
typedef float f32x4 __attribute__((ext_vector_type(4)));
typedef unsigned u32x4 __attribute__((ext_vector_type(4)));
constexpr int BM = 256, BK = 64, HALF = 128, HTB = HALF * BK * 2  , STAGE_BYTES = 8 * HTB, NXCD = 8, WGM = 8;

__host__ __device__ __forceinline__ int lds_byte(int r, int c) { const int st = (r >> 4) * 2 + (c >> 5), rr = r & 15, cc = c & 31, ob = rr * 64 + cc * 2; return st * 1024 + (ob ^ (((ob >> 9) & 1) << 5)); }
__host__ __device__ __forceinline__ void stage_rc(int b, int& R, int& C) { const int st = b / 1024, sb = b % 1024, swz = sb ^ (((sb >> 9) & 1) << 5); R = (st >> 1) * 16 + swz / 64; C = (st & 1) * 32 + (swz % 64) / 2; }
__host__ __device__ __forceinline__ int perm32(int rho) { const int n = rho >> 4, i = rho & 15; return 8 * (i >> 2) + 4 * n + (i & 3); }

struct Unit { int pm, pn; };
struct Gemm { const bf16_t* A; const bf16_t* Bt; int M, N, K; };

struct StaticOrder {
    int nM, nN, nwg, G, c;
    __host__ __device__ void init(int M, int N, int G_, int c_) { nM = M / BM; nN = N / BM; nwg = nM * nN; G = G_; c = c_; }
    __host__ __device__ bool next(int i, Unit& u) const {
        const long L = (long)i * G + c; if (L >= nwg) return false;
        int wgid = (int)L; { const int q = nwg / NXCD, r = nwg % NXCD, xcd = wgid % NXCD, off = wgid / NXCD; wgid = (xcd < r ? xcd * (q + 1) : r * (q + 1) + (xcd - r) * q) + off; }
        const int nig = WGM * nN, gid = wgid / nig, fm = gid * WGM, gsz = (nM - fm) < WGM ? (nM - fm) : WGM;
        u.pm = fm + ((wgid % nig) % gsz); u.pn = (wgid % nig) / gsz; return true;
    }
    __device__ __forceinline__ void a_ready(const Unit&) const {}
    __device__ __forceinline__ void done(const Unit&) const {}
};

__device__ __forceinline__ unsigned cvt_pk_bf16(float lo, float hi) { unsigned r; asm volatile("v_cvt_pk_bf16_f32 %0, %1, %2" : "=v"(r) : "v"(lo), "v"(hi)); return r; }
struct EpiProj {
    static constexpr bool PERM = true, AFTER_DRAIN = false;
    bf16_t* O; int ldc; const float* rs;
    __device__ __forceinline__ void operator()(const f32x4 (&acc)[2][2][4][2], const Unit& u, int wr, int wc, int fr, int fq) const {
        const int row0 = u.pm * BM + wr * 64 + fr, col0 = u.pn * BM + wc * 32 + 8 * fq;
#pragma unroll
        for (int ai = 0; ai < 2; ++ai)
#pragma unroll
            for (int m = 0; m < 4; ++m) { const int row = row0 + ai * HALF + m * 16; const float s = rs[row]; bf16_t* rowp = O + (size_t)row * ldc + col0;
#pragma unroll
                for (int bj = 0; bj < 2; ++bj) { const f32x4 v0 = acc[ai][bj][m][0] * s, v1 = acc[ai][bj][m][1] * s; u32x4 w;
                    w.x = cvt_pk_bf16(v0[0], v0[1]); w.y = cvt_pk_bf16(v0[2], v0[3]); w.z = cvt_pk_bf16(v1[0], v1[1]); w.w = cvt_pk_bf16(v1[2], v1[3]);
                    *(u32x4*)(rowp + bj * HALF) = w; } }
    }
};
struct EpiOut {
    static constexpr bool PERM = false, AFTER_DRAIN = false;
    const float* X; float* X1; bf16_t* X1B; float* SSQ; int ldc;
    __device__ __forceinline__ void operator()(const f32x4 (&acc)[2][2][4][2], const Unit& u, int wr, int wc, int fr, int fq) const {
        typedef unsigned u32x2 __attribute__((ext_vector_type(2)));
        const int row0 = u.pm * BM + wr * 64 + fr, col0 = u.pn * BM + wc * 32 + 4 * fq;
#pragma unroll
        for (int ai = 0; ai < 2; ++ai)
#pragma unroll
            for (int m = 0; m < 4; ++m) { const int row = row0 + ai * HALF + m * 16; const size_t off = (size_t)row * ldc + col0; float ss = 0.f;
#pragma unroll
                for (int bj = 0; bj < 2; ++bj)
#pragma unroll
                    for (int n = 0; n < 2; ++n) { const size_t c = off + bj * HALF + n * 16; const f32x4 xv = *(const f32x4*)(X + c); const f32x4 o = xv + acc[ai][bj][m][n];
                        *(f32x4*)(X1 + c) = o; ss += (o[0] * o[0] + o[1] * o[1]) + (o[2] * o[2] + o[3] * o[3]);
                        u32x2 pk; pk.x = cvt_pk_bf16(o[0], o[1]); pk.y = cvt_pk_bf16(o[2], o[3]); *(u32x2*)(X1B + c) = pk; }
                ss += __shfl_xor(ss, 16); ss += __shfl_xor(ss, 32);
                if (fq == 0) SSQ[(size_t)row * 32 + u.pn * 4 + wc] = ss; }
    }
};
struct EpiQ {
    static constexpr bool PERM = false, AFTER_DRAIN = false;
    float* O; int ldc;
    __device__ __forceinline__ void operator()(const f32x4 (&acc)[2][2][4][2], const Unit& u, int wr, int wc, int fr, int fq) const {
        const int row0 = u.pm * BM + wr * 64 + fr, col0 = u.pn * BM + wc * 32 + 4 * fq;
#pragma unroll
        for (int ai = 0; ai < 2; ++ai)
#pragma unroll
            for (int m = 0; m < 4; ++m) { const size_t off = (size_t)(row0 + ai * HALF + m * 16) * ldc + col0;
#pragma unroll
                for (int bj = 0; bj < 2; ++bj)
#pragma unroll
                    for (int n = 0; n < 2; ++n) *(f32x4*)(O + off + bj * HALF + n * 16) = acc[ai][bj][m][n]; }
    }
};
struct EpiQb {
    static constexpr bool PERM = true, AFTER_DRAIN = false;
    bf16_t* O; int ldc; const float* SSQ;
    __device__ __forceinline__ void operator()(const f32x4 (&acc)[2][2][4][2], const Unit& u, int wr, int wc, int fr, int fq) const {
        const int row0 = u.pm * BM + wr * 64 + fr, col0 = u.pn * BM + wc * 32 + 8 * fq;
#pragma unroll
        for (int ai = 0; ai < 2; ++ai)
#pragma unroll
            for (int m = 0; m < 4; ++m) { const int row = row0 + ai * HALF + m * 16; const f32x4* sp = (const f32x4*)(SSQ + (size_t)row * 32);
                f32x4 s4 = sp[0];
#pragma unroll
                for (int i = 1; i < 8; ++i) s4 += sp[i];
                const float s = rsqrtf(((s4[0] + s4[1]) + (s4[2] + s4[3])) * (1.0f / 2048.0f) + 1e-6f); bf16_t* rowp = O + (size_t)row * ldc + col0;
#pragma unroll
                for (int bj = 0; bj < 2; ++bj) { const f32x4 v0 = acc[ai][bj][m][0] * s, v1 = acc[ai][bj][m][1] * s; u32x4 w;
                    w.x = cvt_pk_bf16(v0[0], v0[1]); w.y = cvt_pk_bf16(v0[2], v0[3]); w.z = cvt_pk_bf16(v1[0], v1[1]); w.w = cvt_pk_bf16(v1[2], v1[3]);
                    *(u32x4*)(rowp + bj * HALF) = w; } }
    }
};
template <class Epi, class Sched, bool ALIGN_EPI = false, bool SP2 = false>
__device__ __forceinline__ void gemm_phase(PG8_LAS unsigned char* lds, const Gemm g, const Sched& S, const Epi& E) {
    const int tid = threadIdx.x, wid = __builtin_amdgcn_readfirstlane(tid >> 6), lane = tid & 63, wr = wid >> 2, wc = wid & 3, fr = lane & 15, fq = lane >> 4;
    const int K = g.K, nt = K / BK;
    unsigned voffA[2], voffB[2];
#pragma unroll
    for (int i = 0; i < 2; ++i) { int R, C; stage_rc(tid * 16 + i * 8192, R, C); const int Rb = Epi::PERM ? ((R & ~31) + perm32(R & 31)) : R;
        voffA[i] = (unsigned)(R * K + C) * 2u; voffB[i] = (unsigned)(Rb * K + C) * 2u; }
    const size_t kstep = (size_t)(BK * 2);
    const size_t hstep = (size_t)HALF * K * 2;
    const size_t tstep = 2 * hstep;
    const unsigned ldsw = (unsigned)wid * 1024u;
    const int aoff = lds_byte(wr * 64 + fr, fq * 8), boff = lds_byte(wc * 32 + fr, fq * 8);
#define PG8_SA(b, h) (((b) * 2 + (h)) * HTB)
#define PG8_SB(b, h) ((4 + (b) * 2 + (h)) * HTB)
#define PG8_STAGE(bufoff, gbase, voff) do { _Pragma("unroll") for (int _i = 0; _i < 2; ++_i) \
        __builtin_amdgcn_global_load_lds((const unsigned*)((const char*)(gbase) + (voff)[_i]), (PG8_LAS unsigned*)(lds + (bufoff) + ldsw + _i * 8192), 16, 0, 0); } while (0)
#define PG8_LDA(dst, b, h) do { _Pragma("unroll") for (int m = 0; m < 4; ++m) _Pragma("unroll") for (int k = 0; k < 2; ++k) dst[m][k] = *(const PG8_LAS bf16x8*)(lds + PG8_SA(b, h) + aoff + m * 2048 + k * 1024); } while (0)
#define PG8_LDB(dst, b, h) do { _Pragma("unroll") for (int n = 0; n < 2; ++n) _Pragma("unroll") for (int k = 0; k < 2; ++k) dst[n][k] = *(const PG8_LAS bf16x8*)(lds + PG8_SB(b, h) + boff + n * 2048 + k * 1024); } while (0)
#define PG8_MMA(ai, bj, At, Bt) do { __builtin_amdgcn_s_setprio(1); _Pragma("unroll") for (int m = 0; m < 4; ++m) _Pragma("unroll") for (int n = 0; n < 2; ++n) _Pragma("unroll") for (int k = 0; k < 2; ++k) \
        acc[ai][bj][m][n] = __builtin_amdgcn_mfma_f32_16x16x32_bf16(Bt[n][k], At[m][k], acc[ai][bj][m][n], 0, 0, 0); __builtin_amdgcn_s_setprio(0); } while (0)
#define PG8_WAIT_V(n) asm volatile("s_waitcnt vmcnt(" #n ")" ::: "memory")
#define PG8_WAIT_L(n) asm volatile("s_waitcnt lgkmcnt(" #n ")" ::: "memory")
#define PG8_BAR __builtin_amdgcn_s_barrier()
#define PG8_SCHED __builtin_amdgcn_sched_barrier(0)
    Unit cur, nxt; int ui = 0;
    if (!S.next(0, cur)) return;
    f32x4 acc[2][2][4][2];
#pragma unroll
    for (int a = 0; a < 2; ++a)
#pragma unroll
        for (int b = 0; b < 2; ++b)
#pragma unroll
            for (int m = 0; m < 4; ++m)
#pragma unroll
                for (int n = 0; n < 2; ++n) acc[a][b][m][n] = (f32x4){0.f, 0.f, 0.f, 0.f};
    bf16x8 At[4][2], B0[2][2], B1[2][2];
    const char* cA = (const char*)g.A + (size_t)cur.pm * tstep; const char* cB = (const char*)g.Bt + (size_t)cur.pn * tstep;
    S.a_ready(cur);
    if constexpr (SP2) {
        PG8_STAGE(PG8_SB(0, 0), cB, voffB); PG8_STAGE(PG8_SB(0, 1), cB + hstep, voffB); PG8_STAGE(PG8_SA(0, 0), cA, voffA); PG8_STAGE(PG8_SA(0, 1), cA + hstep, voffA);
        if (wr == 1) PG8_BAR;
        PG8_WAIT_V(2); PG8_BAR;
        PG8_STAGE(PG8_SB(1, 0), cB + kstep, voffB); PG8_STAGE(PG8_SA(1, 0), cA + kstep, voffA); PG8_STAGE(PG8_SB(1, 1), cB + hstep + kstep, voffB);
        PG8_WAIT_V(6); PG8_BAR;
    } else {
        PG8_STAGE(PG8_SB(0, 0), cB, voffB); PG8_STAGE(PG8_SA(0, 0), cA, voffA); PG8_STAGE(PG8_SB(0, 1), cB + hstep, voffB); PG8_STAGE(PG8_SA(0, 1), cA + hstep, voffA);
        if (wr == 1) PG8_BAR;
        PG8_WAIT_V(4); PG8_BAR;
        PG8_STAGE(PG8_SB(1, 0), cB + kstep, voffB); PG8_STAGE(PG8_SA(1, 0), cA + kstep, voffA); PG8_STAGE(PG8_SB(1, 1), cB + hstep + kstep, voffB);
        PG8_WAIT_V(6); PG8_BAR;
    }
    for (;;) {
        const bool has_next = S.next(ui + 1, nxt);
        const char* nA = has_next ? (const char*)g.A + (size_t)nxt.pm * tstep : cA; const char* nB = has_next ? (const char*)g.Bt + (size_t)nxt.pn * tstep : cB;
        for (int t = 0; t < nt; t += 2) {
            const bool last = (t == nt - 2);
            const char* a1 = cA + (size_t)(t + 1) * kstep;
            const char* a2 = last ? nA : cA + (size_t)(t + 2) * kstep; const char* b2 = last ? nB : cB + (size_t)(t + 2) * kstep;
            const char* a3 = a2 + kstep; const char* b3 = b2 + kstep;
            if (last && has_next) S.a_ready(nxt);
            if constexpr (SP2) {
            PG8_LDB(B0, 0, 0); PG8_LDB(B1, 0, 1); PG8_SCHED; PG8_LDA(At, 0, 0); PG8_STAGE(PG8_SA(1, 1), a1 + hstep, voffA);
            PG8_WAIT_V(8); PG8_WAIT_L(0); PG8_BAR; PG8_MMA(0, 0, At, B0); PG8_MMA(0, 1, At, B1); PG8_BAR; PG8_SCHED;
            PG8_LDA(At, 0, 1); PG8_STAGE(PG8_SB(0, 0), b2, voffB); PG8_STAGE(PG8_SB(0, 1), b2 + hstep, voffB); PG8_STAGE(PG8_SA(0, 0), a2, voffA);
            PG8_WAIT_V(8); PG8_WAIT_L(0); PG8_BAR; PG8_MMA(1, 0, At, B0); PG8_MMA(1, 1, At, B1); PG8_BAR; PG8_SCHED;
            PG8_LDB(B0, 1, 0); PG8_LDB(B1, 1, 1); PG8_SCHED; PG8_LDA(At, 1, 0); PG8_STAGE(PG8_SA(0, 1), a2 + hstep, voffA);
            PG8_WAIT_V(8); PG8_WAIT_L(0); PG8_BAR; PG8_MMA(0, 0, At, B0); PG8_MMA(0, 1, At, B1); PG8_BAR; PG8_SCHED;
            PG8_LDA(At, 1, 1); PG8_STAGE(PG8_SB(1, 0), b3, voffB); PG8_STAGE(PG8_SB(1, 1), b3 + hstep, voffB); PG8_STAGE(PG8_SA(1, 0), a3, voffA);
            PG8_WAIT_V(8); PG8_WAIT_L(0); PG8_BAR; PG8_MMA(1, 0, At, B0); PG8_MMA(1, 1, At, B1); PG8_BAR; PG8_SCHED;
            } else {
            PG8_LDB(B0, 0, 0); PG8_SCHED; PG8_LDA(At, 0, 0); PG8_STAGE(PG8_SA(1, 1), a1 + hstep, voffA);
            PG8_WAIT_L(8); PG8_BAR; PG8_WAIT_L(0); PG8_MMA(0, 0, At, B0); PG8_BAR; PG8_SCHED;
            PG8_LDB(B1, 0, 1); PG8_STAGE(PG8_SB(0, 0), b2, voffB);
            PG8_BAR; PG8_WAIT_L(0); PG8_MMA(0, 1, At, B1); PG8_BAR;
            PG8_LDA(At, 0, 1); PG8_STAGE(PG8_SA(0, 0), a2, voffA);
            PG8_BAR; PG8_WAIT_L(0); PG8_MMA(1, 0, At, B0); PG8_BAR; PG8_SCHED;
            PG8_STAGE(PG8_SB(0, 1), b2 + hstep, voffB);
            PG8_WAIT_V(6); PG8_BAR; PG8_MMA(1, 1, At, B1); PG8_BAR;
            PG8_LDB(B0, 1, 0); PG8_SCHED; PG8_LDA(At, 1, 0); PG8_STAGE(PG8_SA(0, 1), a2 + hstep, voffA);
            PG8_WAIT_L(8); PG8_BAR; PG8_WAIT_L(0); PG8_MMA(0, 0, At, B0); PG8_BAR; PG8_SCHED;
            PG8_LDB(B1, 1, 1); PG8_STAGE(PG8_SB(1, 0), b3, voffB);
            PG8_BAR; PG8_WAIT_L(0); PG8_MMA(0, 1, At, B1); PG8_BAR;
            PG8_LDA(At, 1, 1); PG8_STAGE(PG8_SA(1, 0), a3, voffA);
            PG8_BAR; PG8_WAIT_L(0); PG8_MMA(1, 0, At, B0); PG8_BAR; PG8_SCHED;
            PG8_STAGE(PG8_SB(1, 1), b3 + hstep, voffB);
            PG8_WAIT_V(6); PG8_BAR; PG8_MMA(1, 1, At, B1); PG8_BAR;
            }
        }
        if constexpr (ALIGN_EPI) { if (wr == 0) PG8_BAR; }
        if constexpr (!Epi::AFTER_DRAIN) { E(acc, cur, wr, wc, fr, fq); S.done(cur); }
        if (!has_next) break;
#pragma unroll
        for (int a = 0; a < 2; ++a)
#pragma unroll
            for (int b = 0; b < 2; ++b)
#pragma unroll
                for (int m = 0; m < 4; ++m)
#pragma unroll
                    for (int n = 0; n < 2; ++n) acc[a][b][m][n] = (f32x4){0.f, 0.f, 0.f, 0.f};
        cur = nxt; cA = nA; cB = nB; ++ui;
        if constexpr (ALIGN_EPI) { if (wr == 1) PG8_BAR; }
    }
    PG8_WAIT_V(0);
    if constexpr (!ALIGN_EPI) { if (wr == 0) PG8_BAR; }
    PG8_BAR;
    if constexpr (Epi::AFTER_DRAIN) { E.fused(acc, cur, wr, wc, fr, fq, lds, wid, lane); S.done(cur); }
#undef PG8_SA
#undef PG8_SB
#undef PG8_STAGE
#undef PG8_LDA
#undef PG8_LDB
#undef PG8_MMA
#undef PG8_WAIT_V
#undef PG8_WAIT_L
#undef PG8_BAR
#undef PG8_SCHED
}
}
constexpr int T = 8192, SEQ = 4096, D = 2048, NPROJ = 7168, NIN = 7176;
constexpr int NH = 4, DH = 256, LCH = 64, DML = 1024;
constexpr int NEXP = 16384, PEER_H = 8, TOPK = 16;
constexpr float EPS = 1e-6f;
constexpr int PC_CX = 0, PC_CB = 1024, PC_CC = 2048, PC_Q = 3072, PC_K = 4096, PC_V = 5120, PC_O = 6144;
constexpr int NTHREADS = 512, NWAVES = 8;
constexpr int LDS_BYTES = 147456;

constexpr size_t MiB = 1u << 20;
constexpr size_t WS_CTL = 0, CTL_ZERO_BYTES = 64 * 1024;
constexpr int CW_BAR = 1024;
constexpr size_t WS_RS1 = 1 * MiB, WS_GI = 1 * MiB + 64 * 1024, WS_GF = 1 * MiB + 256 * 1024, WS_SSQ = 3 * MiB, WS_ESC = 4 * MiB;
constexpr size_t WS_XB = 5 * MiB, WS_WINT = 37 * MiB, WS_WOUTT = 65 * MiB, WS_WQT = 73 * MiB;
constexpr size_t WS_PROJ = 81 * MiB;
constexpr size_t WS_X1 = 81 * MiB, WS_X1B = 145 * MiB;
constexpr size_t WS_HRAW = 193 * MiB, WS_MIXIN = 225 * MiB, WS_QV = 257 * MiB, WS_IDX = 321 * MiB, WS_GATE = 325 * MiB;
constexpr size_t WS_UB = 329 * MiB, WS_VB = 393 * MiB, WS_END = 457 * MiB;

struct Params {
    const float *x, *g1, *w_in, *b_ig, *b_fg, *conv_w, *gm, *w_out, *g2, *w_q, *sk1, *sk2, *eu, *ev, *gfin;
    float* out; unsigned char* ws;
    int ph_lo, ph_hi;
};

typedef unsigned short bf16_t;
__device__ __forceinline__ unsigned f2bf(float f) { unsigned u = __float_as_uint(f); return (u + 0x7fffu + ((u >> 16) & 1u)) >> 16; }
__device__ __forceinline__ unsigned pk2(float lo, float hi) { return f2bf(lo) | (f2bf(hi) << 16); }
__device__ __forceinline__ float bflo(unsigned w) { return __uint_as_float(w << 16); }
__device__ __forceinline__ float bfhi(unsigned w) { return __uint_as_float(w & 0xffff0000u); }
__device__ __forceinline__ float bf1(bf16_t h) { return __uint_as_float((unsigned)h << 16); }
__device__ __forceinline__ float wave_sum(float v) {
#pragma unroll
    for (int o = 32; o >= 1; o >>= 1) v += __shfl_xor(v, o);
    return v;
}
__device__ __forceinline__ void unpack8(const uint4 w, float (&f)[8]) {
    f[0] = bflo(w.x); f[1] = bfhi(w.x); f[2] = bflo(w.y); f[3] = bfhi(w.y); f[4] = bflo(w.z); f[5] = bfhi(w.z); f[6] = bflo(w.w); f[7] = bfhi(w.w);
}
__device__ __forceinline__ float log_sigmoid(float z) { return z >= 0.f ? -log1pf(expf(-z)) : z - log1pf(expf(z)); }
__device__ __forceinline__ float gelu_erf(float v) { return 0.5f * v * (1.0f + erff(v * 0.70710678118654752f)); }

__device__ __forceinline__ void p0_rows(const Params& P, unsigned char* lds, int G, int bid) {
    float* wg = (float*)lds;
    const int tid = threadIdx.x, lane = tid & 63, wave = tid >> 6;
    for (int i = tid; i < 8 * D; i += NTHREADS) { const int g = i >> 11, k = i & 2047; wg[i] = P.w_in[(size_t)k * NIN + NPROJ + g] * P.g1[k]; }
    __syncthreads();
    float* rs1 = (float*)(P.ws + WS_RS1); float* gi = (float*)(P.ws + WS_GI); float* gf = (float*)(P.ws + WS_GF); bf16_t* xb = (bf16_t*)(P.ws + WS_XB);
    for (int t = bid * NWAVES + wave; t < T; t += G * NWAVES) {
        const float4* xr = (const float4*)(P.x + (size_t)t * D);
        float ss = 0.f, dg[8];
#pragma unroll
        for (int g = 0; g < 8; ++g) dg[g] = 0.f;
#pragma unroll 1
        for (int j = 0; j < 8; ++j) {
            const float4 v = xr[j * 64 + lane];
            ss += (v.x * v.x + v.y * v.y) + (v.z * v.z + v.w * v.w);
            const int k0 = (j * 64 + lane) * 4;
#pragma unroll
            for (int g = 0; g < 8; ++g) { const float4 w = *(const float4*)(wg + g * D + k0); dg[g] += (v.x * w.x + v.y * w.y) + (v.z * w.z + v.w * w.w); }
            ((uint2*)(xb + (size_t)t * D))[j * 64 + lane] = make_uint2(pk2(v.x, v.y), pk2(v.z, v.w));
        }
        ss = wave_sum(ss);
#pragma unroll
        for (int g = 0; g < 8; ++g) dg[g] = wave_sum(dg[g]);
        const float rs = rsqrtf(ss * (1.0f / D) + EPS);
        if (lane == 0) {
            rs1[t] = rs;
#pragma unroll
            for (int h = 0; h < 4; ++h) { gi[t * 4 + h] = rs * dg[h] + P.b_ig[h]; gf[t * 4 + h] = log_sigmoid(rs * dg[4 + h] + P.b_fg[h]); }
        }
    }
    __syncthreads();
}
__device__ __forceinline__ void transpose_tile(const float* W, int ldw, int K, const float* gain, bf16_t* WT, int k0, int n0, float* tile) {
    const int tid = threadIdx.x;
#pragma unroll
    for (int r = 0; r < 2; ++r) {
        const int kk = (tid >> 4) + 32 * r, n4 = (tid & 15) * 4;
        float4 v = *(const float4*)(W + (size_t)(k0 + kk) * ldw + n0 + n4);
        const float g = gain ? gain[k0 + kk] : 1.0f;
        tile[kk * 65 + n4 + 0] = v.x * g; tile[kk * 65 + n4 + 1] = v.y * g; tile[kk * 65 + n4 + 2] = v.z * g; tile[kk * 65 + n4 + 3] = v.w * g;
    }
    __syncthreads();
    { const int nn = tid >> 3, k8 = (tid & 7) * 8; float f[8];
#pragma unroll
      for (int i = 0; i < 8; ++i) f[i] = tile[(k8 + i) * 65 + nn];
      *(uint4*)(WT + (size_t)(n0 + nn) * K + k0 + k8) = make_uint4(pk2(f[0], f[1]), pk2(f[2], f[3]), pk2(f[4], f[5]), pk2(f[6], f[7])); }
    __syncthreads();
}
__device__ __forceinline__ void p0_weights_in(const Params& P, unsigned char* lds, int G, int bid) {
    float* tile = (float*)lds;
    constexpr int N_IN = (D / 64) * (NPROJ / 64);
    for (int it = bid; it < N_IN; it += G) { const int kt = it / (NPROJ / 64), nt = it % (NPROJ / 64); transpose_tile(P.w_in, NIN, D, P.g1, (bf16_t*)(P.ws + WS_WINT), kt * 64, nt * 64, tile); }
}
__device__ __forceinline__ void p2_weights_sq(const Params& P, unsigned char* lds, int nworkers, int wid) {
    float* tile = (float*)lds;
    constexpr int N_SQ = (D / 64) * (D / 64);
    for (int it = wid; it < 2 * N_SQ; it += nworkers) {
        if (it < N_SQ) { const int kt = it / (D / 64), nt = it % (D / 64); transpose_tile(P.w_out, D, D, nullptr, (bf16_t*)(P.ws + WS_WOUTT), kt * 64, nt * 64, tile); }
        else { const int j = it - N_SQ, kt = j / (D / 64), nt = j % (D / 64); transpose_tile(P.w_q, D, D, P.g2, (bf16_t*)(P.ws + WS_WQT), kt * 64, nt * 64, tile); }
    }
}
typedef float f32x2_t __attribute__((ext_vector_type(2)));
__device__ __forceinline__ float wave_max(float v) {
#pragma unroll
    for (int o = 32; o >= 1; o >>= 1) v = fmaxf(v, __shfl_xor(v, o));
    return v;
}
__device__ __forceinline__ void p0_tables(const Params& P, int nworkers, int wid) {
    const int lane = threadIdx.x & 63, wave = threadIdx.x >> 6;
    float* esc = (float*)(P.ws + WS_ESC);
#pragma unroll 1
    for (int rix = wid * NWAVES + wave; rix < 2 * NEXP; rix += nworkers * NWAVES) {
        const int isv = rix & 1, e = rix >> 1;
        const float4* src = (const float4*)((isv ? P.ev : P.eu) + (size_t)e * D);
        unsigned* dst = (unsigned*)(P.ws + (isv ? WS_VB : WS_UB)) + (size_t)e * (D / 4);
        float4 v[8]; float mx = 0.f;
#pragma unroll
        for (int j = 0; j < 8; ++j) { v[j] = src[j * 64 + lane];
            if (!isv) { const float4 gg = ((const float4*)P.g2)[j * 64 + lane]; v[j].x *= gg.x; v[j].y *= gg.y; v[j].z *= gg.z; v[j].w *= gg.w; }
            mx = fmaxf(mx, fmaxf(fmaxf(fabsf(v[j].x), fabsf(v[j].y)), fmaxf(fabsf(v[j].z), fabsf(v[j].w)))); }
        mx = wave_max(mx);
        const float sc = mx > 0.f ? 240.0f / mx : 1.0f, inv = mx > 0.f ? mx * (1.0f / 240.0f) : 1.0f;
#pragma unroll
        for (int j = 0; j < 8; ++j) { int pk = __builtin_amdgcn_cvt_pk_fp8_f32(v[j].x * sc, v[j].y * sc, 0, false); pk = __builtin_amdgcn_cvt_pk_fp8_f32(v[j].z * sc, v[j].w * sc, pk, true); dst[j * 64 + lane] = (unsigned)pk; }
        if (lane == 0) esc[e * 2 + isv] = inv;
    }
}

__device__ __forceinline__ void p2_conv(const Params& P, int nworkers, int wid) {
    const bf16_t* proj = (const bf16_t*)(P.ws + WS_PROJ); bf16_t* mix = (bf16_t*)(P.ws + WS_MIXIN);
    for (int idx = wid * NTHREADS + threadIdx.x; idx < T * 128; idx += nworkers * NTHREADS) {
        const int t = idx >> 7, c8 = (idx & 127) * 8, s = t & (SEQ - 1);
        float y[8];
#pragma unroll
        for (int i = 0; i < 8; ++i) y[i] = 0.f;
#pragma unroll
        for (int j = 0; j < 3; ++j) {
            const int dt = 2 - j;
            if (s >= dt) {
                const bf16_t* row = proj + (size_t)(t - dt) * NPROJ;
                float cx[8], cc[8]; unpack8(*(const uint4*)(row + PC_CX + c8), cx); unpack8(*(const uint4*)(row + PC_CC + c8), cc);
                const float4 w0 = *(const float4*)(P.conv_w + j * 1024 + c8), w1 = *(const float4*)(P.conv_w + j * 1024 + c8 + 4);
                y[0] += w0.x * (cc[0] * cx[0]); y[1] += w0.y * (cc[1] * cx[1]); y[2] += w0.z * (cc[2] * cx[2]); y[3] += w0.w * (cc[3] * cx[3]);
                y[4] += w1.x * (cc[4] * cx[4]); y[5] += w1.y * (cc[5] * cx[5]); y[6] += w1.z * (cc[6] * cx[6]); y[7] += w1.w * (cc[7] * cx[7]);
            }
        }
        float cb[8]; unpack8(*(const uint4*)(proj + (size_t)t * NPROJ + PC_CB + c8), cb);
        *(uint4*)(mix + (size_t)t * D + c8) = make_uint4(pk2(cb[0] * y[0], cb[1] * y[1]), pk2(cb[2] * y[2], cb[3] * y[3]), pk2(cb[4] * y[4], cb[5] * y[5]), pk2(cb[6] * y[6], cb[7] * y[7]));
    }
}
#define LAS3 __attribute__((address_space(3)))
typedef short s16x4_t __attribute__((ext_vector_type(4)));
typedef unsigned v4u_t __attribute__((ext_vector_type(4)));
typedef unsigned v2u_t __attribute__((ext_vector_type(2)));
__device__ __forceinline__ pg8::bf16x8 tr8(LAS3 unsigned char* p0, LAS3 unsigned char* p1) {
    const s16x4_t a = __builtin_amdgcn_ds_read_tr16_b64_v4i16((LAS3 s16x4_t*)p0), b = __builtin_amdgcn_ds_read_tr16_b64_v4i16((LAS3 s16x4_t*)p1);
    return __builtin_shufflevector(a, b, 0, 1, 2, 3, 4, 5, 6, 7);
}
__device__ __forceinline__ void mlstm_unit(const Params& P, unsigned char* lds_, int unit) {
    typedef pg8::bf16x8 bf16x8; typedef pg8::f32x4 f32x4;
    LAS3 unsigned char* L = (LAS3 unsigned char*)lds_;
    constexpr int QS = 0, KS = 33792, VA = 67584, WV = 73728, SW = 79872, CB = 89088, SM = 114432;
    constexpr int QST = 528, VST = 96, SST = 144;
    LAS3 float* sA = (LAS3 float*)(L + SM); LAS3 float* sM = sA + 64; LAS3 float* sEi = sA + 128; LAS3 float* sWl = sA + 192; LAS3 float* sEnm = sA + 256; LAS3 float* sDen = sA + 320; LAS3 float* sMisc = sA + 384;
    const int tid = threadIdx.x, lane = tid & 63, wave = __builtin_amdgcn_readfirstlane(tid >> 6);
    const int g = lane >> 4, c16 = lane & 15, q4 = c16 >> 2, p4 = lane & 3;
    const int bh = unit >> 3, sl = unit & 7, b = bh >> 2, h = bh & 3, v0 = sl * 32;
    const bf16_t* proj = (const bf16_t*)(P.ws + WS_PROJ);
    const float* gi = (const float*)(P.ws + WS_GI); const float* gf = (const float*)(P.ws + WS_GF);
    float* hraw = (float*)(P.ws + WS_HRAW);
    for (int i = tid; i < 25344 / 16; i += NTHREADS) *(LAS3 v4u_t*)(L + CB + i * 16) = (v4u_t){0u, 0u, 0u, 0u};
    if (tid < 64) { *(LAS3 v4u_t*)(L + VA + tid * VST + 64) = (v4u_t){0x00003F80u, 0u, 0u, 0u}; *(LAS3 v4u_t*)(L + VA + tid * VST + 80) = (v4u_t){0u, 0u, 0u, 0u}; }
    f32x4 accC[2][3];
#pragma unroll
    for (int dt = 0; dt < 2; ++dt)
#pragma unroll
        for (int vt = 0; vt < 3; ++vt) accC[dt][vt] = (f32x4){0.f, 0.f, 0.f, 0.f};
    float m = 0.f;
    const int row = tid >> 3, seg = tid & 7;
    v4u_t rq[4], rk[4], rv = (v4u_t){0u, 0u, 0u, 0u};
    float pa = 0.f, pP = 0.f, pb = 0.f, nic = 0.f, nfc = 0.f, fic = 0.f, ffc = 0.f;
#define MLSTM_SCAN(ic_, fc_) do { float bc_ = (fc_); _Pragma("unroll") for (int o = 1; o < 64; o <<= 1) { const float tv = __shfl_up(bc_, o); if (lane >= o) bc_ += tv; } \
        const float a_ = (ic_) - bc_; float pm_ = a_; _Pragma("unroll") for (int o = 1; o < 64; o <<= 1) { const float tv = __shfl_up(pm_, o); if (lane >= o) pm_ = fmaxf(pm_, tv); } pa = a_; pP = pm_; pb = bc_; } while (0)
    { const int t0 = b * SEQ; const bf16_t* src = proj + (size_t)(t0 + row) * NPROJ + h * DH + seg * 32;
#pragma unroll
      for (int i = 0; i < 4; ++i) { rq[i] = *(const v4u_t*)(src + PC_Q + i * 8); rk[i] = *(const v4u_t*)(src + PC_K + i * 8); }
      if (tid < 256) rv = *(const v4u_t*)(proj + (size_t)(t0 + (tid >> 2)) * NPROJ + PC_V + h * DH + v0 + (tid & 3) * 8);
      if (wave == 1) { const float ic0 = gi[(size_t)(t0 + lane) * 4 + h], fc0 = gf[(size_t)(t0 + lane) * 4 + h]; MLSTM_SCAN(ic0, fc0);
          fic = gi[(size_t)(t0 + LCH + lane) * 4 + h]; ffc = gf[(size_t)(t0 + LCH + lane) * 4 + h]; } }
    __syncthreads();
#pragma unroll 1
    for (int c = 0; c < SEQ / LCH; ++c) {
        const int t0 = b * SEQ + c * LCH;
#pragma unroll
        for (int i = 0; i < 4; ++i) { *(LAS3 v4u_t*)(L + QS + row * QST + seg * 64 + i * 16) = rq[i]; *(LAS3 v4u_t*)(L + KS + row * QST + seg * 64 + i * 16) = rk[i]; }
        if (tid < 256) *(LAS3 v4u_t*)(L + VA + (tid >> 2) * VST + (tid & 3) * 16) = rv;
        if (wave == 1) {
            const float M = fmaxf(m, pP), M63 = __shfl(M, 63), b63 = __shfl(pb, 63);
            sA[lane] = pa; sM[lane] = M; sEi[lane] = __expf(m - M); sWl[lane] = __expf(pa - M63) * 0.0625f; sEnm[lane] = __expf(-pb - M);
            if (lane == 0) { sMisc[0] = b63 + M63; sMisc[1] = __expf(m - M63); }
            nic = fic; nfc = ffc;
            if (c + 2 < SEQ / LCH) { fic = gi[(size_t)(t0 + 2 * LCH + lane) * 4 + h]; ffc = gf[(size_t)(t0 + 2 * LCH + lane) * 4 + h]; }
        }
        if (c + 1 < SEQ / LCH) { const int t1 = t0 + LCH; const bf16_t* src = proj + (size_t)(t1 + row) * NPROJ + h * DH + seg * 32;
#pragma unroll
            for (int i = 0; i < 4; ++i) { rq[i] = *(const v4u_t*)(src + PC_Q + i * 8); rk[i] = *(const v4u_t*)(src + PC_K + i * 8); }
            if (tid < 256) rv = *(const v4u_t*)(proj + (size_t)(t1 + (tid >> 2)) * NPROJ + PC_V + h * DH + v0 + (tid & 3) * 8); }
        __syncthreads();
        { const int rt = wave >> 1;
#pragma unroll
          for (int cc = 0; cc < 2; ++cc) { const int ct = (wave & 1) * 2 + cc; f32x4 acc = (f32x4){0.f, 0.f, 0.f, 0.f};
              if (ct <= rt) {
#pragma unroll
                  for (int ks = 0; ks < 8; ++ks) { const bf16x8 av = *(LAS3 bf16x8*)(L + QS + (rt * 16 + c16) * QST + (ks * 32 + g * 8) * 2), bv = *(LAS3 bf16x8*)(L + KS + (ct * 16 + c16) * QST + (ks * 32 + g * 8) * 2);
                      acc = __builtin_amdgcn_mfma_f32_16x16x32_bf16(av, bv, acc, 0, 0, 0); } }
              const int l = ct * 16 + c16; const float al = sA[l]; const f32x4 M4 = *(LAS3 f32x4*)(sM + rt * 16 + 4 * g);
#pragma unroll
              for (int r = 0; r < 4; ++r) { const int j = rt * 16 + 4 * g + r; const float val = (l <= j) ? acc[r] * 0.0625f * __expf(al - M4[r]) : 0.f;
                  *(LAS3 unsigned short*)(L + SW + j * SST + l * 2) = (unsigned short)f2bf(val); } } }
        if (wave == 1 && c + 1 < SEQ / LCH) MLSTM_SCAN(nic, nfc);
#pragma unroll
        for (int i = 0; i < 6; ++i) { const int e = tid + NTHREADS * i, l = e / 48, vp = e - l * 48;
            *(LAS3 unsigned short*)(L + WV + l * VST + vp * 2) = (unsigned short)f2bf(sWl[l] * bf1(*(LAS3 unsigned short*)(L + VA + l * VST + vp * 2))); }
        __syncthreads();
        const int rt = wave >> 1, vt = wave & 1;
        f32x4 num;
        { f32x4 accI = (f32x4){0.f, 0.f, 0.f, 0.f}, accX = (f32x4){0.f, 0.f, 0.f, 0.f};
#pragma unroll
          for (int ks = 0; ks < 8; ++ks) { const bf16x8 av = *(LAS3 bf16x8*)(L + QS + (rt * 16 + c16) * QST + (ks * 32 + g * 8) * 2), bv = *(LAS3 bf16x8*)(L + CB + (vt * 16 + c16) * QST + (ks * 32 + g * 8) * 2);
              accI = __builtin_amdgcn_mfma_f32_16x16x32_bf16(av, bv, accI, 0, 0, 0); }
#pragma unroll
          for (int ks = 0; ks < 2; ++ks) { const bf16x8 av = *(LAS3 bf16x8*)(L + SW + (rt * 16 + c16) * SST + (ks * 32 + g * 8) * 2);
              LAS3 unsigned char* vp = L + VA + (ks * 32 + g * 8 + q4) * VST + (vt * 16 + 4 * p4) * 2; const bf16x8 bv = tr8(vp, vp + 4 * VST);
              accX = __builtin_amdgcn_mfma_f32_16x16x32_bf16(av, bv, accX, 0, 0, 0); }
          const f32x4 e4 = *(LAS3 f32x4*)(sEi + rt * 16 + 4 * g);
          num = e4 * accI + accX;
          if ((wave & 1) == 0) {
              f32x4 aI = (f32x4){0.f, 0.f, 0.f, 0.f}, aX = (f32x4){0.f, 0.f, 0.f, 0.f};
#pragma unroll
              for (int ks = 0; ks < 8; ++ks) { const bf16x8 av = *(LAS3 bf16x8*)(L + QS + (rt * 16 + c16) * QST + (ks * 32 + g * 8) * 2), bv = *(LAS3 bf16x8*)(L + CB + (32 + c16) * QST + (ks * 32 + g * 8) * 2);
                  aI = __builtin_amdgcn_mfma_f32_16x16x32_bf16(av, bv, aI, 0, 0, 0); }
#pragma unroll
              for (int ks = 0; ks < 2; ++ks) { const bf16x8 av = *(LAS3 bf16x8*)(L + SW + (rt * 16 + c16) * SST + (ks * 32 + g * 8) * 2);
                  LAS3 unsigned char* vp = L + VA + (ks * 32 + g * 8 + q4) * VST + (32 + 4 * p4) * 2; const bf16x8 bv = tr8(vp, vp + 4 * VST);
                  aX = __builtin_amdgcn_mfma_f32_16x16x32_bf16(av, bv, aX, 0, 0, 0); }
              if (c16 == 0) {
#pragma unroll
                  for (int r = 0; r < 4; ++r) { const int j = rt * 16 + 4 * g + r; sDen[j] = fmaxf(fabsf(e4[r] * aI[r] + aX[r]), sEnm[j]); } }
          } }
        __syncthreads();
        { const f32x4 d4 = *(LAS3 f32x4*)(sDen + rt * 16 + 4 * g);
#pragma unroll
          for (int r = 0; r < 4; ++r) hraw[(size_t)(t0 + rt * 16 + 4 * g + r) * DML + h * DH + v0 + vt * 16 + c16] = __fdividef(num[r], d4[r]); }
        { const float decay = sMisc[1];
#pragma unroll
          for (int dt = 0; dt < 2; ++dt)
#pragma unroll
              for (int v3 = 0; v3 < 3; ++v3) accC[dt][v3] *= decay;
#pragma unroll
          for (int ks = 0; ks < 2; ++ks) { bf16x8 af[2], bfr[3];
#pragma unroll
              for (int dt = 0; dt < 2; ++dt) { LAS3 unsigned char* kp = L + KS + (ks * 32 + g * 8 + q4) * QST + ((2 * wave + dt) * 16 + 4 * p4) * 2; af[dt] = tr8(kp, kp + 4 * QST); }
#pragma unroll
              for (int v3 = 0; v3 < 3; ++v3) { LAS3 unsigned char* wp = L + WV + (ks * 32 + g * 8 + q4) * VST + (v3 * 16 + 4 * p4) * 2; bfr[v3] = tr8(wp, wp + 4 * VST); }
#pragma unroll
              for (int dt = 0; dt < 2; ++dt)
#pragma unroll
                  for (int v3 = 0; v3 < 3; ++v3) accC[dt][v3] = __builtin_amdgcn_mfma_f32_16x16x32_bf16(af[dt], bfr[v3], accC[dt][v3], 0, 0, 0); }
#pragma unroll
          for (int dt = 0; dt < 2; ++dt)
#pragma unroll
              for (int v3 = 0; v3 < 3; ++v3) { const int d = (2 * wave + dt) * 16 + 4 * g, vp = v3 * 16 + c16;
                  *(LAS3 v2u_t*)(L + CB + vp * QST + d * 2) = (v2u_t){pk2(accC[dt][v3][0], accC[dt][v3][1]), pk2(accC[dt][v3][2], accC[dt][v3][3])}; }
          m = sMisc[0]; }
        __syncthreads();
    }
#undef MLSTM_SCAN
}

__device__ __forceinline__ void p3_finalize(const Params& P, int G, int bid) {
    const int lane = threadIdx.x & 63, wave = threadIdx.x >> 6;
    const float* hraw = (const float*)(P.ws + WS_HRAW); const bf16_t* proj = (const bf16_t*)(P.ws + WS_PROJ); bf16_t* mix = (bf16_t*)(P.ws + WS_MIXIN);
    for (int idx = bid * NWAVES + wave; idx < T * NH; idx += G * NWAVES) {
        const int t = idx >> 2, hh = idx & 3;
        const float4 hv = *(const float4*)(hraw + (size_t)t * DML + hh * DH + lane * 4);
        const float ss = wave_sum((hv.x * hv.x + hv.y * hv.y) + (hv.z * hv.z + hv.w * hv.w));
        const float r = rsqrtf(ss * (1.0f / DH) + EPS);
        const uint2 ow = *(const uint2*)(proj + (size_t)t * NPROJ + PC_O + hh * DH + lane * 4);
        const float4 g = *(const float4*)(P.gm + hh * DH + lane * 4);
        const float o0 = 1.0f / (1.0f + expf(-bflo(ow.x))), o1 = 1.0f / (1.0f + expf(-bfhi(ow.x))), o2 = 1.0f / (1.0f + expf(-bflo(ow.y))), o3 = 1.0f / (1.0f + expf(-bfhi(ow.y)));
        *(uint2*)(mix + (size_t)t * D + DML + hh * DH + lane * 4) = make_uint2(pk2(o0 * (hv.x * r * g.x), o1 * (hv.y * r * g.y)), pk2(o2 * (hv.z * r * g.z), o3 * (hv.w * r * g.w)));
    }
}

template <int CTRL> __device__ __forceinline__ float dppf(float v) { return __int_as_float(__builtin_amdgcn_update_dpp(0, __float_as_int(v), CTRL, 0xF, 0xF, true)); }
__device__ __forceinline__ float grp16_max(float v) { v = fmaxf(v, dppf<0xB1>(v)); v = fmaxf(v, dppf<0x4E>(v)); v = fmaxf(v, dppf<0x141>(v)); v = fmaxf(v, dppf<0x140>(v)); return v; }
__device__ __forceinline__ float grp16_sum(float v) { v += dppf<0xB1>(v); v += dppf<0x4E>(v); v += dppf<0x141>(v); v += dppf<0x140>(v); return v; }
#define CEX(a, b) do { const float hi_ = fmaxf(a, b), lo_ = fminf(a, b); a = hi_; b = lo_; } while (0)
static __device__ const unsigned char CAND_AB[16][4] = {
    {0x00, 0x01, 0x02, 0x03}, {0x04, 0x05, 0x06, 0x07}, {0x08, 0x09, 0x0A, 0x0B}, {0x0C, 0x0D, 0x0E, 0x0F}, {0x10, 0x11, 0x12, 0x13}, {0x14, 0x15, 0x16, 0x17}, {0x20, 0x21, 0x22, 0x23}, {0x24, 0, 0, 0},
    {0x30, 0x31, 0x32, 0x33}, {0x40, 0x41, 0x42, 0}, {0x50, 0x60, 0x70, 0x80}, {0x90, 0xA0, 0xB0, 0xC0}, {0xD0, 0xE0, 0xF0, 0}, {0x51, 0x61, 0x71, 0}, {0, 0, 0, 0}, {0, 0, 0, 0}};
static __device__ const unsigned char CAND_N[16] = {4, 4, 4, 4, 4, 4, 4, 1, 4, 3, 4, 4, 3, 3, 0, 0};
__device__ __forceinline__ void p6_topk(const Params& P, unsigned char* lds_, int G, int bid) {
    typedef pg8::bf16x8 bf16x8; typedef pg8::f32x4 f32x4;
    LAS3 unsigned char* L = (LAS3 unsigned char*)lds_;
    constexpr int KST = 272, KHALF = 128 * KST;
    const int tid = threadIdx.x, lane = tid & 63, wave = tid >> 6, g = lane >> 4, c16 = lane & 15;
    for (int i = tid; i < 2 * 2048; i += NTHREADS) { const int hf = i >> 11, n = (i >> 4) & 127, d8 = (i & 15) * 8; const float* src = (hf ? P.sk2 : P.sk1) + n * 128 + d8;
        const float4 a = *(const float4*)src, b = *(const float4*)(src + 4);
        *(LAS3 v4u_t*)(L + hf * KHALF + n * KST + d8 * 2) = (v4u_t){pk2(a.x, a.y), pk2(a.z, a.w), pk2(b.x, b.y), pk2(b.z, b.w)}; }
    __syncthreads();
    const bf16_t* qvb = (const bf16_t*)(P.ws + WS_QV);
    int* idxo = (int*)(P.ws + WS_IDX); float* gato = (float*)(P.ws + WS_GATE);
    const float NEGINF = -__builtin_inff();
    unsigned ctab = 0; { const unsigned char* tp = CAND_AB[c16]; ctab = (unsigned)tp[0] | ((unsigned)tp[1] << 8) | ((unsigned)tp[2] << 16) | ((unsigned)tp[3] << 24); }
    const int ccnt = CAND_N[c16];
#pragma unroll 1
    for (int it = bid * NWAVES + wave; it < (T / 16) * PEER_H; it += G * NWAVES) {
        const int t0 = (it >> 3) * 16, hh = it & 7;
        float keepH[2][4];
#pragma unroll
        for (int hf = 0; hf < 2; ++hf) {
            asm volatile("" ::: "memory");
            bf16x8 af[4];
#pragma unroll
            for (int ks = 0; ks < 4; ++ks) af[ks] = *(const bf16x8*)(qvb + (size_t)(t0 + c16) * D + hh * 256 + hf * 128 + ks * 32 + g * 8);
            f32x4 acc[8];
#pragma unroll
            for (int ct = 0; ct < 8; ++ct) { acc[ct] = (f32x4){0.f, 0.f, 0.f, 0.f};
#pragma unroll
                for (int ks = 0; ks < 4; ++ks) { const bf16x8 bv = *(LAS3 bf16x8*)(L + hf * KHALF + (ct * 16 + c16) * KST + (ks * 32 + g * 8) * 2);
                    acc[ct] = __builtin_amdgcn_mfma_f32_16x16x32_bf16(af[ks], bv, acc[ct], 0, 0, 0); } }
            float v[4][8];
#pragma unroll
            for (int r = 0; r < 4; ++r) {
#pragma unroll
                for (int ct = 0; ct < 8; ++ct) v[r][ct] = __uint_as_float((__float_as_uint(acc[ct][r]) & ~127u) | (unsigned)(127 - (ct * 16 + c16)));
                CEX(v[r][0], v[r][1]); CEX(v[r][2], v[r][3]); CEX(v[r][4], v[r][5]); CEX(v[r][6], v[r][7]);
                CEX(v[r][0], v[r][2]); CEX(v[r][1], v[r][3]); CEX(v[r][4], v[r][6]); CEX(v[r][5], v[r][7]);
                CEX(v[r][1], v[r][2]); CEX(v[r][5], v[r][6]); CEX(v[r][0], v[r][4]); CEX(v[r][3], v[r][7]);
                CEX(v[r][1], v[r][5]); CEX(v[r][2], v[r][6]);
                CEX(v[r][1], v[r][4]); CEX(v[r][3], v[r][6]);
                CEX(v[r][2], v[r][4]); CEX(v[r][3], v[r][5]);
                CEX(v[r][3], v[r][4]);
                keepH[hf][r] = 0.f;
            }
#pragma unroll
            for (int rd = 0; rd < TOPK; ++rd) {
#pragma unroll
                for (int r = 0; r < 4; ++r) {
                    const float W = grp16_max(v[r][0]); const bool win = (v[r][0] == W);
                    if (c16 == rd) keepH[hf][r] = W;
#pragma unroll
                    for (int k = 0; k < 7; ++k) v[r][k] = win ? v[r][k + 1] : v[r][k];
                    v[r][7] = win ? NEGINF : v[r][7];
                }
            }
        }
#pragma unroll
        for (int r = 0; r < 4; ++r) {
            const float V1 = keepH[0][r], V2 = keepH[1][r];
            float cv[4];
#pragma unroll
            for (int s4 = 0; s4 < 4; ++s4) { const unsigned code = (ctab >> (8 * s4)) & 255u;
                const float x1 = __shfl(V1, g * 16 + (int)(code >> 4)), x2 = __shfl(V2, g * 16 + (int)(code & 15u));
                const float sum = __uint_as_float(__float_as_uint(x1) & ~127u) + __uint_as_float(__float_as_uint(x2) & ~127u);
                cv[s4] = (s4 < ccnt) ? __uint_as_float((__float_as_uint(sum) & ~255u) | (255u - code)) : NEGINF; }
            float keepc = 0.f;
#pragma unroll
            for (int rd = 0; rd < TOPK; ++rd) {
                const float W = grp16_max(cv[0]); const bool win = (cv[0] == W);
                if (c16 == rd) keepc = W;
                cv[0] = win ? cv[1] : cv[0]; cv[1] = win ? cv[2] : cv[1]; cv[2] = win ? cv[3] : cv[2]; cv[3] = win ? NEGINF : cv[3];
            }
            const unsigned kb = __float_as_uint(keepc), code = 255u - (kb & 255u);
            const unsigned n1 = 127u - (__float_as_uint(__shfl(V1, g * 16 + (int)(code >> 4))) & 127u), n2 = 127u - (__float_as_uint(__shfl(V2, g * 16 + (int)(code & 15u))) & 127u);
            const float sval = __uint_as_float(kb & ~255u), smax = __shfl(sval, g * 16);
            const float ex = __expf(sval - smax), den = grp16_sum(ex);
            const size_t o = (size_t)(t0 + 4 * g + r) * 128 + hh * 16 + c16;
            idxo[o] = (int)(n1 * 128u + n2); gato[o] = ex / den;
        }
    }
    __syncthreads();
}

__device__ __forceinline__ float wave_sum_dpp(float v) {
    v += dppf<0xB1>(v); v += dppf<0x4E>(v); v += dppf<0x141>(v); v += dppf<0x140>(v);
    const int iv = __float_as_int(v);
    return (__int_as_float(__builtin_amdgcn_readlane(iv, 0)) + __int_as_float(__builtin_amdgcn_readlane(iv, 16))) + (__int_as_float(__builtin_amdgcn_readlane(iv, 32)) + __int_as_float(__builtin_amdgcn_readlane(iv, 48)));
}
__device__ __forceinline__ float dot16_fp8(const v4u_t w, const float (&x)[16]) {
    float s = 0.f;
#pragma unroll
    for (int k = 0; k < 4; ++k) { const f32x2_t lo = __builtin_amdgcn_cvt_pk_f32_fp8(w[k], false), hi = __builtin_amdgcn_cvt_pk_f32_fp8(w[k], true);
        s += (x[4 * k] * lo.x + x[4 * k + 1] * lo.y) + (x[4 * k + 2] * hi.x + x[4 * k + 3] * hi.y); }
    return s;
}
__device__ __forceinline__ void axpy16_fp8(const v4u_t w, const float cf, float (&y)[16]) {
#pragma unroll
    for (int k = 0; k < 4; ++k) { const f32x2_t lo = __builtin_amdgcn_cvt_pk_f32_fp8(w[k], false), hi = __builtin_amdgcn_cvt_pk_f32_fp8(w[k], true);
        y[4 * k] += cf * lo.x; y[4 * k + 1] += cf * lo.y; y[4 * k + 2] += cf * hi.x; y[4 * k + 3] += cf * hi.y; }
}
#ifndef P7_SORT
#define P7_SORT 1
#endif
__device__ __forceinline__ void p7_peer(const Params& P, unsigned char* lds_, int G, int bid) {
    const int lane = threadIdx.x & 63, wave = __builtin_amdgcn_readfirstlane(threadIdx.x >> 6);
    LAS3 unsigned char* W = (LAS3 unsigned char*)lds_ + wave * 2048;
    const bf16_t* x1b = (const bf16_t*)(P.ws + WS_X1B); const float* x1 = (const float*)(P.ws + WS_X1); const float* ssq = (const float*)(P.ws + WS_SSQ);
    const int* idxi = (const int*)(P.ws + WS_IDX); const float* gati = (const float*)(P.ws + WS_GATE);
    const unsigned char* ub = P.ws + WS_UB; const unsigned char* vb = P.ws + WS_VB; const float* esc = (const float*)(P.ws + WS_ESC);
#pragma unroll 1
    for (int t = bid * NWAVES + wave; t < T; t += G * NWAVES) {
        int ln = lane; asm volatile("" : "+v"(ln));
        const float rs2 = rsqrtf(wave_sum(ln < 32 ? ssq[(size_t)t * 32 + ln] : 0.f) * (1.0f / D) + EPS);
        int idx0 = idxi[(size_t)t * 128 + ln], idx1 = idxi[(size_t)t * 128 + 64 + ln]; int pos0 = ln, pos1 = 64 + ln;
#if P7_SORT
        { LAS3 int* hist = (LAS3 int*)W; LAS3 int* base = (LAS3 int*)(W + 256); LAS3 v2u_t* list = (LAS3 v2u_t*)(W + 512);
          hist[ln] = 0; asm volatile("s_waitcnt lgkmcnt(0)" ::: "memory");
          const int t0_ = __hip_atomic_fetch_add((int*)(hist + (idx0 >> 8)), 1, __ATOMIC_RELAXED, __HIP_MEMORY_SCOPE_WORKGROUP);
          const int t1_ = __hip_atomic_fetch_add((int*)(hist + (idx1 >> 8)), 1, __ATOMIC_RELAXED, __HIP_MEMORY_SCOPE_WORKGROUP);
          asm volatile("s_waitcnt lgkmcnt(0)" ::: "memory");
          const int cnt = hist[ln]; int inc = cnt;
#pragma unroll
          for (int o = 1; o < 64; o <<= 1) { const int tv = __shfl_up(inc, o); if (ln >= o) inc += tv; }
          base[ln] = inc - cnt; asm volatile("s_waitcnt lgkmcnt(0)" ::: "memory");
          list[base[idx0 >> 8] + t0_] = (v2u_t){(unsigned)idx0, (unsigned)pos0}; list[base[idx1 >> 8] + t1_] = (v2u_t){(unsigned)idx1, (unsigned)pos1};
          asm volatile("s_waitcnt lgkmcnt(0)" ::: "memory");
          const v2u_t a_ = list[ln], b_ = list[64 + ln]; idx0 = (int)a_.x; pos0 = (int)a_.y; idx1 = (int)b_.x; pos1 = (int)b_.y;
          asm volatile("s_waitcnt lgkmcnt(0)" ::: "memory"); }
#endif
        v4u_t bA[8][2], bB[8][2]; const unsigned lane16 = (unsigned)ln * 16u;
#define P7_LOAD(TAB, IDXR, gl, Bf) do { _Pragma("unroll") for (int e = 0; e < 8; ++e) { const int ei = __builtin_amdgcn_readlane(IDXR, (gl) * 8 + e); \
            const unsigned char* rb = (TAB) + (size_t)(unsigned)ei * D; Bf[e][0] = *(const v4u_t*)(rb + lane16); Bf[e][1] = *(const v4u_t*)(rb + lane16 + 1024u); } __builtin_amdgcn_sched_barrier(0); } while (0)
#define PIN16(a) asm volatile("" : "+v"(a[0]), "+v"(a[1]), "+v"(a[2]), "+v"(a[3]), "+v"(a[4]), "+v"(a[5]), "+v"(a[6]), "+v"(a[7]), "+v"(a[8]), "+v"(a[9]), "+v"(a[10]), "+v"(a[11]), "+v"(a[12]), "+v"(a[13]), "+v"(a[14]), "+v"(a[15]))
#define P7_DOT(gl, Bf, DR) do { float ds_[8]; _Pragma("unroll") for (int e = 0; e < 8; ++e) { asm volatile("" : "+v"(Bf[e][0]), "+v"(Bf[e][1])); ds_[e] = dot16_fp8(Bf[e][0], xf[0]) + dot16_fp8(Bf[e][1], xf[1]); } \
            _Pragma("unroll") for (int e = 0; e < 8; ++e) { const float tot = wave_sum_dpp(ds_[e]); int l2_ = lane; asm volatile("" : "+v"(l2_)); DR = (l2_ == (gl) * 8 + e) ? tot : DR; } __builtin_amdgcn_sched_barrier(0); } while (0)
#define P7_AXPY(gl, Bf, CR) do { _Pragma("unroll") for (int e = 0; e < 8; ++e) { const float cf = __int_as_float(__builtin_amdgcn_readlane(__float_as_int(CR), (gl) * 8 + e)); asm volatile("" : "+v"(Bf[e][0]), "+v"(Bf[e][1])); \
            axpy16_fp8(Bf[e][0], cf, y[0]); axpy16_fp8(Bf[e][1], cf, y[1]); PIN16(y[0]); PIN16(y[1]); } } while (0)
        float d0 = 0.f, d1 = 0.f;
        {
            float xf[2][16];
#pragma unroll
            for (int c = 0; c < 2; ++c) { float a[8], b[8]; unpack8(*(const uint4*)(x1b + (size_t)t * D + c * 1024 + ln * 16), a); unpack8(*(const uint4*)(x1b + (size_t)t * D + c * 1024 + ln * 16 + 8), b);
#pragma unroll
                for (int i = 0; i < 8; ++i) { xf[c][i] = a[i]; xf[c][8 + i] = b[i]; } }
            P7_LOAD(ub, idx0, 0, bA);
#pragma unroll 1
            for (int gl = 0; gl < 6; gl += 2) { P7_LOAD(ub, idx0, gl + 1, bB); P7_DOT(gl, bA, d0); P7_LOAD(ub, idx0, gl + 2, bA); P7_DOT(gl + 1, bB, d0); }
            P7_LOAD(ub, idx0, 7, bB); P7_DOT(6, bA, d0); P7_LOAD(ub, idx1, 0, bA); P7_DOT(7, bB, d0);
#pragma unroll 1
            for (int gl = 0; gl < 6; gl += 2) { P7_LOAD(ub, idx1, gl + 1, bB); P7_DOT(gl, bA, d1); P7_LOAD(ub, idx1, gl + 2, bA); P7_DOT(gl + 1, bB, d1); }
            P7_LOAD(ub, idx1, 7, bB); P7_DOT(6, bA, d1); P7_LOAD(vb, idx0, 0, bA); P7_DOT(7, bB, d1);
        }
        float cf0, cf1;
        { const float gt0 = gati[(size_t)t * 128 + pos0], gt1 = gati[(size_t)t * 128 + pos1];
          const float su0 = esc[idx0 * 2], sv0 = esc[idx0 * 2 + 1], su1 = esc[idx1 * 2], sv1 = esc[idx1 * 2 + 1];
          cf0 = gt0 * gelu_erf(d0 * rs2 * su0) * sv0; cf1 = gt1 * gelu_erf(d1 * rs2 * su1) * sv1; }
        float y[2][16];
#pragma unroll
        for (int c = 0; c < 2; ++c)
#pragma unroll
            for (int i = 0; i < 16; ++i) y[c][i] = 0.f;
#pragma unroll 1
        for (int gl = 0; gl < 6; gl += 2) { P7_LOAD(vb, idx0, gl + 1, bB); P7_AXPY(gl, bA, cf0); P7_LOAD(vb, idx0, gl + 2, bA); P7_AXPY(gl + 1, bB, cf0); }
        P7_LOAD(vb, idx0, 7, bB); P7_AXPY(6, bA, cf0); P7_LOAD(vb, idx1, 0, bA); P7_AXPY(7, bB, cf0);
#pragma unroll 1
        for (int gl = 0; gl < 6; gl += 2) { P7_LOAD(vb, idx1, gl + 1, bB); P7_AXPY(gl, bA, cf1); P7_LOAD(vb, idx1, gl + 2, bA); P7_AXPY(gl + 1, bB, cf1); }
        P7_LOAD(vb, idx1, 7, bB); P7_AXPY(6, bA, cf1); P7_AXPY(7, bB, cf1);
#undef P7_AXPY
#undef PIN16
#undef P7_DOT
#undef P7_LOAD
        float ss = 0.f;
#pragma unroll
        for (int c = 0; c < 2; ++c)
#pragma unroll
            for (int k = 0; k < 4; ++k) { const float4 a = *(const float4*)(x1 + (size_t)t * D + c * 1024 + ln * 16 + 4 * k);
                y[c][4 * k] += a.x; y[c][4 * k + 1] += a.y; y[c][4 * k + 2] += a.z; y[c][4 * k + 3] += a.w;
                ss += (y[c][4 * k] * y[c][4 * k] + y[c][4 * k + 1] * y[c][4 * k + 1]) + (y[c][4 * k + 2] * y[c][4 * k + 2] + y[c][4 * k + 3] * y[c][4 * k + 3]); }
        ss = wave_sum(ss);
        const float r = rsqrtf(ss * (1.0f / D) + EPS);
#pragma unroll
        for (int c = 0; c < 2; ++c)
#pragma unroll
            for (int k = 0; k < 4; ++k) { const float4 gg = *(const float4*)(P.gfin + c * 1024 + ln * 16 + 4 * k);
                *(float4*)(P.out + (size_t)t * D + c * 1024 + ln * 16 + 4 * k) = make_float4(y[c][4 * k] * r * gg.x, y[c][4 * k + 1] * r * gg.y, y[c][4 * k + 2] * r * gg.z, y[c][4 * k + 3] * r * gg.w); }
    }
}

#define XB_TMO      128
#define XB_XCNT(j)  (256  + 64 * (j))
#define XB_XSUB(j)  (1280 + 64 * (j))
#define XB_XGEN(j)  (2304 + 64 * (j))
#define XB_TOP      3328
#define XB_TOPGEN   3392
#define XCD_BAR_WORDS 3456
#define XB_SPIN_CAP (1u << 18)

__device__ __forceinline__ unsigned xb_ld(unsigned* p)              { return __hip_atomic_load(p, __ATOMIC_RELAXED, __HIP_MEMORY_SCOPE_AGENT); }
__device__ __forceinline__ unsigned xb_add(unsigned* p, unsigned v) { return __hip_atomic_fetch_add(p, v, __ATOMIC_RELAXED, __HIP_MEMORY_SCOPE_AGENT); }
__device__ __forceinline__ unsigned xb_xcc_id() { return (unsigned)__builtin_amdgcn_s_getreg((3 << 11) | 20) & 0xFu; }
#define XB_SPIN(cond, bar) do { unsigned _sp = 0; while (cond) { __builtin_amdgcn_s_sleep(1); \
    if ((++_sp & 255u) == 0u) { if (xb_ld(&(bar)[XB_TMO])) break; if (_sp > XB_SPIN_CAP) { atomicAdd(&(bar)[XB_TMO], 1u); break; } } } } while (0)

struct XcdBarrier {
    unsigned* bar; unsigned x;
    volatile LAS3 unsigned* st;
};

__device__ __forceinline__ XcdBarrier xcd_barrier_post(unsigned* bar, volatile LAS3 unsigned* st) {
    XcdBarrier b; b.bar = bar; b.x = xb_xcc_id(); b.st = st;
    if (threadIdx.x == 0) (void)xb_add(&bar[XB_XCNT(b.x)], 1u);
    return b;
}
__device__ __forceinline__ void xcd_barrier_complete(unsigned* bar, unsigned x, unsigned& nloc, unsigned& nx) {
    const unsigned G = gridDim.x * gridDim.y * gridDim.z;
    unsigned sum, cnt, mine, sp = 0u;
    for (;;) {
        sum = 0u; cnt = 0u; mine = 0u;
#pragma unroll
        for (unsigned j = 0; j < 16; ++j) { const unsigned c = xb_ld(&bar[XB_XCNT(j)]); sum += c; cnt += (c > 0u) ? 1u : 0u; mine = (j == x) ? c : mine; }
        if (sum == G) break;
        __builtin_amdgcn_s_sleep(1);
        if ((++sp & 255u) == 0u) { if (xb_ld(&bar[XB_TMO])) break; if (sp > XB_SPIN_CAP) { atomicAdd(&bar[XB_TMO], 1u); break; } }
    }
    nloc = mine > 0u ? mine : 1u; nx = cnt > 0u ? cnt : 1u;
}

__device__ __forceinline__ void xcd_barrier(const XcdBarrier& b) {
    asm volatile("s_waitcnt vmcnt(0)" ::: "memory");
    __syncthreads();
    if (threadIdx.x == 0) {
        unsigned* bar = b.bar;
        __builtin_amdgcn_s_waitcnt(0);
        unsigned nloc = b.st[0], nx = b.st[1];
        if (nloc == 0u) { xcd_barrier_complete(bar, b.x, nloc, nx); b.st[0] = nloc; b.st[1] = nx; }
        const unsigned old = xb_add(&bar[XB_XSUB(b.x)], 1u);
        const unsigned gen = old / nloc;
        if (old + 1u == (gen + 1u) * nloc) {
            __builtin_amdgcn_fence(__ATOMIC_RELEASE, "agent");
            asm volatile("s_waitcnt vmcnt(0)" ::: "memory");
            const unsigned og = xb_add(&bar[XB_TOP], 1u);
            const unsigned tg = og / nx;
            if (og + 1u == (tg + 1u) * nx) xb_add(&bar[XB_TOPGEN], 1u);
            else XB_SPIN(xb_ld(&bar[XB_TOPGEN]) == tg, bar);
            __builtin_amdgcn_fence(__ATOMIC_ACQUIRE, "agent");
            xb_add(&bar[XB_XGEN(b.x)], 1u);
            asm volatile("s_waitcnt vmcnt(0)" ::: "memory");
        } else {
            XB_SPIN(xb_ld(&bar[XB_XGEN(b.x)]) == gen, bar);
            __builtin_amdgcn_fence(__ATOMIC_ACQUIRE, "agent");
            asm volatile("s_waitcnt vmcnt(0)" ::: "memory");
        }
    }
    __syncthreads();
}

constexpr int N_PHASES = 8;
#ifndef MK_N_LAUNCHES
#define MK_N_LAUNCHES 1
#endif
__global__ void __launch_bounds__(NTHREADS, 2) layer_fwd(Params P) {
    extern __shared__ __attribute__((aligned(16))) unsigned char lds[];
    const int G = gridDim.x, bid = blockIdx.x;
    volatile LAS3 unsigned* bst = (volatile LAS3 unsigned*)((LAS3 unsigned char*)lds + (LDS_BYTES - 16));
    if (threadIdx.x < 4) bst[threadIdx.x] = 0u;
    __syncthreads();
    XcdBarrier xbar = xcd_barrier_post((unsigned*)(P.ws + WS_CTL) + CW_BAR, bst);
    const int lo = P.ph_lo, hi = P.ph_hi;
#ifndef PH_MASK
#define PH_MASK 0xff
#endif
#define IN(k) (((PH_MASK >> (k)) & 1) && lo <= (k) && (k) < hi)
#define SEAM(k) do { if (IN(k) && IN((k) + 1)) xcd_barrier(xbar); } while (0)
#ifndef REP_MASK
#define REP_MASK 0
#endif
#define REPS(k) (((REP_MASK >> (k)) & 1) ? 2 : 1)
    if (IN(0)) for (int rep = 0; rep < REPS(0); ++rep) { p0_rows(P, lds, G, bid); p0_weights_in(P, lds, G, bid); }
    SEAM(0);
    if (IN(1)) for (int rep = 0; rep < REPS(1); ++rep) {
        pg8::Gemm g{(const pg8::bf16_t*)(P.ws + WS_XB), (const pg8::bf16_t*)(P.ws + WS_WINT), T, NPROJ, D}; pg8::StaticOrder S; S.init(T, NPROJ, G, bid);
        pg8::EpiProj E{(pg8::bf16_t*)(P.ws + WS_PROJ), NPROJ, (const float*)(P.ws + WS_RS1)};
        pg8::gemm_phase<pg8::EpiProj, pg8::StaticOrder, true, true>((PG8_LAS unsigned char*)lds, g, S, E);
    }
    SEAM(1);
    if (IN(2)) for (int rep = 0; rep < REPS(2); ++rep) {
        for (int u = bid; u < 64; u += G) mlstm_unit(P, lds, u);
#ifndef REP_OTH
#define REP_OTH 1
#endif
        if (G > 64) { if (bid >= 64) for (int r2 = 0; r2 < REP_OTH; ++r2) { p2_conv(P, G - 64, bid - 64); p2_weights_sq(P, lds, G - 64, bid - 64); p0_tables(P, G - 64, bid - 64); } }
        else { p2_conv(P, G, bid); p2_weights_sq(P, lds, G, bid); p0_tables(P, G, bid); }
    }
    SEAM(2);
    if (IN(3)) for (int rep = 0; rep < REPS(3); ++rep) p3_finalize(P, G, bid);
    SEAM(3);
    if (IN(4)) for (int rep = 0; rep < REPS(4); ++rep) {
        pg8::Gemm g{(const pg8::bf16_t*)(P.ws + WS_MIXIN), (const pg8::bf16_t*)(P.ws + WS_WOUTT), T, D, D}; pg8::StaticOrder S; S.init(T, D, G, bid);
        pg8::EpiOut E{P.x, (float*)(P.ws + WS_X1), (pg8::bf16_t*)(P.ws + WS_X1B), (float*)(P.ws + WS_SSQ), D};
        pg8::gemm_phase<pg8::EpiOut, pg8::StaticOrder, false, true>((PG8_LAS unsigned char*)lds, g, S, E);
    }
    SEAM(4);
    if (IN(5)) for (int rep = 0; rep < REPS(5); ++rep) {
        pg8::Gemm g{(const pg8::bf16_t*)(P.ws + WS_X1B), (const pg8::bf16_t*)(P.ws + WS_WQT), T, D, D}; pg8::StaticOrder S; S.init(T, D, G, bid);
        pg8::EpiQb E{(pg8::bf16_t*)(P.ws + WS_QV), D, (const float*)(P.ws + WS_SSQ)};
        pg8::gemm_phase<pg8::EpiQb, pg8::StaticOrder, false, true>((PG8_LAS unsigned char*)lds, g, S, E);
    }
    SEAM(5);
    if (IN(6)) for (int rep = 0; rep < REPS(6); ++rep) p6_topk(P, lds, G, bid);
    SEAM(6);
#ifdef EXTRA_SYNCS
    for (int i = 0; i < EXTRA_SYNCS; ++i) xcd_barrier(xbar);
#endif
    if (IN(7)) for (int rep = 0; rep < REPS(7); ++rep) p7_peer(P, lds, G, bid);
#undef IN
#undef SEAM
}

extern "C" void kernel_launch(void* const* d_in, const int* in_sizes, int n_in, void* d_out, int out_size, void* d_ws, size_t ws_size, hipStream_t stream) {
    static int grid = 0;
    if (grid == 0) {
        if (n_in != 15 || in_sizes[0] != T * D || out_size != T * D || ws_size < WS_END) { fprintf(stderr, "kernel_launch: unexpected shapes (n_in %d, in0 %d, out %d, ws %zu); nothing launched\n", n_in, n_in > 0 ? in_sizes[0] : -1, out_size, ws_size); grid = -1; return; }
        int dev = 0, cus = 0, per_cu = 0;
        if (hipGetDevice(&dev) != hipSuccess || hipDeviceGetAttribute(&cus, hipDeviceAttributeMultiprocessorCount, dev) != hipSuccess) { grid = -1; return; }
        if (hipFuncSetAttribute((const void*)layer_fwd, hipFuncAttributeMaxDynamicSharedMemorySize, LDS_BYTES) != hipSuccess) { fprintf(stderr, "kernel_launch: hipFuncSetAttribute failed\n"); grid = -1; return; }
        if (hipOccupancyMaxActiveBlocksPerMultiprocessor(&per_cu, (const void*)layer_fwd, NTHREADS, LDS_BYTES) != hipSuccess || per_cu < 1) { fprintf(stderr, "kernel_launch: occupancy query says %d blocks per CU\n", per_cu); (void)hipGetLastError(); grid = -1; return; }
        grid = cus;
    }
    if (grid < 0) return;
    Params p{};
    p.x = (const float*)d_in[0]; p.g1 = (const float*)d_in[1]; p.w_in = (const float*)d_in[2]; p.b_ig = (const float*)d_in[3]; p.b_fg = (const float*)d_in[4];
    p.conv_w = (const float*)d_in[5]; p.gm = (const float*)d_in[6]; p.w_out = (const float*)d_in[7]; p.g2 = (const float*)d_in[8]; p.w_q = (const float*)d_in[9];
    p.sk1 = (const float*)d_in[10]; p.sk2 = (const float*)d_in[11]; p.eu = (const float*)d_in[12]; p.ev = (const float*)d_in[13]; p.gfin = (const float*)d_in[14];
    p.out = (float*)d_out; p.ws = (unsigned char*)d_ws;
    if (hipMemsetAsync((char*)d_ws + WS_CTL, 0, CTL_ZERO_BYTES, stream) != hipSuccess) { fprintf(stderr, "kernel_launch: hipMemsetAsync failed\n"); return; }
    for (int li = 0; li < MK_N_LAUNCHES; ++li) {
        p.ph_lo = (MK_N_LAUNCHES == 1) ? 0 : li; p.ph_hi = (MK_N_LAUNCHES == 1) ? N_PHASES : li + 1;
        void* args[] = {&p};
        const hipError_t e = hipLaunchCooperativeKernel((const void*)layer_fwd, dim3(grid), dim3(NTHREADS), args, LDS_BYTES, stream);
        if (e != hipSuccess) { fprintf(stderr, "kernel_launch: cooperative launch %d failed: %s (grid %d)\n", li, hipGetErrorString(e), grid); break; }
    }
}
```

```cpp
#include <hip/hip_runtime.h>
#include <hip/hip_cooperative_groups.h>
#include <cstdio>
#include <cstdint>
namespace cg = cooperative_groups;
namespace pg8 {
#define PG8_LAS __attribute__((address_space(3)))
typedef unsigned short bf16_t;
typedef short bf16x8 __attribute__((ext_vector_type(8)));
typedef float f32x4 __attribute__((ext_vector_type(4)));
typedef unsigned u32x4 __attribute__((ext_vector_type(4)));
constexpr int BM = 256, BK = 64, HALF = 128, HTB = HALF * BK * 2  , STAGE_BYTES = 8 * HTB, NXCD = 8, WGM = 8;

__host__ __device__ __forceinline__ int lds_byte(int r, int c) { const int st = (r >> 4) * 2 + (c >> 5), rr = r & 15, cc = c & 31, ob = rr * 64 + cc * 2; return st * 1024 + (ob ^ (((ob >> 9) & 1) << 5)); }
__host__ __device__ __forceinline__ void stage_rc(int b, int& R, int& C) { const int st = b / 1024, sb = b % 1024, swz = sb ^ (((sb >> 9) & 1) << 5); R = (st >> 1) * 16 + swz / 64; C = (st & 1) * 32 + (swz % 64) / 2; }
__host__ __device__ __forceinline__ int perm32(int rho) { const int n = rho >> 4, i = rho & 15; return 8 * (i >> 2) + 4 * n + (i & 3); }

struct Unit { int pm, pn; };
struct Gemm { const bf16_t* A; const bf16_t* Bt; int M, N, K; };

struct StaticOrder {
    int nM, nN, nwg, G, c;
    __host__ __device__ void init(int M, int N, int G_, int c_) { nM = M / BM; nN = N / BM; nwg = nM * nN; G = G_; c = c_; }
    __host__ __device__ bool next(int i, Unit& u) const {
        const long L = (long)i * G + c; if (L >= nwg) return false;
        int wgid = (int)L; { const int q = nwg / NXCD, r = nwg % NXCD, xcd = wgid % NXCD, off = wgid / NXCD; wgid = (xcd < r ? xcd * (q + 1) : r * (q + 1) + (xcd - r) * q) + off; }
        const int nig = WGM * nN, gid = wgid / nig, fm = gid * WGM, gsz = (nM - fm) < WGM ? (nM - fm) : WGM;
        u.pm = fm + ((wgid % nig) % gsz); u.pn = (wgid % nig) / gsz; return true;
    }
    __device__ __forceinline__ void a_ready(const Unit&) const {}
    __device__ __forceinline__ void done(const Unit&) const {}
};

__device__ __forceinline__ unsigned cvt_pk_bf16(float lo, float hi) { unsigned r; asm volatile("v_cvt_pk_bf16_f32 %0, %1, %2" : "=v"(r) : "v"(lo), "v"(hi)); return r; }
struct EpiProj {
    static constexpr bool PERM = true, AFTER_DRAIN = false;
    bf16_t* O; int ldc; const float* rs;
    __device__ __forceinline__ void operator()(const f32x4 (&acc)[2][2][4][2], const Unit& u, int wr, int wc, int fr, int fq) const {
        const int row0 = u.pm * BM + wr * 64 + fr, col0 = u.pn * BM + wc * 32 + 8 * fq;
#pragma unroll
        for (int ai = 0; ai < 2; ++ai)
#pragma unroll
            for (int m = 0; m < 4; ++m) { const int row = row0 + ai * HALF + m * 16; const float s = rs[row]; bf16_t* rowp = O + (size_t)row * ldc + col0;
#pragma unroll
                for (int bj = 0; bj < 2; ++bj) { const f32x4 v0 = acc[ai][bj][m][0] * s, v1 = acc[ai][bj][m][1] * s; u32x4 w;
                    w.x = cvt_pk_bf16(v0[0], v0[1]); w.y = cvt_pk_bf16(v0[2], v0[3]); w.z = cvt_pk_bf16(v1[0], v1[1]); w.w = cvt_pk_bf16(v1[2], v1[3]);
                    *(u32x4*)(rowp + bj * HALF) = w; } }
    }
};
struct EpiOut {
    static constexpr bool PERM = false, AFTER_DRAIN = false;
    const float* X; float* X1; bf16_t* X1B; float* SSQ; int ldc;
    __device__ __forceinline__ void operator()(const f32x4 (&acc)[2][2][4][2], const Unit& u, int wr, int wc, int fr, int fq) const {
        typedef unsigned u32x2 __attribute__((ext_vector_type(2)));
        const int row0 = u.pm * BM + wr * 64 + fr, col0 = u.pn * BM + wc * 32 + 4 * fq;
#pragma unroll
        for (int ai = 0; ai < 2; ++ai)
#pragma unroll
            for (int m = 0; m < 4; ++m) { const int row = row0 + ai * HALF + m * 16; const size_t off = (size_t)row * ldc + col0; float ss = 0.f;
#pragma unroll
                for (int bj = 0; bj < 2; ++bj)
#pragma unroll
                    for (int n = 0; n < 2; ++n) { const size_t c = off + bj * HALF + n * 16; const f32x4 xv = *(const f32x4*)(X + c); const f32x4 o = xv + acc[ai][bj][m][n];
                        *(f32x4*)(X1 + c) = o; ss += (o[0] * o[0] + o[1] * o[1]) + (o[2] * o[2] + o[3] * o[3]);
                        u32x2 pk; pk.x = cvt_pk_bf16(o[0], o[1]); pk.y = cvt_pk_bf16(o[2], o[3]); *(u32x2*)(X1B + c) = pk; }
                ss += __shfl_xor(ss, 16); ss += __shfl_xor(ss, 32);
                if (fq == 0) SSQ[(size_t)row * 32 + u.pn * 4 + wc] = ss; }
    }
};
struct EpiQ {
    static constexpr bool PERM = false, AFTER_DRAIN = false;
    float* O; int ldc;
    __device__ __forceinline__ void operator()(const f32x4 (&acc)[2][2][4][2], const Unit& u, int wr, int wc, int fr, int fq) const {
        const int row0 = u.pm * BM + wr * 64 + fr, col0 = u.pn * BM + wc * 32 + 4 * fq;
#pragma unroll
        for (int ai = 0; ai < 2; ++ai)
#pragma unroll
            for (int m = 0; m < 4; ++m) { const size_t off = (size_t)(row0 + ai * HALF + m * 16) * ldc + col0;
#pragma unroll
                for (int bj = 0; bj < 2; ++bj)
#pragma unroll
                    for (int n = 0; n < 2; ++n) *(f32x4*)(O + off + bj * HALF + n * 16) = acc[ai][bj][m][n]; }
    }
};
struct EpiQb {
    static constexpr bool PERM = true, AFTER_DRAIN = false;
    bf16_t* O; int ldc; const float* SSQ;
    __device__ __forceinline__ void operator()(const f32x4 (&acc)[2][2][4][2], const Unit& u, int wr, int wc, int fr, int fq) const {
        const int row0 = u.pm * BM + wr * 64 + fr, col0 = u.pn * BM + wc * 32 + 8 * fq;
#pragma unroll
        for (int ai = 0; ai < 2; ++ai)
#pragma unroll
            for (int m = 0; m < 4; ++m) { const int row = row0 + ai * HALF + m * 16; const f32x4* sp = (const f32x4*)(SSQ + (size_t)row * 32);
                f32x4 s4 = sp[0];
#pragma unroll
                for (int i = 1; i < 8; ++i) s4 += sp[i];
                const float s = rsqrtf(((s4[0] + s4[1]) + (s4[2] + s4[3])) * (1.0f / 2048.0f) + 1e-6f); bf16_t* rowp = O + (size_t)row * ldc + col0;
#pragma unroll
                for (int bj = 0; bj < 2; ++bj) { const f32x4 v0 = acc[ai][bj][m][0] * s, v1 = acc[ai][bj][m][1] * s; u32x4 w;
                    w.x = cvt_pk_bf16(v0[0], v0[1]); w.y = cvt_pk_bf16(v0[2], v0[3]); w.z = cvt_pk_bf16(v1[0], v1[1]); w.w = cvt_pk_bf16(v1[2], v1[3]);
                    *(u32x4*)(rowp + bj * HALF) = w; } }
    }
};
template <class Epi, class Sched, bool ALIGN_EPI = false, bool SP2 = false>
__device__ __forceinline__ void gemm_phase(PG8_LAS unsigned char* lds, const Gemm g, const Sched& S, const Epi& E) {
    const int tid = threadIdx.x, wid = __builtin_amdgcn_readfirstlane(tid >> 6), lane = tid & 63, wr = wid >> 2, wc = wid & 3, fr = lane & 15, fq = lane >> 4;
    const int K = g.K, nt = K / BK;
    unsigned voffA[2], voffB[2];
#pragma unroll
    for (int i = 0; i < 2; ++i) { int R, C; stage_rc(tid * 16 + i * 8192, R, C); const int Rb = Epi::PERM ? ((R & ~31) + perm32(R & 31)) : R;
        voffA[i] = (unsigned)(R * K + C) * 2u; voffB[i] = (unsigned)(Rb * K + C) * 2u; }
    const size_t kstep = (size_t)(BK * 2);
    const size_t hstep = (size_t)HALF * K * 2;
    const size_t tstep = 2 * hstep;
    const unsigned ldsw = (unsigned)wid * 1024u;
    const int aoff = lds_byte(wr * 64 + fr, fq * 8), boff = lds_byte(wc * 32 + fr, fq * 8);
#define PG8_SA(b, h) (((b) * 2 + (h)) * HTB)
#define PG8_SB(b, h) ((4 + (b) * 2 + (h)) * HTB)
#define PG8_STAGE(bufoff, gbase, voff) do { _Pragma("unroll") for (int _i = 0; _i < 2; ++_i) \
        __builtin_amdgcn_global_load_lds((const unsigned*)((const char*)(gbase) + (voff)[_i]), (PG8_LAS unsigned*)(lds + (bufoff) + ldsw + _i * 8192), 16, 0, 0); } while (0)
#define PG8_LDA(dst, b, h) do { _Pragma("unroll") for (int m = 0; m < 4; ++m) _Pragma("unroll") for (int k = 0; k < 2; ++k) dst[m][k] = *(const PG8_LAS bf16x8*)(lds + PG8_SA(b, h) + aoff + m * 2048 + k * 1024); } while (0)
#define PG8_LDB(dst, b, h) do { _Pragma("unroll") for (int n = 0; n < 2; ++n) _Pragma("unroll") for (int k = 0; k < 2; ++k) dst[n][k] = *(const PG8_LAS bf16x8*)(lds + PG8_SB(b, h) + boff + n * 2048 + k * 1024); } while (0)
#define PG8_MMA(ai, bj, At, Bt) do { __builtin_amdgcn_s_setprio(1); _Pragma("unroll") for (int m = 0; m < 4; ++m) _Pragma("unroll") for (int n = 0; n < 2; ++n) _Pragma("unroll") for (int k = 0; k < 2; ++k) \
        acc[ai][bj][m][n] = __builtin_amdgcn_mfma_f32_16x16x32_bf16(Bt[n][k], At[m][k], acc[ai][bj][m][n], 0, 0, 0); __builtin_amdgcn_s_setprio(0); } while (0)
#define PG8_WAIT_V(n) asm volatile("s_waitcnt vmcnt(" #n ")" ::: "memory")
#define PG8_WAIT_L(n) asm volatile("s_waitcnt lgkmcnt(" #n ")" ::: "memory")
#define PG8_BAR __builtin_amdgcn_s_barrier()
#define PG8_SCHED __builtin_amdgcn_sched_barrier(0)
    Unit cur, nxt; int ui = 0;
    if (!S.next(0, cur)) return;
    f32x4 acc[2][2][4][2];
#pragma unroll
    for (int a = 0; a < 2; ++a)
#pragma unroll
        for (int b = 0; b < 2; ++b)
#pragma unroll
            for (int m = 0; m < 4; ++m)
#pragma unroll
                for (int n = 0; n < 2; ++n) acc[a][b][m][n] = (f32x4){0.f, 0.f, 0.f, 0.f};
    bf16x8 At[4][2], B0[2][2], B1[2][2];
    const char* cA = (const char*)g.A + (size_t)cur.pm * tstep; const char* cB = (const char*)g.Bt + (size_t)cur.pn * tstep;
    S.a_ready(cur);
    if constexpr (SP2) {
        PG8_STAGE(PG8_SB(0, 0), cB, voffB); PG8_STAGE(PG8_SB(0, 1), cB + hstep, voffB); PG8_STAGE(PG8_SA(0, 0), cA, voffA); PG8_STAGE(PG8_SA(0, 1), cA + hstep, voffA);
        if (wr == 1) PG8_BAR;
        PG8_WAIT_V(2); PG8_BAR;
        PG8_STAGE(PG8_SB(1, 0), cB + kstep, voffB); PG8_STAGE(PG8_SA(1, 0), cA + kstep, voffA); PG8_STAGE(PG8_SB(1, 1), cB + hstep + kstep, voffB);
        PG8_WAIT_V(6); PG8_BAR;
    } else {
        PG8_STAGE(PG8_SB(0, 0), cB, voffB); PG8_STAGE(PG8_SA(0, 0), cA, voffA); PG8_STAGE(PG8_SB(0, 1), cB + hstep, voffB); PG8_STAGE(PG8_SA(0, 1), cA + hstep, voffA);
        if (wr == 1) PG8_BAR;
        PG8_WAIT_V(4); PG8_BAR;
        PG8_STAGE(PG8_SB(1, 0), cB + kstep, voffB); PG8_STAGE(PG8_SA(1, 0), cA + kstep, voffA); PG8_STAGE(PG8_SB(1, 1), cB + hstep + kstep, voffB);
        PG8_WAIT_V(6); PG8_BAR;
    }
    for (;;) {
        const bool has_next = S.next(ui + 1, nxt);
        const char* nA = has_next ? (const char*)g.A + (size_t)nxt.pm * tstep : cA; const char* nB = has_next ? (const char*)g.Bt + (size_t)nxt.pn * tstep : cB;
        for (int t = 0; t < nt; t += 2) {
            const bool last = (t == nt - 2);
            const char* a1 = cA + (size_t)(t + 1) * kstep;
            const char* a2 = last ? nA : cA + (size_t)(t + 2) * kstep; const char* b2 = last ? nB : cB + (size_t)(t + 2) * kstep;
            const char* a3 = a2 + kstep; const char* b3 = b2 + kstep;
            if (last && has_next) S.a_ready(nxt);
            if constexpr (SP2) {
            PG8_LDB(B0, 0, 0); PG8_LDB(B1, 0, 1); PG8_SCHED; PG8_LDA(At, 0, 0); PG8_STAGE(PG8_SA(1, 1), a1 + hstep, voffA);
            PG8_WAIT_V(8); PG8_WAIT_L(0); PG8_BAR; PG8_MMA(0, 0, At, B0); PG8_MMA(0, 1, At, B1); PG8_BAR; PG8_SCHED;
            PG8_LDA(At, 0, 1); PG8_STAGE(PG8_SB(0, 0), b2, voffB); PG8_STAGE(PG8_SB(0, 1), b2 + hstep, voffB); PG8_STAGE(PG8_SA(0, 0), a2, voffA);
            PG8_WAIT_V(8); PG8_WAIT_L(0); PG8_BAR; PG8_MMA(1, 0, At, B0); PG8_MMA(1, 1, At, B1); PG8_BAR; PG8_SCHED;
            PG8_LDB(B0, 1, 0); PG8_LDB(B1, 1, 1); PG8_SCHED; PG8_LDA(At, 1, 0); PG8_STAGE(PG8_SA(0, 1), a2 + hstep, voffA);
            PG8_WAIT_V(8); PG8_WAIT_L(0); PG8_BAR; PG8_MMA(0, 0, At, B0); PG8_MMA(0, 1, At, B1); PG8_BAR; PG8_SCHED;
            PG8_LDA(At, 1, 1); PG8_STAGE(PG8_SB(1, 0), b3, voffB); PG8_STAGE(PG8_SB(1, 1), b3 + hstep, voffB); PG8_STAGE(PG8_SA(1, 0), a3, voffA);
            PG8_WAIT_V(8); PG8_WAIT_L(0); PG8_BAR; PG8_MMA(1, 0, At, B0); PG8_MMA(1, 1, At, B1); PG8_BAR; PG8_SCHED;
            } else {
            PG8_LDB(B0, 0, 0); PG8_SCHED; PG8_LDA(At, 0, 0); PG8_STAGE(PG8_SA(1, 1), a1 + hstep, voffA);
            PG8_WAIT_L(8); PG8_BAR; PG8_WAIT_L(0); PG8_MMA(0, 0, At, B0); PG8_BAR; PG8_SCHED;
            PG8_LDB(B1, 0, 1); PG8_STAGE(PG8_SB(0, 0), b2, voffB);
            PG8_BAR; PG8_WAIT_L(0); PG8_MMA(0, 1, At, B1); PG8_BAR;
            PG8_LDA(At, 0, 1); PG8_STAGE(PG8_SA(0, 0), a2, voffA);
            PG8_BAR; PG8_WAIT_L(0); PG8_MMA(1, 0, At, B0); PG8_BAR; PG8_SCHED;
            PG8_STAGE(PG8_SB(0, 1), b2 + hstep, voffB);
            PG8_WAIT_V(6); PG8_BAR; PG8_MMA(1, 1, At, B1); PG8_BAR;
            PG8_LDB(B0, 1, 0); PG8_SCHED; PG8_LDA(At, 1, 0); PG8_STAGE(PG8_SA(0, 1), a2 + hstep, voffA);
            PG8_WAIT_L(8); PG8_BAR; PG8_WAIT_L(0); PG8_MMA(0, 0, At, B0); PG8_BAR; PG8_SCHED;
            PG8_LDB(B1, 1, 1); PG8_STAGE(PG8_SB(1, 0), b3, voffB);
            PG8_BAR; PG8_WAIT_L(0); PG8_MMA(0, 1, At, B1); PG8_BAR;
            PG8_LDA(At, 1, 1); PG8_STAGE(PG8_SA(1, 0), a3, voffA);
            PG8_BAR; PG8_WAIT_L(0); PG8_MMA(1, 0, At, B0); PG8_BAR; PG8_SCHED;
            PG8_STAGE(PG8_SB(1, 1), b3 + hstep, voffB);
            PG8_WAIT_V(6); PG8_BAR; PG8_MMA(1, 1, At, B1); PG8_BAR;
            }
        }
        if constexpr (ALIGN_EPI) { if (wr == 0) PG8_BAR; }
        if constexpr (!Epi::AFTER_DRAIN) { E(acc, cur, wr, wc, fr, fq); S.done(cur); }
        if (!has_next) break;
#pragma unroll
        for (int a = 0; a < 2; ++a)
#pragma unroll
            for (int b = 0; b < 2; ++b)
#pragma unroll
                for (int m = 0; m < 4; ++m)
#pragma unroll
                    for (int n = 0; n < 2; ++n) acc[a][b][m][n] = (f32x4){0.f, 0.f, 0.f, 0.f};
        cur = nxt; cA = nA; cB = nB; ++ui;
        if constexpr (ALIGN_EPI) { if (wr == 1) PG8_BAR; }
    }
    PG8_WAIT_V(0);
    if constexpr (!ALIGN_EPI) { if (wr == 0) PG8_BAR; }
    PG8_BAR;
    if constexpr (Epi::AFTER_DRAIN) { E.fused(acc, cur, wr, wc, fr, fq, lds, wid, lane); S.done(cur); }
#undef PG8_SA
#undef PG8_SB
#undef PG8_STAGE
#undef PG8_LDA
#undef PG8_LDB
#undef PG8_MMA
#undef PG8_WAIT_V
#undef PG8_WAIT_L
#undef PG8_BAR
#undef PG8_SCHED
}
}
constexpr int T = 8192, SEQ = 4096, D = 2048, NPROJ = 7168, NIN = 7176;
constexpr int NH = 4, DH = 256, LCH = 64, DML = 1024;
constexpr int NEXP = 16384, PEER_H = 8, TOPK = 16;
constexpr float EPS = 1e-6f;
constexpr int PC_CX = 0, PC_CB = 1024, PC_CC = 2048, PC_Q = 3072, PC_K = 4096, PC_V = 5120, PC_O = 6144;
constexpr int NTHREADS = 512, NWAVES = 8;
constexpr int LDS_BYTES = 147456;

constexpr size_t MiB = 1u << 20;
constexpr size_t WS_CTL = 0, CTL_ZERO_BYTES = 64 * 1024;
constexpr int CW_BAR = 1024;
constexpr size_t WS_RS1 = 1 * MiB, WS_GI = 1 * MiB + 64 * 1024, WS_GF = 1 * MiB + 256 * 1024, WS_SSQ = 3 * MiB, WS_ESC = 4 * MiB;
constexpr size_t WS_XB = 5 * MiB, WS_WINT = 37 * MiB, WS_WOUTT = 65 * MiB, WS_WQT = 73 * MiB;
constexpr size_t WS_PROJ = 81 * MiB;
constexpr size_t WS_X1 = 81 * MiB, WS_X1B = 145 * MiB;
constexpr size_t WS_HRAW = 193 * MiB, WS_MIXIN = 225 * MiB, WS_QV = 257 * MiB, WS_IDX = 321 * MiB, WS_GATE = 325 * MiB;
constexpr size_t WS_UB = 329 * MiB, WS_VB = 393 * MiB, WS_END = 457 * MiB;

struct Params {
    const float *x, *g1, *w_in, *b_ig, *b_fg, *conv_w, *gm, *w_out, *g2, *w_q, *sk1, *sk2, *eu, *ev, *gfin;
    float* out; unsigned char* ws;
    int ph_lo, ph_hi;
};

typedef unsigned short bf16_t;
__device__ __forceinline__ unsigned f2bf(float f) { unsigned u = __float_as_uint(f); return (u + 0x7fffu + ((u >> 16) & 1u)) >> 16; }
__device__ __forceinline__ unsigned pk2(float lo, float hi) { return f2bf(lo) | (f2bf(hi) << 16); }
__device__ __forceinline__ float bflo(unsigned w) { return __uint_as_float(w << 16); }
__device__ __forceinline__ float bfhi(unsigned w) { return __uint_as_float(w & 0xffff0000u); }
__device__ __forceinline__ float bf1(bf16_t h) { return __uint_as_float((unsigned)h << 16); }
__device__ __forceinline__ float wave_sum(float v) {
#pragma unroll
    for (int o = 32; o >= 1; o >>= 1) v += __shfl_xor(v, o);
    return v;
}
__device__ __forceinline__ void unpack8(const uint4 w, float (&f)[8]) {
    f[0] = bflo(w.x); f[1] = bfhi(w.x); f[2] = bflo(w.y); f[3] = bfhi(w.y); f[4] = bflo(w.z); f[5] = bfhi(w.z); f[6] = bflo(w.w); f[7] = bfhi(w.w);
}
__device__ __forceinline__ float log_sigmoid(float z) { return z >= 0.f ? -log1pf(expf(-z)) : z - log1pf(expf(z)); }
__device__ __forceinline__ float gelu_erf(float v) { return 0.5f * v * (1.0f + erff(v * 0.70710678118654752f)); }

__device__ __forceinline__ void p0_rows(const Params& P, unsigned char* lds, int G, int bid) {
    float* wg = (float*)lds;
    const int tid = threadIdx.x, lane = tid & 63, wave = tid >> 6;
    for (int i = tid; i < 8 * D; i += NTHREADS) { const int g = i >> 11, k = i & 2047; wg[i] = P.w_in[(size_t)k * NIN + NPROJ + g] * P.g1[k]; }
    __syncthreads();
    float* rs1 = (float*)(P.ws + WS_RS1); float* gi = (float*)(P.ws + WS_GI); float* gf = (float*)(P.ws + WS_GF); bf16_t* xb = (bf16_t*)(P.ws + WS_XB);
    for (int t = bid * NWAVES + wave; t < T; t += G * NWAVES) {
        const float4* xr = (const float4*)(P.x + (size_t)t * D);
        float ss = 0.f, dg[8];
#pragma unroll
        for (int g = 0; g < 8; ++g) dg[g] = 0.f;
#pragma unroll 1
        for (int j = 0; j < 8; ++j) {
            const float4 v = xr[j * 64 + lane];
            ss += (v.x * v.x + v.y * v.y) + (v.z * v.z + v.w * v.w);
            const int k0 = (j * 64 + lane) * 4;
#pragma unroll
            for (int g = 0; g < 8; ++g) { const float4 w = *(const float4*)(wg + g * D + k0); dg[g] += (v.x * w.x + v.y * w.y) + (v.z * w.z + v.w * w.w); }
            ((uint2*)(xb + (size_t)t * D))[j * 64 + lane] = make_uint2(pk2(v.x, v.y), pk2(v.z, v.w));
        }
        ss = wave_sum(ss);
#pragma unroll
        for (int g = 0; g < 8; ++g) dg[g] = wave_sum(dg[g]);
        const float rs = rsqrtf(ss * (1.0f / D) + EPS);
        if (lane == 0) {
            rs1[t] = rs;
#pragma unroll
            for (int h = 0; h < 4; ++h) { gi[t * 4 + h] = rs * dg[h] + P.b_ig[h]; gf[t * 4 + h] = log_sigmoid(rs * dg[4 + h] + P.b_fg[h]); }
        }
    }
    __syncthreads();
}
__device__ __forceinline__ void transpose_tile(const float* W, int ldw, int K, const float* gain, bf16_t* WT, int k0, int n0, float* tile) {
    const int tid = threadIdx.x;
#pragma unroll
    for (int r = 0; r < 2; ++r) {
        const int kk = (tid >> 4) + 32 * r, n4 = (tid & 15) * 4;
        float4 v = *(const float4*)(W + (size_t)(k0 + kk) * ldw + n0 + n4);
        const float g = gain ? gain[k0 + kk] : 1.0f;
        tile[kk * 65 + n4 + 0] = v.x * g; tile[kk * 65 + n4 + 1] = v.y * g; tile[kk * 65 + n4 + 2] = v.z * g; tile[kk * 65 + n4 + 3] = v.w * g;
    }
    __syncthreads();
    { const int nn = tid >> 3, k8 = (tid & 7) * 8; float f[8];
#pragma unroll
      for (int i = 0; i < 8; ++i) f[i] = tile[(k8 + i) * 65 + nn];
      *(uint4*)(WT + (size_t)(n0 + nn) * K + k0 + k8) = make_uint4(pk2(f[0], f[1]), pk2(f[2], f[3]), pk2(f[4], f[5]), pk2(f[6], f[7])); }
    __syncthreads();
}
__device__ __forceinline__ void p0_weights_in(const Params& P, unsigned char* lds, int G, int bid) {
    float* tile = (float*)lds;
    constexpr int N_IN = (D / 64) * (NPROJ / 64);
    for (int it = bid; it < N_IN; it += G) { const int kt = it / (NPROJ / 64), nt = it % (NPROJ / 64); transpose_tile(P.w_in, NIN, D, P.g1, (bf16_t*)(P.ws + WS_WINT), kt * 64, nt * 64, tile); }
}
__device__ __forceinline__ void p2_weights_sq(const Params& P, unsigned char* lds, int nworkers, int wid) {
    float* tile = (float*)lds;
    constexpr int N_SQ = (D / 64) * (D / 64);
    for (int it = wid; it < 2 * N_SQ; it += nworkers) {
        if (it < N_SQ) { const int kt = it / (D / 64), nt = it % (D / 64); transpose_tile(P.w_out, D, D, nullptr, (bf16_t*)(P.ws + WS_WOUTT), kt * 64, nt * 64, tile); }
        else { const int j = it - N_SQ, kt = j / (D / 64), nt = j % (D / 64); transpose_tile(P.w_q, D, D, P.g2, (bf16_t*)(P.ws + WS_WQT), kt * 64, nt * 64, tile); }
    }
}
typedef float f32x2_t __attribute__((ext_vector_type(2)));
__device__ __forceinline__ float wave_max(float v) {
#pragma unroll
    for (int o = 32; o >= 1; o >>= 1) v = fmaxf(v, __shfl_xor(v, o));
    return v;
}
__device__ __forceinline__ void p0_tables(const Params& P, int nworkers, int wid) {
    const int lane = threadIdx.x & 63, wave = threadIdx.x >> 6;
    float* esc = (float*)(P.ws + WS_ESC);
#pragma unroll 1
    for (int rix = wid * NWAVES + wave; rix < 2 * NEXP; rix += nworkers * NWAVES) {
        const int isv = rix & 1, e = rix >> 1;
        const float4* src = (const float4*)((isv ? P.ev : P.eu) + (size_t)e * D);
        unsigned* dst = (unsigned*)(P.ws + (isv ? WS_VB : WS_UB)) + (size_t)e * (D / 4);
        float4 v[8]; float mx = 0.f;
#pragma unroll
        for (int j = 0; j < 8; ++j) { v[j] = src[j * 64 + lane];
            if (!isv) { const float4 gg = ((const float4*)P.g2)[j * 64 + lane]; v[j].x *= gg.x; v[j].y *= gg.y; v[j].z *= gg.z; v[j].w *= gg.w; }
            mx = fmaxf(mx, fmaxf(fmaxf(fabsf(v[j].x), fabsf(v[j].y)), fmaxf(fabsf(v[j].z), fabsf(v[j].w)))); }
        mx = wave_max(mx);
        const float sc = mx > 0.f ? 240.0f / mx : 1.0f, inv = mx > 0.f ? mx * (1.0f / 240.0f) : 1.0f;
#pragma unroll
        for (int j = 0; j < 8; ++j) { int pk = __builtin_amdgcn_cvt_pk_fp8_f32(v[j].x * sc, v[j].y * sc, 0, false); pk = __builtin_amdgcn_cvt_pk_fp8_f32(v[j].z * sc, v[j].w * sc, pk, true); dst[j * 64 + lane] = (unsigned)pk; }
        if (lane == 0) esc[e * 2 + isv] = inv;
    }
}

__device__ __forceinline__ void p2_conv(const Params& P, int nworkers, int wid) {
    const bf16_t* proj = (const bf16_t*)(P.ws + WS_PROJ); bf16_t* mix = (bf16_t*)(P.ws + WS_MIXIN);
    for (int idx = wid * NTHREADS + threadIdx.x; idx < T * 128; idx += nworkers * NTHREADS) {
        const int t = idx >> 7, c8 = (idx & 127) * 8, s = t & (SEQ - 1);
        float y[8];
#pragma unroll
        for (int i = 0; i < 8; ++i) y[i] = 0.f;
#pragma unroll
        for (int j = 0; j < 3; ++j) {
            const int dt = 2 - j;
            if (s >= dt) {
                const bf16_t* row = proj + (size_t)(t - dt) * NPROJ;
                float cx[8], cc[8]; unpack8(*(const uint4*)(row + PC_CX + c8), cx); unpack8(*(const uint4*)(row + PC_CC + c8), cc);
                const float4 w0 = *(const float4*)(P.conv_w + j * 1024 + c8), w1 = *(const float4*)(P.conv_w + j * 1024 + c8 + 4);
                y[0] += w0.x * (cc[0] * cx[0]); y[1] += w0.y * (cc[1] * cx[1]); y[2] += w0.z * (cc[2] * cx[2]); y[3] += w0.w * (cc[3] * cx[3]);
                y[4] += w1.x * (cc[4] * cx[4]); y[5] += w1.y * (cc[5] * cx[5]); y[6] += w1.z * (cc[6] * cx[6]); y[7] += w1.w * (cc[7] * cx[7]);
            }
        }
        float cb[8]; unpack8(*(const uint4*)(proj + (size_t)t * NPROJ + PC_CB + c8), cb);
        *(uint4*)(mix + (size_t)t * D + c8) = make_uint4(pk2(cb[0] * y[0], cb[1] * y[1]), pk2(cb[2] * y[2], cb[3] * y[3]), pk2(cb[4] * y[4], cb[5] * y[5]), pk2(cb[6] * y[6], cb[7] * y[7]));
    }
}
#define LAS3 __attribute__((address_space(3)))
typedef short s16x4_t __attribute__((ext_vector_type(4)));
typedef unsigned v4u_t __attribute__((ext_vector_type(4)));
typedef unsigned v2u_t __attribute__((ext_vector_type(2)));
__device__ __forceinline__ pg8::bf16x8 tr8(LAS3 unsigned char* p0, LAS3 unsigned char* p1) {
    const s16x4_t a = __builtin_amdgcn_ds_read_tr16_b64_v4i16((LAS3 s16x4_t*)p0), b = __builtin_amdgcn_ds_read_tr16_b64_v4i16((LAS3 s16x4_t*)p1);
    return __builtin_shufflevector(a, b, 0, 1, 2, 3, 4, 5, 6, 7);
}
__device__ __forceinline__ void mlstm_unit(const Params& P, unsigned char* lds_, int unit) {
    typedef pg8::bf16x8 bf16x8; typedef pg8::f32x4 f32x4;
    LAS3 unsigned char* L = (LAS3 unsigned char*)lds_;
    constexpr int QS = 0, KS = 33792, VA = 67584, WV = 73728, SW = 79872, CB = 89088, SM = 114432;
    constexpr int QST = 528, VST = 96, SST = 144;
    LAS3 float* sA = (LAS3 float*)(L + SM); LAS3 float* sM = sA + 64; LAS3 float* sEi = sA + 128; LAS3 float* sWl = sA + 192; LAS3 float* sEnm = sA + 256; LAS3 float* sDen = sA + 320; LAS3 float* sMisc = sA + 384;
    const int tid = threadIdx.x, lane = tid & 63, wave = __builtin_amdgcn_readfirstlane(tid >> 6);
    const int g = lane >> 4, c16 = lane & 15, q4 = c16 >> 2, p4 = lane & 3;
    const int bh = unit >> 3, sl = unit & 7, b = bh >> 2, h = bh & 3, v0 = sl * 32;
    const bf16_t* proj = (const bf16_t*)(P.ws + WS_PROJ);
    const float* gi = (const float*)(P.ws + WS_GI); const float* gf = (const float*)(P.ws + WS_GF);
    float* hraw = (float*)(P.ws + WS_HRAW);
    for (int i = tid; i < 25344 / 16; i += NTHREADS) *(LAS3 v4u_t*)(L + CB + i * 16) = (v4u_t){0u, 0u, 0u, 0u};
    if (tid < 64) { *(LAS3 v4u_t*)(L + VA + tid * VST + 64) = (v4u_t){0x00003F80u, 0u, 0u, 0u}; *(LAS3 v4u_t*)(L + VA + tid * VST + 80) = (v4u_t){0u, 0u, 0u, 0u}; }
    f32x4 accC[2][3];
#pragma unroll
    for (int dt = 0; dt < 2; ++dt)
#pragma unroll
        for (int vt = 0; vt < 3; ++vt) accC[dt][vt] = (f32x4){0.f, 0.f, 0.f, 0.f};
    float m = 0.f;
    const int row = tid >> 3, seg = tid & 7;
    v4u_t rq[4], rk[4], rv = (v4u_t){0u, 0u, 0u, 0u};
    float pa = 0.f, pP = 0.f, pb = 0.f, nic = 0.f, nfc = 0.f, fic = 0.f, ffc = 0.f;
#define MLSTM_SCAN(ic_, fc_) do { float bc_ = (fc_); _Pragma("unroll") for (int o = 1; o < 64; o <<= 1) { const float tv = __shfl_up(bc_, o); if (lane >= o) bc_ += tv; } \
        const float a_ = (ic_) - bc_; float pm_ = a_; _Pragma("unroll") for (int o = 1; o < 64; o <<= 1) { const float tv = __shfl_up(pm_, o); if (lane >= o) pm_ = fmaxf(pm_, tv); } pa = a_; pP = pm_; pb = bc_; } while (0)
    { const int t0 = b * SEQ; const bf16_t* src = proj + (size_t)(t0 + row) * NPROJ + h * DH + seg * 32;
#pragma unroll
      for (int i = 0; i < 4; ++i) { rq[i] = *(const v4u_t*)(src + PC_Q + i * 8); rk[i] = *(const v4u_t*)(src + PC_K + i * 8); }
      if (tid < 256) rv = *(const v4u_t*)(proj + (size_t)(t0 + (tid >> 2)) * NPROJ + PC_V + h * DH + v0 + (tid & 3) * 8);
      if (wave == 1) { const float ic0 = gi[(size_t)(t0 + lane) * 4 + h], fc0 = gf[(size_t)(t0 + lane) * 4 + h]; MLSTM_SCAN(ic0, fc0);
          fic = gi[(size_t)(t0 + LCH + lane) * 4 + h]; ffc = gf[(size_t)(t0 + LCH + lane) * 4 + h]; } }
    __syncthreads();
#pragma unroll 1
    for (int c = 0; c < SEQ / LCH; ++c) {
        const int t0 = b * SEQ + c * LCH;
#pragma unroll
        for (int i = 0; i < 4; ++i) { *(LAS3 v4u_t*)(L + QS + row * QST + seg * 64 + i * 16) = rq[i]; *(LAS3 v4u_t*)(L + KS + row * QST + seg * 64 + i * 16) = rk[i]; }
        if (tid < 256) *(LAS3 v4u_t*)(L + VA + (tid >> 2) * VST + (tid & 3) * 16) = rv;
        if (wave == 1) {
            const float M = fmaxf(m, pP), M63 = __shfl(M, 63), b63 = __shfl(pb, 63);
            sA[lane] = pa; sM[lane] = M; sEi[lane] = __expf(m - M); sWl[lane] = __expf(pa - M63) * 0.0625f; sEnm[lane] = __expf(-pb - M);
            if (lane == 0) { sMisc[0] = b63 + M63; sMisc[1] = __expf(m - M63); }
            nic = fic; nfc = ffc;
            if (c + 2 < SEQ / LCH) { fic = gi[(size_t)(t0 + 2 * LCH + lane) * 4 + h]; ffc = gf[(size_t)(t0 + 2 * LCH + lane) * 4 + h]; }
        }
        if (c + 1 < SEQ / LCH) { const int t1 = t0 + LCH; const bf16_t* src = proj + (size_t)(t1 + row) * NPROJ + h * DH + seg * 32;
#pragma unroll
            for (int i = 0; i < 4; ++i) { rq[i] = *(const v4u_t*)(src + PC_Q + i * 8); rk[i] = *(const v4u_t*)(src + PC_K + i * 8); }
            if (tid < 256) rv = *(const v4u_t*)(proj + (size_t)(t1 + (tid >> 2)) * NPROJ + PC_V + h * DH + v0 + (tid & 3) * 8); }
        __syncthreads();
        { const int rt = wave >> 1;
#pragma unroll
          for (int cc = 0; cc < 2; ++cc) { const int ct = (wave & 1) * 2 + cc; f32x4 acc = (f32x4){0.f, 0.f, 0.f, 0.f};
              if (ct <= rt) {
#pragma unroll
                  for (int ks = 0; ks < 8; ++ks) { const bf16x8 av = *(LAS3 bf16x8*)(L + QS + (rt * 16 + c16) * QST + (ks * 32 + g * 8) * 2), bv = *(LAS3 bf16x8*)(L + KS + (ct * 16 + c16) * QST + (ks * 32 + g * 8) * 2);
                      acc = __builtin_amdgcn_mfma_f32_16x16x32_bf16(av, bv, acc, 0, 0, 0); } }
              const int l = ct * 16 + c16; const float al = sA[l]; const f32x4 M4 = *(LAS3 f32x4*)(sM + rt * 16 + 4 * g);
#pragma unroll
              for (int r = 0; r < 4; ++r) { const int j = rt * 16 + 4 * g + r; const float val = (l <= j) ? acc[r] * 0.0625f * __expf(al - M4[r]) : 0.f;
                  *(LAS3 unsigned short*)(L + SW + j * SST + l * 2) = (unsigned short)f2bf(val); } } }
        if (wave == 1 && c + 1 < SEQ / LCH) MLSTM_SCAN(nic, nfc);
#pragma unroll
        for (int i = 0; i < 6; ++i) { const int e = tid + NTHREADS * i, l = e / 48, vp = e - l * 48;
            *(LAS3 unsigned short*)(L + WV + l * VST + vp * 2) = (unsigned short)f2bf(sWl[l] * bf1(*(LAS3 unsigned short*)(L + VA + l * VST + vp * 2))); }
        __syncthreads();
        const int rt = wave >> 1, vt = wave & 1;
        f32x4 num;
        { f32x4 accI = (f32x4){0.f, 0.f, 0.f, 0.f}, accX = (f32x4){0.f, 0.f, 0.f, 0.f};
#pragma unroll
          for (int ks = 0; ks < 8; ++ks) { const bf16x8 av = *(LAS3 bf16x8*)(L + QS + (rt * 16 + c16) * QST + (ks * 32 + g * 8) * 2), bv = *(LAS3 bf16x8*)(L + CB + (vt * 16 + c16) * QST + (ks * 32 + g * 8) * 2);
              accI = __builtin_amdgcn_mfma_f32_16x16x32_bf16(av, bv, accI, 0, 0, 0); }
#pragma unroll
          for (int ks = 0; ks < 2; ++ks) { const bf16x8 av = *(LAS3 bf16x8*)(L + SW + (rt * 16 + c16) * SST + (ks * 32 + g * 8) * 2);
              LAS3 unsigned char* vp = L + VA + (ks * 32 + g * 8 + q4) * VST + (vt * 16 + 4 * p4) * 2; const bf16x8 bv = tr8(vp, vp + 4 * VST);
              accX = __builtin_amdgcn_mfma_f32_16x16x32_bf16(av, bv, accX, 0, 0, 0); }
          const f32x4 e4 = *(LAS3 f32x4*)(sEi + rt * 16 + 4 * g);
          num = e4 * accI + accX;
          if ((wave & 1) == 0) {
              f32x4 aI = (f32x4){0.f, 0.f, 0.f, 0.f}, aX = (f32x4){0.f, 0.f, 0.f, 0.f};
#pragma unroll
              for (int ks = 0; ks < 8; ++ks) { const bf16x8 av = *(LAS3 bf16x8*)(L + QS + (rt * 16 + c16) * QST + (ks * 32 + g * 8) * 2), bv = *(LAS3 bf16x8*)(L + CB + (32 + c16) * QST + (ks * 32 + g * 8) * 2);
                  aI = __builtin_amdgcn_mfma_f32_16x16x32_bf16(av, bv, aI, 0, 0, 0); }
#pragma unroll
              for (int ks = 0; ks < 2; ++ks) { const bf16x8 av = *(LAS3 bf16x8*)(L + SW + (rt * 16 + c16) * SST + (ks * 32 + g * 8) * 2);
                  LAS3 unsigned char* vp = L + VA + (ks * 32 + g * 8 + q4) * VST + (32 + 4 * p4) * 2; const bf16x8 bv = tr8(vp, vp + 4 * VST);
                  aX = __builtin_amdgcn_mfma_f32_16x16x32_bf16(av, bv, aX, 0, 0, 0); }
              if (c16 == 0) {
#pragma unroll
                  for (int r = 0; r < 4; ++r) { const int j = rt * 16 + 4 * g + r; sDen[j] = fmaxf(fabsf(e4[r] * aI[r] + aX[r]), sEnm[j]); } }
          } }
        __syncthreads();
        { const f32x4 d4 = *(LAS3 f32x4*)(sDen + rt * 16 + 4 * g);
#pragma unroll
          for (int r = 0; r < 4; ++r) hraw[(size_t)(t0 + rt * 16 + 4 * g + r) * DML + h * DH + v0 + vt * 16 + c16] = __fdividef(num[r], d4[r]); }
        { const float decay = sMisc[1];
#pragma unroll
          for (int dt = 0; dt < 2; ++dt)
#pragma unroll
              for (int v3 = 0; v3 < 3; ++v3) accC[dt][v3] *= decay;
#pragma unroll
          for (int ks = 0; ks < 2; ++ks) { bf16x8 af[2], bfr[3];
#pragma unroll
              for (int dt = 0; dt < 2; ++dt) { LAS3 unsigned char* kp = L + KS + (ks * 32 + g * 8 + q4) * QST + ((2 * wave + dt) * 16 + 4 * p4) * 2; af[dt] = tr8(kp, kp + 4 * QST); }
#pragma unroll
              for (int v3 = 0; v3 < 3; ++v3) { LAS3 unsigned char* wp = L + WV + (ks * 32 + g * 8 + q4) * VST + (v3 * 16 + 4 * p4) * 2; bfr[v3] = tr8(wp, wp + 4 * VST); }
#pragma unroll
              for (int dt = 0; dt < 2; ++dt)
#pragma unroll
                  for (int v3 = 0; v3 < 3; ++v3) accC[dt][v3] = __builtin_amdgcn_mfma_f32_16x16x32_bf16(af[dt], bfr[v3], accC[dt][v3], 0, 0, 0); }
#pragma unroll
          for (int dt = 0; dt < 2; ++dt)
#pragma unroll
              for (int v3 = 0; v3 < 3; ++v3) { const int d = (2 * wave + dt) * 16 + 4 * g, vp = v3 * 16 + c16;
                  *(LAS3 v2u_t*)(L + CB + vp * QST + d * 2) = (v2u_t){pk2(accC[dt][v3][0], accC[dt][v3][1]), pk2(accC[dt][v3][2], accC[dt][v3][3])}; }
          m = sMisc[0]; }
        __syncthreads();
    }
#undef MLSTM_SCAN
}

__device__ __forceinline__ void p3_finalize(const Params& P, int G, int bid) {
    const int lane = threadIdx.x & 63, wave = threadIdx.x >> 6;
    const float* hraw = (const float*)(P.ws + WS_HRAW); const bf16_t* proj = (const bf16_t*)(P.ws + WS_PROJ); bf16_t* mix = (bf16_t*)(P.ws + WS_MIXIN);
    for (int idx = bid * NWAVES + wave; idx < T * NH; idx += G * NWAVES) {
        const int t = idx >> 2, hh = idx & 3;
        const float4 hv = *(const float4*)(hraw + (size_t)t * DML + hh * DH + lane * 4);
        const float ss = wave_sum((hv.x * hv.x + hv.y * hv.y) + (hv.z * hv.z + hv.w * hv.w));
        const float r = rsqrtf(ss * (1.0f / DH) + EPS);
        const uint2 ow = *(const uint2*)(proj + (size_t)t * NPROJ + PC_O + hh * DH + lane * 4);
        const float4 g = *(const float4*)(P.gm + hh * DH + lane * 4);
        const float o0 = 1.0f / (1.0f + expf(-bflo(ow.x))), o1 = 1.0f / (1.0f + expf(-bfhi(ow.x))), o2 = 1.0f / (1.0f + expf(-bflo(ow.y))), o3 = 1.0f / (1.0f + expf(-bfhi(ow.y)));
        *(uint2*)(mix + (size_t)t * D + DML + hh * DH + lane * 4) = make_uint2(pk2(o0 * (hv.x * r * g.x), o1 * (hv.y * r * g.y)), pk2(o2 * (hv.z * r * g.z), o3 * (hv.w * r * g.w)));
    }
}

template <int CTRL> __device__ __forceinline__ float dppf(float v) { return __int_as_float(__builtin_amdgcn_update_dpp(0, __float_as_int(v), CTRL, 0xF, 0xF, true)); }
__device__ __forceinline__ float grp16_max(float v) { v = fmaxf(v, dppf<0xB1>(v)); v = fmaxf(v, dppf<0x4E>(v)); v = fmaxf(v, dppf<0x141>(v)); v = fmaxf(v, dppf<0x140>(v)); return v; }
__device__ __forceinline__ float grp16_sum(float v) { v += dppf<0xB1>(v); v += dppf<0x4E>(v); v += dppf<0x141>(v); v += dppf<0x140>(v); return v; }
#define CEX(a, b) do { const float hi_ = fmaxf(a, b), lo_ = fminf(a, b); a = hi_; b = lo_; } while (0)
static __device__ const unsigned char CAND_AB[16][4] = {
    {0x00, 0x01, 0x02, 0x03}, {0x04, 0x05, 0x06, 0x07}, {0x08, 0x09, 0x0A, 0x0B}, {0x0C, 0x0D, 0x0E, 0x0F}, {0x10, 0x11, 0x12, 0x13}, {0x14, 0x15, 0x16, 0x17}, {0x20, 0x21, 0x22, 0x23}, {0x24, 0, 0, 0},
    {0x30, 0x31, 0x32, 0x33}, {0x40, 0x41, 0x42, 0}, {0x50, 0x60, 0x70, 0x80}, {0x90, 0xA0, 0xB0, 0xC0}, {0xD0, 0xE0, 0xF0, 0}, {0x51, 0x61, 0x71, 0}, {0, 0, 0, 0}, {0, 0, 0, 0}};
static __device__ const unsigned char CAND_N[16] = {4, 4, 4, 4, 4, 4, 4, 1, 4, 3, 4, 4, 3, 3, 0, 0};
__device__ __forceinline__ void p6_topk(const Params& P, unsigned char* lds_, int G, int bid) {
    typedef pg8::bf16x8 bf16x8; typedef pg8::f32x4 f32x4;
    LAS3 unsigned char* L = (LAS3 unsigned char*)lds_;
    constexpr int KST = 272, KHALF = 128 * KST;
    const int tid = threadIdx.x, lane = tid & 63, wave = tid >> 6, g = lane >> 4, c16 = lane & 15;
    for (int i = tid; i < 2 * 2048; i += NTHREADS) { const int hf = i >> 11, n = (i >> 4) & 127, d8 = (i & 15) * 8; const float* src = (hf ? P.sk2 : P.sk1) + n * 128 + d8;
        const float4 a = *(const float4*)src, b = *(const float4*)(src + 4);
        *(LAS3 v4u_t*)(L + hf * KHALF + n * KST + d8 * 2) = (v4u_t){pk2(a.x, a.y), pk2(a.z, a.w), pk2(b.x, b.y), pk2(b.z, b.w)}; }
    __syncthreads();
    const bf16_t* qvb = (const bf16_t*)(P.ws + WS_QV);
    int* idxo = (int*)(P.ws + WS_IDX); float* gato = (float*)(P.ws + WS_GATE);
    const float NEGINF = -__builtin_inff();
    unsigned ctab = 0; { const unsigned char* tp = CAND_AB[c16]; ctab = (unsigned)tp[0] | ((unsigned)tp[1] << 8) | ((unsigned)tp[2] << 16) | ((unsigned)tp[3] << 24); }
    const int ccnt = CAND_N[c16];
#pragma unroll 1
    for (int it = bid * NWAVES + wave; it < (T / 16) * PEER_H; it += G * NWAVES) {
        const int t0 = (it >> 3) * 16, hh = it & 7;
        float keepH[2][4];
#pragma unroll
        for (int hf = 0; hf < 2; ++hf) {
            asm volatile("" ::: "memory");
            bf16x8 af[4];
#pragma unroll
            for (int ks = 0; ks < 4; ++ks) af[ks] = *(const bf16x8*)(qvb + (size_t)(t0 + c16) * D + hh * 256 + hf * 128 + ks * 32 + g * 8);
            f32x4 acc[8];
#pragma unroll
            for (int ct = 0; ct < 8; ++ct) { acc[ct] = (f32x4){0.f, 0.f, 0.f, 0.f};
#pragma unroll
                for (int ks = 0; ks < 4; ++ks) { const bf16x8 bv = *(LAS3 bf16x8*)(L + hf * KHALF + (ct * 16 + c16) * KST + (ks * 32 + g * 8) * 2);
                    acc[ct] = __builtin_amdgcn_mfma_f32_16x16x32_bf16(af[ks], bv, acc[ct], 0, 0, 0); } }
            float v[4][8];
#pragma unroll
            for (int r = 0; r < 4; ++r) {
#pragma unroll
                for (int ct = 0; ct < 8; ++ct) v[r][ct] = __uint_as_float((__float_as_uint(acc[ct][r]) & ~127u) | (unsigned)(127 - (ct * 16 + c16)));
                CEX(v[r][0], v[r][1]); CEX(v[r][2], v[r][3]); CEX(v[r][4], v[r][5]); CEX(v[r][6], v[r][7]);
                CEX(v[r][0], v[r][2]); CEX(v[r][1], v[r][3]); CEX(v[r][4], v[r][6]); CEX(v[r][5], v[r][7]);
                CEX(v[r][1], v[r][2]); CEX(v[r][5], v[r][6]); CEX(v[r][0], v[r][4]); CEX(v[r][3], v[r][7]);
                CEX(v[r][1], v[r][5]); CEX(v[r][2], v[r][6]);
                CEX(v[r][1], v[r][4]); CEX(v[r][3], v[r][6]);
                CEX(v[r][2], v[r][4]); CEX(v[r][3], v[r][5]);
                CEX(v[r][3], v[r][4]);
                keepH[hf][r] = 0.f;
            }
#pragma unroll
            for (int rd = 0; rd < TOPK; ++rd) {
#pragma unroll
                for (int r = 0; r < 4; ++r) {
                    const float W = grp16_max(v[r][0]); const bool win = (v[r][0] == W);
                    if (c16 == rd) keepH[hf][r] = W;
#pragma unroll
                    for (int k = 0; k < 7; ++k) v[r][k] = win ? v[r][k + 1] : v[r][k];
                    v[r][7] = win ? NEGINF : v[r][7];
                }
            }
        }
#pragma unroll
        for (int r = 0; r < 4; ++r) {
            const float V1 = keepH[0][r], V2 = keepH[1][r];
            float cv[4];
#pragma unroll
            for (int s4 = 0; s4 < 4; ++s4) { const unsigned code = (ctab >> (8 * s4)) & 255u;
                const float x1 = __shfl(V1, g * 16 + (int)(code >> 4)), x2 = __shfl(V2, g * 16 + (int)(code & 15u));
                const float sum = __uint_as_float(__float_as_uint(x1) & ~127u) + __uint_as_float(__float_as_uint(x2) & ~127u);
                cv[s4] = (s4 < ccnt) ? __uint_as_float((__float_as_uint(sum) & ~255u) | (255u - code)) : NEGINF; }
            float keepc = 0.f;
#pragma unroll
            for (int rd = 0; rd < TOPK; ++rd) {
                const float W = grp16_max(cv[0]); const bool win = (cv[0] == W);
                if (c16 == rd) keepc = W;
                cv[0] = win ? cv[1] : cv[0]; cv[1] = win ? cv[2] : cv[1]; cv[2] = win ? cv[3] : cv[2]; cv[3] = win ? NEGINF : cv[3];
            }
            const unsigned kb = __float_as_uint(keepc), code = 255u - (kb & 255u);
            const unsigned n1 = 127u - (__float_as_uint(__shfl(V1, g * 16 + (int)(code >> 4))) & 127u), n2 = 127u - (__float_as_uint(__shfl(V2, g * 16 + (int)(code & 15u))) & 127u);
            const float sval = __uint_as_float(kb & ~255u), smax = __shfl(sval, g * 16);
            const float ex = __expf(sval - smax), den = grp16_sum(ex);
            const size_t o = (size_t)(t0 + 4 * g + r) * 128 + hh * 16 + c16;
            idxo[o] = (int)(n1 * 128u + n2); gato[o] = ex / den;
        }
    }
    __syncthreads();
}

__device__ __forceinline__ float wave_sum_dpp(float v) {
    v += dppf<0xB1>(v); v += dppf<0x4E>(v); v += dppf<0x141>(v); v += dppf<0x140>(v);
    const int iv = __float_as_int(v);
    return (__int_as_float(__builtin_amdgcn_readlane(iv, 0)) + __int_as_float(__builtin_amdgcn_readlane(iv, 16))) + (__int_as_float(__builtin_amdgcn_readlane(iv, 32)) + __int_as_float(__builtin_amdgcn_readlane(iv, 48)));
}
__device__ __forceinline__ float dot16_fp8(const v4u_t w, const float (&x)[16]) {
    float s = 0.f;
#pragma unroll
    for (int k = 0; k < 4; ++k) { const f32x2_t lo = __builtin_amdgcn_cvt_pk_f32_fp8(w[k], false), hi = __builtin_amdgcn_cvt_pk_f32_fp8(w[k], true);
        s += (x[4 * k] * lo.x + x[4 * k + 1] * lo.y) + (x[4 * k + 2] * hi.x + x[4 * k + 3] * hi.y); }
    return s;
}
__device__ __forceinline__ void axpy16_fp8(const v4u_t w, const float cf, float (&y)[16]) {
#pragma unroll
    for (int k = 0; k < 4; ++k) { const f32x2_t lo = __builtin_amdgcn_cvt_pk_f32_fp8(w[k], false), hi = __builtin_amdgcn_cvt_pk_f32_fp8(w[k], true);
        y[4 * k] += cf * lo.x; y[4 * k + 1] += cf * lo.y; y[4 * k + 2] += cf * hi.x; y[4 * k + 3] += cf * hi.y; }
}
#define PIN16(a) asm volatile("" : "+v"(a[0]), "+v"(a[1]), "+v"(a[2]), "+v"(a[3]), "+v"(a[4]), "+v"(a[5]), "+v"(a[6]), "+v"(a[7]), "+v"(a[8]), "+v"(a[9]), "+v"(a[10]), "+v"(a[11]), "+v"(a[12]), "+v"(a[13]), "+v"(a[14]), "+v"(a[15]))
__device__ __forceinline__ float row16_sum(float v) { v += dppf<0xB1>(v); v += dppf<0x4E>(v); v += dppf<0x141>(v); v += dppf<0x140>(v); return v; }
__device__ __forceinline__ void p7_peer(const Params& P, unsigned char* lds_, int G, int bid) {
    const int lane = threadIdx.x & 63, wave = __builtin_amdgcn_readfirstlane(threadIdx.x >> 6);
    LAS3 unsigned char* W = (LAS3 unsigned char*)lds_ + wave * 8192;
    const bf16_t* x1b = (const bf16_t*)(P.ws + WS_X1B); const float* x1 = (const float*)(P.ws + WS_X1); const float* ssq = (const float*)(P.ws + WS_SSQ);
    const int* idxi = (const int*)(P.ws + WS_IDX); const float* gati = (const float*)(P.ws + WS_GATE);
    const unsigned char* ub = P.ws + WS_UB; const unsigned char* vb = P.ws + WS_VB; const float* esc = (const float*)(P.ws + WS_ESC);
#pragma unroll 1
    for (int qd = bid * NWAVES + wave; qd < T / 4; qd += G * NWAVES) {
        int ln = lane; asm volatile("" : "+v"(ln));
        const int tb = qd * 4, q = ln >> 4, l16 = ln & 15, t = tb + q;
        const unsigned loff = (unsigned)l16 * 16u;
#pragma unroll 1
        for (int s4 = 0; s4 < 4; ++s4) {
            LAS3 int* hist = (LAS3 int*)(W + 4096); LAS3 int* base = (LAS3 int*)(W + 4096 + 256); LAS3 v2u_t* list = (LAS3 v2u_t*)(W + s4 * 1024);
            const size_t o = (size_t)(tb + s4) * 128 + ln;
            const int i0 = idxi[o], i1 = idxi[o + 64]; const float g0 = gati[o], g1 = gati[o + 64];
            hist[ln] = 0; asm volatile("s_waitcnt lgkmcnt(0)" ::: "memory");
            const int t0_ = __hip_atomic_fetch_add((int*)(hist + (i0 >> 8)), 1, __ATOMIC_RELAXED, __HIP_MEMORY_SCOPE_WORKGROUP);
            const int t1_ = __hip_atomic_fetch_add((int*)(hist + (i1 >> 8)), 1, __ATOMIC_RELAXED, __HIP_MEMORY_SCOPE_WORKGROUP);
            asm volatile("s_waitcnt lgkmcnt(0)" ::: "memory");
            const int cnt = hist[ln]; int inc = cnt;
#pragma unroll
            for (int o2 = 1; o2 < 64; o2 <<= 1) { const int tv = __shfl_up(inc, o2); if (ln >= o2) inc += tv; }
            base[ln] = inc - cnt; asm volatile("s_waitcnt lgkmcnt(0)" ::: "memory");
            list[base[i0 >> 8] + t0_] = (v2u_t){(unsigned)i0, __float_as_uint(g0)}; list[base[i1 >> 8] + t1_] = (v2u_t){(unsigned)i1, __float_as_uint(g1)};
            asm volatile("s_waitcnt lgkmcnt(0)" ::: "memory");
        }
        LAS3 v2u_t* mylist = (LAS3 v2u_t*)(W + q * 1024); LAS3 float* mydot = (LAS3 float*)(W + 4096 + q * 512);
        const float rs2 = rsqrtf(row16_sum(ssq[(size_t)t * 32 + l16] + ssq[(size_t)t * 32 + 16 + l16]) * (1.0f / D) + EPS);
        v4u_t bA[8], bB[8];
#define P7_LOADQ(TAB, j, Bf) do { const unsigned e_ = mylist[j].x; const unsigned char* rp = (TAB) + (size_t)e_ * D + loff; \
            _Pragma("unroll") for (int jj = 0; jj < 8; ++jj) Bf[jj] = *(const v4u_t*)(rp + jj * 256); } while (0)
        {
            float xf[8][16];
#pragma unroll
            for (int jj = 0; jj < 8; ++jj) { float a[8], b[8]; unpack8(*(const uint4*)(x1b + (size_t)t * D + jj * 256 + l16 * 16), a); unpack8(*(const uint4*)(x1b + (size_t)t * D + jj * 256 + l16 * 16 + 8), b);
#pragma unroll
                for (int i = 0; i < 8; ++i) { xf[jj][i] = a[i]; xf[jj][8 + i] = b[i]; } }
#define P7_DOTQ(j, Bf) do { float sacc = 0.f; _Pragma("unroll") for (int jj = 0; jj < 8; ++jj) { asm volatile("" : "+v"(Bf[jj])); sacc += dot16_fp8(Bf[jj], xf[jj]); } \
            const float tot = row16_sum(sacc); if (l16 == 0) mydot[j] = tot; } while (0)
            P7_LOADQ(ub, 0, bA);
#pragma unroll 1
            for (int j = 0; j < 126; j += 2) { P7_LOADQ(ub, j + 1, bB); P7_DOTQ(j, bA); P7_LOADQ(ub, j + 2, bA); P7_DOTQ(j + 1, bB); }
            P7_LOADQ(ub, 127, bB); P7_DOTQ(126, bA); P7_LOADQ(vb, 0, bA); P7_DOTQ(127, bB);
#undef P7_DOTQ
        }
        asm volatile("s_waitcnt lgkmcnt(0)" ::: "memory");
        { const float r0 = __int_as_float(__builtin_amdgcn_readlane(__float_as_int(rs2), 0)), r1 = __int_as_float(__builtin_amdgcn_readlane(__float_as_int(rs2), 16)),
                      r2 = __int_as_float(__builtin_amdgcn_readlane(__float_as_int(rs2), 32)), r3 = __int_as_float(__builtin_amdgcn_readlane(__float_as_int(rs2), 48));
#pragma unroll
          for (int k = 0; k < 8; ++k) { const int n = k * 64 + ln; const v2u_t en = *(LAS3 v2u_t*)(W + n * 8); LAS3 float* dp = (LAS3 float*)(W + 4096 + n * 4);
              const float rr = (k >> 1) == 0 ? r0 : (k >> 1) == 1 ? r1 : (k >> 1) == 2 ? r2 : r3; const float su = esc[en.x * 2], sv = esc[en.x * 2 + 1];
              *dp = __uint_as_float(en.y) * gelu_erf(*dp * rr * su) * sv; } }
        asm volatile("s_waitcnt lgkmcnt(0)" ::: "memory");
        float y[8][16];
#pragma unroll
        for (int jj = 0; jj < 8; ++jj)
#pragma unroll
            for (int i = 0; i < 16; ++i) y[jj][i] = 0.f;
#define P7_AXQ(j, Bf) do { const float cf = mydot[j]; _Pragma("unroll") for (int jj = 0; jj < 8; ++jj) { asm volatile("" : "+v"(Bf[jj])); axpy16_fp8(Bf[jj], cf, y[jj]); PIN16(y[jj]); } } while (0)
#pragma unroll 1
        for (int j = 0; j < 126; j += 2) { P7_LOADQ(vb, j + 1, bB); P7_AXQ(j, bA); P7_LOADQ(vb, j + 2, bA); P7_AXQ(j + 1, bB); }
        P7_LOADQ(vb, 127, bB); P7_AXQ(126, bA); P7_AXQ(127, bB);
#undef P7_AXQ
#undef P7_LOADQ
#undef PIN16
        float ss = 0.f;
#pragma unroll
        for (int jj = 0; jj < 8; ++jj)
#pragma unroll
            for (int k = 0; k < 4; ++k) { const float4 a = *(const float4*)(x1 + (size_t)t * D + jj * 256 + l16 * 16 + 4 * k);
                y[jj][4 * k] += a.x; y[jj][4 * k + 1] += a.y; y[jj][4 * k + 2] += a.z; y[jj][4 * k + 3] += a.w;
                ss += (y[jj][4 * k] * y[jj][4 * k] + y[jj][4 * k + 1] * y[jj][4 * k + 1]) + (y[jj][4 * k + 2] * y[jj][4 * k + 2] + y[jj][4 * k + 3] * y[jj][4 * k + 3]); }
        ss = row16_sum(ss);
        const float r = rsqrtf(ss * (1.0f / D) + EPS);
#pragma unroll
        for (int jj = 0; jj < 8; ++jj)
#pragma unroll
            for (int k = 0; k < 4; ++k) { const float4 gg = *(const float4*)(P.gfin + jj * 256 + l16 * 16 + 4 * k);
                *(float4*)(P.out + (size_t)t * D + jj * 256 + l16 * 16 + 4 * k) = make_float4(y[jj][4 * k] * r * gg.x, y[jj][4 * k + 1] * r * gg.y, y[jj][4 * k + 2] * r * gg.z, y[jj][4 * k + 3] * r * gg.w); }
    }
}

#define XB_TMO      128
#define XB_XCNT(j)  (256  + 64 * (j))
#define XB_XSUB(j)  (1280 + 64 * (j))
#define XB_XGEN(j)  (2304 + 64 * (j))
#define XB_TOP      3328
#define XB_TOPGEN   3392
#define XCD_BAR_WORDS 3456
#define XB_SPIN_CAP (1u << 18)

__device__ __forceinline__ unsigned xb_ld(unsigned* p)              { return __hip_atomic_load(p, __ATOMIC_RELAXED, __HIP_MEMORY_SCOPE_AGENT); }
__device__ __forceinline__ unsigned xb_add(unsigned* p, unsigned v) { return __hip_atomic_fetch_add(p, v, __ATOMIC_RELAXED, __HIP_MEMORY_SCOPE_AGENT); }
__device__ __forceinline__ unsigned xb_xcc_id() { return (unsigned)__builtin_amdgcn_s_getreg((3 << 11) | 20) & 0xFu; }
#define XB_SPIN(cond, bar) do { unsigned _sp = 0; while (cond) { __builtin_amdgcn_s_sleep(1); \
    if ((++_sp & 255u) == 0u) { if (xb_ld(&(bar)[XB_TMO])) break; if (_sp > XB_SPIN_CAP) { atomicAdd(&(bar)[XB_TMO], 1u); break; } } } } while (0)

struct XcdBarrier {
    unsigned* bar; unsigned x;
    volatile LAS3 unsigned* st;
};

__device__ __forceinline__ XcdBarrier xcd_barrier_post(unsigned* bar, volatile LAS3 unsigned* st) {
    XcdBarrier b; b.bar = bar; b.x = xb_xcc_id(); b.st = st;
    if (threadIdx.x == 0) (void)xb_add(&bar[XB_XCNT(b.x)], 1u);
    return b;
}
__device__ __forceinline__ void xcd_barrier_complete(unsigned* bar, unsigned x, unsigned& nloc, unsigned& nx) {
    const unsigned G = gridDim.x * gridDim.y * gridDim.z;
    unsigned sum, cnt, mine, sp = 0u;
    for (;;) {
        sum = 0u; cnt = 0u; mine = 0u;
#pragma unroll
        for (unsigned j = 0; j < 16; ++j) { const unsigned c = xb_ld(&bar[XB_XCNT(j)]); sum += c; cnt += (c > 0u) ? 1u : 0u; mine = (j == x) ? c : mine; }
        if (sum == G) break;
        __builtin_amdgcn_s_sleep(1);
        if ((++sp & 255u) == 0u) { if (xb_ld(&bar[XB_TMO])) break; if (sp > XB_SPIN_CAP) { atomicAdd(&bar[XB_TMO], 1u); break; } }
    }
    nloc = mine > 0u ? mine : 1u; nx = cnt > 0u ? cnt : 1u;
}

__device__ __forceinline__ void xcd_barrier(const XcdBarrier& b) {
    asm volatile("s_waitcnt vmcnt(0)" ::: "memory");
    __syncthreads();
    if (threadIdx.x == 0) {
        unsigned* bar = b.bar;
        __builtin_amdgcn_s_waitcnt(0);
        unsigned nloc = b.st[0], nx = b.st[1];
        if (nloc == 0u) { xcd_barrier_complete(bar, b.x, nloc, nx); b.st[0] = nloc; b.st[1] = nx; }
        const unsigned old = xb_add(&bar[XB_XSUB(b.x)], 1u);
        const unsigned gen = old / nloc;
        if (old + 1u == (gen + 1u) * nloc) {
            __builtin_amdgcn_fence(__ATOMIC_RELEASE, "agent");
            asm volatile("s_waitcnt vmcnt(0)" ::: "memory");
            const unsigned og = xb_add(&bar[XB_TOP], 1u);
            const unsigned tg = og / nx;
            if (og + 1u == (tg + 1u) * nx) xb_add(&bar[XB_TOPGEN], 1u);
            else XB_SPIN(xb_ld(&bar[XB_TOPGEN]) == tg, bar);
            __builtin_amdgcn_fence(__ATOMIC_ACQUIRE, "agent");
            xb_add(&bar[XB_XGEN(b.x)], 1u);
            asm volatile("s_waitcnt vmcnt(0)" ::: "memory");
        } else {
            XB_SPIN(xb_ld(&bar[XB_XGEN(b.x)]) == gen, bar);
            __builtin_amdgcn_fence(__ATOMIC_ACQUIRE, "agent");
            asm volatile("s_waitcnt vmcnt(0)" ::: "memory");
        }
    }
    __syncthreads();
}

constexpr int N_PHASES = 8;
#ifndef MK_N_LAUNCHES
#define MK_N_LAUNCHES 1
#endif
__global__ void __launch_bounds__(NTHREADS, 2) layer_fwd(Params P) {
    extern __shared__ __attribute__((aligned(16))) unsigned char lds[];
    const int G = gridDim.x, bid = blockIdx.x;
    volatile LAS3 unsigned* bst = (volatile LAS3 unsigned*)((LAS3 unsigned char*)lds + (LDS_BYTES - 16));
    if (threadIdx.x < 4) bst[threadIdx.x] = 0u;
    __syncthreads();
    XcdBarrier xbar = xcd_barrier_post((unsigned*)(P.ws + WS_CTL) + CW_BAR, bst);
    const int lo = P.ph_lo, hi = P.ph_hi;
#ifndef PH_MASK
#define PH_MASK 0xff
#endif
#define IN(k) (((PH_MASK >> (k)) & 1) && lo <= (k) && (k) < hi)
#define SEAM(k) do { if (IN(k) && IN((k) + 1)) xcd_barrier(xbar); } while (0)
#ifndef REP_MASK
#define REP_MASK 0
#endif
#define REPS(k) (((REP_MASK >> (k)) & 1) ? 2 : 1)
    if (IN(0)) for (int rep = 0; rep < REPS(0); ++rep) { p0_rows(P, lds, G, bid); p0_weights_in(P, lds, G, bid); }
    SEAM(0);
    if (IN(1)) for (int rep = 0; rep < REPS(1); ++rep) {
        pg8::Gemm g{(const pg8::bf16_t*)(P.ws + WS_XB), (const pg8::bf16_t*)(P.ws + WS_WINT), T, NPROJ, D}; pg8::StaticOrder S; S.init(T, NPROJ, G, bid);
        pg8::EpiProj E{(pg8::bf16_t*)(P.ws + WS_PROJ), NPROJ, (const float*)(P.ws + WS_RS1)};
        pg8::gemm_phase<pg8::EpiProj, pg8::StaticOrder, true, true>((PG8_LAS unsigned char*)lds, g, S, E);
    }
    SEAM(1);
    if (IN(2)) for (int rep = 0; rep < REPS(2); ++rep) {
        for (int u = bid; u < 64; u += G) mlstm_unit(P, lds, u);
#ifndef REP_OTH
#define REP_OTH 1
#endif
        if (G > 64) { if (bid >= 64) for (int r2 = 0; r2 < REP_OTH; ++r2) { p2_conv(P, G - 64, bid - 64); p2_weights_sq(P, lds, G - 64, bid - 64); p0_tables(P, G - 64, bid - 64); } }
        else { p2_conv(P, G, bid); p2_weights_sq(P, lds, G, bid); p0_tables(P, G, bid); }
    }
    SEAM(2);
    if (IN(3)) for (int rep = 0; rep < REPS(3); ++rep) p3_finalize(P, G, bid);
    SEAM(3);
    if (IN(4)) for (int rep = 0; rep < REPS(4); ++rep) {
        pg8::Gemm g{(const pg8::bf16_t*)(P.ws + WS_MIXIN), (const pg8::bf16_t*)(P.ws + WS_WOUTT), T, D, D}; pg8::StaticOrder S; S.init(T, D, G, bid);
        pg8::EpiOut E{P.x, (float*)(P.ws + WS_X1), (pg8::bf16_t*)(P.ws + WS_X1B), (float*)(P.ws + WS_SSQ), D};
        pg8::gemm_phase<pg8::EpiOut, pg8::StaticOrder, false, true>((PG8_LAS unsigned char*)lds, g, S, E);
    }
    SEAM(4);
    if (IN(5)) for (int rep = 0; rep < REPS(5); ++rep) {
        pg8::Gemm g{(const pg8::bf16_t*)(P.ws + WS_X1B), (const pg8::bf16_t*)(P.ws + WS_WQT), T, D, D}; pg8::StaticOrder S; S.init(T, D, G, bid);
        pg8::EpiQb E{(pg8::bf16_t*)(P.ws + WS_QV), D, (const float*)(P.ws + WS_SSQ)};
        pg8::gemm_phase<pg8::EpiQb, pg8::StaticOrder, false, true>((PG8_LAS unsigned char*)lds, g, S, E);
    }
    SEAM(5);
    if (IN(6)) for (int rep = 0; rep < REPS(6); ++rep) p6_topk(P, lds, G, bid);
    SEAM(6);
#ifdef EXTRA_SYNCS
    for (int i = 0; i < EXTRA_SYNCS; ++i) xcd_barrier(xbar);
#endif
    if (IN(7)) for (int rep = 0; rep < REPS(7); ++rep) p7_peer(P, lds, G, bid);
#undef IN
#undef SEAM
}

extern "C" void kernel_launch(void* const* d_in, const int* in_sizes, int n_in, void* d_out, int out_size, void* d_ws, size_t ws_size, hipStream_t stream) {
    static int grid = 0;
    if (grid == 0) {
        if (n_in != 15 || in_sizes[0] != T * D || out_size != T * D || ws_size < WS_END) { fprintf(stderr, "kernel_launch: unexpected shapes (n_in %d, in0 %d, out %d, ws %zu); nothing launched\n", n_in, n_in > 0 ? in_sizes[0] : -1, out_size, ws_size); grid = -1; return; }
        int dev = 0, cus = 0, per_cu = 0;
        if (hipGetDevice(&dev) != hipSuccess || hipDeviceGetAttribute(&cus, hipDeviceAttributeMultiprocessorCount, dev) != hipSuccess) { grid = -1; return; }
        if (hipFuncSetAttribute((const void*)layer_fwd, hipFuncAttributeMaxDynamicSharedMemorySize, LDS_BYTES) != hipSuccess) { fprintf(stderr, "kernel_launch: hipFuncSetAttribute failed\n"); grid = -1; return; }
        if (hipOccupancyMaxActiveBlocksPerMultiprocessor(&per_cu, (const void*)layer_fwd, NTHREADS, LDS_BYTES) != hipSuccess || per_cu < 1) { fprintf(stderr, "kernel_launch: occupancy query says %d blocks per CU\n", per_cu); (void)hipGetLastError(); grid = -1; return; }
        grid = cus;
    }
    if (grid < 0) return;
    Params p{};
    p.x = (const float*)d_in[0]; p.g1 = (const float*)d_in[1]; p.w_in = (const float*)d_in[2]; p.b_ig = (const float*)d_in[3]; p.b_fg = (const float*)d_in[4];
    p.conv_w = (const float*)d_in[5]; p.gm = (const float*)d_in[6]; p.w_out = (const float*)d_in[7]; p.g2 = (const float*)d_in[8]; p.w_q = (const float*)d_in[9];
    p.sk1 = (const float*)d_in[10]; p.sk2 = (const float*)d_in[11]; p.eu = (const float*)d_in[12]; p.ev = (const float*)d_in[13]; p.gfin = (const float*)d_in[14];
    p.out = (float*)d_out; p.ws = (unsigned char*)d_ws;
    if (hipMemsetAsync((char*)d_ws + WS_CTL, 0, CTL_ZERO_BYTES, stream) != hipSuccess) { fprintf(stderr, "kernel_launch: hipMemsetAsync failed\n"); return; }
    for (int li = 0; li < MK_N_LAUNCHES; ++li) {
        p.ph_lo = (MK_N_LAUNCHES == 1) ? 0 : li; p.ph_hi = (MK_N_LAUNCHES == 1) ? N_PHASES : li + 1;
        void* args[] = {&p};
        const hipError_t e = hipLaunchCooperativeKernel((const void*)layer_fwd, dim3(grid), dim3(NTHREADS), args, LDS_BYTES, stream);
        if (e != hipSuccess) { fprintf(stderr, "kernel_launch: cooperative launch %d failed: %s (grid %d)\n", li, hipGetErrorString(e), grid); break; }
    }
}
```

```cpp
#include <hip/hip_runtime.h>
#include <hip/hip_cooperative_groups.h>
#include <cstdio>
#include <cstdint>
namespace cg = cooperative_groups;
namespace pg8 {
#define PG8_LAS __attribute__((address_space(3)))
typedef unsigned short bf16_t;
typedef short bf16x8 __attribute__((ext_vector_type(8)));
typedef float f32x4 __attribute__((ext_vector_type(4)));
typedef unsigned u32x4 __attribute__((ext_vector_type(4)));
constexpr int BM = 256, BK = 64, HALF = 128, HTB = HALF * BK * 2  , STAGE_BYTES = 8 * HTB, NXCD = 8, WGM = 8;

__host__ __device__ __forceinline__ int lds_byte(int r, int c) { const int st = (r >> 4) * 2 + (c >> 5), rr = r & 15, cc = c & 31, ob = rr * 64 + cc * 2; return st * 1024 + (ob ^ (((ob >> 9) & 1) << 5)); }
__host__ __device__ __forceinline__ void stage_rc(int b, int& R, int& C) { const int st = b / 1024, sb = b % 1024, swz = sb ^ (((sb >> 9) & 1) << 5); R = (st >> 1) * 16 + swz / 64; C = (st & 1) * 32 + (swz % 64) / 2; }
__host__ __device__ __forceinline__ int perm32(int rho) { const int n = rho >> 4, i = rho & 15; return 8 * (i >> 2) + 4 * n + (i & 3); }

struct Unit { int pm, pn; };
struct Gemm { const bf16_t* A; const bf16_t* Bt; int M, N, K; };

struct StaticOrder {
    int nM, nN, nwg, G, c;
    __host__ __device__ void init(int M, int N, int G_, int c_) { nM = M / BM; nN = N / BM; nwg = nM * nN; G = G_; c = c_; }
    __host__ __device__ bool next(int i, Unit& u) const {
        const long L = (long)i * G + c; if (L >= nwg) return false;
        int wgid = (int)L; { const int q = nwg / NXCD, r = nwg % NXCD, xcd = wgid % NXCD, off = wgid / NXCD; wgid = (xcd < r ? xcd * (q + 1) : r * (q + 1) + (xcd - r) * q) + off; }
        const int nig = WGM * nN, gid = wgid / nig, fm = gid * WGM, gsz = (nM - fm) < WGM ? (nM - fm) : WGM;
        u.pm = fm + ((wgid % nig) % gsz); u.pn = (wgid % nig) / gsz; return true;
    }
    __device__ __forceinline__ void a_ready(const Unit&) const {}
    __device__ __forceinline__ void done(const Unit&) const {}
};

__device__ __forceinline__ unsigned cvt_pk_bf16(float lo, float hi) { unsigned r; asm volatile("v_cvt_pk_bf16_f32 %0, %1, %2" : "=v"(r) : "v"(lo), "v"(hi)); return r; }
struct EpiProj {
    static constexpr bool PERM = true, AFTER_DRAIN = false;
    bf16_t* O; int ldc; const float* rs;
    __device__ __forceinline__ void operator()(const f32x4 (&acc)[2][2][4][2], const Unit& u, int wr, int wc, int fr, int fq) const {
        const int row0 = u.pm * BM + wr * 64 + fr, col0 = u.pn * BM + wc * 32 + 8 * fq;
#pragma unroll
        for (int ai = 0; ai < 2; ++ai)
#pragma unroll
            for (int m = 0; m < 4; ++m) { const int row = row0 + ai * HALF + m * 16; const float s = rs[row]; bf16_t* rowp = O + (size_t)row * ldc + col0;
#pragma unroll
                for (int bj = 0; bj < 2; ++bj) { const f32x4 v0 = acc[ai][bj][m][0] * s, v1 = acc[ai][bj][m][1] * s; u32x4 w;
                    w.x = cvt_pk_bf16(v0[0], v0[1]); w.y = cvt_pk_bf16(v0[2], v0[3]); w.z = cvt_pk_bf16(v1[0], v1[1]); w.w = cvt_pk_bf16(v1[2], v1[3]);
                    *(u32x4*)(rowp + bj * HALF) = w; } }
    }
};
struct EpiOut {
    static constexpr bool PERM = false, AFTER_DRAIN = false;
    const float* X; float* X1; bf16_t* X1B; float* SSQ; int ldc;
    __device__ __forceinline__ void operator()(const f32x4 (&acc)[2][2][4][2], const Unit& u, int wr, int wc, int fr, int fq) const {
        typedef unsigned u32x2 __attribute__((ext_vector_type(2)));
        const int row0 = u.pm * BM + wr * 64 + fr, col0 = u.pn * BM + wc * 32 + 4 * fq;
#pragma unroll
        for (int ai = 0; ai < 2; ++ai)
#pragma unroll
            for (int m = 0; m < 4; ++m) { const int row = row0 + ai * HALF + m * 16; const size_t off = (size_t)row * ldc + col0; float ss = 0.f;
#pragma unroll
                for (int bj = 0; bj < 2; ++bj)
#pragma unroll
                    for (int n = 0; n < 2; ++n) { const size_t c = off + bj * HALF + n * 16; const f32x4 xv = *(const f32x4*)(X + c); const f32x4 o = xv + acc[ai][bj][m][n];
                        *(f32x4*)(X1 + c) = o; ss += (o[0] * o[0] + o[1] * o[1]) + (o[2] * o[2] + o[3] * o[3]);
                        u32x2 pk; pk.x = cvt_pk_bf16(o[0], o[1]); pk.y = cvt_pk_bf16(o[2], o[3]); *(u32x2*)(X1B + c) = pk; }
                ss += __shfl_xor(ss, 16); ss += __shfl_xor(ss, 32);
                if (fq == 0) SSQ[(size_t)row * 32 + u.pn * 4 + wc] = ss; }
    }
};
struct EpiQ {
    static constexpr bool PERM = false, AFTER_DRAIN = false;
    float* O; int ldc;
    __device__ __forceinline__ void operator()(const f32x4 (&acc)[2][2][4][2], const Unit& u, int wr, int wc, int fr, int fq) const {
        const int row0 = u.pm * BM + wr * 64 + fr, col0 = u.pn * BM + wc * 32 + 4 * fq;
#pragma unroll
        for (int ai = 0; ai < 2; ++ai)
#pragma unroll
            for (int m = 0; m < 4; ++m) { const size_t off = (size_t)(row0 + ai * HALF + m * 16) * ldc + col0;
#pragma unroll
                for (int bj = 0; bj < 2; ++bj)
#pragma unroll
                    for (int n = 0; n < 2; ++n) *(f32x4*)(O + off + bj * HALF + n * 16) = acc[ai][bj][m][n]; }
    }
};
struct EpiQb {
    static constexpr bool PERM = true, AFTER_DRAIN = false;
    bf16_t* O; int ldc; const float* SSQ;
    __device__ __forceinline__ void operator()(const f32x4 (&acc)[2][2][4][2], const Unit& u, int wr, int wc, int fr, int fq) const {
        const int row0 = u.pm * BM + wr * 64 + fr, col0 = u.pn * BM + wc * 32 + 8 * fq;
#pragma unroll
        for (int ai = 0; ai < 2; ++ai)
#pragma unroll
            for (int m = 0; m < 4; ++m) { const int row = row0 + ai * HALF + m * 16; const f32x4* sp = (const f32x4*)(SSQ + (size_t)row * 32);
                f32x4 s4 = sp[0];
#pragma unroll
                for (int i = 1; i < 8; ++i) s4 += sp[i];
                const float s = rsqrtf(((s4[0] + s4[1]) + (s4[2] + s4[3])) * (1.0f / 2048.0f) + 1e-6f); bf16_t* rowp = O + (size_t)row * ldc + col0;
#pragma unroll
                for (int bj = 0; bj < 2; ++bj) { const f32x4 v0 = acc[ai][bj][m][0] * s, v1 = acc[ai][bj][m][1] * s; u32x4 w;
                    w.x = cvt_pk_bf16(v0[0], v0[1]); w.y = cvt_pk_bf16(v0[2], v0[3]); w.z = cvt_pk_bf16(v1[0], v1[1]); w.w = cvt_pk_bf16(v1[2], v1[3]);
                    *(u32x4*)(rowp + bj * HALF) = w; } }
    }
};
template <class Epi, class Sched, bool ALIGN_EPI = false, bool SP2 = false>
__device__ __forceinline__ void gemm_phase(PG8_LAS unsigned char* lds, const Gemm g, const Sched& S, const Epi& E) {
    const int tid = threadIdx.x, wid = __builtin_amdgcn_readfirstlane(tid >> 6), lane = tid & 63, wr = wid >> 2, wc = wid & 3, fr = lane & 15, fq = lane >> 4;
    const int K = g.K, nt = K / BK;
    unsigned voffA[2], voffB[2];
#pragma unroll
    for (int i = 0; i < 2; ++i) { int R, C; stage_rc(tid * 16 + i * 8192, R, C); const int Rb = Epi::PERM ? ((R & ~31) + perm32(R & 31)) : R;
        voffA[i] = (unsigned)(R * K + C) * 2u; voffB[i] = (unsigned)(Rb * K + C) * 2u; }
    const size_t kstep = (size_t)(BK * 2);
    const size_t hstep = (size_t)HALF * K * 2;
    const size_t tstep = 2 * hstep;
    const unsigned ldsw = (unsigned)wid * 1024u;
    const int aoff = lds_byte(wr * 64 + fr, fq * 8), boff = lds_byte(wc * 32 + fr, fq * 8);
#define PG8_SA(b, h) (((b) * 2 + (h)) * HTB)
#define PG8_SB(b, h) ((4 + (b) * 2 + (h)) * HTB)
#define PG8_STAGE(bufoff, gbase, voff) do { _Pragma("unroll") for (int _i = 0; _i < 2; ++_i) \
        __builtin_amdgcn_global_load_lds((const unsigned*)((const char*)(gbase) + (voff)[_i]), (PG8_LAS unsigned*)(lds + (bufoff) + ldsw + _i * 8192), 16, 0, 0); } while (0)
#define PG8_LDA(dst, b, h) do { _Pragma("unroll") for (int m = 0; m < 4; ++m) _Pragma("unroll") for (int k = 0; k < 2; ++k) dst[m][k] = *(const PG8_LAS bf16x8*)(lds + PG8_SA(b, h) + aoff + m * 2048 + k * 1024); } while (0)
#define PG8_LDB(dst, b, h) do { _Pragma("unroll") for (int n = 0; n < 2; ++n) _Pragma("unroll") for (int k = 0; k < 2; ++k) dst[n][k] = *(const PG8_LAS bf16x8*)(lds + PG8_SB(b, h) + boff + n * 2048 + k * 1024); } while (0)
#define PG8_MMA(ai, bj, At, Bt) do { __builtin_amdgcn_s_setprio(1); _Pragma("unroll") for (int m = 0; m < 4; ++m) _Pragma("unroll") for (int n = 0; n < 2; ++n) _Pragma("unroll") for (int k = 0; k < 2; ++k) \
        acc[ai][bj][m][n] = __builtin_amdgcn_mfma_f32_16x16x32_bf16(Bt[n][k], At[m][k], acc[ai][bj][m][n], 0, 0, 0); __builtin_amdgcn_s_setprio(0); } while (0)
#define PG8_WAIT_V(n) asm volatile("s_waitcnt vmcnt(" #n ")" ::: "memory")
#define PG8_WAIT_L(n) asm volatile("s_waitcnt lgkmcnt(" #n ")" ::: "memory")
#define PG8_BAR __builtin_amdgcn_s_barrier()
#define PG8_SCHED __builtin_amdgcn_sched_barrier(0)
    Unit cur, nxt; int ui = 0;
    if (!S.next(0, cur)) return;
    f32x4 acc[2][2][4][2];
#pragma unroll
    for (int a = 0; a < 2; ++a)
#pragma unroll
        for (int b = 0; b < 2; ++b)
#pragma unroll
            for (int m = 0; m < 4; ++m)
#pragma unroll
                for (int n = 0; n < 2; ++n) acc[a][b][m][n] = (f32x4){0.f, 0.f, 0.f, 0.f};
    bf16x8 At[4][2], B0[2][2], B1[2][2];
    const char* cA = (const char*)g.A + (size_t)cur.pm * tstep; const char* cB = (const char*)g.Bt + (size_t)cur.pn * tstep;
    S.a_ready(cur);
    if constexpr (SP2) {
        PG8_STAGE(PG8_SB(0, 0), cB, voffB); PG8_STAGE(PG8_SB(0, 1), cB + hstep, voffB); PG8_STAGE(PG8_SA(0, 0), cA, voffA); PG8_STAGE(PG8_SA(0, 1), cA + hstep, voffA);
        if (wr == 1) PG8_BAR;
        PG8_WAIT_V(2); PG8_BAR;
        PG8_STAGE(PG8_SB(1, 0), cB + kstep, voffB); PG8_STAGE(PG8_SA(1, 0), cA + kstep, voffA); PG8_STAGE(PG8_SB(1, 1), cB + hstep + kstep, voffB);
        PG8_WAIT_V(6); PG8_BAR;
    } else {
        PG8_STAGE(PG8_SB(0, 0), cB, voffB); PG8_STAGE(PG8_SA(0, 0), cA, voffA); PG8_STAGE(PG8_SB(0, 1), cB + hstep, voffB); PG8_STAGE(PG8_SA(0, 1), cA + hstep, voffA);
        if (wr == 1) PG8_BAR;
        PG8_WAIT_V(4); PG8_BAR;
        PG8_STAGE(PG8_SB(1, 0), cB + kstep, voffB); PG8_STAGE(PG8_SA(1, 0), cA + kstep, voffA); PG8_STAGE(PG8_SB(1, 1), cB + hstep + kstep, voffB);
        PG8_WAIT_V(6); PG8_BAR;
    }
    for (;;) {
        const bool has_next = S.next(ui + 1, nxt);
        const char* nA = has_next ? (const char*)g.A + (size_t)nxt.pm * tstep : cA; const char* nB = has_next ? (const char*)g.Bt + (size_t)nxt.pn * tstep : cB;
        for (int t = 0; t < nt; t += 2) {
            const bool last = (t == nt - 2);
            const char* a1 = cA + (size_t)(t + 1) * kstep;
            const char* a2 = last ? nA : cA + (size_t)(t + 2) * kstep; const char* b2 = last ? nB : cB + (size_t)(t + 2) * kstep;
            const char* a3 = a2 + kstep; const char* b3 = b2 + kstep;
            if (last && has_next) S.a_ready(nxt);
            if constexpr (SP2) {
            PG8_LDB(B0, 0, 0); PG8_LDB(B1, 0, 1); PG8_SCHED; PG8_LDA(At, 0, 0); PG8_STAGE(PG8_SA(1, 1), a1 + hstep, voffA);
            PG8_WAIT_V(8); PG8_WAIT_L(0); PG8_BAR; PG8_MMA(0, 0, At, B0); PG8_MMA(0, 1, At, B1); PG8_BAR; PG8_SCHED;
            PG8_LDA(At, 0, 1); PG8_STAGE(PG8_SB(0, 0), b2, voffB); PG8_STAGE(PG8_SB(0, 1), b2 + hstep, voffB); PG8_STAGE(PG8_SA(0, 0), a2, voffA);
            PG8_WAIT_V(8); PG8_WAIT_L(0); PG8_BAR; PG8_MMA(1, 0, At, B0); PG8_MMA(1, 1, At, B1); PG8_BAR; PG8_SCHED;
            PG8_LDB(B0, 1, 0); PG8_LDB(B1, 1, 1); PG8_SCHED; PG8_LDA(At, 1, 0); PG8_STAGE(PG8_SA(0, 1), a2 + hstep, voffA);
            PG8_WAIT_V(8); PG8_WAIT_L(0); PG8_BAR; PG8_MMA(0, 0, At, B0); PG8_MMA(0, 1, At, B1); PG8_BAR; PG8_SCHED;
            PG8_LDA(At, 1, 1); PG8_STAGE(PG8_SB(1, 0), b3, voffB); PG8_STAGE(PG8_SB(1, 1), b3 + hstep, voffB); PG8_STAGE(PG8_SA(1, 0), a3, voffA);
            PG8_WAIT_V(8); PG8_WAIT_L(0); PG8_BAR; PG8_MMA(1, 0, At, B0); PG8_MMA(1, 1, At, B1); PG8_BAR; PG8_SCHED;
            } else {
            PG8_LDB(B0, 0, 0); PG8_SCHED; PG8_LDA(At, 0, 0); PG8_STAGE(PG8_SA(1, 1), a1 + hstep, voffA);
            PG8_WAIT_L(8); PG8_BAR; PG8_WAIT_L(0); PG8_MMA(0, 0, At, B0); PG8_BAR; PG8_SCHED;
            PG8_LDB(B1, 0, 1); PG8_STAGE(PG8_SB(0, 0), b2, voffB);
            PG8_BAR; PG8_WAIT_L(0); PG8_MMA(0, 1, At, B1); PG8_BAR;
            PG8_LDA(At, 0, 1); PG8_STAGE(PG8_SA(0, 0), a2, voffA);
            PG8_BAR; PG8_WAIT_L(0); PG8_MMA(1, 0, At, B0); PG8_BAR; PG8_SCHED;
            PG8_STAGE(PG8_SB(0, 1), b2 + hstep, voffB);
            PG8_WAIT_V(6); PG8_BAR; PG8_MMA(1, 1, At, B1); PG8_BAR;
            PG8_LDB(B0, 1, 0); PG8_SCHED; PG8_LDA(At, 1, 0); PG8_STAGE(PG8_SA(0, 1), a2 + hstep, voffA);
            PG8_WAIT_L(8); PG8_BAR; PG8_WAIT_L(0); PG8_MMA(0, 0, At, B0); PG8_BAR; PG8_SCHED;
            PG8_LDB(B1, 1, 1); PG8_STAGE(PG8_SB(1, 0), b3, voffB);
            PG8_BAR; PG8_WAIT_L(0); PG8_MMA(0, 1, At, B1); PG8_BAR;
            PG8_LDA(At, 1, 1); PG8_STAGE(PG8_SA(1, 0), a3, voffA);
            PG8_BAR; PG8_WAIT_L(0); PG8_MMA(1, 0, At, B0); PG8_BAR; PG8_SCHED;
            PG8_STAGE(PG8_SB(1, 1), b3 + hstep, voffB);
            PG8_WAIT_V(6); PG8_BAR; PG8_MMA(1, 1, At, B1); PG8_BAR;
            }
        }
        if constexpr (ALIGN_EPI) { if (wr == 0) PG8_BAR; }
        if constexpr (!Epi::AFTER_DRAIN) { E(acc, cur, wr, wc, fr, fq); S.done(cur); }
        if (!has_next) break;
#pragma unroll
        for (int a = 0; a < 2; ++a)
#pragma unroll
            for (int b = 0; b < 2; ++b)
#pragma unroll
                for (int m = 0; m < 4; ++m)
#pragma unroll
                    for (int n = 0; n < 2; ++n) acc[a][b][m][n] = (f32x4){0.f, 0.f, 0.f, 0.f};
        cur = nxt; cA = nA; cB = nB; ++ui;
        if constexpr (ALIGN_EPI) { if (wr == 1) PG8_BAR; }
    }
    PG8_WAIT_V(0);
    if constexpr (!ALIGN_EPI) { if (wr == 0) PG8_BAR; }
    PG8_BAR;
    if constexpr (Epi::AFTER_DRAIN) { E.fused(acc, cur, wr, wc, fr, fq, lds, wid, lane); S.done(cur); }
#undef PG8_SA
#undef PG8_SB
#undef PG8_STAGE
#undef PG8_LDA
#undef PG8_LDB
#undef PG8_MMA
#undef PG8_WAIT_V
#undef PG8_WAIT_L
#undef PG8_BAR
#undef PG8_SCHED
}
}
constexpr int T = 8192, SEQ = 4096, D = 2048, NPROJ = 7168, NIN = 7176;
constexpr int NH = 4, DH = 256, LCH = 64, DML = 1024;
constexpr int NEXP = 16384, PEER_H = 8, TOPK = 16;
constexpr float EPS = 1e-6f;
constexpr int PC_CX = 0, PC_CB = 1024, PC_CC = 2048, PC_Q = 3072, PC_K = 4096, PC_V = 5120, PC_O = 6144;
constexpr int NTHREADS = 512, NWAVES = 8;
constexpr int LDS_BYTES = 147456;

constexpr size_t MiB = 1u << 20;
constexpr size_t WS_CTL = 0, CTL_ZERO_BYTES = 64 * 1024;
constexpr int CW_BAR = 1024;
constexpr size_t WS_RS1 = 1 * MiB, WS_GI = 1 * MiB + 64 * 1024, WS_GF = 1 * MiB + 256 * 1024, WS_SSQ = 3 * MiB, WS_ESC = 4 * MiB;
constexpr size_t WS_XB = 5 * MiB, WS_WINT = 37 * MiB, WS_WOUTT = 65 * MiB, WS_WQT = 73 * MiB;
constexpr size_t WS_PROJ = 81 * MiB;
constexpr size_t WS_X1 = 81 * MiB, WS_X1B = 145 * MiB;
constexpr size_t WS_HRAW = 193 * MiB, WS_MIXIN = 225 * MiB, WS_QV = 257 * MiB, WS_IDX = 321 * MiB, WS_GATE = 325 * MiB;
constexpr size_t WS_UB = 329 * MiB, WS_VB = 393 * MiB, WS_END = 457 * MiB;

struct Params {
    const float *x, *g1, *w_in, *b_ig, *b_fg, *conv_w, *gm, *w_out, *g2, *w_q, *sk1, *sk2, *eu, *ev, *gfin;
    float* out; unsigned char* ws;
    int ph_lo, ph_hi;
};

typedef unsigned short bf16_t;
__device__ __forceinline__ unsigned f2bf(float f) { unsigned u = __float_as_uint(f); return (u + 0x7fffu + ((u >> 16) & 1u)) >> 16; }
__device__ __forceinline__ unsigned pk2(float lo, float hi) { return f2bf(lo) | (f2bf(hi) << 16); }
__device__ __forceinline__ float bflo(unsigned w) { return __uint_as_float(w << 16); }
__device__ __forceinline__ float bfhi(unsigned w) { return __uint_as_float(w & 0xffff0000u); }
__device__ __forceinline__ float bf1(bf16_t h) { return __uint_as_float((unsigned)h << 16); }
__device__ __forceinline__ float wave_sum(float v) {
#pragma unroll
    for (int o = 32; o >= 1; o >>= 1) v += __shfl_xor(v, o);
    return v;
}
__device__ __forceinline__ void unpack8(const uint4 w, float (&f)[8]) {
    f[0] = bflo(w.x); f[1] = bfhi(w.x); f[2] = bflo(w.y); f[3] = bfhi(w.y); f[4] = bflo(w.z); f[5] = bfhi(w.z); f[6] = bflo(w.w); f[7] = bfhi(w.w);
}
__device__ __forceinline__ float log_sigmoid(float z) { return z >= 0.f ? -log1pf(expf(-z)) : z - log1pf(expf(z)); }
__device__ __forceinline__ float gelu_erf(float v) { return 0.5f * v * (1.0f + erff(v * 0.70710678118654752f)); }

__device__ __forceinline__ void p0_rows(const Params& P, unsigned char* lds, int G, int bid) {
    float* wg = (float*)lds;
    const int tid = threadIdx.x, lane = tid & 63, wave = tid >> 6;
    for (int i = tid; i < 8 * D; i += NTHREADS) { const int g = i >> 11, k = i & 2047; wg[i] = P.w_in[(size_t)k * NIN + NPROJ + g] * P.g1[k]; }
    __syncthreads();
    float* rs1 = (float*)(P.ws + WS_RS1); float* gi = (float*)(P.ws + WS_GI); float* gf = (float*)(P.ws + WS_GF); bf16_t* xb = (bf16_t*)(P.ws + WS_XB);
    for (int t = bid * NWAVES + wave; t < T; t += G * NWAVES) {
        const float4* xr = (const float4*)(P.x + (size_t)t * D);
        float ss = 0.f, dg[8];
#pragma unroll
        for (int g = 0; g < 8; ++g) dg[g] = 0.f;
#pragma unroll 1
        for (int j = 0; j < 8; ++j) {
            const float4 v = xr[j * 64 + lane];
            ss += (v.x * v.x + v.y * v.y) + (v.z * v.z + v.w * v.w);
            const int k0 = (j * 64 + lane) * 4;
#pragma unroll
            for (int g = 0; g < 8; ++g) { const float4 w = *(const float4*)(wg + g * D + k0); dg[g] += (v.x * w.x + v.y * w.y) + (v.z * w.z + v.w * w.w); }
            ((uint2*)(xb + (size_t)t * D))[j * 64 + lane] = make_uint2(pk2(v.x, v.y), pk2(v.z, v.w));
        }
        ss = wave_sum(ss);
#pragma unroll
        for (int g = 0; g < 8; ++g) dg[g] = wave_sum(dg[g]);
        const float rs = rsqrtf(ss * (1.0f / D) + EPS);
        if (lane == 0) {
            rs1[t] = rs;
#pragma unroll
            for (int h = 0; h < 4; ++h) { gi[t * 4 + h] = rs * dg[h] + P.b_ig[h]; gf[t * 4 + h] = log_sigmoid(rs * dg[4 + h] + P.b_fg[h]); }
        }
    }
    __syncthreads();
}
__device__ __forceinline__ void transpose_tile(const float* W, int ldw, int K, const float* gain, bf16_t* WT, int k0, int n0, float* tile) {
    const int tid = threadIdx.x;
#pragma unroll
    for (int r = 0; r < 2; ++r) {
        const int kk = (tid >> 4) + 32 * r, n4 = (tid & 15) * 4;
        float4 v = *(const float4*)(W + (size_t)(k0 + kk) * ldw + n0 + n4);
        const float g = gain ? gain[k0 + kk] : 1.0f;
        tile[kk * 65 + n4 + 0] = v.x * g; tile[kk * 65 + n4 + 1] = v.y * g; tile[kk * 65 + n4 + 2] = v.z * g; tile[kk * 65 + n4 + 3] = v.w * g;
    }
    __syncthreads();
    { const int nn = tid >> 3, k8 = (tid & 7) * 8; float f[8];
#pragma unroll
      for (int i = 0; i < 8; ++i) f[i] = tile[(k8 + i) * 65 + nn];
      *(uint4*)(WT + (size_t)(n0 + nn) * K + k0 + k8) = make_uint4(pk2(f[0], f[1]), pk2(f[2], f[3]), pk2(f[4], f[5]), pk2(f[6], f[7])); }
    __syncthreads();
}
__device__ __forceinline__ void p0_weights_in(const Params& P, unsigned char* lds, int G, int bid) {
    float* tile = (float*)lds;
    constexpr int N_IN = (D / 64) * (NPROJ / 64);
    for (int it = bid; it < N_IN; it += G) { const int kt = it / (NPROJ / 64), nt = it % (NPROJ / 64); transpose_tile(P.w_in, NIN, D, P.g1, (bf16_t*)(P.ws + WS_WINT), kt * 64, nt * 64, tile); }
}
__device__ __forceinline__ void p2_weights_sq(const Params& P, unsigned char* lds, int nworkers, int wid) {
    float* tile = (float*)lds;
    constexpr int N_SQ = (D / 64) * (D / 64);
    for (int it = wid; it < 2 * N_SQ; it += nworkers) {
        if (it < N_SQ) { const int kt = it / (D / 64), nt = it % (D / 64); transpose_tile(P.w_out, D, D, nullptr, (bf16_t*)(P.ws + WS_WOUTT), kt * 64, nt * 64, tile); }
        else { const int j = it - N_SQ, kt = j / (D / 64), nt = j % (D / 64); transpose_tile(P.w_q, D, D, P.g2, (bf16_t*)(P.ws + WS_WQT), kt * 64, nt * 64, tile); }
    }
}
typedef float f32x2_t __attribute__((ext_vector_type(2)));
__device__ __forceinline__ float wave_max(float v) {
#pragma unroll
    for (int o = 32; o >= 1; o >>= 1) v = fmaxf(v, __shfl_xor(v, o));
    return v;
}
__device__ __forceinline__ void p0_tables(const Params& P, int nworkers, int wid) {
    const int lane = threadIdx.x & 63, wave = threadIdx.x >> 6;
    float* esc = (float*)(P.ws + WS_ESC);
#pragma unroll 1
    for (int rix = wid * NWAVES + wave; rix < 2 * NEXP; rix += nworkers * NWAVES) {
        const int isv = rix & 1, e = rix >> 1;
        const float4* src = (const float4*)((isv ? P.ev : P.eu) + (size_t)e * D);
        unsigned* dst = (unsigned*)(P.ws + (isv ? WS_VB : WS_UB)) + (size_t)e * (D / 4);
        float4 v[8]; float mx = 0.f;
#pragma unroll
        for (int j = 0; j < 8; ++j) { v[j] = src[j * 64 + lane];
            if (!isv) { const float4 gg = ((const float4*)P.g2)[j * 64 + lane]; v[j].x *= gg.x; v[j].y *= gg.y; v[j].z *= gg.z; v[j].w *= gg.w; }
            mx = fmaxf(mx, fmaxf(fmaxf(fabsf(v[j].x), fabsf(v[j].y)), fmaxf(fabsf(v[j].z), fabsf(v[j].w)))); }
        mx = wave_max(mx);
        const float sc = mx > 0.f ? 240.0f / mx : 1.0f, inv = mx > 0.f ? mx * (1.0f / 240.0f) : 1.0f;
#pragma unroll
        for (int j = 0; j < 8; ++j) { int pk = __builtin_amdgcn_cvt_pk_fp8_f32(v[j].x * sc, v[j].y * sc, 0, false); pk = __builtin_amdgcn_cvt_pk_fp8_f32(v[j].z * sc, v[j].w * sc, pk, true); dst[j * 64 + lane] = (unsigned)pk; }
        if (lane == 0) esc[e * 2 + isv] = inv;
    }
}

__device__ __forceinline__ void p2_conv(const Params& P, int nworkers, int wid) {
    const bf16_t* proj = (const bf16_t*)(P.ws + WS_PROJ); bf16_t* mix = (bf16_t*)(P.ws + WS_MIXIN);
    for (int idx = wid * NTHREADS + threadIdx.x; idx < T * 128; idx += nworkers * NTHREADS) {
        const int t = idx >> 7, c8 = (idx & 127) * 8, s = t & (SEQ - 1);
        float y[8];
#pragma unroll
        for (int i = 0; i < 8; ++i) y[i] = 0.f;
#pragma unroll
        for (int j = 0; j < 3; ++j) {
            const int dt = 2 - j;
            if (s >= dt) {
                const bf16_t* row = proj + (size_t)(t - dt) * NPROJ;
                float cx[8], cc[8]; unpack8(*(const uint4*)(row + PC_CX + c8), cx); unpack8(*(const uint4*)(row + PC_CC + c8), cc);
                const float4 w0 = *(const float4*)(P.conv_w + j * 1024 + c8), w1 = *(const float4*)(P.conv_w + j * 1024 + c8 + 4);
                y[0] += w0.x * (cc[0] * cx[0]); y[1] += w0.y * (cc[1] * cx[1]); y[2] += w0.z * (cc[2] * cx[2]); y[3] += w0.w * (cc[3] * cx[3]);
                y[4] += w1.x * (cc[4] * cx[4]); y[5] += w1.y * (cc[5] * cx[5]); y[6] += w1.z * (cc[6] * cx[6]); y[7] += w1.w * (cc[7] * cx[7]);
            }
        }
        float cb[8]; unpack8(*(const uint4*)(proj + (size_t)t * NPROJ + PC_CB + c8), cb);
        *(uint4*)(mix + (size_t)t * D + c8) = make_uint4(pk2(cb[0] * y[0], cb[1] * y[1]), pk2(cb[2] * y[2], cb[3] * y[3]), pk2(cb[4] * y[4], cb[5] * y[5]), pk2(cb[6] * y[6], cb[7] * y[7]));
    }
}
#define LAS3 __attribute__((address_space(3)))
typedef short s16x4_t __attribute__((ext_vector_type(4)));
typedef unsigned v4u_t __attribute__((ext_vector_type(4)));
typedef unsigned v2u_t __attribute__((ext_vector_type(2)));
__device__ __forceinline__ pg8::bf16x8 tr8(LAS3 unsigned char* p0, LAS3 unsigned char* p1) {
    const s16x4_t a = __builtin_amdgcn_ds_read_tr16_b64_v4i16((LAS3 s16x4_t*)p0), b = __builtin_amdgcn_ds_read_tr16_b64_v4i16((LAS3 s16x4_t*)p1);
    return __builtin_shufflevector(a, b, 0, 1, 2, 3, 4, 5, 6, 7);
}
template <int CTRL, int RMASK> __device__ __forceinline__ float dpp_keep(float oldv, float v) { return __int_as_float(__builtin_amdgcn_update_dpp(__float_as_int(oldv), __float_as_int(v), CTRL, RMASK, 0xF, false)); }
__device__ __forceinline__ float wave_incl_sum(float v) {
    v += dpp_keep<0x111, 0xF>(0.f, v); v += dpp_keep<0x112, 0xF>(0.f, v); v += dpp_keep<0x114, 0xF>(0.f, v); v += dpp_keep<0x118, 0xF>(0.f, v);
    v += dpp_keep<0x142, 0xA>(0.f, v); v += dpp_keep<0x143, 0xC>(0.f, v); return v;
}
__device__ __forceinline__ float wave_incl_max(float v) {
    const float NI = -__builtin_inff();
    v = fmaxf(v, dpp_keep<0x111, 0xF>(NI, v)); v = fmaxf(v, dpp_keep<0x112, 0xF>(NI, v)); v = fmaxf(v, dpp_keep<0x114, 0xF>(NI, v)); v = fmaxf(v, dpp_keep<0x118, 0xF>(NI, v));
    v = fmaxf(v, dpp_keep<0x142, 0xA>(NI, v)); v = fmaxf(v, dpp_keep<0x143, 0xC>(NI, v)); return v;
}
template <int VAR> __device__ __forceinline__ void mlstm_unit(const Params& P, unsigned char* lds_, int unit, float* hraw) {
    typedef pg8::bf16x8 bf16x8; typedef pg8::f32x4 f32x4;
    LAS3 unsigned char* L = (LAS3 unsigned char*)lds_;
    constexpr int QS = 0, KS = 33792, VA = 67584, WV = 73728, CB0 = 79872, CBSZ = 25344, SW0 = CB0 + 2 * CBSZ, SWSZ = 2304, SM0 = SW0 + 4 * SWSZ, SMSZ = 1600;
    constexpr int QST = 528, VST = 96, SST = 144;
    const int tid = threadIdx.x, lane = tid & 63, wave = __builtin_amdgcn_readfirstlane(tid >> 6);
    const int g = lane >> 4, c16 = lane & 15, q4 = c16 >> 2, p4 = lane & 3;
    const int bh = unit >> 3, sl = unit & 7, b = bh >> 2, h = bh & 3, v0 = sl * 32;
    const bf16_t* proj = (const bf16_t*)(P.ws + WS_PROJ);
    const float* gi = (const float*)(P.ws + WS_GI); const float* gf = (const float*)(P.ws + WS_GF);
#define SMF(sb, off) ((LAS3 float*)(L + SM0 + (sb) * SMSZ + (off)))
    for (int i = tid; i < (2 * CBSZ) / 16; i += NTHREADS) *(LAS3 v4u_t*)(L + CB0 + i * 16) = (v4u_t){0u, 0u, 0u, 0u};
    for (int i = tid; i < 6144 / 16; i += NTHREADS) *(LAS3 v4u_t*)(L + WV + i * 16) = (v4u_t){0u, 0u, 0u, 0u};
    if (tid < 64) { *(LAS3 v4u_t*)(L + VA + tid * VST + 64) = (v4u_t){0x00003F80u, 0u, 0u, 0u}; *(LAS3 v4u_t*)(L + VA + tid * VST + 80) = (v4u_t){0u, 0u, 0u, 0u}; }
    f32x4 accC[4][3];
#pragma unroll
    for (int dt = 0; dt < 4; ++dt)
#pragma unroll
        for (int vt = 0; vt < 3; ++vt) accC[dt][vt] = (f32x4){0.f, 0.f, 0.f, 0.f};
    const int row = tid >> 3, seg = tid & 7;
    v4u_t rq[4], rk[4], rv = (v4u_t){0u, 0u, 0u, 0u};
    float m = 0.f, nic = 0.f, nfc = 0.f;
#define MLSTM_SMALLS(sb, ic_, fc_) do { const float bc_ = wave_incl_sum(fc_); const float a_ = (ic_) - bc_; const float pm_ = wave_incl_max(a_); \
        const float M_ = fmaxf(m, pm_), M63_ = __shfl(M_, 63), b63_ = __shfl(bc_, 63); \
        SMF(sb, 0)[lane] = a_ * 1.4426950408889634f; SMF(sb, 256)[lane] = M_ * 1.4426950408889634f; SMF(sb, 512)[lane] = __expf(m - M_); SMF(sb, 768)[lane] = __expf(a_ - M63_) * 0.0625f; SMF(sb, 1024)[lane] = __expf(-bc_ - M_); \
        if (lane == 0) { SMF(sb, 1280)[0] = b63_ + M63_; SMF(sb, 1280)[1] = __expf(m - M63_); } m = b63_ + M63_; } while (0)
    { const int t0 = b * SEQ; const bf16_t* src = proj + (size_t)(t0 + row) * NPROJ + h * DH + seg * 8;
#pragma unroll
      for (int i = 0; i < 4; ++i) { rq[i] = *(const v4u_t*)(src + PC_Q + i * 64); rk[i] = *(const v4u_t*)(src + PC_K + i * 64); }
      if (tid < 256) rv = *(const v4u_t*)(proj + (size_t)(t0 + (tid >> 2)) * NPROJ + PC_V + h * DH + v0 + (tid & 3) * 8);
      if (wave == 0) { const float ic0 = gi[(size_t)(t0 + lane) * 4 + h], fc0 = gf[(size_t)(t0 + lane) * 4 + h]; MLSTM_SMALLS(0, ic0, fc0);
          nic = gi[(size_t)(t0 + LCH + lane) * 4 + h]; nfc = gf[(size_t)(t0 + LCH + lane) * 4 + h]; } }
    __syncthreads();
#pragma unroll 1
    for (int c = 0; c < SEQ / LCH; ++c) {
        const int t0 = b * SEQ + c * LCH, sb = c & 1;
        LAS3 unsigned char* CBc = L + CB0 + sb * CBSZ; LAS3 unsigned char* CBn = L + CB0 + (sb ^ 1) * CBSZ;
#pragma unroll
        for (int i = 0; i < 4; ++i) { *(LAS3 v4u_t*)(L + QS + row * QST + (i * 8 + seg) * 16) = rq[i]; *(LAS3 v4u_t*)(L + KS + row * QST + (i * 8 + seg) * 16) = rk[i]; }
        if (tid < 256) { const int l = tid >> 2, part = tid & 3; const float wl = SMF(sb, 768)[l];
            *(LAS3 v4u_t*)(L + VA + l * VST + part * 16) = rv;
            *(LAS3 v4u_t*)(L + WV + l * VST + part * 16) = (v4u_t){pg8::cvt_pk_bf16(wl * bflo(rv.x), wl * bfhi(rv.x)), pg8::cvt_pk_bf16(wl * bflo(rv.y), wl * bfhi(rv.y)), pg8::cvt_pk_bf16(wl * bflo(rv.z), wl * bfhi(rv.z)), pg8::cvt_pk_bf16(wl * bflo(rv.w), wl * bfhi(rv.w))}; }
        else if (tid < 320) { const int l = tid - 256; *(LAS3 unsigned short*)(L + WV + l * VST + 64) = (unsigned short)pg8::cvt_pk_bf16(SMF(sb, 768)[l], 0.f); }
        if (!(VAR & 1) && c + 1 < SEQ / LCH) { const int t1 = t0 + LCH; const bf16_t* src = proj + (size_t)(t1 + row) * NPROJ + h * DH + seg * 8;
#pragma unroll
            for (int i = 0; i < 4; ++i) { rq[i] = *(const v4u_t*)(src + PC_Q + i * 64); rk[i] = *(const v4u_t*)(src + PC_K + i * 64); }
            if (tid < 256) rv = *(const v4u_t*)(proj + (size_t)(t1 + (tid >> 2)) * NPROJ + PC_V + h * DH + v0 + (tid & 3) * 8); }
        __syncthreads();
        if ((VAR & 4) && wave < 4) {   } else
        if (wave < 4) {
            const int rt = wave; LAS3 unsigned char* SWp = L + SW0 + rt * SWSZ;
            const f32x4 M4 = *(LAS3 f32x4*)(SMF(sb, 256) + rt * 16 + 4 * g);
            bf16x8 qf[8];
#pragma unroll
            for (int ks = 0; ks < 8; ++ks) qf[ks] = *(LAS3 bf16x8*)(L + QS + (rt * 16 + c16) * QST + (ks * 32 + g * 8) * 2);
#pragma unroll
            for (int ct = 0; ct < 4; ++ct) { f32x4 acc = (f32x4){0.f, 0.f, 0.f, 0.f};
                if (ct <= rt) {
#pragma unroll
                    for (int ks = 0; ks < 8; ++ks) { const bf16x8 bv = *(LAS3 bf16x8*)(L + KS + (ct * 16 + c16) * QST + (ks * 32 + g * 8) * 2);
                        acc = __builtin_amdgcn_mfma_f32_16x16x32_bf16(qf[ks], bv, acc, 0, 0, 0); } }
                const int l = ct * 16 + c16; const float al = SMF(sb, 0)[l];
#pragma unroll
                for (int r = 0; r < 4; ++r) { const int jr = 4 * g + r; const float val = (l <= rt * 16 + jr) ? acc[r] * 0.0625f * __builtin_amdgcn_exp2f(al - M4[r]) : 0.f;
                    *(LAS3 unsigned short*)(SWp + jr * SST + l * 2) = (unsigned short)pg8::cvt_pk_bf16(val, 0.f); } }
            asm volatile("s_waitcnt lgkmcnt(0)" ::: "memory");
            f32x4 aI[3], aX[3];
#pragma unroll
            for (int vt = 0; vt < 3; ++vt) { aI[vt] = (f32x4){0.f, 0.f, 0.f, 0.f}; aX[vt] = (f32x4){0.f, 0.f, 0.f, 0.f}; }
#pragma unroll
            for (int ks = 0; ks < 8; ++ks) {
#pragma unroll
                for (int vt = 0; vt < 3; ++vt) { const bf16x8 bv = *(LAS3 bf16x8*)(CBc + (vt * 16 + c16) * QST + (ks * 32 + g * 8) * 2); aI[vt] = __builtin_amdgcn_mfma_f32_16x16x32_bf16(qf[ks], bv, aI[vt], 0, 0, 0); } }
#pragma unroll
            for (int ks = 0; ks < 2; ++ks) { const bf16x8 av = *(LAS3 bf16x8*)(SWp + c16 * SST + (ks * 32 + g * 8) * 2);
#pragma unroll
                for (int vt = 0; vt < 3; ++vt) { LAS3 unsigned char* vp = L + VA + (ks * 32 + g * 8 + q4) * VST + (vt * 16 + 4 * p4) * 2; const bf16x8 bv = tr8(vp, vp + 4 * VST);
                    aX[vt] = __builtin_amdgcn_mfma_f32_16x16x32_bf16(av, bv, aX[vt], 0, 0, 0); } }
            const f32x4 e4 = *(LAS3 f32x4*)(SMF(sb, 512) + rt * 16 + 4 * g), n4 = *(LAS3 f32x4*)(SMF(sb, 1024) + rt * 16 + 4 * g);
#pragma unroll
            for (int r = 0; r < 4; ++r) { const float den0 = __builtin_amdgcn_rcpf(fmaxf(fabsf(e4[r] * aI[2][r] + aX[2][r]), n4[r])); const float rden = __shfl(den0, g * 16);
                const size_t o = (size_t)(t0 + rt * 16 + 4 * g + r) * DML + h * DH + v0 + c16;
                const float h0_ = (e4[r] * aI[0][r] + aX[0][r]) * rden, h1_ = (e4[r] * aI[1][r] + aX[1][r]) * rden;
                if (VAR & 2) { asm volatile("" :: "v"(h0_), "v"(h1_), "v"(o)); } else { hraw[o] = h0_; hraw[o + 16] = h1_; } }
            if (wave == 0 && c + 1 < SEQ / LCH) {
                MLSTM_SMALLS(sb ^ 1, nic, nfc);
                const int c2 = (c + 2 < SEQ / LCH) ? c + 2 : SEQ / LCH - 1;
                nic = gi[(size_t)(b * SEQ + c2 * LCH + lane) * 4 + h]; nfc = gf[(size_t)(b * SEQ + c2 * LCH + lane) * 4 + h];
            }
        } else if (VAR & 8) {   } else {
            const int wB = wave - 4; const float decay = SMF(sb, 1280)[1];
#pragma unroll
            for (int dt = 0; dt < 4; ++dt)
#pragma unroll
                for (int v3 = 0; v3 < 3; ++v3) accC[dt][v3] *= decay;
#pragma unroll
            for (int ks = 0; ks < 2; ++ks) { bf16x8 af[4], bfr[3];
#pragma unroll
                for (int dt = 0; dt < 4; ++dt) { LAS3 unsigned char* kp = L + KS + (ks * 32 + g * 8 + q4) * QST + ((4 * wB + dt) * 16 + 4 * p4) * 2; af[dt] = tr8(kp, kp + 4 * QST); }
#pragma unroll
                for (int v3 = 0; v3 < 3; ++v3) { LAS3 unsigned char* wp = L + WV + (ks * 32 + g * 8 + q4) * VST + (v3 * 16 + 4 * p4) * 2; bfr[v3] = tr8(wp, wp + 4 * VST); }
#pragma unroll
                for (int dt = 0; dt < 4; ++dt)
#pragma unroll
                    for (int v3 = 0; v3 < 3; ++v3) accC[dt][v3] = __builtin_amdgcn_mfma_f32_16x16x32_bf16(af[dt], bfr[v3], accC[dt][v3], 0, 0, 0); }
#pragma unroll
            for (int dt = 0; dt < 4; ++dt)
#pragma unroll
                for (int v3 = 0; v3 < 3; ++v3) { const int d = (4 * wB + dt) * 16 + 4 * g, vp = v3 * 16 + c16;
                    *(LAS3 v2u_t*)(CBn + vp * QST + d * 2) = (v2u_t){pg8::cvt_pk_bf16(accC[dt][v3][0], accC[dt][v3][1]), pg8::cvt_pk_bf16(accC[dt][v3][2], accC[dt][v3][3])}; }
        }
        __syncthreads();
    }
#undef MLSTM_SMALLS
#undef SMF
}

__device__ __forceinline__ void p3_finalize(const Params& P, int G, int bid) {
    const int lane = threadIdx.x & 63, wave = threadIdx.x >> 6;
    const float* hraw = (const float*)(P.ws + WS_HRAW); const bf16_t* proj = (const bf16_t*)(P.ws + WS_PROJ); bf16_t* mix = (bf16_t*)(P.ws + WS_MIXIN);
    for (int idx = bid * NWAVES + wave; idx < T * NH; idx += G * NWAVES) {
        const int t = idx >> 2, hh = idx & 3;
        const float4 hv = *(const float4*)(hraw + (size_t)t * DML + hh * DH + lane * 4);
        const float ss = wave_sum((hv.x * hv.x + hv.y * hv.y) + (hv.z * hv.z + hv.w * hv.w));
        const float r = rsqrtf(ss * (1.0f / DH) + EPS);
        const uint2 ow = *(const uint2*)(proj + (size_t)t * NPROJ + PC_O + hh * DH + lane * 4);
        const float4 g = *(const float4*)(P.gm + hh * DH + lane * 4);
        const float o0 = 1.0f / (1.0f + expf(-bflo(ow.x))), o1 = 1.0f / (1.0f + expf(-bfhi(ow.x))), o2 = 1.0f / (1.0f + expf(-bflo(ow.y))), o3 = 1.0f / (1.0f + expf(-bfhi(ow.y)));
        *(uint2*)(mix + (size_t)t * D + DML + hh * DH + lane * 4) = make_uint2(pk2(o0 * (hv.x * r * g.x), o1 * (hv.y * r * g.y)), pk2(o2 * (hv.z * r * g.z), o3 * (hv.w * r * g.w)));
    }
}

template <int CTRL> __device__ __forceinline__ float dppf(float v) { return __int_as_float(__builtin_amdgcn_update_dpp(0, __float_as_int(v), CTRL, 0xF, 0xF, true)); }
__device__ __forceinline__ float grp16_max(float v) { v = fmaxf(v, dppf<0xB1>(v)); v = fmaxf(v, dppf<0x4E>(v)); v = fmaxf(v, dppf<0x141>(v)); v = fmaxf(v, dppf<0x140>(v)); return v; }
__device__ __forceinline__ float grp16_sum(float v) { v += dppf<0xB1>(v); v += dppf<0x4E>(v); v += dppf<0x141>(v); v += dppf<0x140>(v); return v; }
#define CEX(a, b) do { const float hi_ = fmaxf(a, b), lo_ = fminf(a, b); a = hi_; b = lo_; } while (0)
static __device__ const unsigned char CAND_AB[16][4] = {
    {0x00, 0x01, 0x02, 0x03}, {0x04, 0x05, 0x06, 0x07}, {0x08, 0x09, 0x0A, 0x0B}, {0x0C, 0x0D, 0x0E, 0x0F}, {0x10, 0x11, 0x12, 0x13}, {0x14, 0x15, 0x16, 0x17}, {0x20, 0x21, 0x22, 0x23}, {0x24, 0, 0, 0},
    {0x30, 0x31, 0x32, 0x33}, {0x40, 0x41, 0x42, 0}, {0x50, 0x60, 0x70, 0x80}, {0x90, 0xA0, 0xB0, 0xC0}, {0xD0, 0xE0, 0xF0, 0}, {0x51, 0x61, 0x71, 0}, {0, 0, 0, 0}, {0, 0, 0, 0}};
static __device__ const unsigned char CAND_N[16] = {4, 4, 4, 4, 4, 4, 4, 1, 4, 3, 4, 4, 3, 3, 0, 0};
__device__ __forceinline__ void p6_topk(const Params& P, unsigned char* lds_, int G, int bid) {
    typedef pg8::bf16x8 bf16x8; typedef pg8::f32x4 f32x4;
    LAS3 unsigned char* L = (LAS3 unsigned char*)lds_;
    constexpr int KST = 272, KHALF = 128 * KST;
    const int tid = threadIdx.x, lane = tid & 63, wave = tid >> 6, g = lane >> 4, c16 = lane & 15;
    for (int i = tid; i < 2 * 2048; i += NTHREADS) { const int hf = i >> 11, n = (i >> 4) & 127, d8 = (i & 15) * 8; const float* src = (hf ? P.sk2 : P.sk1) + n * 128 + d8;
        const float4 a = *(const float4*)src, b = *(const float4*)(src + 4);
        *(LAS3 v4u_t*)(L + hf * KHALF + n * KST + d8 * 2) = (v4u_t){pk2(a.x, a.y), pk2(a.z, a.w), pk2(b.x, b.y), pk2(b.z, b.w)}; }
    __syncthreads();
    const bf16_t* qvb = (const bf16_t*)(P.ws + WS_QV);
    int* idxo = (int*)(P.ws + WS_IDX); float* gato = (float*)(P.ws + WS_GATE);
    const float NEGINF = -__builtin_inff();
    unsigned ctab = 0; { const unsigned char* tp = CAND_AB[c16]; ctab = (unsigned)tp[0] | ((unsigned)tp[1] << 8) | ((unsigned)tp[2] << 16) | ((unsigned)tp[3] << 24); }
    const int ccnt = CAND_N[c16];
#pragma unroll 1
    for (int it = bid * NWAVES + wave; it < (T / 16) * PEER_H; it += G * NWAVES) {
        const int t0 = (it >> 3) * 16, hh = it & 7;
        float keepH[2][4];
#pragma unroll
        for (int hf = 0; hf < 2; ++hf) {
            asm volatile("" ::: "memory");
            bf16x8 af[4];
#pragma unroll
            for (int ks = 0; ks < 4; ++ks) af[ks] = *(const bf16x8*)(qvb + (size_t)(t0 + c16) * D + hh * 256 + hf * 128 + ks * 32 + g * 8);
            f32x4 acc[8];
#pragma unroll
            for (int ct = 0; ct < 8; ++ct) { acc[ct] = (f32x4){0.f, 0.f, 0.f, 0.f};
#pragma unroll
                for (int ks = 0; ks < 4; ++ks) { const bf16x8 bv = *(LAS3 bf16x8*)(L + hf * KHALF + (ct * 16 + c16) * KST + (ks * 32 + g * 8) * 2);
                    acc[ct] = __builtin_amdgcn_mfma_f32_16x16x32_bf16(af[ks], bv, acc[ct], 0, 0, 0); } }
            float v[4][8];
#pragma unroll
            for (int r = 0; r < 4; ++r) {
#pragma unroll
                for (int ct = 0; ct < 8; ++ct) v[r][ct] = __uint_as_float((__float_as_uint(acc[ct][r]) & ~127u) | (unsigned)(127 - (ct * 16 + c16)));
                CEX(v[r][0], v[r][1]); CEX(v[r][2], v[r][3]); CEX(v[r][4], v[r][5]); CEX(v[r][6], v[r][7]);
                CEX(v[r][0], v[r][2]); CEX(v[r][1], v[r][3]); CEX(v[r][4], v[r][6]); CEX(v[r][5], v[r][7]);
                CEX(v[r][1], v[r][2]); CEX(v[r][5], v[r][6]); CEX(v[r][0], v[r][4]); CEX(v[r][3], v[r][7]);
                CEX(v[r][1], v[r][5]); CEX(v[r][2], v[r][6]);
                CEX(v[r][1], v[r][4]); CEX(v[r][3], v[r][6]);
                CEX(v[r][2], v[r][4]); CEX(v[r][3], v[r][5]);
                CEX(v[r][3], v[r][4]);
                keepH[hf][r] = 0.f;
            }
#pragma unroll
            for (int rd = 0; rd < TOPK; ++rd) {
#pragma unroll
                for (int r = 0; r < 4; ++r) {
                    const float W = grp16_max(v[r][0]); const bool win = (v[r][0] == W);
                    if (c16 == rd) keepH[hf][r] = W;
#pragma unroll
                    for (int k = 0; k < 7; ++k) v[r][k] = win ? v[r][k + 1] : v[r][k];
                    v[r][7] = win ? NEGINF : v[r][7];
                }
            }
        }
#pragma unroll
        for (int r = 0; r < 4; ++r) {
            const float V1 = keepH[0][r], V2 = keepH[1][r];
            float cv[4];
#pragma unroll
            for (int s4 = 0; s4 < 4; ++s4) { const unsigned code = (ctab >> (8 * s4)) & 255u;
                const float x1 = __shfl(V1, g * 16 + (int)(code >> 4)), x2 = __shfl(V2, g * 16 + (int)(code & 15u));
                const float sum = __uint_as_float(__float_as_uint(x1) & ~127u) + __uint_as_float(__float_as_uint(x2) & ~127u);
                cv[s4] = (s4 < ccnt) ? __uint_as_float((__float_as_uint(sum) & ~255u) | (255u - code)) : NEGINF; }
            float keepc = 0.f;
#pragma unroll
            for (int rd = 0; rd < TOPK; ++rd) {
                const float W = grp16_max(cv[0]); const bool win = (cv[0] == W);
                if (c16 == rd) keepc = W;
                cv[0] = win ? cv[1] : cv[0]; cv[1] = win ? cv[2] : cv[1]; cv[2] = win ? cv[3] : cv[2]; cv[3] = win ? NEGINF : cv[3];
            }
            const unsigned kb = __float_as_uint(keepc), code = 255u - (kb & 255u);
            const unsigned n1 = 127u - (__float_as_uint(__shfl(V1, g * 16 + (int)(code >> 4))) & 127u), n2 = 127u - (__float_as_uint(__shfl(V2, g * 16 + (int)(code & 15u))) & 127u);
            const float sval = __uint_as_float(kb & ~255u), smax = __shfl(sval, g * 16);
            const float ex = __expf(sval - smax), den = grp16_sum(ex);
            const size_t o = (size_t)(t0 + 4 * g + r) * 128 + hh * 16 + c16;
            idxo[o] = (int)(n1 * 128u + n2); gato[o] = ex / den;
        }
    }
    __syncthreads();
}

__device__ __forceinline__ float wave_sum_dpp(float v) {
    v += dppf<0xB1>(v); v += dppf<0x4E>(v); v += dppf<0x141>(v); v += dppf<0x140>(v);
    const int iv = __float_as_int(v);
    return (__int_as_float(__builtin_amdgcn_readlane(iv, 0)) + __int_as_float(__builtin_amdgcn_readlane(iv, 16))) + (__int_as_float(__builtin_amdgcn_readlane(iv, 32)) + __int_as_float(__builtin_amdgcn_readlane(iv, 48)));
}
__device__ __forceinline__ float dot16_fp8(const v4u_t w, const float (&x)[16]) {
    float s = 0.f;
#pragma unroll
    for (int k = 0; k < 4; ++k) { const f32x2_t lo = __builtin_amdgcn_cvt_pk_f32_fp8(w[k], false), hi = __builtin_amdgcn_cvt_pk_f32_fp8(w[k], true);
        s += (x[4 * k] * lo.x + x[4 * k + 1] * lo.y) + (x[4 * k + 2] * hi.x + x[4 * k + 3] * hi.y); }
    return s;
}
__device__ __forceinline__ void axpy16_fp8(const v4u_t w, const float cf, float (&y)[16]) {
#pragma unroll
    for (int k = 0; k < 4; ++k) { const f32x2_t lo = __builtin_amdgcn_cvt_pk_f32_fp8(w[k], false), hi = __builtin_amdgcn_cvt_pk_f32_fp8(w[k], true);
        y[4 * k] += cf * lo.x; y[4 * k + 1] += cf * lo.y; y[4 * k + 2] += cf * hi.x; y[4 * k + 3] += cf * hi.y; }
}
#define PIN16(a) asm volatile("" : "+v"(a[0]), "+v"(a[1]), "+v"(a[2]), "+v"(a[3]), "+v"(a[4]), "+v"(a[5]), "+v"(a[6]), "+v"(a[7]), "+v"(a[8]), "+v"(a[9]), "+v"(a[10]), "+v"(a[11]), "+v"(a[12]), "+v"(a[13]), "+v"(a[14]), "+v"(a[15]))
__device__ __forceinline__ float row16_sum(float v) { v += dppf<0xB1>(v); v += dppf<0x4E>(v); v += dppf<0x141>(v); v += dppf<0x140>(v); return v; }
__device__ __forceinline__ void p7_peer(const Params& P, unsigned char* lds_, int G, int bid) {
    const int lane = threadIdx.x & 63, wave = __builtin_amdgcn_readfirstlane(threadIdx.x >> 6);
    LAS3 unsigned char* W = (LAS3 unsigned char*)lds_ + wave * 8192;
    const bf16_t* x1b = (const bf16_t*)(P.ws + WS_X1B); const float* x1 = (const float*)(P.ws + WS_X1); const float* ssq = (const float*)(P.ws + WS_SSQ);
    const int* idxi = (const int*)(P.ws + WS_IDX); const float* gati = (const float*)(P.ws + WS_GATE);
    const unsigned char* ub = P.ws + WS_UB; const unsigned char* vb = P.ws + WS_VB; const float* esc = (const float*)(P.ws + WS_ESC);
#pragma unroll 1
    for (int qd = bid * NWAVES + wave; qd < T / 4; qd += G * NWAVES) {
        int ln = lane; asm volatile("" : "+v"(ln));
        const int tb = qd * 4, q = ln >> 4, l16 = ln & 15, t = tb + q;
        const unsigned loff = (unsigned)l16 * 16u;
#pragma unroll 1
        for (int s4 = 0; s4 < 4; ++s4) {
            LAS3 int* hist = (LAS3 int*)(W + 4096); LAS3 int* base = (LAS3 int*)(W + 4096 + 256); LAS3 v2u_t* list = (LAS3 v2u_t*)(W + s4 * 1024);
            const size_t o = (size_t)(tb + s4) * 128 + ln;
            const int i0 = idxi[o], i1 = idxi[o + 64]; const float g0 = gati[o], g1 = gati[o + 64];
            hist[ln] = 0; asm volatile("s_waitcnt lgkmcnt(0)" ::: "memory");
            const int t0_ = __hip_atomic_fetch_add((int*)(hist + (i0 >> 8)), 1, __ATOMIC_RELAXED, __HIP_MEMORY_SCOPE_WORKGROUP);
            const int t1_ = __hip_atomic_fetch_add((int*)(hist + (i1 >> 8)), 1, __ATOMIC_RELAXED, __HIP_MEMORY_SCOPE_WORKGROUP);
            asm volatile("s_waitcnt lgkmcnt(0)" ::: "memory");
            const int cnt = hist[ln]; int inc = cnt;
#pragma unroll
            for (int o2 = 1; o2 < 64; o2 <<= 1) { const int tv = __shfl_up(inc, o2); if (ln >= o2) inc += tv; }
            base[ln] = inc - cnt; asm volatile("s_waitcnt lgkmcnt(0)" ::: "memory");
            list[base[i0 >> 8] + t0_] = (v2u_t){(unsigned)i0, __float_as_uint(g0)}; list[base[i1 >> 8] + t1_] = (v2u_t){(unsigned)i1, __float_as_uint(g1)};
            asm volatile("s_waitcnt lgkmcnt(0)" ::: "memory");
        }
        LAS3 v2u_t* mylist = (LAS3 v2u_t*)(W + q * 1024); LAS3 float* mydot = (LAS3 float*)(W + 4096 + q * 512);
        const float rs2 = rsqrtf(row16_sum(ssq[(size_t)t * 32 + l16] + ssq[(size_t)t * 32 + 16 + l16]) * (1.0f / D) + EPS);
        v4u_t bA[8], bB[8];
#define P7_LOADQ(TAB, j, Bf) do { const unsigned e_ = mylist[j].x; const unsigned char* rp = (TAB) + (size_t)e_ * D + loff; \
            _Pragma("unroll") for (int jj = 0; jj < 8; ++jj) Bf[jj] = *(const v4u_t*)(rp + jj * 256); } while (0)
        {
            float xf[8][16];
#pragma unroll
            for (int jj = 0; jj < 8; ++jj) { float a[8], b[8]; unpack8(*(const uint4*)(x1b + (size_t)t * D + jj * 256 + l16 * 16), a); unpack8(*(const uint4*)(x1b + (size_t)t * D + jj * 256 + l16 * 16 + 8), b);
#pragma unroll
                for (int i = 0; i < 8; ++i) { xf[jj][i] = a[i]; xf[jj][8 + i] = b[i]; } }
#define P7_DOTQ(j, Bf) do { float sacc = 0.f; _Pragma("unroll") for (int jj = 0; jj < 8; ++jj) { asm volatile("" : "+v"(Bf[jj])); sacc += dot16_fp8(Bf[jj], xf[jj]); } \
            const float tot = row16_sum(sacc); if (l16 == 0) mydot[j] = tot; } while (0)
            P7_LOADQ(ub, 0, bA);
#pragma unroll 1
            for (int j = 0; j < 126; j += 2) { P7_LOADQ(ub, j + 1, bB); P7_DOTQ(j, bA); P7_LOADQ(ub, j + 2, bA); P7_DOTQ(j + 1, bB); }
            P7_LOADQ(ub, 127, bB); P7_DOTQ(126, bA); P7_LOADQ(vb, 0, bA); P7_DOTQ(127, bB);
#undef P7_DOTQ
        }
        asm volatile("s_waitcnt lgkmcnt(0)" ::: "memory");
        { const float r0 = __int_as_float(__builtin_amdgcn_readlane(__float_as_int(rs2), 0)), r1 = __int_as_float(__builtin_amdgcn_readlane(__float_as_int(rs2), 16)),
                      r2 = __int_as_float(__builtin_amdgcn_readlane(__float_as_int(rs2), 32)), r3 = __int_as_float(__builtin_amdgcn_readlane(__float_as_int(rs2), 48));
#pragma unroll
          for (int k = 0; k < 8; ++k) { const int n = k * 64 + ln; const v2u_t en = *(LAS3 v2u_t*)(W + n * 8); LAS3 float* dp = (LAS3 float*)(W + 4096 + n * 4);
              const float rr = (k >> 1) == 0 ? r0 : (k >> 1) == 1 ? r1 : (k >> 1) == 2 ? r2 : r3; const float su = esc[en.x * 2], sv = esc[en.x * 2 + 1];
              *dp = __uint_as_float(en.y) * gelu_erf(*dp * rr * su) * sv; } }
        asm volatile("s_waitcnt lgkmcnt(0)" ::: "memory");
        float y[8][16];
#pragma unroll
        for (int jj = 0; jj < 8; ++jj)
#pragma unroll
            for (int i = 0; i < 16; ++i) y[jj][i] = 0.f;
#define P7_AXQ(j, Bf) do { const float cf = mydot[j]; _Pragma("unroll") for (int jj = 0; jj < 8; ++jj) { asm volatile("" : "+v"(Bf[jj])); axpy16_fp8(Bf[jj], cf, y[jj]); PIN16(y[jj]); } } while (0)
#pragma unroll 1
        for (int j = 0; j < 126; j += 2) { P7_LOADQ(vb, j + 1, bB); P7_AXQ(j, bA); P7_LOADQ(vb, j + 2, bA); P7_AXQ(j + 1, bB); }
        P7_LOADQ(vb, 127, bB); P7_AXQ(126, bA); P7_AXQ(127, bB);
#undef P7_AXQ
#undef P7_LOADQ
#undef PIN16
        float ss = 0.f;
#pragma unroll
        for (int jj = 0; jj < 8; ++jj)
#pragma unroll
            for (int k = 0; k < 4; ++k) { const float4 a = *(const float4*)(x1 + (size_t)t * D + jj * 256 + l16 * 16 + 4 * k);
                y[jj][4 * k] += a.x; y[jj][4 * k + 1] += a.y; y[jj][4 * k + 2] += a.z; y[jj][4 * k + 3] += a.w;
                ss += (y[jj][4 * k] * y[jj][4 * k] + y[jj][4 * k + 1] * y[jj][4 * k + 1]) + (y[jj][4 * k + 2] * y[jj][4 * k + 2] + y[jj][4 * k + 3] * y[jj][4 * k + 3]); }
        ss = row16_sum(ss);
        const float r = rsqrtf(ss * (1.0f / D) + EPS);
#pragma unroll
        for (int jj = 0; jj < 8; ++jj)
#pragma unroll
            for (int k = 0; k < 4; ++k) { const float4 gg = *(const float4*)(P.gfin + jj * 256 + l16 * 16 + 4 * k);
                *(float4*)(P.out + (size_t)t * D + jj * 256 + l16 * 16 + 4 * k) = make_float4(y[jj][4 * k] * r * gg.x, y[jj][4 * k + 1] * r * gg.y, y[jj][4 * k + 2] * r * gg.z, y[jj][4 * k + 3] * r * gg.w); }
    }
}

#define XB_TMO      128
#define XB_XCNT(j)  (256  + 64 * (j))
#define XB_XSUB(j)  (1280 + 64 * (j))
#define XB_XGEN(j)  (2304 + 64 * (j))
#define XB_TOP      3328
#define XB_TOPGEN   3392
#define XCD_BAR_WORDS 3456
#define XB_SPIN_CAP (1u << 18)

__device__ __forceinline__ unsigned xb_ld(unsigned* p)              { return __hip_atomic_load(p, __ATOMIC_RELAXED, __HIP_MEMORY_SCOPE_AGENT); }
__device__ __forceinline__ unsigned xb_add(unsigned* p, unsigned v) { return __hip_atomic_fetch_add(p, v, __ATOMIC_RELAXED, __HIP_MEMORY_SCOPE_AGENT); }
__device__ __forceinline__ unsigned xb_xcc_id() { return (unsigned)__builtin_amdgcn_s_getreg((3 << 11) | 20) & 0xFu; }
#define XB_SPIN(cond, bar) do { unsigned _sp = 0; while (cond) { __builtin_amdgcn_s_sleep(1); \
    if ((++_sp & 255u) == 0u) { if (xb_ld(&(bar)[XB_TMO])) break; if (_sp > XB_SPIN_CAP) { atomicAdd(&(bar)[XB_TMO], 1u); break; } } } } while (0)

struct XcdBarrier {
    unsigned* bar; unsigned x;
    volatile LAS3 unsigned* st;
};

__device__ __forceinline__ XcdBarrier xcd_barrier_post(unsigned* bar, volatile LAS3 unsigned* st) {
    XcdBarrier b; b.bar = bar; b.x = xb_xcc_id(); b.st = st;
    if (threadIdx.x == 0) (void)xb_add(&bar[XB_XCNT(b.x)], 1u);
    return b;
}
__device__ __forceinline__ void xcd_barrier_complete(unsigned* bar, unsigned x, unsigned& nloc, unsigned& nx) {
    const unsigned G = gridDim.x * gridDim.y * gridDim.z;
    unsigned sum, cnt, mine, sp = 0u;
    for (;;) {
        sum = 0u; cnt = 0u; mine = 0u;
#pragma unroll
        for (unsigned j = 0; j < 16; ++j) { const unsigned c = xb_ld(&bar[XB_XCNT(j)]); sum += c; cnt += (c > 0u) ? 1u : 0u; mine = (j == x) ? c : mine; }
        if (sum == G) break;
        __builtin_amdgcn_s_sleep(1);
        if ((++sp & 255u) == 0u) { if (xb_ld(&bar[XB_TMO])) break; if (sp > XB_SPIN_CAP) { atomicAdd(&bar[XB_TMO], 1u); break; } }
    }
    nloc = mine > 0u ? mine : 1u; nx = cnt > 0u ? cnt : 1u;
}

__device__ __forceinline__ void xcd_barrier(const XcdBarrier& b) {
    asm volatile("s_waitcnt vmcnt(0)" ::: "memory");
    __syncthreads();
    if (threadIdx.x == 0) {
        unsigned* bar = b.bar;
        __builtin_amdgcn_s_waitcnt(0);
        unsigned nloc = b.st[0], nx = b.st[1];
        if (nloc == 0u) { xcd_barrier_complete(bar, b.x, nloc, nx); b.st[0] = nloc; b.st[1] = nx; }
        const unsigned old = xb_add(&bar[XB_XSUB(b.x)], 1u);
        const unsigned gen = old / nloc;
        if (old + 1u == (gen + 1u) * nloc) {
            __builtin_amdgcn_fence(__ATOMIC_RELEASE, "agent");
            asm volatile("s_waitcnt vmcnt(0)" ::: "memory");
            const unsigned og = xb_add(&bar[XB_TOP], 1u);
            const unsigned tg = og / nx;
            if (og + 1u == (tg + 1u) * nx) xb_add(&bar[XB_TOPGEN], 1u);
            else XB_SPIN(xb_ld(&bar[XB_TOPGEN]) == tg, bar);
            __builtin_amdgcn_fence(__ATOMIC_ACQUIRE, "agent");
            xb_add(&bar[XB_XGEN(b.x)], 1u);
            asm volatile("s_waitcnt vmcnt(0)" ::: "memory");
        } else {
            XB_SPIN(xb_ld(&bar[XB_XGEN(b.x)]) == gen, bar);
            __builtin_amdgcn_fence(__ATOMIC_ACQUIRE, "agent");
            asm volatile("s_waitcnt vmcnt(0)" ::: "memory");
        }
    }
    __syncthreads();
}

constexpr int N_PHASES = 8;
#ifndef MK_N_LAUNCHES
#define MK_N_LAUNCHES 1
#endif
__global__ void __launch_bounds__(NTHREADS, 2) layer_fwd(Params P) {
    extern __shared__ __attribute__((aligned(16))) unsigned char lds[];
    const int G = gridDim.x, bid = blockIdx.x;
    volatile LAS3 unsigned* bst = (volatile LAS3 unsigned*)((LAS3 unsigned char*)lds + (LDS_BYTES - 16));
    if (threadIdx.x < 4) bst[threadIdx.x] = 0u;
    __syncthreads();
    XcdBarrier xbar = xcd_barrier_post((unsigned*)(P.ws + WS_CTL) + CW_BAR, bst);
    const int lo = P.ph_lo, hi = P.ph_hi;
#ifndef PH_MASK
#define PH_MASK 0xff
#endif
#define IN(k) (((PH_MASK >> (k)) & 1) && lo <= (k) && (k) < hi)
#define SEAM(k) do { if (IN(k) && IN((k) + 1)) xcd_barrier(xbar); } while (0)
#ifndef REP_MASK
#define REP_MASK 0
#endif
#define REPS(k) (((REP_MASK >> (k)) & 1) ? 2 : 1)
    if (IN(0)) for (int rep = 0; rep < REPS(0); ++rep) { p0_rows(P, lds, G, bid); p0_weights_in(P, lds, G, bid); }
    SEAM(0);
    if (IN(1)) for (int rep = 0; rep < REPS(1); ++rep) {
        pg8::Gemm g{(const pg8::bf16_t*)(P.ws + WS_XB), (const pg8::bf16_t*)(P.ws + WS_WINT), T, NPROJ, D}; pg8::StaticOrder S; S.init(T, NPROJ, G, bid);
        pg8::EpiProj E{(pg8::bf16_t*)(P.ws + WS_PROJ), NPROJ, (const float*)(P.ws + WS_RS1)};
        pg8::gemm_phase<pg8::EpiProj, pg8::StaticOrder, true, true>((PG8_LAS unsigned char*)lds, g, S, E);
    }
    SEAM(1);
    if (IN(2)) for (int rep = 0; rep < REPS(2); ++rep) {
        for (int u = bid; u < 64; u += G) mlstm_unit<0>(P, lds, u, (float*)(P.ws + WS_HRAW));
#ifndef REP_OTH
#define REP_OTH 1
#endif
        if (G > 64) { if (bid >= 64) for (int r2 = 0; r2 < REP_OTH; ++r2) { p2_conv(P, G - 64, bid - 64); p2_weights_sq(P, lds, G - 64, bid - 64); p0_tables(P, G - 64, bid - 64); } }
        else { p2_conv(P, G, bid); p2_weights_sq(P, lds, G, bid); p0_tables(P, G, bid); }
    }
    SEAM(2);
#ifdef MLSTM_PROBE
    if (IN(3)) { if (bid < 64) mlstm_unit<MLSTM_PROBE>(P, lds, bid, (float*)(P.ws + 460 * MiB)); }
#endif
    if (IN(3)) for (int rep = 0; rep < REPS(3); ++rep) p3_finalize(P, G, bid);
    SEAM(3);
    if (IN(4)) for (int rep = 0; rep < REPS(4); ++rep) {
        pg8::Gemm g{(const pg8::bf16_t*)(P.ws + WS_MIXIN), (const pg8::bf16_t*)(P.ws + WS_WOUTT), T, D, D}; pg8::StaticOrder S; S.init(T, D, G, bid);
        pg8::EpiOut E{P.x, (float*)(P.ws + WS_X1), (pg8::bf16_t*)(P.ws + WS_X1B), (float*)(P.ws + WS_SSQ), D};
        pg8::gemm_phase<pg8::EpiOut, pg8::StaticOrder, false, true>((PG8_LAS unsigned char*)lds, g, S, E);
    }
    SEAM(4);
    if (IN(5)) for (int rep = 0; rep < REPS(5); ++rep) {
        pg8::Gemm g{(const pg8::bf16_t*)(P.ws + WS_X1B), (const pg8::bf16_t*)(P.ws + WS_WQT), T, D, D}; pg8::StaticOrder S; S.init(T, D, G, bid);
        pg8::EpiQb E{(pg8::bf16_t*)(P.ws + WS_QV), D, (const float*)(P.ws + WS_SSQ)};
        pg8::gemm_phase<pg8::EpiQb, pg8::StaticOrder, false, true>((PG8_LAS unsigned char*)lds, g, S, E);
    }
    SEAM(5);
    if (IN(6)) for (int rep = 0; rep < REPS(6); ++rep) p6_topk(P, lds, G, bid);
    SEAM(6);
#ifdef EXTRA_SYNCS
    for (int i = 0; i < EXTRA_SYNCS; ++i) xcd_barrier(xbar);
#endif
    if (IN(7)) for (int rep = 0; rep < REPS(7); ++rep) p7_peer(P, lds, G, bid);
#undef IN
#undef SEAM
}

extern "C" void kernel_launch(void* const* d_in, const int* in_sizes, int n_in, void* d_out, int out_size, void* d_ws, size_t ws_size, hipStream_t stream) {
    static int grid = 0;
    if (grid == 0) {
        if (n_in != 15 || in_sizes[0] != T * D || out_size != T * D || ws_size < WS_END) { fprintf(stderr, "kernel_launch: unexpected shapes (n_in %d, in0 %d, out %d, ws %zu); nothing launched\n", n_in, n_in > 0 ? in_sizes[0] : -1, out_size, ws_size); grid = -1; return; }
        int dev = 0, cus = 0, per_cu = 0;
        if (hipGetDevice(&dev) != hipSuccess || hipDeviceGetAttribute(&cus, hipDeviceAttributeMultiprocessorCount, dev) != hipSuccess) { grid = -1; return; }
        if (hipFuncSetAttribute((const void*)layer_fwd, hipFuncAttributeMaxDynamicSharedMemorySize, LDS_BYTES) != hipSuccess) { fprintf(stderr, "kernel_launch: hipFuncSetAttribute failed\n"); grid = -1; return; }
        if (hipOccupancyMaxActiveBlocksPerMultiprocessor(&per_cu, (const void*)layer_fwd, NTHREADS, LDS_BYTES) != hipSuccess || per_cu < 1) { fprintf(stderr, "kernel_launch: occupancy query says %d blocks per CU\n", per_cu); (void)hipGetLastError(); grid = -1; return; }
        grid = cus;
    }
    if (grid < 0) return;
    Params p{};
    p.x = (const float*)d_in[0]; p.g1 = (const float*)d_in[1]; p.w_in = (const float*)d_in[2]; p.b_ig = (const float*)d_in[3]; p.b_fg = (const float*)d_in[4];
    p.conv_w = (const float*)d_in[5]; p.gm = (const float*)d_in[6]; p.w_out = (const float*)d_in[7]; p.g2 = (const float*)d_in[8]; p.w_q = (const float*)d_in[9];
    p.sk1 = (const float*)d_in[10]; p.sk2 = (const float*)d_in[11]; p.eu = (const float*)d_in[12]; p.ev = (const float*)d_in[13]; p.gfin = (const float*)d_in[14];
    p.out = (float*)d_out; p.ws = (unsigned char*)d_ws;
    if (hipMemsetAsync((char*)d_ws + WS_CTL, 0, CTL_ZERO_BYTES, stream) != hipSuccess) { fprintf(stderr, "kernel_launch: hipMemsetAsync failed\n"); return; }
    for (int li = 0; li < MK_N_LAUNCHES; ++li) {
        p.ph_lo = (MK_N_LAUNCHES == 1) ? 0 : li; p.ph_hi = (MK_N_LAUNCHES == 1) ? N_PHASES : li + 1;
        void* args[] = {&p};
        const hipError_t e = hipLaunchCooperativeKernel((const void*)layer_fwd, dim3(grid), dim3(NTHREADS), args, LDS_BYTES, stream);
        if (e != hipSuccess) { fprintf(stderr, "kernel_launch: cooperative launch %d failed: %s (grid %d)\n", li, hipGetErrorString(e), grid); break; }
    }
}
```

```cpp
#include <hip/hip_runtime.h>
#include <hip/hip_cooperative_groups.h>
#include <cstdio>
#include <cstdint>
namespace cg = cooperative_groups;
namespace pg8 {
#define PG8_LAS __attribute__((address_space(3)))
typedef unsigned short bf16_t;
typedef short bf16x8 __attribute__((ext_vector_type(8)));
typedef float f32x4 __attribute__((ext_vector_type(4)));
typedef unsigned u32x4 __attribute__((ext_vector_type(4)));
constexpr int BM = 256, BK = 64, HALF = 128, HTB = HALF * BK * 2  , STAGE_BYTES = 8 * HTB, NXCD = 8, WGM = 8;

__host__ __device__ __forceinline__ int lds_byte(int r, int c) { const int st = (r >> 4) * 2 + (c >> 5), rr = r & 15, cc = c & 31, ob = rr * 64 + cc * 2; return st * 1024 + (ob ^ (((ob >> 9) & 1) << 5)); }
__host__ __device__ __forceinline__ void stage_rc(int b, int& R, int& C) { const int st = b / 1024, sb = b % 1024, swz = sb ^ (((sb >> 9) & 1) << 5); R = (st >> 1) * 16 + swz / 64; C = (st & 1) * 32 + (swz % 64) / 2; }
__host__ __device__ __forceinline__ int perm32(int rho) { const int n = rho >> 4, i = rho & 15; return 8 * (i >> 2) + 4 * n + (i & 3); }

struct Unit { int pm, pn; };
struct Gemm { const bf16_t* A; const bf16_t* Bt; int M, N, K; };

struct StaticOrder {
    int nM, nN, nwg, G, c;
    __host__ __device__ void init(int M, int N, int G_, int c_) { nM = M / BM; nN = N / BM; nwg = nM * nN; G = G_; c = c_; }
    __host__ __device__ bool next(int i, Unit& u) const {
        const long L = (long)i * G + c; if (L >= nwg) return false;
        int wgid = (int)L; { const int q = nwg / NXCD, r = nwg % NXCD, xcd = wgid % NXCD, off = wgid / NXCD; wgid = (xcd < r ? xcd * (q + 1) : r * (q + 1) + (xcd - r) * q) + off; }
        const int nig = WGM * nN, gid = wgid / nig, fm = gid * WGM, gsz = (nM - fm) < WGM ? (nM - fm) : WGM;
        u.pm = fm + ((wgid % nig) % gsz); u.pn = (wgid % nig) / gsz; return true;
    }
    __device__ __forceinline__ void a_ready(const Unit&) const {}
    __device__ __forceinline__ void done(const Unit&) const {}
};

__device__ __forceinline__ unsigned cvt_pk_bf16(float lo, float hi) { unsigned r; asm volatile("v_cvt_pk_bf16_f32 %0, %1, %2" : "=v"(r) : "v"(lo), "v"(hi)); return r; }
struct EpiProj {
    static constexpr bool PERM = true, AFTER_DRAIN = false;
    bf16_t* O; int ldc; const float* rs;
    __device__ __forceinline__ void operator()(const f32x4 (&acc)[2][2][4][2], const Unit& u, int wr, int wc, int fr, int fq) const {
        const int row0 = u.pm * BM + wr * 64 + fr, col0 = u.pn * BM + wc * 32 + 8 * fq;
#pragma unroll
        for (int ai = 0; ai < 2; ++ai)
#pragma unroll
            for (int m = 0; m < 4; ++m) { const int row = row0 + ai * HALF + m * 16; const float s = rs[row]; bf16_t* rowp = O + (size_t)row * ldc + col0;
#pragma unroll
                for (int bj = 0; bj < 2; ++bj) { const f32x4 v0 = acc[ai][bj][m][0] * s, v1 = acc[ai][bj][m][1] * s; u32x4 w;
                    w.x = cvt_pk_bf16(v0[0], v0[1]); w.y = cvt_pk_bf16(v0[2], v0[3]); w.z = cvt_pk_bf16(v1[0], v1[1]); w.w = cvt_pk_bf16(v1[2], v1[3]);
                    *(u32x4*)(rowp + bj * HALF) = w; } }
    }
};
struct EpiOut {
    static constexpr bool PERM = false, AFTER_DRAIN = false;
    const float* X; float* X1; bf16_t* X1B; float* SSQ; int ldc;
    __device__ __forceinline__ void operator()(const f32x4 (&acc)[2][2][4][2], const Unit& u, int wr, int wc, int fr, int fq) const {
        typedef unsigned u32x2 __attribute__((ext_vector_type(2)));
        const int row0 = u.pm * BM + wr * 64 + fr, col0 = u.pn * BM + wc * 32 + 4 * fq;
#pragma unroll
        for (int ai = 0; ai < 2; ++ai)
#pragma unroll
            for (int m = 0; m < 4; ++m) { const int row = row0 + ai * HALF + m * 16; const size_t off = (size_t)row * ldc + col0; float ss = 0.f;
#pragma unroll
                for (int bj = 0; bj < 2; ++bj)
#pragma unroll
                    for (int n = 0; n < 2; ++n) { const size_t c = off + bj * HALF + n * 16; const f32x4 xv = *(const f32x4*)(X + c); const f32x4 o = xv + acc[ai][bj][m][n];
                        *(f32x4*)(X1 + c) = o; ss += (o[0] * o[0] + o[1] * o[1]) + (o[2] * o[2] + o[3] * o[3]);
                        u32x2 pk; pk.x = cvt_pk_bf16(o[0], o[1]); pk.y = cvt_pk_bf16(o[2], o[3]); *(u32x2*)(X1B + c) = pk; }
                ss += __shfl_xor(ss, 16); ss += __shfl_xor(ss, 32);
                if (fq == 0) SSQ[(size_t)row * 32 + u.pn * 4 + wc] = ss; }
    }
};
struct EpiQ {
    static constexpr bool PERM = false, AFTER_DRAIN = false;
    float* O; int ldc;
    __device__ __forceinline__ void operator()(const f32x4 (&acc)[2][2][4][2], const Unit& u, int wr, int wc, int fr, int fq) const {
        const int row0 = u.pm * BM + wr * 64 + fr, col0 = u.pn * BM + wc * 32 + 4 * fq;
#pragma unroll
        for (int ai = 0; ai < 2; ++ai)
#pragma unroll
            for (int m = 0; m < 4; ++m) { const size_t off = (size_t)(row0 + ai * HALF + m * 16) * ldc + col0;
#pragma unroll
                for (int bj = 0; bj < 2; ++bj)
#pragma unroll
                    for (int n = 0; n < 2; ++n) *(f32x4*)(O + off + bj * HALF + n * 16) = acc[ai][bj][m][n]; }
    }
};
struct EpiQb {
    static constexpr bool PERM = true, AFTER_DRAIN = false;
    bf16_t* O; int ldc; const float* SSQ;
    __device__ __forceinline__ void operator()(const f32x4 (&acc)[2][2][4][2], const Unit& u, int wr, int wc, int fr, int fq) const {
        const int row0 = u.pm * BM + wr * 64 + fr, col0 = u.pn * BM + wc * 32 + 8 * fq;
#pragma unroll
        for (int ai = 0; ai < 2; ++ai)
#pragma unroll
            for (int m = 0; m < 4; ++m) { const int row = row0 + ai * HALF + m * 16; const f32x4* sp = (const f32x4*)(SSQ + (size_t)row * 32);
                f32x4 s4 = sp[0];
#pragma unroll
                for (int i = 1; i < 8; ++i) s4 += sp[i];
                const float s = rsqrtf(((s4[0] + s4[1]) + (s4[2] + s4[3])) * (1.0f / 2048.0f) + 1e-6f); bf16_t* rowp = O + (size_t)row * ldc + col0;
#pragma unroll
                for (int bj = 0; bj < 2; ++bj) { const f32x4 v0 = acc[ai][bj][m][0] * s, v1 = acc[ai][bj][m][1] * s; u32x4 w;
                    w.x = cvt_pk_bf16(v0[0], v0[1]); w.y = cvt_pk_bf16(v0[2], v0[3]); w.z = cvt_pk_bf16(v1[0], v1[1]); w.w = cvt_pk_bf16(v1[2], v1[3]);
                    *(u32x4*)(rowp + bj * HALF) = w; } }
    }
};
template <class Epi, class Sched, bool ALIGN_EPI = false, bool SP2 = false>
__device__ __forceinline__ void gemm_phase(PG8_LAS unsigned char* lds, const Gemm g, const Sched& S, const Epi& E) {
    const int tid = threadIdx.x, wid = __builtin_amdgcn_readfirstlane(tid >> 6), lane = tid & 63, wr = wid >> 2, wc = wid & 3, fr = lane & 15, fq = lane >> 4;
    const int K = g.K, nt = K / BK;
    unsigned voffA[2], voffB[2];
#pragma unroll
    for (int i = 0; i < 2; ++i) { int R, C; stage_rc(tid * 16 + i * 8192, R, C); const int Rb = Epi::PERM ? ((R & ~31) + perm32(R & 31)) : R;
        voffA[i] = (unsigned)(R * K + C) * 2u; voffB[i] = (unsigned)(Rb * K + C) * 2u; }
    const size_t kstep = (size_t)(BK * 2);
    const size_t hstep = (size_t)HALF * K * 2;
    const size_t tstep = 2 * hstep;
    const unsigned ldsw = (unsigned)wid * 1024u;
    const int aoff = lds_byte(wr * 64 + fr, fq * 8), boff = lds_byte(wc * 32 + fr, fq * 8);
#define PG8_SA(b, h) (((b) * 2 + (h)) * HTB)
#define PG8_SB(b, h) ((4 + (b) * 2 + (h)) * HTB)
#define PG8_STAGE(bufoff, gbase, voff) do { _Pragma("unroll") for (int _i = 0; _i < 2; ++_i) \
        __builtin_amdgcn_global_load_lds((const unsigned*)((const char*)(gbase) + (voff)[_i]), (PG8_LAS unsigned*)(lds + (bufoff) + ldsw + _i * 8192), 16, 0, 0); } while (0)
#define PG8_LDA(dst, b, h) do { _Pragma("unroll") for (int m = 0; m < 4; ++m) _Pragma("unroll") for (int k = 0; k < 2; ++k) dst[m][k] = *(const PG8_LAS bf16x8*)(lds + PG8_SA(b, h) + aoff + m * 2048 + k * 1024); } while (0)
#define PG8_LDB(dst, b, h) do { _Pragma("unroll") for (int n = 0; n < 2; ++n) _Pragma("unroll") for (int k = 0; k < 2; ++k) dst[n][k] = *(const PG8_LAS bf16x8*)(lds + PG8_SB(b, h) + boff + n * 2048 + k * 1024); } while (0)
#define PG8_MMA(ai, bj, At, Bt) do { __builtin_amdgcn_s_setprio(1); _Pragma("unroll") for (int m = 0; m < 4; ++m) _Pragma("unroll") for (int n = 0; n < 2; ++n) _Pragma("unroll") for (int k = 0; k < 2; ++k) \
        acc[ai][bj][m][n] = __builtin_amdgcn_mfma_f32_16x16x32_bf16(Bt[n][k], At[m][k], acc[ai][bj][m][n], 0, 0, 0); __builtin_amdgcn_s_setprio(0); } while (0)
#define PG8_WAIT_V(n) asm volatile("s_waitcnt vmcnt(" #n ")" ::: "memory")
#define PG8_WAIT_L(n) asm volatile("s_waitcnt lgkmcnt(" #n ")" ::: "memory")
#define PG8_BAR __builtin_amdgcn_s_barrier()
#define PG8_SCHED __builtin_amdgcn_sched_barrier(0)
    Unit cur, nxt; int ui = 0;
    if (!S.next(0, cur)) return;
    f32x4 acc[2][2][4][2];
#pragma unroll
    for (int a = 0; a < 2; ++a)
#pragma unroll
        for (int b = 0; b < 2; ++b)
#pragma unroll
            for (int m = 0; m < 4; ++m)
#pragma unroll
                for (int n = 0; n < 2; ++n) acc[a][b][m][n] = (f32x4){0.f, 0.f, 0.f, 0.f};
    bf16x8 At[4][2], B0[2][2], B1[2][2];
    const char* cA = (const char*)g.A + (size_t)cur.pm * tstep; const char* cB = (const char*)g.Bt + (size_t)cur.pn * tstep;
    S.a_ready(cur);
    if constexpr (SP2) {
        PG8_STAGE(PG8_SB(0, 0), cB, voffB); PG8_STAGE(PG8_SB(0, 1), cB + hstep, voffB); PG8_STAGE(PG8_SA(0, 0), cA, voffA); PG8_STAGE(PG8_SA(0, 1), cA + hstep, voffA);
        if (wr == 1) PG8_BAR;
        PG8_WAIT_V(2); PG8_BAR;
        PG8_STAGE(PG8_SB(1, 0), cB + kstep, voffB); PG8_STAGE(PG8_SA(1, 0), cA + kstep, voffA); PG8_STAGE(PG8_SB(1, 1), cB + hstep + kstep, voffB);
        PG8_WAIT_V(6); PG8_BAR;
    } else {
        PG8_STAGE(PG8_SB(0, 0), cB, voffB); PG8_STAGE(PG8_SA(0, 0), cA, voffA); PG8_STAGE(PG8_SB(0, 1), cB + hstep, voffB); PG8_STAGE(PG8_SA(0, 1), cA + hstep, voffA);
        if (wr == 1) PG8_BAR;
        PG8_WAIT_V(4); PG8_BAR;
        PG8_STAGE(PG8_SB(1, 0), cB + kstep, voffB); PG8_STAGE(PG8_SA(1, 0), cA + kstep, voffA); PG8_STAGE(PG8_SB(1, 1), cB + hstep + kstep, voffB);
        PG8_WAIT_V(6); PG8_BAR;
    }
    for (;;) {
        const bool has_next = S.next(ui + 1, nxt);
        const char* nA = has_next ? (const char*)g.A + (size_t)nxt.pm * tstep : cA; const char* nB = has_next ? (const char*)g.Bt + (size_t)nxt.pn * tstep : cB;
        for (int t = 0; t < nt; t += 2) {
            const bool last = (t == nt - 2);
            const char* a1 = cA + (size_t)(t + 1) * kstep;
            const char* a2 = last ? nA : cA + (size_t)(t + 2) * kstep; const char* b2 = last ? nB : cB + (size_t)(t + 2) * kstep;
            const char* a3 = a2 + kstep; const char* b3 = b2 + kstep;
            if (last && has_next) S.a_ready(nxt);
            if constexpr (SP2) {
            PG8_LDB(B0, 0, 0); PG8_LDB(B1, 0, 1); PG8_SCHED; PG8_LDA(At, 0, 0); PG8_STAGE(PG8_SA(1, 1), a1 + hstep, voffA);
            PG8_WAIT_V(8); PG8_WAIT_L(0); PG8_BAR; PG8_MMA(0, 0, At, B0); PG8_MMA(0, 1, At, B1); PG8_BAR; PG8_SCHED;
            PG8_LDA(At, 0, 1); PG8_STAGE(PG8_SB(0, 0), b2, voffB); PG8_STAGE(PG8_SB(0, 1), b2 + hstep, voffB); PG8_STAGE(PG8_SA(0, 0), a2, voffA);
            PG8_WAIT_V(8); PG8_WAIT_L(0); PG8_BAR; PG8_MMA(1, 0, At, B0); PG8_MMA(1, 1, At, B1); PG8_BAR; PG8_SCHED;
            PG8_LDB(B0, 1, 0); PG8_LDB(B1, 1, 1); PG8_SCHED; PG8_LDA(At, 1, 0); PG8_STAGE(PG8_SA(0, 1), a2 + hstep, voffA);
            PG8_WAIT_V(8); PG8_WAIT_L(0); PG8_BAR; PG8_MMA(0, 0, At, B0); PG8_MMA(0, 1, At, B1); PG8_BAR; PG8_SCHED;
            PG8_LDA(At, 1, 1); PG8_STAGE(PG8_SB(1, 0), b3, voffB); PG8_STAGE(PG8_SB(1, 1), b3 + hstep, voffB); PG8_STAGE(PG8_SA(1, 0), a3, voffA);
            PG8_WAIT_V(8); PG8_WAIT_L(0); PG8_BAR; PG8_MMA(1, 0, At, B0); PG8_MMA(1, 1, At, B1); PG8_BAR; PG8_SCHED;
            } else {
            PG8_LDB(B0, 0, 0); PG8_SCHED; PG8_LDA(At, 0, 0); PG8_STAGE(PG8_SA(1, 1), a1 + hstep, voffA);
            PG8_WAIT_L(8); PG8_BAR; PG8_WAIT_L(0); PG8_MMA(0, 0, At, B0); PG8_BAR; PG8_SCHED;
            PG8_LDB(B1, 0, 1); PG8_STAGE(PG8_SB(0, 0), b2, voffB);
            PG8_BAR; PG8_WAIT_L(0); PG8_MMA(0, 1, At, B1); PG8_BAR;
            PG8_LDA(At, 0, 1); PG8_STAGE(PG8_SA(0, 0), a2, voffA);
            PG8_BAR; PG8_WAIT_L(0); PG8_MMA(1, 0, At, B0); PG8_BAR; PG8_SCHED;
            PG8_STAGE(PG8_SB(0, 1), b2 + hstep, voffB);
            PG8_WAIT_V(6); PG8_BAR; PG8_MMA(1, 1, At, B1); PG8_BAR;
            PG8_LDB(B0, 1, 0); PG8_SCHED; PG8_LDA(At, 1, 0); PG8_STAGE(PG8_SA(0, 1), a2 + hstep, voffA);
            PG8_WAIT_L(8); PG8_BAR; PG8_WAIT_L(0); PG8_MMA(0, 0, At, B0); PG8_BAR; PG8_SCHED;
            PG8_LDB(B1, 1, 1); PG8_STAGE(PG8_SB(1, 0), b3, voffB);
            PG8_BAR; PG8_WAIT_L(0); PG8_MMA(0, 1, At, B1); PG8_BAR;
            PG8_LDA(At, 1, 1); PG8_STAGE(PG8_SA(1, 0), a3, voffA);
            PG8_BAR; PG8_WAIT_L(0); PG8_MMA(1, 0, At, B0); PG8_BAR; PG8_SCHED;
            PG8_STAGE(PG8_SB(1, 1), b3 + hstep, voffB);
            PG8_WAIT_V(6); PG8_BAR; PG8_MMA(1, 1, At, B1); PG8_BAR;
            }
        }
        if constexpr (ALIGN_EPI) { if (wr == 0) PG8_BAR; }
        if constexpr (!Epi::AFTER_DRAIN) { E(acc, cur, wr, wc, fr, fq); S.done(cur); }
        if (!has_next) break;
#pragma unroll
        for (int a = 0; a < 2; ++a)
#pragma unroll
            for (int b = 0; b < 2; ++b)
#pragma unroll
                for (int m = 0; m < 4; ++m)
#pragma unroll
                    for (int n = 0; n < 2; ++n) acc[a][b][m][n] = (f32x4){0.f, 0.f, 0.f, 0.f};
        cur = nxt; cA = nA; cB = nB; ++ui;
        if constexpr (ALIGN_EPI) { if (wr == 1) PG8_BAR; }
    }
    PG8_WAIT_V(0);
    if constexpr (!ALIGN_EPI) { if (wr == 0) PG8_BAR; }
    PG8_BAR;
    if constexpr (Epi::AFTER_DRAIN) { E.fused(acc, cur, wr, wc, fr, fq, lds, wid, lane); S.done(cur); }
#undef PG8_SA
#undef PG8_SB
#undef PG8_STAGE
#undef PG8_LDA
#undef PG8_LDB
#undef PG8_MMA
#undef PG8_WAIT_V
#undef PG8_WAIT_L
#undef PG8_BAR
#undef PG8_SCHED
}
}
constexpr int T = 8192, SEQ = 4096, D = 2048, NPROJ = 7168, NIN = 7176;
constexpr int NH = 4, DH = 256, LCH = 64, DML = 1024;
constexpr int NEXP = 16384, PEER_H = 8, TOPK = 16;
constexpr float EPS = 1e-6f;
constexpr int PC_CX = 0, PC_CB = 1024, PC_CC = 2048, PC_Q = 3072, PC_K = 4096, PC_V = 5120, PC_O = 6144;
constexpr int NTHREADS = 512, NWAVES = 8;
constexpr int LDS_BYTES = 147456;

constexpr size_t MiB = 1u << 20;
constexpr size_t WS_CTL = 0, CTL_ZERO_BYTES = 64 * 1024;
constexpr int CW_BAR = 1024;
constexpr size_t WS_RS1 = 1 * MiB, WS_GI = 1 * MiB + 64 * 1024, WS_GF = 1 * MiB + 256 * 1024, WS_SSQ = 3 * MiB, WS_ESC = 4 * MiB;
constexpr size_t WS_XB = 5 * MiB, WS_WINT = 37 * MiB, WS_WOUTT = 65 * MiB, WS_WQT = 73 * MiB;
constexpr size_t WS_PROJ = 81 * MiB;
constexpr size_t WS_X1 = 81 * MiB, WS_X1B = 145 * MiB;
constexpr size_t WS_HRAW = 193 * MiB, WS_MIXIN = 225 * MiB, WS_QV = 257 * MiB, WS_IDX = 321 * MiB, WS_GATE = 325 * MiB;
constexpr size_t WS_UB = 329 * MiB, WS_VB = 393 * MiB, WS_END = 457 * MiB;

struct Params {
    const float *x, *g1, *w_in, *b_ig, *b_fg, *conv_w, *gm, *w_out, *g2, *w_q, *sk1, *sk2, *eu, *ev, *gfin;
    float* out; unsigned char* ws;
    int ph_lo, ph_hi;
};

typedef unsigned short bf16_t;
typedef unsigned v4u_t __attribute__((ext_vector_type(4)));
typedef unsigned v2u_t __attribute__((ext_vector_type(2)));
__device__ __forceinline__ unsigned f2bf(float f) { unsigned u = __float_as_uint(f); return (u + 0x7fffu + ((u >> 16) & 1u)) >> 16; }
__device__ __forceinline__ unsigned pk2(float lo, float hi) { return f2bf(lo) | (f2bf(hi) << 16); }
__device__ __forceinline__ float bflo(unsigned w) { return __uint_as_float(w << 16); }
__device__ __forceinline__ float bfhi(unsigned w) { return __uint_as_float(w & 0xffff0000u); }
__device__ __forceinline__ float bf1(bf16_t h) { return __uint_as_float((unsigned)h << 16); }
__device__ __forceinline__ float wave_sum(float v) {
#pragma unroll
    for (int o = 32; o >= 1; o >>= 1) v += __shfl_xor(v, o);
    return v;
}
__device__ __forceinline__ void unpack8(const uint4 w, float (&f)[8]) {
    f[0] = bflo(w.x); f[1] = bfhi(w.x); f[2] = bflo(w.y); f[3] = bfhi(w.y); f[4] = bflo(w.z); f[5] = bfhi(w.z); f[6] = bflo(w.w); f[7] = bfhi(w.w);
}
__device__ __forceinline__ float log_sigmoid(float z) { return z >= 0.f ? -log1pf(expf(-z)) : z - log1pf(expf(z)); }
__device__ __forceinline__ float gelu_erf(float v) { return 0.5f * v * (1.0f + erff(v * 0.70710678118654752f)); }

__device__ __forceinline__ void p0_rows(const Params& P, unsigned char* lds, int G, int bid) {
    float* wg = (float*)lds;
    const int tid = threadIdx.x, lane = tid & 63, wave = tid >> 6;
    for (int i = tid; i < 8 * D; i += NTHREADS) { const int g = i >> 11, k = i & 2047; wg[i] = P.w_in[(size_t)k * NIN + NPROJ + g] * P.g1[k]; }
    __syncthreads();
    float* rs1 = (float*)(P.ws + WS_RS1); float* gi = (float*)(P.ws + WS_GI); float* gf = (float*)(P.ws + WS_GF); bf16_t* xb = (bf16_t*)(P.ws + WS_XB);
    for (int t = bid * NWAVES + wave; t < T; t += G * NWAVES) {
        const float4* xr = (const float4*)(P.x + (size_t)t * D);
        float ss = 0.f, dg[8];
#pragma unroll
        for (int g = 0; g < 8; ++g) dg[g] = 0.f;
#pragma unroll 1
        for (int j = 0; j < 8; ++j) {
            const float4 v = xr[j * 64 + lane];
            ss += (v.x * v.x + v.y * v.y) + (v.z * v.z + v.w * v.w);
            const int k0 = (j * 64 + lane) * 4;
#pragma unroll
            for (int g = 0; g < 8; ++g) { const float4 w = *(const float4*)(wg + g * D + k0); dg[g] += (v.x * w.x + v.y * w.y) + (v.z * w.z + v.w * w.w); }
            ((uint2*)(xb + (size_t)t * D))[j * 64 + lane] = make_uint2(pk2(v.x, v.y), pk2(v.z, v.w));
        }
        ss = wave_sum(ss);
#pragma unroll
        for (int g = 0; g < 8; ++g) dg[g] = wave_sum(dg[g]);
        const float rs = rsqrtf(ss * (1.0f / D) + EPS);
        if (lane == 0) {
            rs1[t] = rs;
#pragma unroll
            for (int h = 0; h < 4; ++h) { gi[t * 4 + h] = rs * dg[h] + P.b_ig[h]; gf[t * 4 + h] = log_sigmoid(rs * dg[4 + h] + P.b_fg[h]); }
        }
    }
    __syncthreads();
}
__device__ __forceinline__ void transpose_tile(const float* W, int ldw, int K, const float* gain, bf16_t* WT, int k0, int n0, float* tile) {
    const int tid = threadIdx.x;
#pragma unroll
    for (int r = 0; r < 2; ++r) {
        const int kk = (tid >> 4) + 32 * r, n4 = (tid & 15) * 4;
        float4 v = *(const float4*)(W + (size_t)(k0 + kk) * ldw + n0 + n4);
        const float g = gain ? gain[k0 + kk] : 1.0f;
        tile[kk * 65 + n4 + 0] = v.x * g; tile[kk * 65 + n4 + 1] = v.y * g; tile[kk * 65 + n4 + 2] = v.z * g; tile[kk * 65 + n4 + 3] = v.w * g;
    }
    __syncthreads();
    { const int nn = tid >> 3, k8 = (tid & 7) * 8; float f[8];
#pragma unroll
      for (int i = 0; i < 8; ++i) f[i] = tile[(k8 + i) * 65 + nn];
      *(uint4*)(WT + (size_t)(n0 + nn) * K + k0 + k8) = make_uint4(pk2(f[0], f[1]), pk2(f[2], f[3]), pk2(f[4], f[5]), pk2(f[6], f[7])); }
    __syncthreads();
}
__device__ __forceinline__ void p0_weights_in(const Params& P, unsigned char* lds, int G, int bid) {
    float* tile = (float*)lds;
    constexpr int N_IN = (D / 64) * (NPROJ / 64);
    for (int it = bid; it < N_IN; it += G) { const int kt = it / (NPROJ / 64), nt = it % (NPROJ / 64); transpose_tile(P.w_in, NIN, D, P.g1, (bf16_t*)(P.ws + WS_WINT), kt * 64, nt * 64, tile); }
}
__device__ __forceinline__ void p2_weights_sq(const Params& P, unsigned char* lds, int nworkers, int wid) {
    float* tile = (float*)lds;
    constexpr int N_SQ = (D / 64) * (D / 64);
    for (int it = wid; it < 2 * N_SQ; it += nworkers) {
        if (it < N_SQ) { const int kt = it / (D / 64), nt = it % (D / 64); transpose_tile(P.w_out, D, D, nullptr, (bf16_t*)(P.ws + WS_WOUTT), kt * 64, nt * 64, tile); }
        else { const int j = it - N_SQ, kt = j / (D / 64), nt = j % (D / 64); transpose_tile(P.w_q, D, D, P.g2, (bf16_t*)(P.ws + WS_WQT), kt * 64, nt * 64, tile); }
    }
}
typedef float f32x2_t __attribute__((ext_vector_type(2)));
typedef float v16f_t __attribute__((ext_vector_type(16)));
typedef float v32f_t __attribute__((ext_vector_type(32)));
typedef unsigned v6u_t __attribute__((ext_vector_type(6)));
constexpr int EROW = 1536;
__device__ __forceinline__ float wave_max(float v) {
#pragma unroll
    for (int o = 32; o >= 1; o >>= 1) v = fmaxf(v, __shfl_xor(v, o));
    return v;
}
__device__ __forceinline__ void p0_tables(const Params& P, int nworkers, int wid) {
    const int lane = threadIdx.x & 63, wave = threadIdx.x >> 6;
    float* esc = (float*)(P.ws + WS_ESC);
#pragma unroll 1
    for (int rix = wid * NWAVES + wave; rix < 2 * NEXP; rix += nworkers * NWAVES) {
        const int isv = rix & 1, e = rix >> 1;
        const float4* src = (const float4*)((isv ? P.ev : P.eu) + (size_t)e * D) + lane * 8;
        float4 v[8]; float mx = 0.f;
#pragma unroll
        for (int j = 0; j < 8; ++j) { v[j] = src[j];
            if (!isv) { const float4 gg = ((const float4*)P.g2)[lane * 8 + j]; v[j].x *= gg.x; v[j].y *= gg.y; v[j].z *= gg.z; v[j].w *= gg.w; }
            mx = fmaxf(mx, fmaxf(fmaxf(fabsf(v[j].x), fabsf(v[j].y)), fmaxf(fabsf(v[j].z), fabsf(v[j].w)))); }
        mx = wave_max(mx);
        int ex = 0; (void)frexpf(mx * (1.0f / 7.5f), &ex);
        const float sc = mx > 0.f ? ldexpf(1.0f, ex) : 1.0f;
        const v16f_t a = {v[0].x, v[0].z, v[1].x, v[1].z, v[2].x, v[2].z, v[3].x, v[3].z, v[4].x, v[4].z, v[5].x, v[5].z, v[6].x, v[6].z, v[7].x, v[7].z};
        const v16f_t b = {v[0].y, v[0].w, v[1].y, v[1].w, v[2].y, v[2].w, v[3].y, v[3].w, v[4].y, v[4].w, v[5].y, v[5].w, v[6].y, v[6].w, v[7].y, v[7].w};
        const v6u_t pk = __builtin_amdgcn_cvt_scalef32_2xpk16_fp6_f32(a, b, sc);
        v2u_t* dst = (v2u_t*)(P.ws + (isv ? WS_VB : WS_UB) + (size_t)e * EROW + lane * 24);
        dst[0] = (v2u_t){pk[0], pk[1]}; dst[1] = (v2u_t){pk[2], pk[3]}; dst[2] = (v2u_t){pk[4], pk[5]};
        if (lane == 0) esc[e * 2 + isv] = sc;
    }
}

__device__ __forceinline__ void p2_conv(const Params& P, int nworkers, int wid) {
    const bf16_t* proj = (const bf16_t*)(P.ws + WS_PROJ); bf16_t* mix = (bf16_t*)(P.ws + WS_MIXIN);
    for (int idx = wid * NTHREADS + threadIdx.x; idx < T * 128; idx += nworkers * NTHREADS) {
        const int t = idx >> 7, c8 = (idx & 127) * 8, s = t & (SEQ - 1);
        float y[8];
#pragma unroll
        for (int i = 0; i < 8; ++i) y[i] = 0.f;
#pragma unroll
        for (int j = 0; j < 3; ++j) {
            const int dt = 2 - j;
            if (s >= dt) {
                const bf16_t* row = proj + (size_t)(t - dt) * NPROJ;
                float cx[8], cc[8]; unpack8(*(const uint4*)(row + PC_CX + c8), cx); unpack8(*(const uint4*)(row + PC_CC + c8), cc);
                const float4 w0 = *(const float4*)(P.conv_w + j * 1024 + c8), w1 = *(const float4*)(P.conv_w + j * 1024 + c8 + 4);
                y[0] += w0.x * (cc[0] * cx[0]); y[1] += w0.y * (cc[1] * cx[1]); y[2] += w0.z * (cc[2] * cx[2]); y[3] += w0.w * (cc[3] * cx[3]);
                y[4] += w1.x * (cc[4] * cx[4]); y[5] += w1.y * (cc[5] * cx[5]); y[6] += w1.z * (cc[6] * cx[6]); y[7] += w1.w * (cc[7] * cx[7]);
            }
        }
        float cb[8]; unpack8(*(const uint4*)(proj + (size_t)t * NPROJ + PC_CB + c8), cb);
        *(uint4*)(mix + (size_t)t * D + c8) = make_uint4(pk2(cb[0] * y[0], cb[1] * y[1]), pk2(cb[2] * y[2], cb[3] * y[3]), pk2(cb[4] * y[4], cb[5] * y[5]), pk2(cb[6] * y[6], cb[7] * y[7]));
    }
}
#define LAS3 __attribute__((address_space(3)))
typedef short s16x4_t __attribute__((ext_vector_type(4)));
__device__ __forceinline__ pg8::bf16x8 tr8(LAS3 unsigned char* p0, LAS3 unsigned char* p1) {
    const s16x4_t a = __builtin_amdgcn_ds_read_tr16_b64_v4i16((LAS3 s16x4_t*)p0), b = __builtin_amdgcn_ds_read_tr16_b64_v4i16((LAS3 s16x4_t*)p1);
    return __builtin_shufflevector(a, b, 0, 1, 2, 3, 4, 5, 6, 7);
}
template <int CTRL, int RMASK> __device__ __forceinline__ float dpp_keep(float oldv, float v) { return __int_as_float(__builtin_amdgcn_update_dpp(__float_as_int(oldv), __float_as_int(v), CTRL, RMASK, 0xF, false)); }
__device__ __forceinline__ float wave_incl_sum(float v) {
    v += dpp_keep<0x111, 0xF>(0.f, v); v += dpp_keep<0x112, 0xF>(0.f, v); v += dpp_keep<0x114, 0xF>(0.f, v); v += dpp_keep<0x118, 0xF>(0.f, v);
    v += dpp_keep<0x142, 0xA>(0.f, v); v += dpp_keep<0x143, 0xC>(0.f, v); return v;
}
__device__ __forceinline__ float wave_incl_max(float v) {
    const float NI = -__builtin_inff();
    v = fmaxf(v, dpp_keep<0x111, 0xF>(NI, v)); v = fmaxf(v, dpp_keep<0x112, 0xF>(NI, v)); v = fmaxf(v, dpp_keep<0x114, 0xF>(NI, v)); v = fmaxf(v, dpp_keep<0x118, 0xF>(NI, v));
    v = fmaxf(v, dpp_keep<0x142, 0xA>(NI, v)); v = fmaxf(v, dpp_keep<0x143, 0xC>(NI, v)); return v;
}
template <int VAR> __device__ __forceinline__ void mlstm_unit(const Params& P, unsigned char* lds_, int unit, float* hraw) {
    typedef pg8::bf16x8 bf16x8; typedef pg8::f32x4 f32x4;
    LAS3 unsigned char* L = (LAS3 unsigned char*)lds_;
    constexpr int QS = 0, KS = 33792, VA = 67584, WV = 73728, CB0 = 79872, CBSZ = 25344, SW0 = CB0 + 2 * CBSZ, SWSZ = 2304, SM0 = SW0 + 4 * SWSZ, SMSZ = 1600;
    constexpr int QST = 528, VST = 96, SST = 144;
    const int tid = threadIdx.x, lane = tid & 63, wave = __builtin_amdgcn_readfirstlane(tid >> 6);
    const int g = lane >> 4, c16 = lane & 15, q4 = c16 >> 2, p4 = lane & 3;
    const int bh = unit >> 3, sl = unit & 7, b = bh >> 2, h = bh & 3, v0 = sl * 32;
    const bf16_t* proj = (const bf16_t*)(P.ws + WS_PROJ);
    const float* gi = (const float*)(P.ws + WS_GI); const float* gf = (const float*)(P.ws + WS_GF);
#define SMF(sb, off) ((LAS3 float*)(L + SM0 + (sb) * SMSZ + (off)))
    for (int i = tid; i < (2 * CBSZ) / 16; i += NTHREADS) *(LAS3 v4u_t*)(L + CB0 + i * 16) = (v4u_t){0u, 0u, 0u, 0u};
    for (int i = tid; i < 6144 / 16; i += NTHREADS) *(LAS3 v4u_t*)(L + WV + i * 16) = (v4u_t){0u, 0u, 0u, 0u};
    if (tid < 64) { *(LAS3 v4u_t*)(L + VA + tid * VST + 64) = (v4u_t){0x00003F80u, 0u, 0u, 0u}; *(LAS3 v4u_t*)(L + VA + tid * VST + 80) = (v4u_t){0u, 0u, 0u, 0u}; }
    f32x4 accC[4][3];
#pragma unroll
    for (int dt = 0; dt < 4; ++dt)
#pragma unroll
        for (int vt = 0; vt < 3; ++vt) accC[dt][vt] = (f32x4){0.f, 0.f, 0.f, 0.f};
    const int row = tid >> 3, seg = tid & 7;
    v4u_t rq[4], rk[4], rv = (v4u_t){0u, 0u, 0u, 0u};
    float m = 0.f, nic = 0.f, nfc = 0.f;
#define MLSTM_SMALLS(sb, ic_, fc_) do { const float bc_ = wave_incl_sum(fc_); const float a_ = (ic_) - bc_; const float pm_ = wave_incl_max(a_); \
        const float M_ = fmaxf(m, pm_), M63_ = __shfl(M_, 63), b63_ = __shfl(bc_, 63); \
        SMF(sb, 0)[lane] = a_ * 1.4426950408889634f; SMF(sb, 256)[lane] = M_ * 1.4426950408889634f; SMF(sb, 512)[lane] = __expf(m - M_); SMF(sb, 768)[lane] = __expf(a_ - M63_) * 0.0625f; SMF(sb, 1024)[lane] = __expf(-bc_ - M_); \
        if (lane == 0) { SMF(sb, 1280)[0] = b63_ + M63_; SMF(sb, 1280)[1] = __expf(m - M63_); } m = b63_ + M63_; } while (0)
    { const int t0 = b * SEQ; const bf16_t* src = proj + (size_t)(t0 + row) * NPROJ + h * DH + seg * 8;
#pragma unroll
      for (int i = 0; i < 4; ++i) { rq[i] = *(const v4u_t*)(src + PC_Q + i * 64); rk[i] = *(const v4u_t*)(src + PC_K + i * 64); }
      if (tid < 256) rv = *(const v4u_t*)(proj + (size_t)(t0 + (tid >> 2)) * NPROJ + PC_V + h * DH + v0 + (tid & 3) * 8);
      if (wave == 0) { const float ic0 = gi[(size_t)(t0 + lane) * 4 + h], fc0 = gf[(size_t)(t0 + lane) * 4 + h]; MLSTM_SMALLS(0, ic0, fc0);
          nic = gi[(size_t)(t0 + LCH + lane) * 4 + h]; nfc = gf[(size_t)(t0 + LCH + lane) * 4 + h]; } }
    __syncthreads();
#pragma unroll 1
    for (int c = 0; c < SEQ / LCH; ++c) {
        const int t0 = b * SEQ + c * LCH, sb = c & 1;
        LAS3 unsigned char* CBc = L + CB0 + sb * CBSZ; LAS3 unsigned char* CBn = L + CB0 + (sb ^ 1) * CBSZ;
#pragma unroll
        for (int i = 0; i < 4; ++i) { *(LAS3 v4u_t*)(L + QS + row * QST + (i * 8 + seg) * 16) = rq[i]; *(LAS3 v4u_t*)(L + KS + row * QST + (i * 8 + seg) * 16) = rk[i]; }
        if (tid < 256) { const int l = tid >> 2, part = tid & 3; const float wl = SMF(sb, 768)[l];
            *(LAS3 v4u_t*)(L + VA + l * VST + part * 16) = rv;
            *(LAS3 v4u_t*)(L + WV + l * VST + part * 16) = (v4u_t){pg8::cvt_pk_bf16(wl * bflo(rv.x), wl * bfhi(rv.x)), pg8::cvt_pk_bf16(wl * bflo(rv.y), wl * bfhi(rv.y)), pg8::cvt_pk_bf16(wl * bflo(rv.z), wl * bfhi(rv.z)), pg8::cvt_pk_bf16(wl * bflo(rv.w), wl * bfhi(rv.w))}; }
        else if (tid < 320) { const int l = tid - 256; *(LAS3 unsigned short*)(L + WV + l * VST + 64) = (unsigned short)pg8::cvt_pk_bf16(SMF(sb, 768)[l], 0.f); }
        if (!(VAR & 1) && c + 1 < SEQ / LCH) { const int t1 = t0 + LCH; const bf16_t* src = proj + (size_t)(t1 + row) * NPROJ + h * DH + seg * 8;
#pragma unroll
            for (int i = 0; i < 4; ++i) { rq[i] = *(const v4u_t*)(src + PC_Q + i * 64); rk[i] = *(const v4u_t*)(src + PC_K + i * 64); }
            if (tid < 256) rv = *(const v4u_t*)(proj + (size_t)(t1 + (tid >> 2)) * NPROJ + PC_V + h * DH + v0 + (tid & 3) * 8); }
        __syncthreads();
        if ((VAR & 4) && wave < 4) {   } else
        if (wave < 4) {
            const int rt = wave; LAS3 unsigned char* SWp = L + SW0 + rt * SWSZ;
            const f32x4 M4 = *(LAS3 f32x4*)(SMF(sb, 256) + rt * 16 + 4 * g);
            bf16x8 qf[8];
#pragma unroll
            for (int ks = 0; ks < 8; ++ks) qf[ks] = *(LAS3 bf16x8*)(L + QS + (rt * 16 + c16) * QST + (ks * 32 + g * 8) * 2);
#pragma unroll
            for (int ct = 0; ct < 4; ++ct) { f32x4 acc = (f32x4){0.f, 0.f, 0.f, 0.f};
                if (ct <= rt) {
#pragma unroll
                    for (int ks = 0; ks < 8; ++ks) { const bf16x8 bv = *(LAS3 bf16x8*)(L + KS + (ct * 16 + c16) * QST + (ks * 32 + g * 8) * 2);
                        acc = __builtin_amdgcn_mfma_f32_16x16x32_bf16(qf[ks], bv, acc, 0, 0, 0); } }
                const int l = ct * 16 + c16; const float al = SMF(sb, 0)[l];
#pragma unroll
                for (int r = 0; r < 4; ++r) { const int jr = 4 * g + r; const float val = (l <= rt * 16 + jr) ? acc[r] * 0.0625f * __builtin_amdgcn_exp2f(al - M4[r]) : 0.f;
                    *(LAS3 unsigned short*)(SWp + jr * SST + l * 2) = (unsigned short)pg8::cvt_pk_bf16(val, 0.f); } }
            asm volatile("s_waitcnt lgkmcnt(0)" ::: "memory");
            f32x4 aI[3], aX[3];
#pragma unroll
            for (int vt = 0; vt < 3; ++vt) { aI[vt] = (f32x4){0.f, 0.f, 0.f, 0.f}; aX[vt] = (f32x4){0.f, 0.f, 0.f, 0.f}; }
#pragma unroll
            for (int ks = 0; ks < 8; ++ks) {
#pragma unroll
                for (int vt = 0; vt < 3; ++vt) { const bf16x8 bv = *(LAS3 bf16x8*)(CBc + (vt * 16 + c16) * QST + (ks * 32 + g * 8) * 2); aI[vt] = __builtin_amdgcn_mfma_f32_16x16x32_bf16(qf[ks], bv, aI[vt], 0, 0, 0); } }
#pragma unroll
            for (int ks = 0; ks < 2; ++ks) { const bf16x8 av = *(LAS3 bf16x8*)(SWp + c16 * SST + (ks * 32 + g * 8) * 2);
#pragma unroll
                for (int vt = 0; vt < 3; ++vt) { LAS3 unsigned char* vp = L + VA + (ks * 32 + g * 8 + q4) * VST + (vt * 16 + 4 * p4) * 2; const bf16x8 bv = tr8(vp, vp + 4 * VST);
                    aX[vt] = __builtin_amdgcn_mfma_f32_16x16x32_bf16(av, bv, aX[vt], 0, 0, 0); } }
            const f32x4 e4 = *(LAS3 f32x4*)(SMF(sb, 512) + rt * 16 + 4 * g), n4 = *(LAS3 f32x4*)(SMF(sb, 1024) + rt * 16 + 4 * g);
#pragma unroll
            for (int r = 0; r < 4; ++r) { const float den0 = __builtin_amdgcn_rcpf(fmaxf(fabsf(e4[r] * aI[2][r] + aX[2][r]), n4[r])); const float rden = __shfl(den0, g * 16);
                const size_t o = (size_t)(t0 + rt * 16 + 4 * g + r) * DML + h * DH + v0 + c16;
                const float h0_ = (e4[r] * aI[0][r] + aX[0][r]) * rden, h1_ = (e4[r] * aI[1][r] + aX[1][r]) * rden;
                if (VAR & 2) { asm volatile("" :: "v"(h0_), "v"(h1_), "v"(o)); } else { hraw[o] = h0_; hraw[o + 16] = h1_; } }
            if (wave == 0 && c + 1 < SEQ / LCH) {
                MLSTM_SMALLS(sb ^ 1, nic, nfc);
                const int c2 = (c + 2 < SEQ / LCH) ? c + 2 : SEQ / LCH - 1;
                nic = gi[(size_t)(b * SEQ + c2 * LCH + lane) * 4 + h]; nfc = gf[(size_t)(b * SEQ + c2 * LCH + lane) * 4 + h];
            }
        } else if (VAR & 8) {   } else {
            const int wB = wave - 4; const float decay = SMF(sb, 1280)[1];
#pragma unroll
            for (int dt = 0; dt < 4; ++dt)
#pragma unroll
                for (int v3 = 0; v3 < 3; ++v3) accC[dt][v3] *= decay;
#pragma unroll
            for (int ks = 0; ks < 2; ++ks) { bf16x8 af[4], bfr[3];
#pragma unroll
                for (int dt = 0; dt < 4; ++dt) { LAS3 unsigned char* kp = L + KS + (ks * 32 + g * 8 + q4) * QST + ((4 * wB + dt) * 16 + 4 * p4) * 2; af[dt] = tr8(kp, kp + 4 * QST); }
#pragma unroll
                for (int v3 = 0; v3 < 3; ++v3) { LAS3 unsigned char* wp = L + WV + (ks * 32 + g * 8 + q4) * VST + (v3 * 16 + 4 * p4) * 2; bfr[v3] = tr8(wp, wp + 4 * VST); }
#pragma unroll
                for (int dt = 0; dt < 4; ++dt)
#pragma unroll
                    for (int v3 = 0; v3 < 3; ++v3) accC[dt][v3] = __builtin_amdgcn_mfma_f32_16x16x32_bf16(af[dt], bfr[v3], accC[dt][v3], 0, 0, 0); }
#pragma unroll
            for (int dt = 0; dt < 4; ++dt)
#pragma unroll
                for (int v3 = 0; v3 < 3; ++v3) { const int d = (4 * wB + dt) * 16 + 4 * g, vp = v3 * 16 + c16;
                    *(LAS3 v2u_t*)(CBn + vp * QST + d * 2) = (v2u_t){pg8::cvt_pk_bf16(accC[dt][v3][0], accC[dt][v3][1]), pg8::cvt_pk_bf16(accC[dt][v3][2], accC[dt][v3][3])}; }
        }
        __syncthreads();
    }
#undef MLSTM_SMALLS
#undef SMF
}

__device__ __forceinline__ void p3_finalize(const Params& P, int G, int bid) {
    const int lane = threadIdx.x & 63, wave = threadIdx.x >> 6;
    const float* hraw = (const float*)(P.ws + WS_HRAW); const bf16_t* proj = (const bf16_t*)(P.ws + WS_PROJ); bf16_t* mix = (bf16_t*)(P.ws + WS_MIXIN);
    for (int idx = bid * NWAVES + wave; idx < T * NH; idx += G * NWAVES) {
        const int t = idx >> 2, hh = idx & 3;
        const float4 hv = *(const float4*)(hraw + (size_t)t * DML + hh * DH + lane * 4);
        const float ss = wave_sum((hv.x * hv.x + hv.y * hv.y) + (hv.z * hv.z + hv.w * hv.w));
        const float r = rsqrtf(ss * (1.0f / DH) + EPS);
        const uint2 ow = *(const uint2*)(proj + (size_t)t * NPROJ + PC_O + hh * DH + lane * 4);
        const float4 g = *(const float4*)(P.gm + hh * DH + lane * 4);
        const float o0 = 1.0f / (1.0f + expf(-bflo(ow.x))), o1 = 1.0f / (1.0f + expf(-bfhi(ow.x))), o2 = 1.0f / (1.0f + expf(-bflo(ow.y))), o3 = 1.0f / (1.0f + expf(-bfhi(ow.y)));
        *(uint2*)(mix + (size_t)t * D + DML + hh * DH + lane * 4) = make_uint2(pk2(o0 * (hv.x * r * g.x), o1 * (hv.y * r * g.y)), pk2(o2 * (hv.z * r * g.z), o3 * (hv.w * r * g.w)));
    }
}

template <int CTRL> __device__ __forceinline__ float dppf(float v) { return __int_as_float(__builtin_amdgcn_update_dpp(0, __float_as_int(v), CTRL, 0xF, 0xF, true)); }
__device__ __forceinline__ float grp16_max(float v) { v = fmaxf(v, dppf<0xB1>(v)); v = fmaxf(v, dppf<0x4E>(v)); v = fmaxf(v, dppf<0x141>(v)); v = fmaxf(v, dppf<0x140>(v)); return v; }
__device__ __forceinline__ float grp16_sum(float v) { v += dppf<0xB1>(v); v += dppf<0x4E>(v); v += dppf<0x141>(v); v += dppf<0x140>(v); return v; }
#define CEX(a, b) do { const float hi_ = fmaxf(a, b), lo_ = fminf(a, b); a = hi_; b = lo_; } while (0)
static __device__ const unsigned char CAND_AB[16][4] = {
    {0x00, 0x01, 0x02, 0x03}, {0x04, 0x05, 0x06, 0x07}, {0x08, 0x09, 0x0A, 0x0B}, {0x0C, 0x0D, 0x0E, 0x0F}, {0x10, 0x11, 0x12, 0x13}, {0x14, 0x15, 0x16, 0x17}, {0x20, 0x21, 0x22, 0x23}, {0x24, 0, 0, 0},
    {0x30, 0x31, 0x32, 0x33}, {0x40, 0x41, 0x42, 0}, {0x50, 0x60, 0x70, 0x80}, {0x90, 0xA0, 0xB0, 0xC0}, {0xD0, 0xE0, 0xF0, 0}, {0x51, 0x61, 0x71, 0}, {0, 0, 0, 0}, {0, 0, 0, 0}};
static __device__ const unsigned char CAND_N[16] = {4, 4, 4, 4, 4, 4, 4, 1, 4, 3, 4, 4, 3, 3, 0, 0};
__device__ __forceinline__ void p6_topk(const Params& P, unsigned char* lds_, int G, int bid) {
    typedef pg8::bf16x8 bf16x8; typedef pg8::f32x4 f32x4;
    LAS3 unsigned char* L = (LAS3 unsigned char*)lds_;
    constexpr int KST = 272, KHALF = 128 * KST;
    const int tid = threadIdx.x, lane = tid & 63, wave = tid >> 6, g = lane >> 4, c16 = lane & 15;
    for (int i = tid; i < 2 * 2048; i += NTHREADS) { const int hf = i >> 11, n = (i >> 4) & 127, d8 = (i & 15) * 8; const float* src = (hf ? P.sk2 : P.sk1) + n * 128 + d8;
        const float4 a = *(const float4*)src, b = *(const float4*)(src + 4);
        *(LAS3 v4u_t*)(L + hf * KHALF + n * KST + d8 * 2) = (v4u_t){pk2(a.x, a.y), pk2(a.z, a.w), pk2(b.x, b.y), pk2(b.z, b.w)}; }
    __syncthreads();
    const bf16_t* qvb = (const bf16_t*)(P.ws + WS_QV);
    int* idxo = (int*)(P.ws + WS_IDX); float* gato = (float*)(P.ws + WS_GATE);
    const float NEGINF = -__builtin_inff();
    unsigned ctab = 0; { const unsigned char* tp = CAND_AB[c16]; ctab = (unsigned)tp[0] | ((unsigned)tp[1] << 8) | ((unsigned)tp[2] << 16) | ((unsigned)tp[3] << 24); }
    const int ccnt = CAND_N[c16];
#pragma unroll 1
    for (int it = bid * NWAVES + wave; it < (T / 16) * PEER_H; it += G * NWAVES) {
        const int t0 = (it >> 3) * 16, hh = it & 7;
        float keepH[2][4];
#pragma unroll
        for (int hf = 0; hf < 2; ++hf) {
            asm volatile("" ::: "memory");
            bf16x8 af[4];
#pragma unroll
            for (int ks = 0; ks < 4; ++ks) af[ks] = *(const bf16x8*)(qvb + (size_t)(t0 + c16) * D + hh * 256 + hf * 128 + ks * 32 + g * 8);
            f32x4 acc[8];
#pragma unroll
            for (int ct = 0; ct < 8; ++ct) { acc[ct] = (f32x4){0.f, 0.f, 0.f, 0.f};
#pragma unroll
                for (int ks = 0; ks < 4; ++ks) { const bf16x8 bv = *(LAS3 bf16x8*)(L + hf * KHALF + (ct * 16 + c16) * KST + (ks * 32 + g * 8) * 2);
                    acc[ct] = __builtin_amdgcn_mfma_f32_16x16x32_bf16(af[ks], bv, acc[ct], 0, 0, 0); } }
            float v[4][8];
#pragma unroll
            for (int r = 0; r < 4; ++r) {
#pragma unroll
                for (int ct = 0; ct < 8; ++ct) v[r][ct] = __uint_as_float((__float_as_uint(acc[ct][r]) & ~127u) | (unsigned)(127 - (ct * 16 + c16)));
                CEX(v[r][0], v[r][1]); CEX(v[r][2], v[r][3]); CEX(v[r][4], v[r][5]); CEX(v[r][6], v[r][7]);
                CEX(v[r][0], v[r][2]); CEX(v[r][1], v[r][3]); CEX(v[r][4], v[r][6]); CEX(v[r][5], v[r][7]);
                CEX(v[r][1], v[r][2]); CEX(v[r][5], v[r][6]); CEX(v[r][0], v[r][4]); CEX(v[r][3], v[r][7]);
                CEX(v[r][1], v[r][5]); CEX(v[r][2], v[r][6]);
                CEX(v[r][1], v[r][4]); CEX(v[r][3], v[r][6]);
                CEX(v[r][2], v[r][4]); CEX(v[r][3], v[r][5]);
                CEX(v[r][3], v[r][4]);
                keepH[hf][r] = 0.f;
            }
#pragma unroll
            for (int rd = 0; rd < TOPK; ++rd) {
#pragma unroll
                for (int r = 0; r < 4; ++r) {
                    const float W = grp16_max(v[r][0]); const bool win = (v[r][0] == W);
                    if (c16 == rd) keepH[hf][r] = W;
#pragma unroll
                    for (int k = 0; k < 7; ++k) v[r][k] = win ? v[r][k + 1] : v[r][k];
                    v[r][7] = win ? NEGINF : v[r][7];
                }
            }
        }
#pragma unroll
        for (int r = 0; r < 4; ++r) {
            const float V1 = keepH[0][r], V2 = keepH[1][r];
            float cv[4];
#pragma unroll
            for (int s4 = 0; s4 < 4; ++s4) { const unsigned code = (ctab >> (8 * s4)) & 255u;
                const float x1 = __shfl(V1, g * 16 + (int)(code >> 4)), x2 = __shfl(V2, g * 16 + (int)(code & 15u));
                const float sum = __uint_as_float(__float_as_uint(x1) & ~127u) + __uint_as_float(__float_as_uint(x2) & ~127u);
                cv[s4] = (s4 < ccnt) ? __uint_as_float((__float_as_uint(sum) & ~255u) | (255u - code)) : NEGINF; }
            float keepc = 0.f;
#pragma unroll
            for (int rd = 0; rd < TOPK; ++rd) {
                const float W = grp16_max(cv[0]); const bool win = (cv[0] == W);
                if (c16 == rd) keepc = W;
                cv[0] = win ? cv[1] : cv[0]; cv[1] = win ? cv[2] : cv[1]; cv[2] = win ? cv[3] : cv[2]; cv[3] = win ? NEGINF : cv[3];
            }
            const unsigned kb = __float_as_uint(keepc), code = 255u - (kb & 255u);
            const unsigned n1 = 127u - (__float_as_uint(__shfl(V1, g * 16 + (int)(code >> 4))) & 127u), n2 = 127u - (__float_as_uint(__shfl(V2, g * 16 + (int)(code & 15u))) & 127u);
            const float sval = __uint_as_float(kb & ~255u), smax = __shfl(sval, g * 16);
            const float ex = __expf(sval - smax), den = grp16_sum(ex);
            const size_t o = (size_t)(t0 + 4 * g + r) * 128 + hh * 16 + c16;
            idxo[o] = (int)(n1 * 128u + n2); gato[o] = ex / den;
        }
    }
    __syncthreads();
}

__device__ __forceinline__ float wave_sum_dpp(float v) {
    v += dppf<0xB1>(v); v += dppf<0x4E>(v); v += dppf<0x141>(v); v += dppf<0x140>(v);
    const int iv = __float_as_int(v);
    return (__int_as_float(__builtin_amdgcn_readlane(iv, 0)) + __int_as_float(__builtin_amdgcn_readlane(iv, 16))) + (__int_as_float(__builtin_amdgcn_readlane(iv, 32)) + __int_as_float(__builtin_amdgcn_readlane(iv, 48)));
}
__device__ __forceinline__ float dot16_fp8(const v4u_t w, const float (&x)[16]) {
    float s = 0.f;
#pragma unroll
    for (int k = 0; k < 4; ++k) { const f32x2_t lo = __builtin_amdgcn_cvt_pk_f32_fp8(w[k], false), hi = __builtin_amdgcn_cvt_pk_f32_fp8(w[k], true);
        s += (x[4 * k] * lo.x + x[4 * k + 1] * lo.y) + (x[4 * k + 2] * hi.x + x[4 * k + 3] * hi.y); }
    return s;
}
__device__ __forceinline__ void axpy16_fp8(const v4u_t w, const float cf, float (&y)[16]) {
#pragma unroll
    for (int k = 0; k < 4; ++k) { const f32x2_t lo = __builtin_amdgcn_cvt_pk_f32_fp8(w[k], false), hi = __builtin_amdgcn_cvt_pk_f32_fp8(w[k], true);
        y[4 * k] += cf * lo.x; y[4 * k + 1] += cf * lo.y; y[4 * k + 2] += cf * hi.x; y[4 * k + 3] += cf * hi.y; }
}
#define PIN16(a, o) asm volatile("" : "+v"(a[o + 0]), "+v"(a[o + 1]), "+v"(a[o + 2]), "+v"(a[o + 3]), "+v"(a[o + 4]), "+v"(a[o + 5]), "+v"(a[o + 6]), "+v"(a[o + 7]), "+v"(a[o + 8]), "+v"(a[o + 9]), "+v"(a[o + 10]), "+v"(a[o + 11]), "+v"(a[o + 12]), "+v"(a[o + 13]), "+v"(a[o + 14]), "+v"(a[o + 15]))
__device__ __forceinline__ float row16_sum(float v) { v += dppf<0xB1>(v); v += dppf<0x4E>(v); v += dppf<0x141>(v); v += dppf<0x140>(v); return v; }
__device__ __forceinline__ void p7_peer(const Params& P, unsigned char* lds_, int G, int bid) {
    const int lane = threadIdx.x & 63, wave = __builtin_amdgcn_readfirstlane(threadIdx.x >> 6);
    LAS3 unsigned char* W = (LAS3 unsigned char*)lds_ + wave * 8192;
    const bf16_t* x1b = (const bf16_t*)(P.ws + WS_X1B); const float* x1 = (const float*)(P.ws + WS_X1); const float* ssq = (const float*)(P.ws + WS_SSQ);
    const int* idxi = (const int*)(P.ws + WS_IDX); const float* gati = (const float*)(P.ws + WS_GATE);
    const unsigned char* ub = P.ws + WS_UB; const unsigned char* vb = P.ws + WS_VB; const float* esc = (const float*)(P.ws + WS_ESC);
#pragma unroll 1
    for (int qd = bid * NWAVES + wave; qd < T / 4; qd += G * NWAVES) {
        int ln = lane; asm volatile("" : "+v"(ln));
        const int tb = qd * 4, q = ln >> 4, l16 = ln & 15, t = tb + q;
        const unsigned loff = (unsigned)l16 * 24u;
#pragma unroll 1
        for (int s4 = 0; s4 < 4; ++s4) {
            LAS3 int* hist = (LAS3 int*)(W + 4096); LAS3 int* base = (LAS3 int*)(W + 4096 + 256); LAS3 v2u_t* list = (LAS3 v2u_t*)(W + s4 * 1024);
            const size_t o = (size_t)(tb + s4) * 128 + ln;
            const int i0 = idxi[o], i1 = idxi[o + 64]; const float g0 = gati[o], g1 = gati[o + 64];
            hist[ln] = 0; asm volatile("s_waitcnt lgkmcnt(0)" ::: "memory");
            const int t0_ = __hip_atomic_fetch_add((int*)(hist + (i0 >> 8)), 1, __ATOMIC_RELAXED, __HIP_MEMORY_SCOPE_WORKGROUP);
            const int t1_ = __hip_atomic_fetch_add((int*)(hist + (i1 >> 8)), 1, __ATOMIC_RELAXED, __HIP_MEMORY_SCOPE_WORKGROUP);
            asm volatile("s_waitcnt lgkmcnt(0)" ::: "memory");
            const int cnt = hist[ln]; int inc = cnt;
#pragma unroll
            for (int o2 = 1; o2 < 64; o2 <<= 1) { const int tv = __shfl_up(inc, o2); if (ln >= o2) inc += tv; }
            base[ln] = inc - cnt; asm volatile("s_waitcnt lgkmcnt(0)" ::: "memory");
            list[base[i0 >> 8] + t0_] = (v2u_t){(unsigned)i0, __float_as_uint(g0)}; list[base[i1 >> 8] + t1_] = (v2u_t){(unsigned)i1, __float_as_uint(g1)};
            asm volatile("s_waitcnt lgkmcnt(0)" ::: "memory");
        }
        LAS3 v2u_t* mylist = (LAS3 v2u_t*)(W + q * 1024); LAS3 float* mydot = (LAS3 float*)(W + 4096 + q * 512);
        const float rs2 = rsqrtf(row16_sum(ssq[(size_t)t * 32 + l16] + ssq[(size_t)t * 32 + 16 + l16]) * (1.0f / D) + EPS);
        v6u_t bA[4], bB[4]; float scA = 1.f, scB = 1.f;
#define P7_LOADQ(TAB, tsel, j, Bf, SC) do { const unsigned e_ = mylist[j].x; const unsigned char* rp = (TAB) + (size_t)e_ * EROW + loff; SC = esc[e_ * 2 + (tsel)]; \
            _Pragma("unroll") for (int jj = 0; jj < 4; ++jj) { const v2u_t* cp = (const v2u_t*)(rp + jj * 384); const v2u_t c0 = cp[0], c1 = cp[1], c2 = cp[2]; Bf[jj] = (v6u_t){c0.x, c0.y, c1.x, c1.y, c2.x, c2.y}; } } while (0)
        {
            float xf[4][32];
#pragma unroll
            for (int jj = 0; jj < 4; ++jj)
#pragma unroll
                for (int k = 0; k < 4; ++k) { float a[8]; unpack8(*(const uint4*)(x1b + (size_t)t * D + jj * 512 + l16 * 32 + k * 8), a);
#pragma unroll
                    for (int i = 0; i < 8; ++i) xf[jj][k * 8 + i] = a[i]; }
#define P7_DOTQ(j, Bf, SC) do { float sacc = 0.f; _Pragma("unroll") for (int jj = 0; jj < 4; ++jj) { asm volatile("" : "+v"(Bf[jj])); const v32f_t w = __builtin_amdgcn_cvt_scalef32_pk32_f32_fp6(Bf[jj], SC); \
                float s0 = 0.f, s1 = 0.f, s2 = 0.f, s3 = 0.f; _Pragma("unroll") for (int i = 0; i < 32; i += 4) { s0 += w[i] * xf[jj][i]; s1 += w[i + 1] * xf[jj][i + 1]; s2 += w[i + 2] * xf[jj][i + 2]; s3 += w[i + 3] * xf[jj][i + 3]; } \
                sacc += (s0 + s1) + (s2 + s3); } \
            const float tot = row16_sum(sacc); if (l16 == 0) mydot[j] = tot; } while (0)
            P7_LOADQ(ub, 0, 0, bA, scA);
#pragma unroll 1
            for (int j = 0; j < 126; j += 2) { P7_LOADQ(ub, 0, j + 1, bB, scB); P7_DOTQ(j, bA, scA); P7_LOADQ(ub, 0, j + 2, bA, scA); P7_DOTQ(j + 1, bB, scB); }
            P7_LOADQ(ub, 0, 127, bB, scB); P7_DOTQ(126, bA, scA); P7_LOADQ(vb, 1, 0, bA, scA); P7_DOTQ(127, bB, scB);
#undef P7_DOTQ
        }
        asm volatile("s_waitcnt lgkmcnt(0)" ::: "memory");
        { const float r0 = __int_as_float(__builtin_amdgcn_readlane(__float_as_int(rs2), 0)), r1 = __int_as_float(__builtin_amdgcn_readlane(__float_as_int(rs2), 16)),
                      r2 = __int_as_float(__builtin_amdgcn_readlane(__float_as_int(rs2), 32)), r3 = __int_as_float(__builtin_amdgcn_readlane(__float_as_int(rs2), 48));
#pragma unroll
          for (int k = 0; k < 8; ++k) { const int n = k * 64 + ln; const v2u_t en = *(LAS3 v2u_t*)(W + n * 8); LAS3 float* dp = (LAS3 float*)(W + 4096 + n * 4);
              const float rr = (k >> 1) == 0 ? r0 : (k >> 1) == 1 ? r1 : (k >> 1) == 2 ? r2 : r3;
              *dp = __uint_as_float(en.y) * gelu_erf(*dp * rr); } }
        asm volatile("s_waitcnt lgkmcnt(0)" ::: "memory");
        float y[4][32];
#pragma unroll
        for (int jj = 0; jj < 4; ++jj)
#pragma unroll
            for (int i = 0; i < 32; ++i) y[jj][i] = 0.f;
#define P7_AXQ(j, Bf, SC) do { const float cf = mydot[j]; _Pragma("unroll") for (int jj = 0; jj < 4; ++jj) { asm volatile("" : "+v"(Bf[jj])); const v32f_t w = __builtin_amdgcn_cvt_scalef32_pk32_f32_fp6(Bf[jj], SC); \
            _Pragma("unroll") for (int i = 0; i < 32; ++i) y[jj][i] += cf * w[i]; PIN16(y[jj], 0); PIN16(y[jj], 16); } } while (0)
#pragma unroll 1
        for (int j = 0; j < 126; j += 2) { P7_LOADQ(vb, 1, j + 1, bB, scB); P7_AXQ(j, bA, scA); P7_LOADQ(vb, 1, j + 2, bA, scA); P7_AXQ(j + 1, bB, scB); }
        P7_LOADQ(vb, 1, 127, bB, scB); P7_AXQ(126, bA, scA); P7_AXQ(127, bB, scB);
#undef P7_AXQ
#undef P7_LOADQ
        float ss = 0.f;
#pragma unroll
        for (int jj = 0; jj < 4; ++jj)
#pragma unroll
            for (int k = 0; k < 8; ++k) { const float4 a = *(const float4*)(x1 + (size_t)t * D + jj * 512 + l16 * 32 + 4 * k);
                y[jj][4 * k] += a.x; y[jj][4 * k + 1] += a.y; y[jj][4 * k + 2] += a.z; y[jj][4 * k + 3] += a.w;
                ss += (y[jj][4 * k] * y[jj][4 * k] + y[jj][4 * k + 1] * y[jj][4 * k + 1]) + (y[jj][4 * k + 2] * y[jj][4 * k + 2] + y[jj][4 * k + 3] * y[jj][4 * k + 3]); }
        ss = row16_sum(ss);
        const float r = rsqrtf(ss * (1.0f / D) + EPS);
#pragma unroll
        for (int jj = 0; jj < 4; ++jj)
#pragma unroll
            for (int k = 0; k < 8; ++k) { const float4 gg = *(const float4*)(P.gfin + jj * 512 + l16 * 32 + 4 * k);
                *(float4*)(P.out + (size_t)t * D + jj * 512 + l16 * 32 + 4 * k) = make_float4(y[jj][4 * k] * r * gg.x, y[jj][4 * k + 1] * r * gg.y, y[jj][4 * k + 2] * r * gg.z, y[jj][4 * k + 3] * r * gg.w); }
    }
}
#undef PIN16

#define XB_TMO      128
#define XB_XCNT(j)  (256  + 64 * (j))
#define XB_XSUB(j)  (1280 + 64 * (j))
#define XB_XGEN(j)  (2304 + 64 * (j))
#define XB_TOP      3328
#define XB_TOPGEN   3392
#define XCD_BAR_WORDS 3456
#define XB_SPIN_CAP (1u << 18)

__device__ __forceinline__ unsigned xb_ld(unsigned* p)              { return __hip_atomic_load(p, __ATOMIC_RELAXED, __HIP_MEMORY_SCOPE_AGENT); }
__device__ __forceinline__ unsigned xb_add(unsigned* p, unsigned v) { return __hip_atomic_fetch_add(p, v, __ATOMIC_RELAXED, __HIP_MEMORY_SCOPE_AGENT); }
__device__ __forceinline__ unsigned xb_xcc_id() { return (unsigned)__builtin_amdgcn_s_getreg((3 << 11) | 20) & 0xFu; }
#define XB_SPIN(cond, bar) do { unsigned _sp = 0; while (cond) { __builtin_amdgcn_s_sleep(1); \
    if ((++_sp & 255u) == 0u) { if (xb_ld(&(bar)[XB_TMO])) break; if (_sp > XB_SPIN_CAP) { atomicAdd(&(bar)[XB_TMO], 1u); break; } } } } while (0)

struct XcdBarrier {
    unsigned* bar; unsigned x;
    volatile LAS3 unsigned* st;
};

__device__ __forceinline__ XcdBarrier xcd_barrier_post(unsigned* bar, volatile LAS3 unsigned* st) {
    XcdBarrier b; b.bar = bar; b.x = xb_xcc_id(); b.st = st;
    if (threadIdx.x == 0) (void)xb_add(&bar[XB_XCNT(b.x)], 1u);
    return b;
}
__device__ __forceinline__ void xcd_barrier_complete(unsigned* bar, unsigned x, unsigned& nloc, unsigned& nx) {
    const unsigned G = gridDim.x * gridDim.y * gridDim.z;
    unsigned sum, cnt, mine, sp = 0u;
    for (;;) {
        sum = 0u; cnt = 0u; mine = 0u;
#pragma unroll
        for (unsigned j = 0; j < 16; ++j) { const unsigned c = xb_ld(&bar[XB_XCNT(j)]); sum += c; cnt += (c > 0u) ? 1u : 0u; mine = (j == x) ? c : mine; }
        if (sum == G) break;
        __builtin_amdgcn_s_sleep(1);
        if ((++sp & 255u) == 0u) { if (xb_ld(&bar[XB_TMO])) break; if (sp > XB_SPIN_CAP) { atomicAdd(&bar[XB_TMO], 1u); break; } }
    }
    nloc = mine > 0u ? mine : 1u; nx = cnt > 0u ? cnt : 1u;
}

__device__ __forceinline__ void xcd_barrier(const XcdBarrier& b) {
    asm volatile("s_waitcnt vmcnt(0)" ::: "memory");
    __syncthreads();
    if (threadIdx.x == 0) {
        unsigned* bar = b.bar;
        __builtin_amdgcn_s_waitcnt(0);
        unsigned nloc = b.st[0], nx = b.st[1];
        if (nloc == 0u) { xcd_barrier_complete(bar, b.x, nloc, nx); b.st[0] = nloc; b.st[1] = nx; }
        const unsigned old = xb_add(&bar[XB_XSUB(b.x)], 1u);
        const unsigned gen = old / nloc;
        if (old + 1u == (gen + 1u) * nloc) {
            __builtin_amdgcn_fence(__ATOMIC_RELEASE, "agent");
            asm volatile("s_waitcnt vmcnt(0)" ::: "memory");
            const unsigned og = xb_add(&bar[XB_TOP], 1u);
            const unsigned tg = og / nx;
            if (og + 1u == (tg + 1u) * nx) xb_add(&bar[XB_TOPGEN], 1u);
            else XB_SPIN(xb_ld(&bar[XB_TOPGEN]) == tg, bar);
            __builtin_amdgcn_fence(__ATOMIC_ACQUIRE, "agent");
            xb_add(&bar[XB_XGEN(b.x)], 1u);
            asm volatile("s_waitcnt vmcnt(0)" ::: "memory");
        } else {
            XB_SPIN(xb_ld(&bar[XB_XGEN(b.x)]) == gen, bar);
            __builtin_amdgcn_fence(__ATOMIC_ACQUIRE, "agent");
            asm volatile("s_waitcnt vmcnt(0)" ::: "memory");
        }
    }
    __syncthreads();
}

constexpr int N_PHASES = 8;
#ifndef MK_N_LAUNCHES
#define MK_N_LAUNCHES 1
#endif
__global__ void __launch_bounds__(NTHREADS, 2) layer_fwd(Params P) {
    extern __shared__ __attribute__((aligned(16))) unsigned char lds[];
    const int G = gridDim.x, bid = blockIdx.x;
    volatile LAS3 unsigned* bst = (volatile LAS3 unsigned*)((LAS3 unsigned char*)lds + (LDS_BYTES - 16));
    if (threadIdx.x < 4) bst[threadIdx.x] = 0u;
    __syncthreads();
    XcdBarrier xbar = xcd_barrier_post((unsigned*)(P.ws + WS_CTL) + CW_BAR, bst);
    const int lo = P.ph_lo, hi = P.ph_hi;
#ifndef PH_MASK
#define PH_MASK 0xff
#endif
#define IN(k) (((PH_MASK >> (k)) & 1) && lo <= (k) && (k) < hi)
#define SEAM(k) do { if (IN(k) && IN((k) + 1)) xcd_barrier(xbar); } while (0)
#ifndef REP_MASK
#define REP_MASK 0
#endif
#define REPS(k) (((REP_MASK >> (k)) & 1) ? 2 : 1)
    if (IN(0)) for (int rep = 0; rep < REPS(0); ++rep) { p0_rows(P, lds, G, bid); p0_weights_in(P, lds, G, bid); }
    SEAM(0);
    if (IN(1)) for (int rep = 0; rep < REPS(1); ++rep) {
        pg8::Gemm g{(const pg8::bf16_t*)(P.ws + WS_XB), (const pg8::bf16_t*)(P.ws + WS_WINT), T, NPROJ, D}; pg8::StaticOrder S; S.init(T, NPROJ, G, bid);
        pg8::EpiProj E{(pg8::bf16_t*)(P.ws + WS_PROJ), NPROJ, (const float*)(P.ws + WS_RS1)};
        pg8::gemm_phase<pg8::EpiProj, pg8::StaticOrder, true, true>((PG8_LAS unsigned char*)lds, g, S, E);
    }
    SEAM(1);
    if (IN(2)) for (int rep = 0; rep < REPS(2); ++rep) {
        for (int u = bid; u < 64; u += G) mlstm_unit<0>(P, lds, u, (float*)(P.ws + WS_HRAW));
#ifndef REP_OTH
#define REP_OTH 1
#endif
        if (G > 64) { if (bid >= 64) for (int r2 = 0; r2 < REP_OTH; ++r2) { p2_conv(P, G - 64, bid - 64); p2_weights_sq(P, lds, G - 64, bid - 64); p0_tables(P, G - 64, bid - 64); } }
        else { p2_conv(P, G, bid); p2_weights_sq(P, lds, G, bid); p0_tables(P, G, bid); }
    }
    SEAM(2);
#ifdef MLSTM_PROBE
    if (IN(3)) { if (bid < 64) mlstm_unit<MLSTM_PROBE>(P, lds, bid, (float*)(P.ws + 460 * MiB)); }
#endif
    if (IN(3)) for (int rep = 0; rep < REPS(3); ++rep) p3_finalize(P, G, bid);
    SEAM(3);
    if (IN(4)) for (int rep = 0; rep < REPS(4); ++rep) {
        pg8::Gemm g{(const pg8::bf16_t*)(P.ws + WS_MIXIN), (const pg8::bf16_t*)(P.ws + WS_WOUTT), T, D, D}; pg8::StaticOrder S; S.init(T, D, G, bid);
        pg8::EpiOut E{P.x, (float*)(P.ws + WS_X1), (pg8::bf16_t*)(P.ws + WS_X1B), (float*)(P.ws + WS_SSQ), D};
        pg8::gemm_phase<pg8::EpiOut, pg8::StaticOrder, false, true>((PG8_LAS unsigned char*)lds, g, S, E);
    }
    SEAM(4);
    if (IN(5)) for (int rep = 0; rep < REPS(5); ++rep) {
        pg8::Gemm g{(const pg8::bf16_t*)(P.ws + WS_X1B), (const pg8::bf16_t*)(P.ws + WS_WQT), T, D, D}; pg8::StaticOrder S; S.init(T, D, G, bid);
        pg8::EpiQb E{(pg8::bf16_t*)(P.ws + WS_QV), D, (const float*)(P.ws + WS_SSQ)};
        pg8::gemm_phase<pg8::EpiQb, pg8::StaticOrder, false, true>((PG8_LAS unsigned char*)lds, g, S, E);
    }
    SEAM(5);
    if (IN(6)) for (int rep = 0; rep < REPS(6); ++rep) p6_topk(P, lds, G, bid);
    SEAM(6);
#ifdef EXTRA_SYNCS
    for (int i = 0; i < EXTRA_SYNCS; ++i) xcd_barrier(xbar);
#endif
    if (IN(7)) for (int rep = 0; rep < REPS(7); ++rep) p7_peer(P, lds, G, bid);
#undef IN
#undef SEAM
}

extern "C" void kernel_launch(void* const* d_in, const int* in_sizes, int n_in, void* d_out, int out_size, void* d_ws, size_t ws_size, hipStream_t stream) {
    static int grid = 0;
    if (grid == 0) {
        if (n_in != 15 || in_sizes[0] != T * D || out_size != T * D || ws_size < WS_END) { fprintf(stderr, "kernel_launch: unexpected shapes (n_in %d, in0 %d, out %d, ws %zu); nothing launched\n", n_in, n_in > 0 ? in_sizes[0] : -1, out_size, ws_size); grid = -1; return; }
        int dev = 0, cus = 0, per_cu = 0;
        if (hipGetDevice(&dev) != hipSuccess || hipDeviceGetAttribute(&cus, hipDeviceAttributeMultiprocessorCount, dev) != hipSuccess) { grid = -1; return; }
        if (hipFuncSetAttribute((const void*)layer_fwd, hipFuncAttributeMaxDynamicSharedMemorySize, LDS_BYTES) != hipSuccess) { fprintf(stderr, "kernel_launch: hipFuncSetAttribute failed\n"); grid = -1; return; }
        if (hipOccupancyMaxActiveBlocksPerMultiprocessor(&per_cu, (const void*)layer_fwd, NTHREADS, LDS_BYTES) != hipSuccess || per_cu < 1) { fprintf(stderr, "kernel_launch: occupancy query says %d blocks per CU\n", per_cu); (void)hipGetLastError(); grid = -1; return; }
        grid = cus;
    }
    if (grid < 0) return;
    Params p{};
    p.x = (const float*)d_in[0]; p.g1 = (const float*)d_in[1]; p.w_in = (const float*)d_in[2]; p.b_ig = (const float*)d_in[3]; p.b_fg = (const float*)d_in[4];
    p.conv_w = (const float*)d_in[5]; p.gm = (const float*)d_in[6]; p.w_out = (const float*)d_in[7]; p.g2 = (const float*)d_in[8]; p.w_q = (const float*)d_in[9];
    p.sk1 = (const float*)d_in[10]; p.sk2 = (const float*)d_in[11]; p.eu = (const float*)d_in[12]; p.ev = (const float*)d_in[13]; p.gfin = (const float*)d_in[14];
    p.out = (float*)d_out; p.ws = (unsigned char*)d_ws;
    if (hipMemsetAsync((char*)d_ws + WS_CTL, 0, CTL_ZERO_BYTES, stream) != hipSuccess) { fprintf(stderr, "kernel_launch: hipMemsetAsync failed\n"); return; }
    for (int li = 0; li < MK_N_LAUNCHES; ++li) {
        p.ph_lo = (MK_N_LAUNCHES == 1) ? 0 : li; p.ph_hi = (MK_N_LAUNCHES == 1) ? N_PHASES : li + 1;
        void* args[] = {&p};
        const hipError_t e = hipLaunchCooperativeKernel((const void*)layer_fwd, dim3(grid), dim3(NTHREADS), args, LDS_BYTES, stream);
        if (e != hipSuccess) { fprintf(stderr, "kernel_launch: cooperative launch %d failed: %s (grid %d)\n", li, hipGetErrorString(e), grid); break; }
    }
}
```

```cpp
#include <hip/hip_runtime.h>
#include <hip/hip_cooperative_groups.h>
#include <cstdio>
#include <cstdint>
namespace cg = cooperative_groups;
namespace pg8 {
#define PG8_LAS __attribute__((address_space(3)))
typedef unsigned short bf16_t;
typedef short bf16x8 __attribute__((ext_vector_type(8)));
typedef float f32x4 __attribute__((ext_vector_type(4)));
typedef unsigned u32x4 __attribute__((ext_vector_type(4)));
constexpr int BM = 256, BK = 64, HALF = 128, HTB = HALF * BK * 2  , STAGE_BYTES = 8 * HTB, NXCD = 8, WGM = 8;

__host__ __device__ __forceinline__ int lds_byte(int r, int c) { const int st = (r >> 4) * 2 + (c >> 5), rr = r & 15, cc = c & 31, ob = rr * 64 + cc * 2; return st * 1024 + (ob ^ (((ob >> 9) & 1) << 5)); }
__host__ __device__ __forceinline__ void stage_rc(int b, int& R, int& C) { const int st = b / 1024, sb = b % 1024, swz = sb ^ (((sb >> 9) & 1) << 5); R = (st >> 1) * 16 + swz / 64; C = (st & 1) * 32 + (swz % 64) / 2; }
__host__ __device__ __forceinline__ int perm32(int rho) { const int n = rho >> 4, i = rho & 15; return 8 * (i >> 2) + 4 * n + (i & 3); }

struct Unit { int pm, pn; };
struct Gemm { const bf16_t* A; const bf16_t* Bt; int M, N, K; };

struct StaticOrder {
    int nM, nN, nwg, G, c;
    __host__ __device__ void init(int M, int N, int G_, int c_) { nM = M / BM; nN = N / BM; nwg = nM * nN; G = G_; c = c_; }
    __host__ __device__ bool next(int i, Unit& u) const {
        const long L = (long)i * G + c; if (L >= nwg) return false;
        int wgid = (int)L; { const int q = nwg / NXCD, r = nwg % NXCD, xcd = wgid % NXCD, off = wgid / NXCD; wgid = (xcd < r ? xcd * (q + 1) : r * (q + 1) + (xcd - r) * q) + off; }
        const int nig = WGM * nN, gid = wgid / nig, fm = gid * WGM, gsz = (nM - fm) < WGM ? (nM - fm) : WGM;
        u.pm = fm + ((wgid % nig) % gsz); u.pn = (wgid % nig) / gsz; return true;
    }
    __device__ __forceinline__ void a_ready(const Unit&) const {}
    __device__ __forceinline__ void done(const Unit&) const {}
};

__device__ __forceinline__ unsigned cvt_pk_bf16(float lo, float hi) { unsigned r; asm volatile("v_cvt_pk_bf16_f32 %0, %1, %2" : "=v"(r) : "v"(lo), "v"(hi)); return r; }
struct EpiProj {
    static constexpr bool PERM = true, AFTER_DRAIN = false;
    bf16_t* O; int ldc; const float* rs;
    __device__ __forceinline__ void operator()(const f32x4 (&acc)[2][2][4][2], const Unit& u, int wr, int wc, int fr, int fq) const {
        const int row0 = u.pm * BM + wr * 64 + fr, col0 = u.pn * BM + wc * 32 + 8 * fq;
#pragma unroll
        for (int ai = 0; ai < 2; ++ai)
#pragma unroll
            for (int m = 0; m < 4; ++m) { const int row = row0 + ai * HALF + m * 16; const float s = rs[row]; bf16_t* rowp = O + (size_t)row * ldc + col0;
#pragma unroll
                for (int bj = 0; bj < 2; ++bj) { const f32x4 v0 = acc[ai][bj][m][0] * s, v1 = acc[ai][bj][m][1] * s; u32x4 w;
                    w.x = cvt_pk_bf16(v0[0], v0[1]); w.y = cvt_pk_bf16(v0[2], v0[3]); w.z = cvt_pk_bf16(v1[0], v1[1]); w.w = cvt_pk_bf16(v1[2], v1[3]);
                    *(u32x4*)(rowp + bj * HALF) = w; } }
    }
};
struct EpiOut {
    static constexpr bool PERM = false, AFTER_DRAIN = false;
    const float* X; bf16_t* X1B; float* SSQ; int ldc;
    __device__ __forceinline__ void operator()(const f32x4 (&acc)[2][2][4][2], const Unit& u, int wr, int wc, int fr, int fq) const {
        typedef unsigned u32x2 __attribute__((ext_vector_type(2)));
        const int row0 = u.pm * BM + wr * 64 + fr, col0 = u.pn * BM + wc * 32 + 4 * fq;
#pragma unroll
        for (int ai = 0; ai < 2; ++ai)
#pragma unroll
            for (int m = 0; m < 4; ++m) { const int row = row0 + ai * HALF + m * 16; const size_t off = (size_t)row * ldc + col0; float ss = 0.f;
#pragma unroll
                for (int bj = 0; bj < 2; ++bj)
#pragma unroll
                    for (int n = 0; n < 2; ++n) { const size_t c = off + bj * HALF + n * 16; const f32x4 xv = *(const f32x4*)(X + c); const f32x4 o = xv + acc[ai][bj][m][n];
                        ss += (o[0] * o[0] + o[1] * o[1]) + (o[2] * o[2] + o[3] * o[3]);
                        u32x2 pk; pk.x = cvt_pk_bf16(o[0], o[1]); pk.y = cvt_pk_bf16(o[2], o[3]); *(u32x2*)(X1B + c) = pk; }
                ss += __shfl_xor(ss, 16); ss += __shfl_xor(ss, 32);
                if (fq == 0) SSQ[(size_t)row * 32 + u.pn * 4 + wc] = ss; }
    }
};
struct EpiQ {
    static constexpr bool PERM = false, AFTER_DRAIN = false;
    float* O; int ldc;
    __device__ __forceinline__ void operator()(const f32x4 (&acc)[2][2][4][2], const Unit& u, int wr, int wc, int fr, int fq) const {
        const int row0 = u.pm * BM + wr * 64 + fr, col0 = u.pn * BM + wc * 32 + 4 * fq;
#pragma unroll
        for (int ai = 0; ai < 2; ++ai)
#pragma unroll
            for (int m = 0; m < 4; ++m) { const size_t off = (size_t)(row0 + ai * HALF + m * 16) * ldc + col0;
#pragma unroll
                for (int bj = 0; bj < 2; ++bj)
#pragma unroll
                    for (int n = 0; n < 2; ++n) *(f32x4*)(O + off + bj * HALF + n * 16) = acc[ai][bj][m][n]; }
    }
};
struct EpiQb {
    static constexpr bool PERM = true, AFTER_DRAIN = false;
    bf16_t* O; int ldc; const float* SSQ;
    __device__ __forceinline__ void operator()(const f32x4 (&acc)[2][2][4][2], const Unit& u, int wr, int wc, int fr, int fq) const {
        const int row0 = u.pm * BM + wr * 64 + fr, col0 = u.pn * BM + wc * 32 + 8 * fq;
#pragma unroll
        for (int ai = 0; ai < 2; ++ai)
#pragma unroll
            for (int m = 0; m < 4; ++m) { const int row = row0 + ai * HALF + m * 16; const f32x4* sp = (const f32x4*)(SSQ + (size_t)row * 32);
                f32x4 s4 = sp[0];
#pragma unroll
                for (int i = 1; i < 8; ++i) s4 += sp[i];
                const float s = rsqrtf(((s4[0] + s4[1]) + (s4[2] + s4[3])) * (1.0f / 2048.0f) + 1e-6f); bf16_t* rowp = O + (size_t)row * ldc + col0;
#pragma unroll
                for (int bj = 0; bj < 2; ++bj) { const f32x4 v0 = acc[ai][bj][m][0] * s, v1 = acc[ai][bj][m][1] * s; u32x4 w;
                    w.x = cvt_pk_bf16(v0[0], v0[1]); w.y = cvt_pk_bf16(v0[2], v0[3]); w.z = cvt_pk_bf16(v1[0], v1[1]); w.w = cvt_pk_bf16(v1[2], v1[3]);
                    *(u32x4*)(rowp + bj * HALF) = w; } }
    }
};
template <class Epi, class Sched, bool ALIGN_EPI = false, bool SP2 = false>
__device__ __forceinline__ void gemm_phase(PG8_LAS unsigned char* lds, const Gemm g, const Sched& S, const Epi& E) {
    const int tid = threadIdx.x, wid = __builtin_amdgcn_readfirstlane(tid >> 6), lane = tid & 63, wr = wid >> 2, wc = wid & 3, fr = lane & 15, fq = lane >> 4;
    const int K = g.K, nt = K / BK;
    unsigned voffA[2], voffB[2];
#pragma unroll
    for (int i = 0; i < 2; ++i) { int R, C; stage_rc(tid * 16 + i * 8192, R, C); const int Rb = Epi::PERM ? ((R & ~31) + perm32(R & 31)) : R;
        voffA[i] = (unsigned)(R * K + C) * 2u; voffB[i] = (unsigned)(Rb * K + C) * 2u; }
    const size_t kstep = (size_t)(BK * 2);
    const size_t hstep = (size_t)HALF * K * 2;
    const size_t tstep = 2 * hstep;
    const unsigned ldsw = (unsigned)wid * 1024u;
    const int aoff = lds_byte(wr * 64 + fr, fq * 8), boff = lds_byte(wc * 32 + fr, fq * 8);
#define PG8_SA(b, h) (((b) * 2 + (h)) * HTB)
#define PG8_SB(b, h) ((4 + (b) * 2 + (h)) * HTB)
#define PG8_STAGE(bufoff, gbase, voff) do { _Pragma("unroll") for (int _i = 0; _i < 2; ++_i) \
        __builtin_amdgcn_global_load_lds((const unsigned*)((const char*)(gbase) + (voff)[_i]), (PG8_LAS unsigned*)(lds + (bufoff) + ldsw + _i * 8192), 16, 0, 0); } while (0)
#define PG8_LDA(dst, b, h) do { _Pragma("unroll") for (int m = 0; m < 4; ++m) _Pragma("unroll") for (int k = 0; k < 2; ++k) dst[m][k] = *(const PG8_LAS bf16x8*)(lds + PG8_SA(b, h) + aoff + m * 2048 + k * 1024); } while (0)
#define PG8_LDB(dst, b, h) do { _Pragma("unroll") for (int n = 0; n < 2; ++n) _Pragma("unroll") for (int k = 0; k < 2; ++k) dst[n][k] = *(const PG8_LAS bf16x8*)(lds + PG8_SB(b, h) + boff + n * 2048 + k * 1024); } while (0)
#define PG8_MMA(ai, bj, At, Bt) do { __builtin_amdgcn_s_setprio(1); _Pragma("unroll") for (int m = 0; m < 4; ++m) _Pragma("unroll") for (int n = 0; n < 2; ++n) _Pragma("unroll") for (int k = 0; k < 2; ++k) \
        acc[ai][bj][m][n] = __builtin_amdgcn_mfma_f32_16x16x32_bf16(Bt[n][k], At[m][k], acc[ai][bj][m][n], 0, 0, 0); __builtin_amdgcn_s_setprio(0); } while (0)
#define PG8_WAIT_V(n) asm volatile("s_waitcnt vmcnt(" #n ")" ::: "memory")
#define PG8_WAIT_L(n) asm volatile("s_waitcnt lgkmcnt(" #n ")" ::: "memory")
#define PG8_BAR __builtin_amdgcn_s_barrier()
#define PG8_SCHED __builtin_amdgcn_sched_barrier(0)
    Unit cur, nxt; int ui = 0;
    if (!S.next(0, cur)) return;
    f32x4 acc[2][2][4][2];
#pragma unroll
    for (int a = 0; a < 2; ++a)
#pragma unroll
        for (int b = 0; b < 2; ++b)
#pragma unroll
            for (int m = 0; m < 4; ++m)
#pragma unroll
                for (int n = 0; n < 2; ++n) acc[a][b][m][n] = (f32x4){0.f, 0.f, 0.f, 0.f};
    bf16x8 At[4][2], B0[2][2], B1[2][2];
    const char* cA = (const char*)g.A + (size_t)cur.pm * tstep; const char* cB = (const char*)g.Bt + (size_t)cur.pn * tstep;
    S.a_ready(cur);
    if constexpr (SP2) {
        PG8_STAGE(PG8_SB(0, 0), cB, voffB); PG8_STAGE(PG8_SB(0, 1), cB + hstep, voffB); PG8_STAGE(PG8_SA(0, 0), cA, voffA); PG8_STAGE(PG8_SA(0, 1), cA + hstep, voffA);
        if (wr == 1) PG8_BAR;
        PG8_WAIT_V(2); PG8_BAR;
        PG8_STAGE(PG8_SB(1, 0), cB + kstep, voffB); PG8_STAGE(PG8_SA(1, 0), cA + kstep, voffA); PG8_STAGE(PG8_SB(1, 1), cB + hstep + kstep, voffB);
        PG8_WAIT_V(6); PG8_BAR;
    } else {
        PG8_STAGE(PG8_SB(0, 0), cB, voffB); PG8_STAGE(PG8_SA(0, 0), cA, voffA); PG8_STAGE(PG8_SB(0, 1), cB + hstep, voffB); PG8_STAGE(PG8_SA(0, 1), cA + hstep, voffA);
        if (wr == 1) PG8_BAR;
        PG8_WAIT_V(4); PG8_BAR;
        PG8_STAGE(PG8_SB(1, 0), cB + kstep, voffB); PG8_STAGE(PG8_SA(1, 0), cA + kstep, voffA); PG8_STAGE(PG8_SB(1, 1), cB + hstep + kstep, voffB);
        PG8_WAIT_V(6); PG8_BAR;
    }
    for (;;) {
        const bool has_next = S.next(ui + 1, nxt);
        const char* nA = has_next ? (const char*)g.A + (size_t)nxt.pm * tstep : cA; const char* nB = has_next ? (const char*)g.Bt + (size_t)nxt.pn * tstep : cB;
        for (int t = 0; t < nt; t += 2) {
            const bool last = (t == nt - 2);
            const char* a1 = cA + (size_t)(t + 1) * kstep;
            const char* a2 = last ? nA : cA + (size_t)(t + 2) * kstep; const char* b2 = last ? nB : cB + (size_t)(t + 2) * kstep;
            const char* a3 = a2 + kstep; const char* b3 = b2 + kstep;
            if (last && has_next) S.a_ready(nxt);
            if constexpr (SP2) {
            PG8_LDB(B0, 0, 0); PG8_LDB(B1, 0, 1); PG8_SCHED; PG8_LDA(At, 0, 0); PG8_STAGE(PG8_SA(1, 1), a1 + hstep, voffA);
            PG8_WAIT_V(8); PG8_WAIT_L(0); PG8_BAR; PG8_MMA(0, 0, At, B0); PG8_MMA(0, 1, At, B1); PG8_BAR; PG8_SCHED;
            PG8_LDA(At, 0, 1); PG8_STAGE(PG8_SB(0, 0), b2, voffB); PG8_STAGE(PG8_SB(0, 1), b2 + hstep, voffB); PG8_STAGE(PG8_SA(0, 0), a2, voffA);
            PG8_WAIT_V(8); PG8_WAIT_L(0); PG8_BAR; PG8_MMA(1, 0, At, B0); PG8_MMA(1, 1, At, B1); PG8_BAR; PG8_SCHED;
            PG8_LDB(B0, 1, 0); PG8_LDB(B1, 1, 1); PG8_SCHED; PG8_LDA(At, 1, 0); PG8_STAGE(PG8_SA(0, 1), a2 + hstep, voffA);
            PG8_WAIT_V(8); PG8_WAIT_L(0); PG8_BAR; PG8_MMA(0, 0, At, B0); PG8_MMA(0, 1, At, B1); PG8_BAR; PG8_SCHED;
            PG8_LDA(At, 1, 1); PG8_STAGE(PG8_SB(1, 0), b3, voffB); PG8_STAGE(PG8_SB(1, 1), b3 + hstep, voffB); PG8_STAGE(PG8_SA(1, 0), a3, voffA);
            PG8_WAIT_V(8); PG8_WAIT_L(0); PG8_BAR; PG8_MMA(1, 0, At, B0); PG8_MMA(1, 1, At, B1); PG8_BAR; PG8_SCHED;
            } else {
            PG8_LDB(B0, 0, 0); PG8_SCHED; PG8_LDA(At, 0, 0); PG8_STAGE(PG8_SA(1, 1), a1 + hstep, voffA);
            PG8_WAIT_L(8); PG8_BAR; PG8_WAIT_L(0); PG8_MMA(0, 0, At, B0); PG8_BAR; PG8_SCHED;
            PG8_LDB(B1, 0, 1); PG8_STAGE(PG8_SB(0, 0), b2, voffB);
            PG8_BAR; PG8_WAIT_L(0); PG8_MMA(0, 1, At, B1); PG8_BAR;
            PG8_LDA(At, 0, 1); PG8_STAGE(PG8_SA(0, 0), a2, voffA);
            PG8_BAR; PG8_WAIT_L(0); PG8_MMA(1, 0, At, B0); PG8_BAR; PG8_SCHED;
            PG8_STAGE(PG8_SB(0, 1), b2 + hstep, voffB);
            PG8_WAIT_V(6); PG8_BAR; PG8_MMA(1, 1, At, B1); PG8_BAR;
            PG8_LDB(B0, 1, 0); PG8_SCHED; PG8_LDA(At, 1, 0); PG8_STAGE(PG8_SA(0, 1), a2 + hstep, voffA);
            PG8_WAIT_L(8); PG8_BAR; PG8_WAIT_L(0); PG8_MMA(0, 0, At, B0); PG8_BAR; PG8_SCHED;
            PG8_LDB(B1, 1, 1); PG8_STAGE(PG8_SB(1, 0), b3, voffB);
            PG8_BAR; PG8_WAIT_L(0); PG8_MMA(0, 1, At, B1); PG8_BAR;
            PG8_LDA(At, 1, 1); PG8_STAGE(PG8_SA(1, 0), a3, voffA);
            PG8_BAR; PG8_WAIT_L(0); PG8_MMA(1, 0, At, B0); PG8_BAR; PG8_SCHED;
            PG8_STAGE(PG8_SB(1, 1), b3 + hstep, voffB);
            PG8_WAIT_V(6); PG8_BAR; PG8_MMA(1, 1, At, B1); PG8_BAR;
            }
        }
        if constexpr (ALIGN_EPI) { if (wr == 0) PG8_BAR; }
        if constexpr (!Epi::AFTER_DRAIN) { E(acc, cur, wr, wc, fr, fq); S.done(cur); }
        if (!has_next) break;
#pragma unroll
        for (int a = 0; a < 2; ++a)
#pragma unroll
            for (int b = 0; b < 2; ++b)
#pragma unroll
                for (int m = 0; m < 4; ++m)
#pragma unroll
                    for (int n = 0; n < 2; ++n) acc[a][b][m][n] = (f32x4){0.f, 0.f, 0.f, 0.f};
        cur = nxt; cA = nA; cB = nB; ++ui;
        if constexpr (ALIGN_EPI) { if (wr == 1) PG8_BAR; }
    }
    PG8_WAIT_V(0);
    if constexpr (!ALIGN_EPI) { if (wr == 0) PG8_BAR; }
    PG8_BAR;
    if constexpr (Epi::AFTER_DRAIN) { E.fused(acc, cur, wr, wc, fr, fq, lds, wid, lane); S.done(cur); }
#undef PG8_SA
#undef PG8_SB
#undef PG8_STAGE
#undef PG8_LDA
#undef PG8_LDB
#undef PG8_MMA
#undef PG8_WAIT_V
#undef PG8_WAIT_L
#undef PG8_BAR
#undef PG8_SCHED
}
}
constexpr int T = 8192, SEQ = 4096, D = 2048, NPROJ = 7168, NIN = 7176;
constexpr int NH = 4, DH = 256, LCH = 64, DML = 1024;
constexpr int NEXP = 16384, PEER_H = 8, TOPK = 16;
constexpr float EPS = 1e-6f;
constexpr int PC_CX = 0, PC_CB = 1024, PC_CC = 2048, PC_Q = 3072, PC_K = 4096, PC_V = 5120, PC_O = 6144;
constexpr int NTHREADS = 512, NWAVES = 8;
constexpr int LDS_BYTES = 147456;

constexpr size_t MiB = 1u << 20;
constexpr size_t WS_CTL = 0, CTL_ZERO_BYTES = 64 * 1024;
constexpr int CW_BAR = 1024;
constexpr size_t WS_RS1 = 1 * MiB, WS_GI = 1 * MiB + 64 * 1024, WS_GF = 1 * MiB + 256 * 1024, WS_SSQ = 3 * MiB, WS_ESC = 4 * MiB;
constexpr size_t WS_XB = 5 * MiB, WS_WINT = 37 * MiB, WS_WOUTT = 65 * MiB, WS_WQT = 73 * MiB;
constexpr size_t WS_PROJ = 81 * MiB;
constexpr size_t WS_X1 = 81 * MiB, WS_X1B = 145 * MiB;
constexpr size_t WS_HRAW = 193 * MiB, WS_MIXIN = 225 * MiB, WS_QV = 257 * MiB, WS_IDX = 321 * MiB, WS_GATE = 325 * MiB;
constexpr size_t WS_UB = 329 * MiB, WS_VB = 393 * MiB, WS_END = 457 * MiB;

struct Params {
    const float *x, *g1, *w_in, *b_ig, *b_fg, *conv_w, *gm, *w_out, *g2, *w_q, *sk1, *sk2, *eu, *ev, *gfin;
    float* out; unsigned char* ws;
    int ph_lo, ph_hi;
};

typedef unsigned short bf16_t;
typedef unsigned v4u_t __attribute__((ext_vector_type(4)));
typedef unsigned v2u_t __attribute__((ext_vector_type(2)));
__device__ __forceinline__ unsigned f2bf(float f) { unsigned u = __float_as_uint(f); return (u + 0x7fffu + ((u >> 16) & 1u)) >> 16; }
__device__ __forceinline__ unsigned pk2(float lo, float hi) { return f2bf(lo) | (f2bf(hi) << 16); }
__device__ __forceinline__ float bflo(unsigned w) { return __uint_as_float(w << 16); }
__device__ __forceinline__ float bfhi(unsigned w) { return __uint_as_float(w & 0xffff0000u); }
__device__ __forceinline__ float bf1(bf16_t h) { return __uint_as_float((unsigned)h << 16); }
__device__ __forceinline__ float wave_sum(float v) {
#pragma unroll
    for (int o = 32; o >= 1; o >>= 1) v += __shfl_xor(v, o);
    return v;
}
__device__ __forceinline__ void unpack8(const uint4 w, float (&f)[8]) {
    f[0] = bflo(w.x); f[1] = bfhi(w.x); f[2] = bflo(w.y); f[3] = bfhi(w.y); f[4] = bflo(w.z); f[5] = bfhi(w.z); f[6] = bflo(w.w); f[7] = bfhi(w.w);
}
__device__ __forceinline__ float log_sigmoid(float z) { return z >= 0.f ? -log1pf(expf(-z)) : z - log1pf(expf(z)); }
__device__ __forceinline__ float gelu_erf(float v) { return 0.5f * v * (1.0f + erff(v * 0.70710678118654752f)); }

__device__ __forceinline__ void p0_rows(const Params& P, unsigned char* lds, int G, int bid) {
    float* wg = (float*)lds;
    const int tid = threadIdx.x, lane = tid & 63, wave = tid >> 6;
    {
    for (int i = tid; i < 2 * D; i += NTHREADS) { const int k = i >> 1, hf = i & 1; const float4 w4 = *(const float4*)(P.w_in + (size_t)k * NIN + NPROJ + hf * 4); const float gk = P.g1[k];
        wg[(hf * 4 + 0) * D + k] = w4.x * gk; wg[(hf * 4 + 1) * D + k] = w4.y * gk; wg[(hf * 4 + 2) * D + k] = w4.z * gk; wg[(hf * 4 + 3) * D + k] = w4.w * gk; }
    __syncthreads(); }
    float* rs1 = (float*)(P.ws + WS_RS1); float* gi = (float*)(P.ws + WS_GI); float* gf = (float*)(P.ws + WS_GF); bf16_t* xb = (bf16_t*)(P.ws + WS_XB);
    for (int tp = bid * NWAVES + wave; tp < T / 2; tp += G * NWAVES) {
        const int t = tp * 2;
        const float4* xr = (const float4*)(P.x + (size_t)t * D);
        float ss[2] = {0.f, 0.f}, dg[2][8];
#pragma unroll
        for (int g = 0; g < 8; ++g) { dg[0][g] = 0.f; dg[1][g] = 0.f; }
        float4 v[2][8];
#pragma unroll
        for (int rr = 0; rr < 2; ++rr)
#pragma unroll
            for (int j = 0; j < 8; ++j) v[rr][j] = xr[rr * (D / 4) + j * 64 + lane];
#pragma unroll 1
        for (int j = 0; j < 8; ++j) {
            const int k0 = (j * 64 + lane) * 4;
#pragma unroll
            for (int rr = 0; rr < 2; ++rr) { const float4 vv = j == 0 ? v[rr][0] : j == 1 ? v[rr][1] : j == 2 ? v[rr][2] : j == 3 ? v[rr][3] : j == 4 ? v[rr][4] : j == 5 ? v[rr][5] : j == 6 ? v[rr][6] : v[rr][7];
                ss[rr] += (vv.x * vv.x + vv.y * vv.y) + (vv.z * vv.z + vv.w * vv.w);
#pragma unroll
                for (int g = 0; g < 8; ++g) { const float4 w = *(const float4*)(wg + g * D + k0); dg[rr][g] += (vv.x * w.x + vv.y * w.y) + (vv.z * w.z + vv.w * w.w); }
                ((uint2*)(xb + (size_t)(t + rr) * D))[j * 64 + lane] = make_uint2(pk2(vv.x, vv.y), pk2(vv.z, vv.w)); }
        }
#pragma unroll
        for (int rr = 0; rr < 2; ++rr) {
            const float s1 = wave_sum(ss[rr]);
#pragma unroll
            for (int g = 0; g < 8; ++g) dg[rr][g] = wave_sum(dg[rr][g]);
            const float rs = rsqrtf(s1 * (1.0f / D) + EPS);
            if (lane == 0) {
                rs1[t + rr] = rs;
#pragma unroll
                for (int h = 0; h < 4; ++h) { gi[(t + rr) * 4 + h] = rs * dg[rr][h] + P.b_ig[h]; gf[(t + rr) * 4 + h] = log_sigmoid(rs * dg[rr][4 + h] + P.b_fg[h]); }
            }
        }
    }
    __syncthreads();
}
__device__ __forceinline__ void transpose_tile(const float* W, int ldw, int K, const float* gain, bf16_t* WT, int k0, int n0, float* tile) {
    const int tid = threadIdx.x;
    float4 v[4];
#pragma unroll
    for (int r = 0; r < 4; ++r) v[r] = *(const float4*)(W + (size_t)(k0 + (tid >> 5) + 16 * r) * ldw + n0 + (tid & 31) * 4);
#pragma unroll
    for (int r = 0; r < 4; ++r) { const int kk = (tid >> 5) + 16 * r, n4 = (tid & 31) * 4; const float g = gain ? gain[k0 + kk] : 1.0f;
        tile[kk * 129 + n4 + 0] = v[r].x * g; tile[kk * 129 + n4 + 1] = v[r].y * g; tile[kk * 129 + n4 + 2] = v[r].z * g; tile[kk * 129 + n4 + 3] = v[r].w * g; }
    __syncthreads();
    { const int nn = tid >> 2, k16 = (tid & 3) * 16; float f[16];
#pragma unroll
      for (int i = 0; i < 16; ++i) f[i] = tile[(k16 + i) * 129 + nn];
      uint4* dst = (uint4*)(WT + (size_t)(n0 + nn) * K + k0 + k16);
      dst[0] = make_uint4(pk2(f[0], f[1]), pk2(f[2], f[3]), pk2(f[4], f[5]), pk2(f[6], f[7])); dst[1] = make_uint4(pk2(f[8], f[9]), pk2(f[10], f[11]), pk2(f[12], f[13]), pk2(f[14], f[15])); }
    __syncthreads();
}
__device__ __forceinline__ void p0_weights_in(const Params& P, unsigned char* lds, int G, int bid) {
    float* tile = (float*)lds;
    constexpr int N_IN = (D / 64) * (NPROJ / 128);
    for (int it = bid; it < N_IN; it += G) { const int kt = it / (NPROJ / 128), nt = it % (NPROJ / 128); transpose_tile(P.w_in, NIN, D, P.g1, (bf16_t*)(P.ws + WS_WINT), kt * 64, nt * 128, tile); }
}
__device__ __forceinline__ void p2_weights_sq(const Params& P, unsigned char* lds, int nworkers, int wid) {
    float* tile = (float*)lds;
    constexpr int N_SQ = (D / 64) * (D / 128);
    for (int it = wid; it < 2 * N_SQ; it += nworkers) {
        if (it < N_SQ) { const int kt = it / (D / 128), nt = it % (D / 128); transpose_tile(P.w_out, D, D, nullptr, (bf16_t*)(P.ws + WS_WOUTT), kt * 64, nt * 128, tile); }
        else { const int j = it - N_SQ, kt = j / (D / 128), nt = j % (D / 128); transpose_tile(P.w_q, D, D, P.g2, (bf16_t*)(P.ws + WS_WQT), kt * 64, nt * 128, tile); }
    }
}
typedef float f32x2_t __attribute__((ext_vector_type(2)));
typedef float v16f_t __attribute__((ext_vector_type(16)));
typedef float v32f_t __attribute__((ext_vector_type(32)));
typedef unsigned v6u_t __attribute__((ext_vector_type(6)));
constexpr int EROW = 1536;
__device__ __forceinline__ float wave_max(float v) {
#pragma unroll
    for (int o = 32; o >= 1; o >>= 1) v = fmaxf(v, __shfl_xor(v, o));
    return v;
}
__device__ __forceinline__ void p0_tables(const Params& P, int nworkers, int wid) {
    const int lane = threadIdx.x & 63, wave = threadIdx.x >> 6;
    float* esc = (float*)(P.ws + WS_ESC);
#pragma unroll 1
    for (int e = wid * NWAVES + wave; e < NEXP; e += nworkers * NWAVES) {
        float4 v[2][8];
#pragma unroll
        for (int isv = 0; isv < 2; ++isv) { const float4* src = (const float4*)((isv ? P.ev : P.eu) + (size_t)e * D) + lane * 8;
#pragma unroll
            for (int j = 0; j < 8; ++j) v[isv][j] = src[j]; }
#pragma unroll
        for (int isv = 0; isv < 2; ++isv) {
            float mx = 0.f;
#pragma unroll
            for (int j = 0; j < 8; ++j) { float4 w = v[isv][j];
                if (!isv) { const float4 gg = ((const float4*)P.g2)[lane * 8 + j]; w.x *= gg.x; w.y *= gg.y; w.z *= gg.z; w.w *= gg.w; v[isv][j] = w; }
                mx = fmaxf(mx, fmaxf(fmaxf(fabsf(w.x), fabsf(w.y)), fmaxf(fabsf(w.z), fabsf(w.w)))); }
            mx = wave_max(mx);
            int ex = 0; (void)frexpf(mx * (1.0f / 7.5f), &ex);
            const float sc = mx > 0.f ? ldexpf(1.0f, ex) : 1.0f;
            const v16f_t a = {v[isv][0].x, v[isv][0].z, v[isv][1].x, v[isv][1].z, v[isv][2].x, v[isv][2].z, v[isv][3].x, v[isv][3].z, v[isv][4].x, v[isv][4].z, v[isv][5].x, v[isv][5].z, v[isv][6].x, v[isv][6].z, v[isv][7].x, v[isv][7].z};
            const v16f_t b = {v[isv][0].y, v[isv][0].w, v[isv][1].y, v[isv][1].w, v[isv][2].y, v[isv][2].w, v[isv][3].y, v[isv][3].w, v[isv][4].y, v[isv][4].w, v[isv][5].y, v[isv][5].w, v[isv][6].y, v[isv][6].w, v[isv][7].y, v[isv][7].w};
            const v6u_t pk = __builtin_amdgcn_cvt_scalef32_2xpk16_fp6_f32(a, b, sc);
            v2u_t* dst = (v2u_t*)(P.ws + (isv ? WS_VB : WS_UB) + (size_t)e * EROW + lane * 24);
            dst[0] = (v2u_t){pk[0], pk[1]}; dst[1] = (v2u_t){pk[2], pk[3]}; dst[2] = (v2u_t){pk[4], pk[5]};
            if (lane == 0) esc[e * 2 + isv] = sc;
        }
    }
}

__device__ __forceinline__ void p2_conv(const Params& P, int nworkers, int wid) {
    const bf16_t* proj = (const bf16_t*)(P.ws + WS_PROJ); bf16_t* mix = (bf16_t*)(P.ws + WS_MIXIN);
    for (int idx = wid * NTHREADS + threadIdx.x; idx < T * 128; idx += nworkers * NTHREADS) {
        const int t = idx >> 7, c8 = (idx & 127) * 8, s = t & (SEQ - 1);
        float y[8];
#pragma unroll
        for (int i = 0; i < 8; ++i) y[i] = 0.f;
#pragma unroll
        for (int j = 0; j < 3; ++j) {
            const int dt = 2 - j;
            if (s >= dt) {
                const bf16_t* row = proj + (size_t)(t - dt) * NPROJ;
                float cx[8], cc[8]; unpack8(*(const uint4*)(row + PC_CX + c8), cx); unpack8(*(const uint4*)(row + PC_CC + c8), cc);
                const float4 w0 = *(const float4*)(P.conv_w + j * 1024 + c8), w1 = *(const float4*)(P.conv_w + j * 1024 + c8 + 4);
                y[0] += w0.x * (cc[0] * cx[0]); y[1] += w0.y * (cc[1] * cx[1]); y[2] += w0.z * (cc[2] * cx[2]); y[3] += w0.w * (cc[3] * cx[3]);
                y[4] += w1.x * (cc[4] * cx[4]); y[5] += w1.y * (cc[5] * cx[5]); y[6] += w1.z * (cc[6] * cx[6]); y[7] += w1.w * (cc[7] * cx[7]);
            }
        }
        float cb[8]; unpack8(*(const uint4*)(proj + (size_t)t * NPROJ + PC_CB + c8), cb);
        *(uint4*)(mix + (size_t)t * D + c8) = make_uint4(pk2(cb[0] * y[0], cb[1] * y[1]), pk2(cb[2] * y[2], cb[3] * y[3]), pk2(cb[4] * y[4], cb[5] * y[5]), pk2(cb[6] * y[6], cb[7] * y[7]));
    }
}
#define LAS3 __attribute__((address_space(3)))
typedef short s16x4_t __attribute__((ext_vector_type(4)));
__device__ __forceinline__ pg8::bf16x8 tr8(LAS3 unsigned char* p0, LAS3 unsigned char* p1) {
    const s16x4_t a = __builtin_amdgcn_ds_read_tr16_b64_v4i16((LAS3 s16x4_t*)p0), b = __builtin_amdgcn_ds_read_tr16_b64_v4i16((LAS3 s16x4_t*)p1);
    return __builtin_shufflevector(a, b, 0, 1, 2, 3, 4, 5, 6, 7);
}
template <int CTRL, int RMASK> __device__ __forceinline__ float dpp_keep(float oldv, float v) { return __int_as_float(__builtin_amdgcn_update_dpp(__float_as_int(oldv), __float_as_int(v), CTRL, RMASK, 0xF, false)); }
__device__ __forceinline__ float wave_incl_sum(float v) {
    v += dpp_keep<0x111, 0xF>(0.f, v); v += dpp_keep<0x112, 0xF>(0.f, v); v += dpp_keep<0x114, 0xF>(0.f, v); v += dpp_keep<0x118, 0xF>(0.f, v);
    v += dpp_keep<0x142, 0xA>(0.f, v); v += dpp_keep<0x143, 0xC>(0.f, v); return v;
}
__device__ __forceinline__ float wave_incl_max(float v) {
    const float NI = -__builtin_inff();
    v = fmaxf(v, dpp_keep<0x111, 0xF>(NI, v)); v = fmaxf(v, dpp_keep<0x112, 0xF>(NI, v)); v = fmaxf(v, dpp_keep<0x114, 0xF>(NI, v)); v = fmaxf(v, dpp_keep<0x118, 0xF>(NI, v));
    v = fmaxf(v, dpp_keep<0x142, 0xA>(NI, v)); v = fmaxf(v, dpp_keep<0x143, 0xC>(NI, v)); return v;
}
__device__ __forceinline__ void mlstm_unit(const Params& P, unsigned char* lds_, int unit, float* hraw) {
    typedef pg8::bf16x8 bf16x8; typedef pg8::f32x4 f32x4;
    LAS3 unsigned char* L = (LAS3 unsigned char*)lds_;
    constexpr int QS = 0, KS = 33792, VA = 67584, WV = 73728, CB0 = 79872, CBSZ = 25344, SW0 = CB0 + 2 * CBSZ, SWSZ = 2304, SM0 = SW0 + 4 * SWSZ, SMSZ = 1600;
    constexpr int QST = 528, VST = 96, SST = 144;
    const int tid = threadIdx.x, lane = tid & 63, wave = __builtin_amdgcn_readfirstlane(tid >> 6);
    const int g = lane >> 4, c16 = lane & 15, q4 = c16 >> 2, p4 = lane & 3;
    const int bh = unit >> 3, sl = unit & 7, b = bh >> 2, h = bh & 3, v0 = sl * 32;
    const bf16_t* proj = (const bf16_t*)(P.ws + WS_PROJ);
    const float* gi = (const float*)(P.ws + WS_GI); const float* gf = (const float*)(P.ws + WS_GF);
#define SMF(sb, off) ((LAS3 float*)(L + SM0 + (sb) * SMSZ + (off)))
    for (int i = tid; i < (2 * CBSZ) / 16; i += NTHREADS) *(LAS3 v4u_t*)(L + CB0 + i * 16) = (v4u_t){0u, 0u, 0u, 0u};
    for (int i = tid; i < 6144 / 16; i += NTHREADS) *(LAS3 v4u_t*)(L + WV + i * 16) = (v4u_t){0u, 0u, 0u, 0u};
    if (tid < 64) { *(LAS3 v4u_t*)(L + VA + tid * VST + 64) = (v4u_t){0x00003F80u, 0u, 0u, 0u}; *(LAS3 v4u_t*)(L + VA + tid * VST + 80) = (v4u_t){0u, 0u, 0u, 0u}; }
    f32x4 accC[4][3];
#pragma unroll
    for (int dt = 0; dt < 4; ++dt)
#pragma unroll
        for (int vt = 0; vt < 3; ++vt) accC[dt][vt] = (f32x4){0.f, 0.f, 0.f, 0.f};
    const int row = tid >> 3, seg = tid & 7;
    v4u_t rq[4], rk[4], rv = (v4u_t){0u, 0u, 0u, 0u};
    float m = 0.f, nic = 0.f, nfc = 0.f;
#define MLSTM_SMALLS(sb, ic_, fc_) do { const float bc_ = wave_incl_sum(fc_); const float a_ = (ic_) - bc_; const float pm_ = wave_incl_max(a_); \
        const float M_ = fmaxf(m, pm_), M63_ = __shfl(M_, 63), b63_ = __shfl(bc_, 63); \
        SMF(sb, 0)[lane] = a_ * 1.4426950408889634f; SMF(sb, 256)[lane] = M_ * 1.4426950408889634f; SMF(sb, 512)[lane] = __expf(m - M_); SMF(sb, 768)[lane] = __expf(a_ - M63_) * 0.0625f; SMF(sb, 1024)[lane] = __expf(-bc_ - M_); \
        if (lane == 0) { SMF(sb, 1280)[0] = b63_ + M63_; SMF(sb, 1280)[1] = __expf(m - M63_); } m = b63_ + M63_; } while (0)
    { const int t0 = b * SEQ; const bf16_t* src = proj + (size_t)(t0 + row) * NPROJ + h * DH + seg * 8;
#pragma unroll
      for (int i = 0; i < 4; ++i) { rq[i] = *(const v4u_t*)(src + PC_Q + i * 64); rk[i] = *(const v4u_t*)(src + PC_K + i * 64); }
      if (tid < 256) rv = *(const v4u_t*)(proj + (size_t)(t0 + (tid >> 2)) * NPROJ + PC_V + h * DH + v0 + (tid & 3) * 8);
      if (wave == 0) { const float ic0 = gi[(size_t)(t0 + lane) * 4 + h], fc0 = gf[(size_t)(t0 + lane) * 4 + h]; MLSTM_SMALLS(0, ic0, fc0);
          nic = gi[(size_t)(t0 + LCH + lane) * 4 + h]; nfc = gf[(size_t)(t0 + LCH + lane) * 4 + h]; } }
    __syncthreads();
#pragma unroll 1
    for (int c = 0; c < SEQ / LCH; ++c) {
        const int t0 = b * SEQ + c * LCH, sb = c & 1;
        LAS3 unsigned char* CBc = L + CB0 + sb * CBSZ; LAS3 unsigned char* CBn = L + CB0 + (sb ^ 1) * CBSZ;
#pragma unroll
        for (int i = 0; i < 4; ++i) { *(LAS3 v4u_t*)(L + QS + row * QST + (i * 8 + seg) * 16) = rq[i]; *(LAS3 v4u_t*)(L + KS + row * QST + (i * 8 + seg) * 16) = rk[i]; }
        if (tid < 256) { const int l = tid >> 2, part = tid & 3; const float wl = SMF(sb, 768)[l];
            *(LAS3 v4u_t*)(L + VA + l * VST + part * 16) = rv;
            *(LAS3 v4u_t*)(L + WV + l * VST + part * 16) = (v4u_t){pg8::cvt_pk_bf16(wl * bflo(rv.x), wl * bfhi(rv.x)), pg8::cvt_pk_bf16(wl * bflo(rv.y), wl * bfhi(rv.y)), pg8::cvt_pk_bf16(wl * bflo(rv.z), wl * bfhi(rv.z)), pg8::cvt_pk_bf16(wl * bflo(rv.w), wl * bfhi(rv.w))}; }
        else if (tid < 320) { const int l = tid - 256; *(LAS3 unsigned short*)(L + WV + l * VST + 64) = (unsigned short)pg8::cvt_pk_bf16(SMF(sb, 768)[l], 0.f); }
        if (c + 1 < SEQ / LCH) { const int t1 = t0 + LCH; const bf16_t* src = proj + (size_t)(t1 + row) * NPROJ + h * DH + seg * 8;
#pragma unroll
            for (int i = 0; i < 4; ++i) { rq[i] = *(const v4u_t*)(src + PC_Q + i * 64); rk[i] = *(const v4u_t*)(src + PC_K + i * 64); }
            if (tid < 256) rv = *(const v4u_t*)(proj + (size_t)(t1 + (tid >> 2)) * NPROJ + PC_V + h * DH + v0 + (tid & 3) * 8); }
        __syncthreads();
        if (wave < 4) {
            const int rt = wave; LAS3 unsigned char* SWp = L + SW0 + rt * SWSZ;
            const f32x4 M4 = *(LAS3 f32x4*)(SMF(sb, 256) + rt * 16 + 4 * g);
            bf16x8 qf[8];
#pragma unroll
            for (int ks = 0; ks < 8; ++ks) qf[ks] = *(LAS3 bf16x8*)(L + QS + (rt * 16 + c16) * QST + (ks * 32 + g * 8) * 2);
#pragma unroll
            for (int ct = 0; ct < 4; ++ct) { f32x4 acc = (f32x4){0.f, 0.f, 0.f, 0.f};
                if (ct <= rt) {
#pragma unroll
                    for (int ks = 0; ks < 8; ++ks) { const bf16x8 bv = *(LAS3 bf16x8*)(L + KS + (ct * 16 + c16) * QST + (ks * 32 + g * 8) * 2);
                        acc = __builtin_amdgcn_mfma_f32_16x16x32_bf16(qf[ks], bv, acc, 0, 0, 0); } }
                const int l = ct * 16 + c16; const float al = SMF(sb, 0)[l];
#pragma unroll
                for (int r = 0; r < 4; ++r) { const int jr = 4 * g + r; const float val = (l <= rt * 16 + jr) ? acc[r] * 0.0625f * __builtin_amdgcn_exp2f(al - M4[r]) : 0.f;
                    *(LAS3 unsigned short*)(SWp + jr * SST + l * 2) = (unsigned short)pg8::cvt_pk_bf16(val, 0.f); } }
            asm volatile("s_waitcnt lgkmcnt(0)" ::: "memory");
            f32x4 aI[3], aX[3];
#pragma unroll
            for (int vt = 0; vt < 3; ++vt) { aI[vt] = (f32x4){0.f, 0.f, 0.f, 0.f}; aX[vt] = (f32x4){0.f, 0.f, 0.f, 0.f}; }
#pragma unroll
            for (int ks = 0; ks < 8; ++ks) {
#pragma unroll
                for (int vt = 0; vt < 3; ++vt) { const bf16x8 bv = *(LAS3 bf16x8*)(CBc + (vt * 16 + c16) * QST + (ks * 32 + g * 8) * 2); aI[vt] = __builtin_amdgcn_mfma_f32_16x16x32_bf16(qf[ks], bv, aI[vt], 0, 0, 0); } }
#pragma unroll
            for (int ks = 0; ks < 2; ++ks) { const bf16x8 av = *(LAS3 bf16x8*)(SWp + c16 * SST + (ks * 32 + g * 8) * 2);
#pragma unroll
                for (int vt = 0; vt < 3; ++vt) { LAS3 unsigned char* vp = L + VA + (ks * 32 + g * 8 + q4) * VST + (vt * 16 + 4 * p4) * 2; const bf16x8 bv = tr8(vp, vp + 4 * VST);
                    aX[vt] = __builtin_amdgcn_mfma_f32_16x16x32_bf16(av, bv, aX[vt], 0, 0, 0); } }
            const f32x4 e4 = *(LAS3 f32x4*)(SMF(sb, 512) + rt * 16 + 4 * g), n4 = *(LAS3 f32x4*)(SMF(sb, 1024) + rt * 16 + 4 * g);
#pragma unroll
            for (int r = 0; r < 4; ++r) { const float den0 = __builtin_amdgcn_rcpf(fmaxf(fabsf(e4[r] * aI[2][r] + aX[2][r]), n4[r])); const float rden = __shfl(den0, g * 16);
                const size_t o = (size_t)(t0 + rt * 16 + 4 * g + r) * DML + h * DH + v0 + c16;
                const float h0_ = (e4[r] * aI[0][r] + aX[0][r]) * rden, h1_ = (e4[r] * aI[1][r] + aX[1][r]) * rden;
                hraw[o] = h0_; hraw[o + 16] = h1_; }
            if (wave == 0 && c + 1 < SEQ / LCH) {
                MLSTM_SMALLS(sb ^ 1, nic, nfc);
                const int c2 = (c + 2 < SEQ / LCH) ? c + 2 : SEQ / LCH - 1;
                nic = gi[(size_t)(b * SEQ + c2 * LCH + lane) * 4 + h]; nfc = gf[(size_t)(b * SEQ + c2 * LCH + lane) * 4 + h];
            }
        } else {
            const int wB = wave - 4; const float decay = SMF(sb, 1280)[1];
#pragma unroll
            for (int dt = 0; dt < 4; ++dt)
#pragma unroll
                for (int v3 = 0; v3 < 3; ++v3) accC[dt][v3] *= decay;
#pragma unroll
            for (int ks = 0; ks < 2; ++ks) { bf16x8 af[4], bfr[3];
#pragma unroll
                for (int dt = 0; dt < 4; ++dt) { LAS3 unsigned char* kp = L + KS + (ks * 32 + g * 8 + q4) * QST + ((4 * wB + dt) * 16 + 4 * p4) * 2; af[dt] = tr8(kp, kp + 4 * QST); }
#pragma unroll
                for (int v3 = 0; v3 < 3; ++v3) { LAS3 unsigned char* wp = L + WV + (ks * 32 + g * 8 + q4) * VST + (v3 * 16 + 4 * p4) * 2; bfr[v3] = tr8(wp, wp + 4 * VST); }
#pragma unroll
                for (int dt = 0; dt < 4; ++dt)
#pragma unroll
                    for (int v3 = 0; v3 < 3; ++v3) accC[dt][v3] = __builtin_amdgcn_mfma_f32_16x16x32_bf16(af[dt], bfr[v3], accC[dt][v3], 0, 0, 0); }
#pragma unroll
            for (int dt = 0; dt < 4; ++dt)
#pragma unroll
                for (int v3 = 0; v3 < 3; ++v3) { const int d = (4 * wB + dt) * 16 + 4 * g, vp = v3 * 16 + c16;
                    *(LAS3 v2u_t*)(CBn + vp * QST + d * 2) = (v2u_t){pg8::cvt_pk_bf16(accC[dt][v3][0], accC[dt][v3][1]), pg8::cvt_pk_bf16(accC[dt][v3][2], accC[dt][v3][3])}; }
        }
        __syncthreads();
    }
#undef MLSTM_SMALLS
#undef SMF
}

__device__ __forceinline__ void p3_finalize(const Params& P, int G, int bid) {
    const int lane = threadIdx.x & 63, wave = threadIdx.x >> 6;
    const float* hraw = (const float*)(P.ws + WS_HRAW); const bf16_t* proj = (const bf16_t*)(P.ws + WS_PROJ); bf16_t* mix = (bf16_t*)(P.ws + WS_MIXIN);
    for (int idx = bid * NWAVES + wave; idx < T * NH; idx += G * NWAVES) {
        const int t = idx >> 2, hh = idx & 3;
        const float4 hv = *(const float4*)(hraw + (size_t)t * DML + hh * DH + lane * 4);
        const float ss = wave_sum((hv.x * hv.x + hv.y * hv.y) + (hv.z * hv.z + hv.w * hv.w));
        const float r = rsqrtf(ss * (1.0f / DH) + EPS);
        const uint2 ow = *(const uint2*)(proj + (size_t)t * NPROJ + PC_O + hh * DH + lane * 4);
        const float4 g = *(const float4*)(P.gm + hh * DH + lane * 4);
        const float o0 = 1.0f / (1.0f + expf(-bflo(ow.x))), o1 = 1.0f / (1.0f + expf(-bfhi(ow.x))), o2 = 1.0f / (1.0f + expf(-bflo(ow.y))), o3 = 1.0f / (1.0f + expf(-bfhi(ow.y)));
        *(uint2*)(mix + (size_t)t * D + DML + hh * DH + lane * 4) = make_uint2(pk2(o0 * (hv.x * r * g.x), o1 * (hv.y * r * g.y)), pk2(o2 * (hv.z * r * g.z), o3 * (hv.w * r * g.w)));
    }
}

template <int CTRL> __device__ __forceinline__ float dppf(float v) { return __int_as_float(__builtin_amdgcn_update_dpp(0, __float_as_int(v), CTRL, 0xF, 0xF, true)); }
__device__ __forceinline__ float grp16_max(float v) { v = fmaxf(v, dppf<0xB1>(v)); v = fmaxf(v, dppf<0x4E>(v)); v = fmaxf(v, dppf<0x141>(v)); v = fmaxf(v, dppf<0x140>(v)); return v; }
__device__ __forceinline__ float grp16_sum(float v) { v += dppf<0xB1>(v); v += dppf<0x4E>(v); v += dppf<0x141>(v); v += dppf<0x140>(v); return v; }
#define CEX(a, b) do { const float hi_ = fmaxf(a, b), lo_ = fminf(a, b); a = hi_; b = lo_; } while (0)
static __device__ const unsigned char CAND_AB[16][4] = {
    {0x00, 0x01, 0x02, 0x03}, {0x04, 0x05, 0x06, 0x07}, {0x08, 0x09, 0x0A, 0x0B}, {0x0C, 0x0D, 0x0E, 0x0F}, {0x10, 0x11, 0x12, 0x13}, {0x14, 0x15, 0x16, 0x17}, {0x20, 0x21, 0x22, 0x23}, {0x24, 0, 0, 0},
    {0x30, 0x31, 0x32, 0x33}, {0x40, 0x41, 0x42, 0}, {0x50, 0x60, 0x70, 0x80}, {0x90, 0xA0, 0xB0, 0xC0}, {0xD0, 0xE0, 0xF0, 0}, {0x51, 0x61, 0x71, 0}, {0, 0, 0, 0}, {0, 0, 0, 0}};
static __device__ const unsigned char CAND_N[16] = {4, 4, 4, 4, 4, 4, 4, 1, 4, 3, 4, 4, 3, 3, 0, 0};
__device__ __forceinline__ void p6_topk(const Params& P, unsigned char* lds_, int G, int bid) {
    typedef pg8::bf16x8 bf16x8; typedef pg8::f32x4 f32x4;
    LAS3 unsigned char* L = (LAS3 unsigned char*)lds_;
    constexpr int KST = 272, KHALF = 128 * KST;
    const int tid = threadIdx.x, lane = tid & 63, wave = tid >> 6, g = lane >> 4, c16 = lane & 15;
    for (int i = tid; i < 2 * 2048; i += NTHREADS) { const int hf = i >> 11, n = (i >> 4) & 127, d8 = (i & 15) * 8; const float* src = (hf ? P.sk2 : P.sk1) + n * 128 + d8;
        const float4 a = *(const float4*)src, b = *(const float4*)(src + 4);
        *(LAS3 v4u_t*)(L + hf * KHALF + n * KST + d8 * 2) = (v4u_t){pk2(a.x, a.y), pk2(a.z, a.w), pk2(b.x, b.y), pk2(b.z, b.w)}; }
    __syncthreads();
    const bf16_t* qvb = (const bf16_t*)(P.ws + WS_QV);
    int* idxo = (int*)(P.ws + WS_IDX); float* gato = (float*)(P.ws + WS_GATE);
    const float NEGINF = -__builtin_inff();
    unsigned ctab = 0; { const unsigned char* tp = CAND_AB[c16]; ctab = (unsigned)tp[0] | ((unsigned)tp[1] << 8) | ((unsigned)tp[2] << 16) | ((unsigned)tp[3] << 24); }
    const int ccnt = CAND_N[c16];
#pragma unroll 1
    for (int it = bid * NWAVES + wave; it < (T / 16) * PEER_H; it += G * NWAVES) {
        const int t0 = (it >> 3) * 16, hh = it & 7;
        float keepH[2][4];
#pragma unroll
        for (int hf = 0; hf < 2; ++hf) {
            asm volatile("" ::: "memory");
            bf16x8 af[4];
#pragma unroll
            for (int ks = 0; ks < 4; ++ks) af[ks] = *(const bf16x8*)(qvb + (size_t)(t0 + c16) * D + hh * 256 + hf * 128 + ks * 32 + g * 8);
            f32x4 acc[8];
#pragma unroll
            for (int ct = 0; ct < 8; ++ct) { acc[ct] = (f32x4){0.f, 0.f, 0.f, 0.f};
#pragma unroll
                for (int ks = 0; ks < 4; ++ks) { const bf16x8 bv = *(LAS3 bf16x8*)(L + hf * KHALF + (ct * 16 + c16) * KST + (ks * 32 + g * 8) * 2);
                    acc[ct] = __builtin_amdgcn_mfma_f32_16x16x32_bf16(af[ks], bv, acc[ct], 0, 0, 0); } }
            float v[4][8];
#pragma unroll
            for (int r = 0; r < 4; ++r) {
#pragma unroll
                for (int ct = 0; ct < 8; ++ct) v[r][ct] = __uint_as_float((__float_as_uint(acc[ct][r]) & ~127u) | (unsigned)(127 - (ct * 16 + c16)));
                CEX(v[r][0], v[r][1]); CEX(v[r][2], v[r][3]); CEX(v[r][4], v[r][5]); CEX(v[r][6], v[r][7]);
                CEX(v[r][0], v[r][2]); CEX(v[r][1], v[r][3]); CEX(v[r][4], v[r][6]); CEX(v[r][5], v[r][7]);
                CEX(v[r][1], v[r][2]); CEX(v[r][5], v[r][6]); CEX(v[r][0], v[r][4]); CEX(v[r][3], v[r][7]);
                CEX(v[r][1], v[r][5]); CEX(v[r][2], v[r][6]);
                CEX(v[r][1], v[r][4]); CEX(v[r][3], v[r][6]);
                CEX(v[r][2], v[r][4]); CEX(v[r][3], v[r][5]);
                CEX(v[r][3], v[r][4]);
                keepH[hf][r] = 0.f;
            }
#pragma unroll
            for (int rd = 0; rd < TOPK; ++rd) {
#pragma unroll
                for (int r = 0; r < 4; ++r) {
                    const float W = grp16_max(v[r][0]); const bool win = (v[r][0] == W);
                    if (c16 == rd) keepH[hf][r] = W;
#pragma unroll
                    for (int k = 0; k < 7; ++k) v[r][k] = win ? v[r][k + 1] : v[r][k];
                    v[r][7] = win ? NEGINF : v[r][7];
                }
            }
        }
#pragma unroll
        for (int r = 0; r < 4; ++r) {
            const float V1 = keepH[0][r], V2 = keepH[1][r];
            float cv[4];
#pragma unroll
            for (int s4 = 0; s4 < 4; ++s4) { const unsigned code = (ctab >> (8 * s4)) & 255u;
                const float x1 = __shfl(V1, g * 16 + (int)(code >> 4)), x2 = __shfl(V2, g * 16 + (int)(code & 15u));
                const float sum = __uint_as_float(__float_as_uint(x1) & ~127u) + __uint_as_float(__float_as_uint(x2) & ~127u);
                cv[s4] = (s4 < ccnt) ? __uint_as_float((__float_as_uint(sum) & ~255u) | (255u - code)) : NEGINF; }
            float keepc = 0.f;
#pragma unroll
            for (int rd = 0; rd < TOPK; ++rd) {
                const float W = grp16_max(cv[0]); const bool win = (cv[0] == W);
                if (c16 == rd) keepc = W;
                cv[0] = win ? cv[1] : cv[0]; cv[1] = win ? cv[2] : cv[1]; cv[2] = win ? cv[3] : cv[2]; cv[3] = win ? NEGINF : cv[3];
            }
            const unsigned kb = __float_as_uint(keepc), code = 255u - (kb & 255u);
            const unsigned n1 = 127u - (__float_as_uint(__shfl(V1, g * 16 + (int)(code >> 4))) & 127u), n2 = 127u - (__float_as_uint(__shfl(V2, g * 16 + (int)(code & 15u))) & 127u);
            const float sval = __uint_as_float(kb & ~255u), smax = __shfl(sval, g * 16);
            const float ex = __expf(sval - smax), den = grp16_sum(ex);
            const size_t o = (size_t)(t0 + 4 * g + r) * 128 + hh * 16 + c16;
            idxo[o] = (int)(n1 * 128u + n2); gato[o] = ex / den;
        }
    }
    __syncthreads();
}

__device__ __forceinline__ float wave_sum_dpp(float v) {
    v += dppf<0xB1>(v); v += dppf<0x4E>(v); v += dppf<0x141>(v); v += dppf<0x140>(v);
    const int iv = __float_as_int(v);
    return (__int_as_float(__builtin_amdgcn_readlane(iv, 0)) + __int_as_float(__builtin_amdgcn_readlane(iv, 16))) + (__int_as_float(__builtin_amdgcn_readlane(iv, 32)) + __int_as_float(__builtin_amdgcn_readlane(iv, 48)));
}
__device__ __forceinline__ float dot16_fp8(const v4u_t w, const float (&x)[16]) {
    float s = 0.f;
#pragma unroll
    for (int k = 0; k < 4; ++k) { const f32x2_t lo = __builtin_amdgcn_cvt_pk_f32_fp8(w[k], false), hi = __builtin_amdgcn_cvt_pk_f32_fp8(w[k], true);
        s += (x[4 * k] * lo.x + x[4 * k + 1] * lo.y) + (x[4 * k + 2] * hi.x + x[4 * k + 3] * hi.y); }
    return s;
}
__device__ __forceinline__ void axpy16_fp8(const v4u_t w, const float cf, float (&y)[16]) {
#pragma unroll
    for (int k = 0; k < 4; ++k) { const f32x2_t lo = __builtin_amdgcn_cvt_pk_f32_fp8(w[k], false), hi = __builtin_amdgcn_cvt_pk_f32_fp8(w[k], true);
        y[4 * k] += cf * lo.x; y[4 * k + 1] += cf * lo.y; y[4 * k + 2] += cf * hi.x; y[4 * k + 3] += cf * hi.y; }
}
#define PIN16(a, o) asm volatile("" : "+v"(a[o + 0]), "+v"(a[o + 1]), "+v"(a[o + 2]), "+v"(a[o + 3]), "+v"(a[o + 4]), "+v"(a[o + 5]), "+v"(a[o + 6]), "+v"(a[o + 7]), "+v"(a[o + 8]), "+v"(a[o + 9]), "+v"(a[o + 10]), "+v"(a[o + 11]), "+v"(a[o + 12]), "+v"(a[o + 13]), "+v"(a[o + 14]), "+v"(a[o + 15]))
typedef __bf16 v2bf_t __attribute__((ext_vector_type(2)));
typedef __bf16 v32bf_t __attribute__((ext_vector_type(32)));
typedef unsigned v16u_t __attribute__((ext_vector_type(16)));
__device__ __forceinline__ float row16_sum(float v) { v += dppf<0xB1>(v); v += dppf<0x4E>(v); v += dppf<0x141>(v); v += dppf<0x140>(v); return v; }
__device__ __forceinline__ void p7_peer(const Params& P, unsigned char* lds_, int G, int bid) {
    const int lane = threadIdx.x & 63, wave = __builtin_amdgcn_readfirstlane(threadIdx.x >> 6);
    LAS3 unsigned char* W = (LAS3 unsigned char*)lds_ + wave * 8192;
    const bf16_t* x1b = (const bf16_t*)(P.ws + WS_X1B); const float* ssq = (const float*)(P.ws + WS_SSQ);
    const int* idxi = (const int*)(P.ws + WS_IDX); const float* gati = (const float*)(P.ws + WS_GATE);
    const unsigned char* ub = P.ws + WS_UB; const unsigned char* vb = P.ws + WS_VB; const float* esc = (const float*)(P.ws + WS_ESC);
#pragma unroll 1
    for (int qd = bid * NWAVES + wave; qd < T / 4; qd += G * NWAVES) {
        int ln = lane; asm volatile("" : "+v"(ln));
        const int tb = qd * 4, q = ln >> 4, l16 = ln & 15, t = tb + q;
        const unsigned loff = (unsigned)l16 * 24u;
#pragma unroll 1
        for (int s4 = 0; s4 < 4; ++s4) {
            LAS3 int* hist = (LAS3 int*)(W + 4096); LAS3 int* base = (LAS3 int*)(W + 4096 + 256); LAS3 v2u_t* list = (LAS3 v2u_t*)(W + s4 * 1024);
            const size_t o = (size_t)(tb + s4) * 128 + ln;
            const int i0 = idxi[o], i1 = idxi[o + 64]; const float g0 = gati[o], g1 = gati[o + 64];
            hist[ln] = 0; asm volatile("s_waitcnt lgkmcnt(0)" ::: "memory");
            const int t0_ = __hip_atomic_fetch_add((int*)(hist + (i0 >> 8)), 1, __ATOMIC_RELAXED, __HIP_MEMORY_SCOPE_WORKGROUP);
            const int t1_ = __hip_atomic_fetch_add((int*)(hist + (i1 >> 8)), 1, __ATOMIC_RELAXED, __HIP_MEMORY_SCOPE_WORKGROUP);
            asm volatile("s_waitcnt lgkmcnt(0)" ::: "memory");
            const int cnt = hist[ln]; int inc = cnt;
#pragma unroll
            for (int o2 = 1; o2 < 64; o2 <<= 1) { const int tv = __shfl_up(inc, o2); if (ln >= o2) inc += tv; }
            base[ln] = inc - cnt; asm volatile("s_waitcnt lgkmcnt(0)" ::: "memory");
            list[base[i0 >> 8] + t0_] = (v2u_t){(unsigned)i0, __float_as_uint(g0)}; list[base[i1 >> 8] + t1_] = (v2u_t){(unsigned)i1, __float_as_uint(g1)};
            asm volatile("s_waitcnt lgkmcnt(0)" ::: "memory");
        }
        LAS3 v2u_t* mylist = (LAS3 v2u_t*)(W + q * 1024); LAS3 float* mydot = (LAS3 float*)(W + 4096 + q * 512);
        const float rs2 = rsqrtf(row16_sum(ssq[(size_t)t * 32 + l16] + ssq[(size_t)t * 32 + 16 + l16]) * (1.0f / D) + EPS);
        {
            unsigned xp[4][16];
#pragma unroll
            for (int jj = 0; jj < 4; ++jj) { const v4u_t* xs = (const v4u_t*)(x1b + (size_t)t * D + jj * 512 + l16 * 32);
#pragma unroll
                for (int k = 0; k < 4; ++k) { const v4u_t a = xs[k]; xp[jj][4 * k] = a.x; xp[jj][4 * k + 1] = a.y; xp[jj][4 * k + 2] = a.z; xp[jj][4 * k + 3] = a.w; } }
            v6u_t rb[4][4]; float rsc[4];
#define P7_LD1(j, b) do { const unsigned e_ = mylist[j].x; const unsigned char* rp = ub + (size_t)e_ * EROW + loff; rsc[b] = esc[e_ * 2]; \
            _Pragma("unroll") for (int jj = 0; jj < 4; ++jj) { const v2u_t* cp = (const v2u_t*)(rp + jj * 384); const v2u_t c0 = cp[0], c1 = cp[1], c2 = cp[2]; rb[b][jj] = (v6u_t){c0.x, c0.y, c1.x, c1.y, c2.x, c2.y}; } } while (0)
#define P7_D2(k_) __builtin_amdgcn_fdot2_f32_bf16((v2bf_t){w[2 * (k_)], w[2 * (k_) + 1]}, __builtin_bit_cast(v2bf_t, xp[jj][k_]),
#define P7_DOT1(j, b) do { float s0 = 0.f, s1 = 0.f, s2 = 0.f, s3 = 0.f; _Pragma("unroll") for (int jj = 0; jj < 4; ++jj) { asm volatile("" : "+v"(rb[b][jj])); \
                const v32bf_t w = __builtin_amdgcn_cvt_scalef32_pk32_bf16_fp6(rb[b][jj], rsc[b]);     \
                _Pragma("unroll") for (int i = 0; i < 16; i += 4) { s0 = P7_D2(i) s0, false); s1 = P7_D2(i + 1) s1, false); s2 = P7_D2(i + 2) s2, false); s3 = P7_D2(i + 3) s3, false); } } \
            const float tot = row16_sum((s0 + s1) + (s2 + s3)); if (l16 == 0) mydot[j] = tot; } while (0)
#pragma unroll
            for (int b = 0; b < 4; ++b) P7_LD1(b, b);
#pragma unroll 1
            for (int j = 0; j < 124; j += 4) {
#pragma unroll
                for (int b = 0; b < 4; ++b) { P7_DOT1(j + b, b); P7_LD1(j + 4 + b, b); } }
#pragma unroll
            for (int b = 0; b < 4; ++b) P7_DOT1(124 + b, b);
#undef P7_DOT1
#undef P7_D2
#undef P7_LD1
        }
        asm volatile("s_waitcnt lgkmcnt(0)" ::: "memory");
        { const float r0 = __int_as_float(__builtin_amdgcn_readlane(__float_as_int(rs2), 0)), r1 = __int_as_float(__builtin_amdgcn_readlane(__float_as_int(rs2), 16)),
                      r2 = __int_as_float(__builtin_amdgcn_readlane(__float_as_int(rs2), 32)), r3 = __int_as_float(__builtin_amdgcn_readlane(__float_as_int(rs2), 48));
#pragma unroll
          for (int k = 0; k < 8; ++k) { const int n = k * 64 + ln; const v2u_t en = *(LAS3 v2u_t*)(W + n * 8); LAS3 float* dp = (LAS3 float*)(W + 4096 + n * 4);
              const float rr = (k >> 1) == 0 ? r0 : (k >> 1) == 1 ? r1 : (k >> 1) == 2 ? r2 : r3;
              *dp = __uint_as_float(en.y) * gelu_erf(*dp * rr); } }
        asm volatile("s_waitcnt lgkmcnt(0)" ::: "memory");
        float y[4][32];
#pragma unroll
        for (int jj = 0; jj < 4; ++jj)
#pragma unroll
            for (int k = 0; k < 4; ++k) { float a[8]; unpack8(*(const uint4*)(x1b + (size_t)t * D + jj * 512 + l16 * 32 + 8 * k), a);
#pragma unroll
                for (int i = 0; i < 8; ++i) y[jj][8 * k + i] = a[i]; }
        {
            v6u_t bA[4], bB[4]; float scA = 1.f, scB = 1.f;
#define P7_LOADQ(j, Bf, SC) do { const unsigned e_ = mylist[j].x; const unsigned char* rp = vb + (size_t)e_ * EROW + loff; SC = esc[e_ * 2 + 1]; \
            _Pragma("unroll") for (int jj = 0; jj < 4; ++jj) { const v2u_t* cp = (const v2u_t*)(rp + jj * 384); const v2u_t c0 = cp[0], c1 = cp[1], c2 = cp[2]; Bf[jj] = (v6u_t){c0.x, c0.y, c1.x, c1.y, c2.x, c2.y}; } } while (0)
#define P7_AXQ(j, Bf, SC) do { const float cf = mydot[j]; _Pragma("unroll") for (int jj = 0; jj < 4; ++jj) { asm volatile("" : "+v"(Bf[jj])); const v32f_t w = __builtin_amdgcn_cvt_scalef32_pk32_f32_fp6(Bf[jj], SC); \
            _Pragma("unroll") for (int i = 0; i < 32; ++i) y[jj][i] += cf * w[i]; PIN16(y[jj], 0); PIN16(y[jj], 16); } } while (0)
            P7_LOADQ(0, bA, scA);
#pragma unroll 1
            for (int j = 0; j < 126; j += 2) { P7_LOADQ(j + 1, bB, scB); P7_AXQ(j, bA, scA); P7_LOADQ(j + 2, bA, scA); P7_AXQ(j + 1, bB, scB); }
            P7_LOADQ(127, bB, scB); P7_AXQ(126, bA, scA); P7_AXQ(127, bB, scB);
#undef P7_AXQ
#undef P7_LOADQ
        }
        float ss = 0.f;
        const float* grow = P.gfin + l16 * 32; float* orow = P.out + (size_t)t * D + l16 * 32;
#pragma unroll
        for (int jj = 0; jj < 4; ++jj)
#pragma unroll
            for (int i = 0; i < 32; ++i) ss += y[jj][i] * y[jj][i];
        ss = row16_sum(ss);
        const float r = rsqrtf(ss * (1.0f / D) + EPS);
#pragma unroll
        for (int jj = 0; jj < 4; ++jj)
#pragma unroll
            for (int k = 0; k < 8; ++k) { const float4 gg = *(const float4*)(grow + jj * 512 + 4 * k);
                const float4 ov = make_float4(y[jj][4 * k] * r * gg.x, y[jj][4 * k + 1] * r * gg.y, y[jj][4 * k + 2] * r * gg.z, y[jj][4 * k + 3] * r * gg.w);
                *(float4*)(orow + jj * 512 + 4 * k) = ov; }
    }
}
#undef PIN16

#define XB_TMO      128
#define XB_XCNT(j)  (256  + 64 * (j))
#define XB_XSUB(j)  (1280 + 64 * (j))
#define XB_XGEN(j)  (2304 + 64 * (j))
#define XB_TOP      3328
#define XB_TOPGEN   3392
#define XCD_BAR_WORDS 3456
#define XB_SPIN_CAP (1u << 18)

__device__ __forceinline__ unsigned xb_ld(unsigned* p)              { return __hip_atomic_load(p, __ATOMIC_RELAXED, __HIP_MEMORY_SCOPE_AGENT); }
__device__ __forceinline__ unsigned xb_add(unsigned* p, unsigned v) { return __hip_atomic_fetch_add(p, v, __ATOMIC_RELAXED, __HIP_MEMORY_SCOPE_AGENT); }
__device__ __forceinline__ unsigned xb_xcc_id() { return (unsigned)__builtin_amdgcn_s_getreg((3 << 11) | 20) & 0xFu; }
#define XB_SPIN(cond, bar) do { unsigned _sp = 0; while (cond) { __builtin_amdgcn_s_sleep(1); \
    if ((++_sp & 255u) == 0u) { if (xb_ld(&(bar)[XB_TMO])) break; if (_sp > XB_SPIN_CAP) { atomicAdd(&(bar)[XB_TMO], 1u); break; } } } } while (0)

struct XcdBarrier {
    unsigned* bar; unsigned x;
    volatile LAS3 unsigned* st;
};

__device__ __forceinline__ XcdBarrier xcd_barrier_post(unsigned* bar, volatile LAS3 unsigned* st) {
    XcdBarrier b; b.bar = bar; b.x = xb_xcc_id(); b.st = st;
    if (threadIdx.x == 0) (void)xb_add(&bar[XB_XCNT(b.x)], 1u);
    return b;
}
__device__ __forceinline__ void xcd_barrier_complete(unsigned* bar, unsigned x, unsigned& nloc, unsigned& nx) {
    const unsigned G = gridDim.x * gridDim.y * gridDim.z;
    unsigned sum, cnt, mine, sp = 0u;
    for (;;) {
        sum = 0u; cnt = 0u; mine = 0u;
#pragma unroll
        for (unsigned j = 0; j < 16; ++j) { const unsigned c = xb_ld(&bar[XB_XCNT(j)]); sum += c; cnt += (c > 0u) ? 1u : 0u; mine = (j == x) ? c : mine; }
        if (sum == G) break;
        __builtin_amdgcn_s_sleep(1);
        if ((++sp & 255u) == 0u) { if (xb_ld(&bar[XB_TMO])) break; if (sp > XB_SPIN_CAP) { atomicAdd(&bar[XB_TMO], 1u); break; } }
    }
    nloc = mine > 0u ? mine : 1u; nx = cnt > 0u ? cnt : 1u;
}

__device__ __forceinline__ void xcd_barrier(const XcdBarrier& b) {
    asm volatile("s_waitcnt vmcnt(0)" ::: "memory");
    __syncthreads();
    if (threadIdx.x == 0) {
        unsigned* bar = b.bar;
        __builtin_amdgcn_s_waitcnt(0);
        unsigned nloc = b.st[0], nx = b.st[1];
        if (nloc == 0u) { xcd_barrier_complete(bar, b.x, nloc, nx); b.st[0] = nloc; b.st[1] = nx; }
        const unsigned old = xb_add(&bar[XB_XSUB(b.x)], 1u);
        const unsigned gen = old / nloc;
        if (old + 1u == (gen + 1u) * nloc) {
            __builtin_amdgcn_fence(__ATOMIC_RELEASE, "agent");
            asm volatile("s_waitcnt vmcnt(0)" ::: "memory");
            const unsigned og = xb_add(&bar[XB_TOP], 1u);
            const unsigned tg = og / nx;
            if (og + 1u == (tg + 1u) * nx) xb_add(&bar[XB_TOPGEN], 1u);
            else XB_SPIN(xb_ld(&bar[XB_TOPGEN]) == tg, bar);
            __builtin_amdgcn_fence(__ATOMIC_ACQUIRE, "agent");
            xb_add(&bar[XB_XGEN(b.x)], 1u);
            asm volatile("s_waitcnt vmcnt(0)" ::: "memory");
        } else {
            XB_SPIN(xb_ld(&bar[XB_XGEN(b.x)]) == gen, bar);
            __builtin_amdgcn_fence(__ATOMIC_ACQUIRE, "agent");
            asm volatile("s_waitcnt vmcnt(0)" ::: "memory");
        }
    }
    __syncthreads();
}

__device__ __forceinline__ void sub_barrier(unsigned* cnt, unsigned n) {
    asm volatile("s_waitcnt vmcnt(0)" ::: "memory"); __syncthreads();
    if (threadIdx.x == 0) {
        __builtin_amdgcn_fence(__ATOMIC_RELEASE, "agent"); asm volatile("s_waitcnt vmcnt(0)" ::: "memory");
        (void)xb_add(cnt, 1u);
        unsigned sp = 0u; while (xb_ld(cnt) < n) { __builtin_amdgcn_s_sleep(2); if (++sp > (1u << 22)) break; }
        __builtin_amdgcn_fence(__ATOMIC_ACQUIRE, "agent"); asm volatile("s_waitcnt vmcnt(0)" ::: "memory");
    }
    __syncthreads();
}

constexpr int N_PHASES = 8;
#ifndef MK_N_LAUNCHES
#define MK_N_LAUNCHES 1
#endif
__global__ void __launch_bounds__(NTHREADS, 2) layer_fwd(Params P) {
    extern __shared__ __attribute__((aligned(16))) unsigned char lds[];
    const int G = gridDim.x, bid = blockIdx.x;
    volatile LAS3 unsigned* bst = (volatile LAS3 unsigned*)((LAS3 unsigned char*)lds + (LDS_BYTES - 16));
    if (threadIdx.x < 4) bst[threadIdx.x] = 0u;
    __syncthreads();
    XcdBarrier xbar = xcd_barrier_post((unsigned*)(P.ws + WS_CTL) + CW_BAR, bst);
    const int lo = P.ph_lo, hi = P.ph_hi;
#define IN(k) (lo <= (k) && (k) < hi)
#define SEAM(k) do { if (IN(k) && IN((k) + 1)) xcd_barrier(xbar); } while (0)
    if (IN(0)) { p0_rows(P, lds, G, bid); p0_weights_in(P, lds, G, bid); }
    SEAM(0);
    if (IN(1)) {
        const int c0 = (G > 64) ? PC_Q : 0;
        pg8::Gemm g{(const pg8::bf16_t*)(P.ws + WS_XB), (const pg8::bf16_t*)(P.ws + WS_WINT) + (size_t)c0 * D, T, NPROJ - c0, D}; pg8::StaticOrder S; S.init(T, NPROJ - c0, G, bid);
        pg8::EpiProj E{(pg8::bf16_t*)(P.ws + WS_PROJ) + c0, NPROJ, (const float*)(P.ws + WS_RS1)};
        pg8::gemm_phase<pg8::EpiProj, pg8::StaticOrder, true, true>((PG8_LAS unsigned char*)lds, g, S, E);
    }
    SEAM(1);
    if (IN(2)) {
        for (int u = bid; u < 64; u += G) mlstm_unit(P, lds, u, (float*)(P.ws + WS_HRAW));
        if (G > 64) { if (bid >= 64) {
            { pg8::Gemm g{(const pg8::bf16_t*)(P.ws + WS_XB), (const pg8::bf16_t*)(P.ws + WS_WINT), T, PC_Q, D}; pg8::StaticOrder S; S.init(T, PC_Q, G - 64, bid - 64);
              pg8::EpiProj E{(pg8::bf16_t*)(P.ws + WS_PROJ), NPROJ, (const float*)(P.ws + WS_RS1)};
              pg8::gemm_phase<pg8::EpiProj, pg8::StaticOrder, true, true>((PG8_LAS unsigned char*)lds, g, S, E); }
            sub_barrier((unsigned*)(P.ws + WS_CTL) + 8192, (unsigned)(G - 64));
            p2_conv(P, G - 64, bid - 64); p2_weights_sq(P, lds, G - 64, bid - 64); p0_tables(P, G - 64, bid - 64); } }
        else { p2_conv(P, G, bid); p2_weights_sq(P, lds, G, bid); p0_tables(P, G, bid); }
    }
    SEAM(2);
    if (IN(3)) p3_finalize(P, G, bid);
    SEAM(3);
    if (IN(4)) {
        pg8::Gemm g{(const pg8::bf16_t*)(P.ws + WS_MIXIN), (const pg8::bf16_t*)(P.ws + WS_WOUTT), T, D, D}; pg8::StaticOrder S; S.init(T, D, G, bid);
        pg8::EpiOut E{P.x, (pg8::bf16_t*)(P.ws + WS_X1B), (float*)(P.ws + WS_SSQ), D};
        pg8::gemm_phase<pg8::EpiOut, pg8::StaticOrder, false, true>((PG8_LAS unsigned char*)lds, g, S, E);
    }
    SEAM(4);
    if (IN(5)) {
        pg8::Gemm g{(const pg8::bf16_t*)(P.ws + WS_X1B), (const pg8::bf16_t*)(P.ws + WS_WQT), T, D, D}; pg8::StaticOrder S; S.init(T, D, G, bid);
        pg8::EpiQb E{(pg8::bf16_t*)(P.ws + WS_QV), D, (const float*)(P.ws + WS_SSQ)};
        pg8::gemm_phase<pg8::EpiQb, pg8::StaticOrder, false, true>((PG8_LAS unsigned char*)lds, g, S, E);
    }
    SEAM(5);
    if (IN(6)) p6_topk(P, lds, G, bid);
    SEAM(6);
    if (IN(7)) p7_peer(P, lds, G, bid);
#undef IN
#undef SEAM
}

extern "C" void kernel_launch(void* const* d_in, const int* in_sizes, int n_in, void* d_out, int out_size, void* d_ws, size_t ws_size, hipStream_t stream) {
    static int grid = 0;
    if (grid == 0) {
        if (n_in != 15 || in_sizes[0] != T * D || out_size != T * D || ws_size < WS_END) { fprintf(stderr, "kernel_launch: unexpected shapes (n_in %d, in0 %d, out %d, ws %zu); nothing launched\n", n_in, n_in > 0 ? in_sizes[0] : -1, out_size, ws_size); grid = -1; return; }
        int dev = 0, cus = 0, per_cu = 0;
        if (hipGetDevice(&dev) != hipSuccess || hipDeviceGetAttribute(&cus, hipDeviceAttributeMultiprocessorCount, dev) != hipSuccess) { grid = -1; return; }
        if (hipFuncSetAttribute((const void*)layer_fwd, hipFuncAttributeMaxDynamicSharedMemorySize, LDS_BYTES) != hipSuccess) { fprintf(stderr, "kernel_launch: hipFuncSetAttribute failed\n"); grid = -1; return; }
        if (hipOccupancyMaxActiveBlocksPerMultiprocessor(&per_cu, (const void*)layer_fwd, NTHREADS, LDS_BYTES) != hipSuccess || per_cu < 1) { fprintf(stderr, "kernel_launch: occupancy query says %d blocks per CU\n", per_cu); (void)hipGetLastError(); grid = -1; return; }
        grid = cus;
    }
    if (grid < 0) return;
    Params p{};
    p.x = (const float*)d_in[0]; p.g1 = (const float*)d_in[1]; p.w_in = (const float*)d_in[2]; p.b_ig = (const float*)d_in[3]; p.b_fg = (const float*)d_in[4];
    p.conv_w = (const float*)d_in[5]; p.gm = (const float*)d_in[6]; p.w_out = (const float*)d_in[7]; p.g2 = (const float*)d_in[8]; p.w_q = (const float*)d_in[9];
    p.sk1 = (const float*)d_in[10]; p.sk2 = (const float*)d_in[11]; p.eu = (const float*)d_in[12]; p.ev = (const float*)d_in[13]; p.gfin = (const float*)d_in[14];
    p.out = (float*)d_out; p.ws = (unsigned char*)d_ws;
    if (hipMemsetAsync((char*)d_ws + WS_CTL, 0, CTL_ZERO_BYTES, stream) != hipSuccess) { fprintf(stderr, "kernel_launch: hipMemsetAsync failed\n"); return; }
    for (int li = 0; li < MK_N_LAUNCHES; ++li) {
        p.ph_lo = (MK_N_LAUNCHES == 1) ? 0 : li; p.ph_hi = (MK_N_LAUNCHES == 1) ? N_PHASES : li + 1;
        void* args[] = {&p};
        const hipError_t e = hipLaunchCooperativeKernel((const void*)layer_fwd, dim3(grid), dim3(NTHREADS), args, LDS_BYTES, stream);
        if (e != hipSuccess) { fprintf(stderr, "kernel_launch: cooperative launch %d failed: %s (grid %d)\n", li, hipGetErrorString(e), grid); break; }
    }
}
```

```cpp
#include <hip/hip_runtime.h>
#include <hip/hip_cooperative_groups.h>
#include <cstdio>
#include <cstdint>
namespace cg = cooperative_groups;
namespace pg8 {
#define PG8_LAS __attribute__((address_space(3)))
typedef unsigned short bf16_t;
typedef short bf16x8 __attribute__((ext_vector_type(8)));
typedef float f32x4 __attribute__((ext_vector_type(4)));
typedef unsigned u32x4 __attribute__((ext_vector_type(4)));
constexpr int BM = 256, BK = 64, HALF = 128, HTB = HALF * BK * 2  , STAGE_BYTES = 8 * HTB, NXCD = 8, WGM = 8;

__host__ __device__ __forceinline__ int lds_byte(int r, int c) { const int st = (r >> 4) * 2 + (c >> 5), rr = r & 15, cc = c & 31, ob = rr * 64 + cc * 2; return st * 1024 + (ob ^ (((ob >> 9) & 1) << 5)); }
__host__ __device__ __forceinline__ void stage_rc(int b, int& R, int& C) { const int st = b / 1024, sb = b % 1024, swz = sb ^ (((sb >> 9) & 1) << 5); R = (st >> 1) * 16 + swz / 64; C = (st & 1) * 32 + (swz % 64) / 2; }
__host__ __device__ __forceinline__ int perm32(int rho) { const int n = rho >> 4, i = rho & 15; return 8 * (i >> 2) + 4 * n + (i & 3); }

struct Unit { int pm, pn; };
struct Gemm { const bf16_t* A; const bf16_t* Bt; int M, N, K; };

struct StaticOrder {
    int nM, nN, nwg, G, c;
    __host__ __device__ void init(int M, int N, int G_, int c_) { nM = M / BM; nN = N / BM; nwg = nM * nN; G = G_; c = c_; }
    __host__ __device__ bool next(int i, Unit& u) const {
        const long L = (long)i * G + c; if (L >= nwg) return false;
        int wgid = (int)L; { const int q = nwg / NXCD, r = nwg % NXCD, xcd = wgid % NXCD, off = wgid / NXCD; wgid = (xcd < r ? xcd * (q + 1) : r * (q + 1) + (xcd - r) * q) + off; }
        const int nig = WGM * nN, gid = wgid / nig, fm = gid * WGM, gsz = (nM - fm) < WGM ? (nM - fm) : WGM;
        u.pm = fm + ((wgid % nig) % gsz); u.pn = (wgid % nig) / gsz; return true;
    }
    __device__ __forceinline__ void a_ready(const Unit&) const {}
    __device__ __forceinline__ void done(const Unit&) const {}
};

__device__ __forceinline__ unsigned cvt_pk_bf16(float lo, float hi) { unsigned r; asm volatile("v_cvt_pk_bf16_f32 %0, %1, %2" : "=v"(r) : "v"(lo), "v"(hi)); return r; }
struct EpiProj {
    static constexpr bool PERM = true, AFTER_DRAIN = false;
    bf16_t* O; int ldc; const float* rs;
    __device__ __forceinline__ void operator()(const f32x4 (&acc)[2][2][4][2], const Unit& u, int wr, int wc, int fr, int fq) const {
        const int row0 = u.pm * BM + wr * 64 + fr, col0 = u.pn * BM + wc * 32 + 8 * fq;
#pragma unroll
        for (int ai = 0; ai < 2; ++ai)
#pragma unroll
            for (int m = 0; m < 4; ++m) { const int row = row0 + ai * HALF + m * 16; const float s = rs[row]; bf16_t* rowp = O + (size_t)row * ldc + col0;
#pragma unroll
                for (int bj = 0; bj < 2; ++bj) { const f32x4 v0 = acc[ai][bj][m][0] * s, v1 = acc[ai][bj][m][1] * s; u32x4 w;
                    w.x = cvt_pk_bf16(v0[0], v0[1]); w.y = cvt_pk_bf16(v0[2], v0[3]); w.z = cvt_pk_bf16(v1[0], v1[1]); w.w = cvt_pk_bf16(v1[2], v1[3]);
                    *(u32x4*)(rowp + bj * HALF) = w; } }
    }
};
struct EpiOut {
    static constexpr bool PERM = false, AFTER_DRAIN = false;
    const float* X; bf16_t* X1B; float* SSQ; int ldc;
    __device__ __forceinline__ void operator()(const f32x4 (&acc)[2][2][4][2], const Unit& u, int wr, int wc, int fr, int fq) const {
        typedef unsigned u32x2 __attribute__((ext_vector_type(2)));
        const int row0 = u.pm * BM + wr * 64 + fr, col0 = u.pn * BM + wc * 32 + 4 * fq;
#pragma unroll
        for (int ai = 0; ai < 2; ++ai)
#pragma unroll
            for (int m = 0; m < 4; ++m) { const int row = row0 + ai * HALF + m * 16; const size_t off = (size_t)row * ldc + col0; float ss = 0.f;
#pragma unroll
                for (int bj = 0; bj < 2; ++bj)
#pragma unroll
                    for (int n = 0; n < 2; ++n) { const size_t c = off + bj * HALF + n * 16; const f32x4 xv = *(const f32x4*)(X + c); const f32x4 o = xv + acc[ai][bj][m][n];
                        ss += (o[0] * o[0] + o[1] * o[1]) + (o[2] * o[2] + o[3] * o[3]);
                        u32x2 pk; pk.x = cvt_pk_bf16(o[0], o[1]); pk.y = cvt_pk_bf16(o[2], o[3]); *(u32x2*)(X1B + c) = pk; }
                ss += __shfl_xor(ss, 16); ss += __shfl_xor(ss, 32);
                if (fq == 0) SSQ[(size_t)row * 32 + u.pn * 4 + wc] = ss; }
    }
};
struct EpiQ {
    static constexpr bool PERM = false, AFTER_DRAIN = false;
    float* O; int ldc;
    __device__ __forceinline__ void operator()(const f32x4 (&acc)[2][2][4][2], const Unit& u, int wr, int wc, int fr, int fq) const {
        const int row0 = u.pm * BM + wr * 64 + fr, col0 = u.pn * BM + wc * 32 + 4 * fq;
#pragma unroll
        for (int ai = 0; ai < 2; ++ai)
#pragma unroll
            for (int m = 0; m < 4; ++m) { const size_t off = (size_t)(row0 + ai * HALF + m * 16) * ldc + col0;
#pragma unroll
                for (int bj = 0; bj < 2; ++bj)
#pragma unroll
                    for (int n = 0; n < 2; ++n) *(f32x4*)(O + off + bj * HALF + n * 16) = acc[ai][bj][m][n]; }
    }
};
struct EpiQb {
    static constexpr bool PERM = true, AFTER_DRAIN = false;
    bf16_t* O; int ldc; const float* SSQ;
    __device__ __forceinline__ void operator()(const f32x4 (&acc)[2][2][4][2], const Unit& u, int wr, int wc, int fr, int fq) const {
        const int row0 = u.pm * BM + wr * 64 + fr, col0 = u.pn * BM + wc * 32 + 8 * fq;
#pragma unroll
        for (int ai = 0; ai < 2; ++ai)
#pragma unroll
            for (int m = 0; m < 4; ++m) { const int row = row0 + ai * HALF + m * 16; const f32x4* sp = (const f32x4*)(SSQ + (size_t)row * 32);
                f32x4 s4 = sp[0];
#pragma unroll
                for (int i = 1; i < 8; ++i) s4 += sp[i];
                const float s = rsqrtf(((s4[0] + s4[1]) + (s4[2] + s4[3])) * (1.0f / 2048.0f) + 1e-6f); bf16_t* rowp = O + (size_t)row * ldc + col0;
#pragma unroll
                for (int bj = 0; bj < 2; ++bj) { const f32x4 v0 = acc[ai][bj][m][0] * s, v1 = acc[ai][bj][m][1] * s; u32x4 w;
                    w.x = cvt_pk_bf16(v0[0], v0[1]); w.y = cvt_pk_bf16(v0[2], v0[3]); w.z = cvt_pk_bf16(v1[0], v1[1]); w.w = cvt_pk_bf16(v1[2], v1[3]);
                    *(u32x4*)(rowp + bj * HALF) = w; } }
    }
};
template <class Epi, class Sched, bool ALIGN_EPI = false, bool SP2 = false>
__device__ __forceinline__ void gemm_phase(PG8_LAS unsigned char* lds, const Gemm g, const Sched& S, const Epi& E) {
    const int tid = threadIdx.x, wid = __builtin_amdgcn_readfirstlane(tid >> 6), lane = tid & 63, wr = wid >> 2, wc = wid & 3, fr = lane & 15, fq = lane >> 4;
    const int K = g.K, nt = K / BK;
    unsigned voffA[2], voffB[2];
#pragma unroll
    for (int i = 0; i < 2; ++i) { int R, C; stage_rc(tid * 16 + i * 8192, R, C); const int Rb = Epi::PERM ? ((R & ~31) + perm32(R & 31)) : R;
        voffA[i] = (unsigned)(R * K + C) * 2u; voffB[i] = (unsigned)(Rb * K + C) * 2u; }
    const size_t kstep = (size_t)(BK * 2);
    const size_t hstep = (size_t)HALF * K * 2;
    const size_t tstep = 2 * hstep;
    const unsigned ldsw = (unsigned)wid * 1024u;
    const int aoff = lds_byte(wr * 64 + fr, fq * 8), boff = lds_byte(wc * 32 + fr, fq * 8);
#define PG8_SA(b, h) (((b) * 2 + (h)) * HTB)
#define PG8_SB(b, h) ((4 + (b) * 2 + (h)) * HTB)
#define PG8_STAGE(bufoff, gbase, voff) do { _Pragma("unroll") for (int _i = 0; _i < 2; ++_i) \
        __builtin_amdgcn_global_load_lds((const unsigned*)((const char*)(gbase) + (voff)[_i]), (PG8_LAS unsigned*)(lds + (bufoff) + ldsw + _i * 8192), 16, 0, 0); } while (0)
#define PG8_LDA(dst, b, h) do { _Pragma("unroll") for (int m = 0; m < 4; ++m) _Pragma("unroll") for (int k = 0; k < 2; ++k) dst[m][k] = *(const PG8_LAS bf16x8*)(lds + PG8_SA(b, h) + aoff + m * 2048 + k * 1024); } while (0)
#define PG8_LDB(dst, b, h) do { _Pragma("unroll") for (int n = 0; n < 2; ++n) _Pragma("unroll") for (int k = 0; k < 2; ++k) dst[n][k] = *(const PG8_LAS bf16x8*)(lds + PG8_SB(b, h) + boff + n * 2048 + k * 1024); } while (0)
#define PG8_MMA(ai, bj, At, Bt) do { __builtin_amdgcn_s_setprio(1); _Pragma("unroll") for (int m = 0; m < 4; ++m) _Pragma("unroll") for (int n = 0; n < 2; ++n) _Pragma("unroll") for (int k = 0; k < 2; ++k) \
        acc[ai][bj][m][n] = __builtin_amdgcn_mfma_f32_16x16x32_bf16(Bt[n][k], At[m][k], acc[ai][bj][m][n], 0, 0, 0); __builtin_amdgcn_s_setprio(0); } while (0)
#define PG8_WAIT_V(n) asm volatile("s_waitcnt vmcnt(" #n ")" ::: "memory")
#define PG8_WAIT_L(n) asm volatile("s_waitcnt lgkmcnt(" #n ")" ::: "memory")
#define PG8_BAR __builtin_amdgcn_s_barrier()
#define PG8_SCHED __builtin_amdgcn_sched_barrier(0)
    Unit cur, nxt; int ui = 0;
    if (!S.next(0, cur)) return;
    f32x4 acc[2][2][4][2];
#pragma unroll
    for (int a = 0; a < 2; ++a)
#pragma unroll
        for (int b = 0; b < 2; ++b)
#pragma unroll
            for (int m = 0; m < 4; ++m)
#pragma unroll
                for (int n = 0; n < 2; ++n) acc[a][b][m][n] = (f32x4){0.f, 0.f, 0.f, 0.f};
    bf16x8 At[4][2], B0[2][2], B1[2][2];
    const char* cA = (const char*)g.A + (size_t)cur.pm * tstep; const char* cB = (const char*)g.Bt + (size_t)cur.pn * tstep;
    S.a_ready(cur);
    if constexpr (SP2) {
        PG8_STAGE(PG8_SB(0, 0), cB, voffB); PG8_STAGE(PG8_SB(0, 1), cB + hstep, voffB); PG8_STAGE(PG8_SA(0, 0), cA, voffA); PG8_STAGE(PG8_SA(0, 1), cA + hstep, voffA);
        if (wr == 1) PG8_BAR;
        PG8_WAIT_V(2); PG8_BAR;
        PG8_STAGE(PG8_SB(1, 0), cB + kstep, voffB); PG8_STAGE(PG8_SA(1, 0), cA + kstep, voffA); PG8_STAGE(PG8_SB(1, 1), cB + hstep + kstep, voffB);
        PG8_WAIT_V(6); PG8_BAR;
    } else {
        PG8_STAGE(PG8_SB(0, 0), cB, voffB); PG8_STAGE(PG8_SA(0, 0), cA, voffA); PG8_STAGE(PG8_SB(0, 1), cB + hstep, voffB); PG8_STAGE(PG8_SA(0, 1), cA + hstep, voffA);
        if (wr == 1) PG8_BAR;
        PG8_WAIT_V(4); PG8_BAR;
        PG8_STAGE(PG8_SB(1, 0), cB + kstep, voffB); PG8_STAGE(PG8_SA(1, 0), cA + kstep, voffA); PG8_STAGE(PG8_SB(1, 1), cB + hstep + kstep, voffB);
        PG8_WAIT_V(6); PG8_BAR;
    }
    for (;;) {
        const bool has_next = S.next(ui + 1, nxt);
        const char* nA = has_next ? (const char*)g.A + (size_t)nxt.pm * tstep : cA; const char* nB = has_next ? (const char*)g.Bt + (size_t)nxt.pn * tstep : cB;
        for (int t = 0; t < nt; t += 2) {
            const bool last = (t == nt - 2);
            const char* a1 = cA + (size_t)(t + 1) * kstep;
            const char* a2 = last ? nA : cA + (size_t)(t + 2) * kstep; const char* b2 = last ? nB : cB + (size_t)(t + 2) * kstep;
            const char* a3 = a2 + kstep; const char* b3 = b2 + kstep;
            if (last && has_next) S.a_ready(nxt);
            if constexpr (SP2) {
            PG8_LDB(B0, 0, 0); PG8_LDB(B1, 0, 1); PG8_SCHED; PG8_LDA(At, 0, 0); PG8_STAGE(PG8_SA(1, 1), a1 + hstep, voffA);
            PG8_WAIT_V(8); PG8_WAIT_L(0); PG8_BAR; PG8_MMA(0, 0, At, B0); PG8_MMA(0, 1, At, B1); PG8_BAR; PG8_SCHED;
            PG8_LDA(At, 0, 1); PG8_STAGE(PG8_SB(0, 0), b2, voffB); PG8_STAGE(PG8_SB(0, 1), b2 + hstep, voffB); PG8_STAGE(PG8_SA(0, 0), a2, voffA);
            PG8_WAIT_V(8); PG8_WAIT_L(0); PG8_BAR; PG8_MMA(1, 0, At, B0); PG8_MMA(1, 1, At, B1); PG8_BAR; PG8_SCHED;
            PG8_LDB(B0, 1, 0); PG8_LDB(B1, 1, 1); PG8_SCHED; PG8_LDA(At, 1, 0); PG8_STAGE(PG8_SA(0, 1), a2 + hstep, voffA);
            PG8_WAIT_V(8); PG8_WAIT_L(0); PG8_BAR; PG8_MMA(0, 0, At, B0); PG8_MMA(0, 1, At, B1); PG8_BAR; PG8_SCHED;
            PG8_LDA(At, 1, 1); PG8_STAGE(PG8_SB(1, 0), b3, voffB); PG8_STAGE(PG8_SB(1, 1), b3 + hstep, voffB); PG8_STAGE(PG8_SA(1, 0), a3, voffA);
            PG8_WAIT_V(8); PG8_WAIT_L(0); PG8_BAR; PG8_MMA(1, 0, At, B0); PG8_MMA(1, 1, At, B1); PG8_BAR; PG8_SCHED;
            } else {
            PG8_LDB(B0, 0, 0); PG8_SCHED; PG8_LDA(At, 0, 0); PG8_STAGE(PG8_SA(1, 1), a1 + hstep, voffA);
            PG8_WAIT_L(8); PG8_BAR; PG8_WAIT_L(0); PG8_MMA(0, 0, At, B0); PG8_BAR; PG8_SCHED;
            PG8_LDB(B1, 0, 1); PG8_STAGE(PG8_SB(0, 0), b2, voffB);
            PG8_BAR; PG8_WAIT_L(0); PG8_MMA(0, 1, At, B1); PG8_BAR;
            PG8_LDA(At, 0, 1); PG8_STAGE(PG8_SA(0, 0), a2, voffA);
            PG8_BAR; PG8_WAIT_L(0); PG8_MMA(1, 0, At, B0); PG8_BAR; PG8_SCHED;
            PG8_STAGE(PG8_SB(0, 1), b2 + hstep, voffB);
            PG8_WAIT_V(6); PG8_BAR; PG8_MMA(1, 1, At, B1); PG8_BAR;
            PG8_LDB(B0, 1, 0); PG8_SCHED; PG8_LDA(At, 1, 0); PG8_STAGE(PG8_SA(0, 1), a2 + hstep, voffA);
            PG8_WAIT_L(8); PG8_BAR; PG8_WAIT_L(0); PG8_MMA(0, 0, At, B0); PG8_BAR; PG8_SCHED;
            PG8_LDB(B1, 1, 1); PG8_STAGE(PG8_SB(1, 0), b3, voffB);
            PG8_BAR; PG8_WAIT_L(0); PG8_MMA(0, 1, At, B1); PG8_BAR;
            PG8_LDA(At, 1, 1); PG8_STAGE(PG8_SA(1, 0), a3, voffA);
            PG8_BAR; PG8_WAIT_L(0); PG8_MMA(1, 0, At, B0); PG8_BAR; PG8_SCHED;
            PG8_STAGE(PG8_SB(1, 1), b3 + hstep, voffB);
            PG8_WAIT_V(6); PG8_BAR; PG8_MMA(1, 1, At, B1); PG8_BAR;
            }
        }
        if constexpr (ALIGN_EPI) { if (wr == 0) PG8_BAR; }
        if constexpr (!Epi::AFTER_DRAIN) { E(acc, cur, wr, wc, fr, fq); S.done(cur); }
        if (!has_next) break;
#pragma unroll
        for (int a = 0; a < 2; ++a)
#pragma unroll
            for (int b = 0; b < 2; ++b)
#pragma unroll
                for (int m = 0; m < 4; ++m)
#pragma unroll
                    for (int n = 0; n < 2; ++n) acc[a][b][m][n] = (f32x4){0.f, 0.f, 0.f, 0.f};
        cur = nxt; cA = nA; cB = nB; ++ui;
        if constexpr (ALIGN_EPI) { if (wr == 1) PG8_BAR; }
    }
    PG8_WAIT_V(0);
    if constexpr (!ALIGN_EPI) { if (wr == 0) PG8_BAR; }
    PG8_BAR;
    if constexpr (Epi::AFTER_DRAIN) { E.fused(acc, cur, wr, wc, fr, fq, lds, wid, lane); S.done(cur); }
#undef PG8_SA
#undef PG8_SB
#undef PG8_STAGE
#undef PG8_LDA
#undef PG8_LDB
#undef PG8_MMA
#undef PG8_WAIT_V
#undef PG8_WAIT_L
#undef PG8_BAR
#undef PG8_SCHED
}
}
constexpr int T = 8192, SEQ = 4096, D = 2048, NPROJ = 7168, NIN = 7176;
constexpr int NH = 4, DH = 256, LCH = 64, DML = 1024;
constexpr int NEXP = 16384, PEER_H = 8, TOPK = 16;
constexpr float EPS = 1e-6f;
constexpr int PC_CX = 0, PC_CB = 1024, PC_CC = 2048, PC_Q = 3072, PC_K = 4096, PC_V = 5120, PC_O = 6144;
constexpr int NTHREADS = 512, NWAVES = 8;
constexpr int LDS_BYTES = 147456;

constexpr size_t MiB = 1u << 20;
constexpr size_t WS_CTL = 0, CTL_ZERO_BYTES = 64 * 1024;
constexpr int CW_BAR = 1024;
constexpr size_t WS_RS1 = 1 * MiB, WS_GI = 1 * MiB + 64 * 1024, WS_GF = 1 * MiB + 256 * 1024, WS_SSQ = 3 * MiB, WS_ESC = 4 * MiB;
constexpr size_t WS_XB = 5 * MiB, WS_WINT = 37 * MiB, WS_WOUTT = 65 * MiB, WS_WQT = 73 * MiB;
constexpr size_t WS_PROJ = 81 * MiB;
constexpr size_t WS_X1 = 81 * MiB, WS_X1B = 145 * MiB;
constexpr size_t WS_HRAW = 193 * MiB, WS_MIXIN = 225 * MiB, WS_QV = 257 * MiB, WS_IDX = 321 * MiB, WS_GATE = 325 * MiB;
constexpr size_t WS_UB = 329 * MiB, WS_VB = 393 * MiB, WS_END = 457 * MiB;

struct Params {
    const float *x, *g1, *w_in, *b_ig, *b_fg, *conv_w, *gm, *w_out, *g2, *w_q, *sk1, *sk2, *eu, *ev, *gfin;
    float* out; unsigned char* ws;
    int ph_lo, ph_hi;
};

typedef unsigned short bf16_t;
typedef unsigned v4u_t __attribute__((ext_vector_type(4)));
typedef unsigned v2u_t __attribute__((ext_vector_type(2)));
__device__ __forceinline__ unsigned f2bf(float f) { unsigned u = __float_as_uint(f); return (u + 0x7fffu + ((u >> 16) & 1u)) >> 16; }
__device__ __forceinline__ unsigned pk2(float lo, float hi) { return f2bf(lo) | (f2bf(hi) << 16); }
__device__ __forceinline__ float bflo(unsigned w) { return __uint_as_float(w << 16); }
__device__ __forceinline__ float bfhi(unsigned w) { return __uint_as_float(w & 0xffff0000u); }
__device__ __forceinline__ float bf1(bf16_t h) { return __uint_as_float((unsigned)h << 16); }
__device__ __forceinline__ float wave_sum(float v) {
#pragma unroll
    for (int o = 32; o >= 1; o >>= 1) v += __shfl_xor(v, o);
    return v;
}
__device__ __forceinline__ void unpack8(const uint4 w, float (&f)[8]) {
    f[0] = bflo(w.x); f[1] = bfhi(w.x); f[2] = bflo(w.y); f[3] = bfhi(w.y); f[4] = bflo(w.z); f[5] = bfhi(w.z); f[6] = bflo(w.w); f[7] = bfhi(w.w);
}
__device__ __forceinline__ float log_sigmoid(float z) { return z >= 0.f ? -log1pf(expf(-z)) : z - log1pf(expf(z)); }
__device__ __forceinline__ float gelu_erf(float v) { return 0.5f * v * (1.0f + erff(v * 0.70710678118654752f)); }

__device__ __forceinline__ void p0_rows(const Params& P, unsigned char* lds, int G, int bid) {
    float* wg = (float*)lds;
    const int tid = threadIdx.x, lane = tid & 63, wave = tid >> 6;
    {
    for (int i = tid; i < 2 * D; i += NTHREADS) { const int k = i >> 1, hf = i & 1; const float4 w4 = *(const float4*)(P.w_in + (size_t)k * NIN + NPROJ + hf * 4); const float gk = P.g1[k];
        wg[(hf * 4 + 0) * D + k] = w4.x * gk; wg[(hf * 4 + 1) * D + k] = w4.y * gk; wg[(hf * 4 + 2) * D + k] = w4.z * gk; wg[(hf * 4 + 3) * D + k] = w4.w * gk; }
    __syncthreads(); }
    float* rs1 = (float*)(P.ws + WS_RS1); float* gi = (float*)(P.ws + WS_GI); float* gf = (float*)(P.ws + WS_GF); bf16_t* xb = (bf16_t*)(P.ws + WS_XB);
    for (int tp = bid * NWAVES + wave; tp < T / 2; tp += G * NWAVES) {
        const int t = tp * 2;
        const float4* xr = (const float4*)(P.x + (size_t)t * D);
        float ss[2] = {0.f, 0.f}, dg[2][8];
#pragma unroll
        for (int g = 0; g < 8; ++g) { dg[0][g] = 0.f; dg[1][g] = 0.f; }
        float4 v[2][8];
#pragma unroll
        for (int rr = 0; rr < 2; ++rr)
#pragma unroll
            for (int j = 0; j < 8; ++j) v[rr][j] = xr[rr * (D / 4) + j * 64 + lane];
#pragma unroll 1
        for (int j = 0; j < 8; ++j) {
            const int k0 = (j * 64 + lane) * 4;
#pragma unroll
            for (int rr = 0; rr < 2; ++rr) { const float4 vv = j == 0 ? v[rr][0] : j == 1 ? v[rr][1] : j == 2 ? v[rr][2] : j == 3 ? v[rr][3] : j == 4 ? v[rr][4] : j == 5 ? v[rr][5] : j == 6 ? v[rr][6] : v[rr][7];
                ss[rr] += (vv.x * vv.x + vv.y * vv.y) + (vv.z * vv.z + vv.w * vv.w);
#pragma unroll
                for (int g = 0; g < 8; ++g) { const float4 w = *(const float4*)(wg + g * D + k0); dg[rr][g] += (vv.x * w.x + vv.y * w.y) + (vv.z * w.z + vv.w * w.w); }
                ((uint2*)(xb + (size_t)(t + rr) * D))[j * 64 + lane] = make_uint2(pk2(vv.x, vv.y), pk2(vv.z, vv.w)); }
        }
#pragma unroll
        for (int rr = 0; rr < 2; ++rr) {
            const float s1 = wave_sum(ss[rr]);
#pragma unroll
            for (int g = 0; g < 8; ++g) dg[rr][g] = wave_sum(dg[rr][g]);
            const float rs = rsqrtf(s1 * (1.0f / D) + EPS);
            if (lane == 0) {
                rs1[t + rr] = rs;
#pragma unroll
                for (int h = 0; h < 4; ++h) { gi[(t + rr) * 4 + h] = rs * dg[rr][h] + P.b_ig[h]; gf[(t + rr) * 4 + h] = log_sigmoid(rs * dg[rr][4 + h] + P.b_fg[h]); }
            }
        }
    }
    __syncthreads();
}
__device__ __forceinline__ void transpose_tile(const float* W, int ldw, int K, const float* gain, bf16_t* WT, int k0, int n0, float* tile) {
    const int tid = threadIdx.x;
    float4 v[4];
#pragma unroll
    for (int r = 0; r < 4; ++r) v[r] = *(const float4*)(W + (size_t)(k0 + (tid >> 5) + 16 * r) * ldw + n0 + (tid & 31) * 4);
#pragma unroll
    for (int r = 0; r < 4; ++r) { const int kk = (tid >> 5) + 16 * r, n4 = (tid & 31) * 4; const float g = gain ? gain[k0 + kk] : 1.0f;
        tile[kk * 129 + n4 + 0] = v[r].x * g; tile[kk * 129 + n4 + 1] = v[r].y * g; tile[kk * 129 + n4 + 2] = v[r].z * g; tile[kk * 129 + n4 + 3] = v[r].w * g; }
    __syncthreads();
    { const int nn = tid >> 2, k16 = (tid & 3) * 16; float f[16];
#pragma unroll
      for (int i = 0; i < 16; ++i) f[i] = tile[(k16 + i) * 129 + nn];
      uint4* dst = (uint4*)(WT + (size_t)(n0 + nn) * K + k0 + k16);
      dst[0] = make_uint4(pk2(f[0], f[1]), pk2(f[2], f[3]), pk2(f[4], f[5]), pk2(f[6], f[7])); dst[1] = make_uint4(pk2(f[8], f[9]), pk2(f[10], f[11]), pk2(f[12], f[13]), pk2(f[14], f[15])); }
    __syncthreads();
}
__device__ __forceinline__ void p0_weights_in(const Params& P, unsigned char* lds, int G, int bid) {
    float* tile = (float*)lds;
    constexpr int N_IN = (D / 64) * (NPROJ / 128);
    for (int it = bid; it < N_IN; it += G) { const int kt = it / (NPROJ / 128), nt = it % (NPROJ / 128); transpose_tile(P.w_in, NIN, D, P.g1, (bf16_t*)(P.ws + WS_WINT), kt * 64, nt * 128, tile); }
}
__device__ __forceinline__ void p2_weights_sq(const Params& P, unsigned char* lds, int nworkers, int wid) {
    float* tile = (float*)lds;
    constexpr int N_SQ = (D / 64) * (D / 128);
    for (int it = wid; it < 2 * N_SQ; it += nworkers) {
        if (it < N_SQ) { const int kt = it / (D / 128), nt = it % (D / 128); transpose_tile(P.w_out, D, D, nullptr, (bf16_t*)(P.ws + WS_WOUTT), kt * 64, nt * 128, tile); }
        else { const int j = it - N_SQ, kt = j / (D / 128), nt = j % (D / 128); transpose_tile(P.w_q, D, D, P.g2, (bf16_t*)(P.ws + WS_WQT), kt * 64, nt * 128, tile); }
    }
}
typedef float f32x2_t __attribute__((ext_vector_type(2)));
typedef float v16f_t __attribute__((ext_vector_type(16)));
typedef float v32f_t __attribute__((ext_vector_type(32)));
typedef unsigned v6u_t __attribute__((ext_vector_type(6)));
constexpr int EROW = 1536;
__device__ __forceinline__ float wave_max(float v) {
#pragma unroll
    for (int o = 32; o >= 1; o >>= 1) v = fmaxf(v, __shfl_xor(v, o));
    return v;
}
__device__ __forceinline__ void p0_tables(const Params& P, int nworkers, int wid) {
    const int lane = threadIdx.x & 63, wave = threadIdx.x >> 6;
    float* esc = (float*)(P.ws + WS_ESC);
#pragma unroll 1
    for (int e = wid * NWAVES + wave; e < NEXP; e += nworkers * NWAVES) {
        float4 v[2][8];
#pragma unroll
        for (int isv = 0; isv < 2; ++isv) { const float4* src = (const float4*)((isv ? P.ev : P.eu) + (size_t)e * D) + lane * 8;
#pragma unroll
            for (int j = 0; j < 8; ++j) v[isv][j] = src[j]; }
#pragma unroll
        for (int isv = 0; isv < 2; ++isv) {
            float mx = 0.f;
#pragma unroll
            for (int j = 0; j < 8; ++j) { float4 w = v[isv][j];
                if (!isv) { const float4 gg = ((const float4*)P.g2)[lane * 8 + j]; w.x *= gg.x; w.y *= gg.y; w.z *= gg.z; w.w *= gg.w; v[isv][j] = w; }
                mx = fmaxf(mx, fmaxf(fmaxf(fabsf(w.x), fabsf(w.y)), fmaxf(fabsf(w.z), fabsf(w.w)))); }
            mx = wave_max(mx);
            int ex = 0; (void)frexpf(mx * (1.0f / 7.5f), &ex);
            const float sc = mx > 0.f ? ldexpf(1.0f, ex) : 1.0f;
            const v16f_t a = {v[isv][0].x, v[isv][0].z, v[isv][1].x, v[isv][1].z, v[isv][2].x, v[isv][2].z, v[isv][3].x, v[isv][3].z, v[isv][4].x, v[isv][4].z, v[isv][5].x, v[isv][5].z, v[isv][6].x, v[isv][6].z, v[isv][7].x, v[isv][7].z};
            const v16f_t b = {v[isv][0].y, v[isv][0].w, v[isv][1].y, v[isv][1].w, v[isv][2].y, v[isv][2].w, v[isv][3].y, v[isv][3].w, v[isv][4].y, v[isv][4].w, v[isv][5].y, v[isv][5].w, v[isv][6].y, v[isv][6].w, v[isv][7].y, v[isv][7].w};
            const v6u_t pk = __builtin_amdgcn_cvt_scalef32_2xpk16_fp6_f32(a, b, sc);
            v2u_t* dst = (v2u_t*)(P.ws + (isv ? WS_VB : WS_UB) + (size_t)e * EROW + lane * 24);
            dst[0] = (v2u_t){pk[0], pk[1]}; dst[1] = (v2u_t){pk[2], pk[3]}; dst[2] = (v2u_t){pk[4], pk[5]};
            if (lane == 0) esc[e * 2 + isv] = sc;
        }
    }
}

__device__ __forceinline__ void p2_conv(const Params& P, int nworkers, int wid) {
    const bf16_t* proj = (const bf16_t*)(P.ws + WS_PROJ); bf16_t* mix = (bf16_t*)(P.ws + WS_MIXIN);
    for (int idx = wid * NTHREADS + threadIdx.x; idx < T * 128; idx += nworkers * NTHREADS) {
        const int t = idx >> 7, c8 = (idx & 127) * 8, s = t & (SEQ - 1);
        float y[8];
#pragma unroll
        for (int i = 0; i < 8; ++i) y[i] = 0.f;
#pragma unroll
        for (int j = 0; j < 3; ++j) {
            const int dt = 2 - j;
            if (s >= dt) {
                const bf16_t* row = proj + (size_t)(t - dt) * NPROJ;
                float cx[8], cc[8]; unpack8(*(const uint4*)(row + PC_CX + c8), cx); unpack8(*(const uint4*)(row + PC_CC + c8), cc);
                const float4 w0 = *(const float4*)(P.conv_w + j * 1024 + c8), w1 = *(const float4*)(P.conv_w + j * 1024 + c8 + 4);
                y[0] += w0.x * (cc[0] * cx[0]); y[1] += w0.y * (cc[1] * cx[1]); y[2] += w0.z * (cc[2] * cx[2]); y[3] += w0.w * (cc[3] * cx[3]);
                y[4] += w1.x * (cc[4] * cx[4]); y[5] += w1.y * (cc[5] * cx[5]); y[6] += w1.z * (cc[6] * cx[6]); y[7] += w1.w * (cc[7] * cx[7]);
            }
        }
        float cb[8]; unpack8(*(const uint4*)(proj + (size_t)t * NPROJ + PC_CB + c8), cb);
        *(uint4*)(mix + (size_t)t * D + c8) = make_uint4(pk2(cb[0] * y[0], cb[1] * y[1]), pk2(cb[2] * y[2], cb[3] * y[3]), pk2(cb[4] * y[4], cb[5] * y[5]), pk2(cb[6] * y[6], cb[7] * y[7]));
    }
}
#define LAS3 __attribute__((address_space(3)))
typedef short s16x4_t __attribute__((ext_vector_type(4)));
__device__ __forceinline__ pg8::bf16x8 tr8(LAS3 unsigned char* p0, LAS3 unsigned char* p1) {
    const s16x4_t a = __builtin_amdgcn_ds_read_tr16_b64_v4i16((LAS3 s16x4_t*)p0), b = __builtin_amdgcn_ds_read_tr16_b64_v4i16((LAS3 s16x4_t*)p1);
    return __builtin_shufflevector(a, b, 0, 1, 2, 3, 4, 5, 6, 7);
}
template <int CTRL, int RMASK> __device__ __forceinline__ float dpp_keep(float oldv, float v) { return __int_as_float(__builtin_amdgcn_update_dpp(__float_as_int(oldv), __float_as_int(v), CTRL, RMASK, 0xF, false)); }
__device__ __forceinline__ float wave_incl_sum(float v) {
    v += dpp_keep<0x111, 0xF>(0.f, v); v += dpp_keep<0x112, 0xF>(0.f, v); v += dpp_keep<0x114, 0xF>(0.f, v); v += dpp_keep<0x118, 0xF>(0.f, v);
    v += dpp_keep<0x142, 0xA>(0.f, v); v += dpp_keep<0x143, 0xC>(0.f, v); return v;
}
__device__ __forceinline__ float wave_incl_max(float v) {
    const float NI = -__builtin_inff();
    v = fmaxf(v, dpp_keep<0x111, 0xF>(NI, v)); v = fmaxf(v, dpp_keep<0x112, 0xF>(NI, v)); v = fmaxf(v, dpp_keep<0x114, 0xF>(NI, v)); v = fmaxf(v, dpp_keep<0x118, 0xF>(NI, v));
    v = fmaxf(v, dpp_keep<0x142, 0xA>(NI, v)); v = fmaxf(v, dpp_keep<0x143, 0xC>(NI, v)); return v;
}
__device__ __forceinline__ void mlstm_unit(const Params& P, unsigned char* lds_, int unit, float* hraw) {
    typedef pg8::bf16x8 bf16x8; typedef pg8::f32x4 f32x4;
    LAS3 unsigned char* L = (LAS3 unsigned char*)lds_;
    constexpr int QS = 0, KS = 33792, VA = 67584, WV = 73728, CB0 = 79872, CBSZ = 25344, SW0 = CB0 + 2 * CBSZ, SWSZ = 2304, SM0 = SW0 + 4 * SWSZ, SMSZ = 1600;
    constexpr int QST = 528, VST = 96, SWT = 32;
    const int tid = threadIdx.x, lane = tid & 63, wave = __builtin_amdgcn_readfirstlane(tid >> 6);
    const int g = lane >> 4, c16 = lane & 15, q4 = c16 >> 2, p4 = lane & 3;
    const int bh = unit >> 3, sl = unit & 7, b = bh >> 2, h = bh & 3, v0 = sl * 32;
    const bf16_t* proj = (const bf16_t*)(P.ws + WS_PROJ);
    const float* gi = (const float*)(P.ws + WS_GI); const float* gf = (const float*)(P.ws + WS_GF);
#define SMF(sb, off) ((LAS3 float*)(L + SM0 + (sb) * SMSZ + (off)))
    for (int i = tid; i < (2 * CBSZ) / 16; i += NTHREADS) *(LAS3 v4u_t*)(L + CB0 + i * 16) = (v4u_t){0u, 0u, 0u, 0u};
    for (int i = tid; i < 6144 / 16; i += NTHREADS) *(LAS3 v4u_t*)(L + WV + i * 16) = (v4u_t){0u, 0u, 0u, 0u};
    for (int i = tid; i < (4 * SWSZ) / 16; i += NTHREADS) *(LAS3 v4u_t*)(L + SW0 + i * 16) = (v4u_t){0u, 0u, 0u, 0u};
    if (tid < 64) { *(LAS3 v4u_t*)(L + VA + tid * VST + 64) = (v4u_t){0x00003F80u, 0u, 0u, 0u}; *(LAS3 v4u_t*)(L + VA + tid * VST + 80) = (v4u_t){0u, 0u, 0u, 0u}; }
    f32x4 accC[4][3];
#pragma unroll
    for (int dt = 0; dt < 4; ++dt)
#pragma unroll
        for (int vt = 0; vt < 3; ++vt) accC[dt][vt] = (f32x4){0.f, 0.f, 0.f, 0.f};
    const int row = tid >> 3, seg = tid & 7;
    v4u_t rq[4], rk[4], rv = (v4u_t){0u, 0u, 0u, 0u};
    float m = 0.f, nic = 0.f, nfc = 0.f;
#define MLSTM_SMALLS(sb, ic_, fc_) do { const float bc_ = wave_incl_sum(fc_); const float a_ = (ic_) - bc_; const float pm_ = wave_incl_max(a_); \
        const float M_ = fmaxf(m, pm_), M63_ = __shfl(M_, 63), b63_ = __shfl(bc_, 63); \
        SMF(sb, 0)[lane] = a_ * 1.4426950408889634f; SMF(sb, 256)[lane] = M_ * 1.4426950408889634f; SMF(sb, 512)[lane] = __expf(m - M_); SMF(sb, 768)[lane] = __expf(a_ - M63_) * 0.0625f; SMF(sb, 1024)[lane] = __expf(-bc_ - M_); \
        if (lane == 0) { SMF(sb, 1280)[0] = b63_ + M63_; SMF(sb, 1280)[1] = __expf(m - M63_); } m = b63_ + M63_; } while (0)
    { const int t0 = b * SEQ; const bf16_t* src = proj + (size_t)(t0 + row) * NPROJ + h * DH + seg * 8;
#pragma unroll
      for (int i = 0; i < 4; ++i) { rq[i] = *(const v4u_t*)(src + PC_Q + i * 64); rk[i] = *(const v4u_t*)(src + PC_K + i * 64); }
      if (tid < 256) rv = *(const v4u_t*)(proj + (size_t)(t0 + (tid >> 2)) * NPROJ + PC_V + h * DH + v0 + (tid & 3) * 8);
      if (wave == 0) { const float ic0 = gi[(size_t)(t0 + lane) * 4 + h], fc0 = gf[(size_t)(t0 + lane) * 4 + h]; MLSTM_SMALLS(0, ic0, fc0);
          nic = gi[(size_t)(t0 + LCH + lane) * 4 + h]; nfc = gf[(size_t)(t0 + LCH + lane) * 4 + h]; } }
    __syncthreads();
#pragma unroll 1
    for (int c = 0; c < SEQ / LCH; ++c) {
        const int t0 = b * SEQ + c * LCH, sb = c & 1;
        int tl = tid; asm volatile("" : "+v"(tl));
        const int lane = tl & 63, g = lane >> 4, c16 = lane & 15, q4 = c16 >> 2, p4 = lane & 3, row = tl >> 3, seg = tl & 7;
        LAS3 unsigned char* CBc = L + CB0 + sb * CBSZ; LAS3 unsigned char* CBn = L + CB0 + (sb ^ 1) * CBSZ;
#pragma unroll
        for (int i = 0; i < 4; ++i) { *(LAS3 v4u_t*)(L + QS + row * QST + (i * 8 + seg) * 16) = rq[i]; *(LAS3 v4u_t*)(L + KS + row * QST + (i * 8 + seg) * 16) = rk[i]; }
        if (tid < 256) { const int l = tid >> 2, part = tid & 3; const float wl = SMF(sb, 768)[l];
            *(LAS3 v4u_t*)(L + VA + l * VST + part * 16) = rv;
            *(LAS3 v4u_t*)(L + WV + l * VST + part * 16) = (v4u_t){pg8::cvt_pk_bf16(wl * bflo(rv.x), wl * bfhi(rv.x)), pg8::cvt_pk_bf16(wl * bflo(rv.y), wl * bfhi(rv.y)), pg8::cvt_pk_bf16(wl * bflo(rv.z), wl * bfhi(rv.z)), pg8::cvt_pk_bf16(wl * bflo(rv.w), wl * bfhi(rv.w))}; }
        else if (tid < 320) { const int l = tid - 256; *(LAS3 unsigned short*)(L + WV + l * VST + 64) = (unsigned short)pg8::cvt_pk_bf16(SMF(sb, 768)[l], 0.f); }
        if (c + 1 < SEQ / LCH) { const int t1 = t0 + LCH; const bf16_t* src = proj + (size_t)(t1 + row) * NPROJ + h * DH + seg * 8;
#pragma unroll
            for (int i = 0; i < 4; ++i) { rq[i] = *(const v4u_t*)(src + PC_Q + i * 64); rk[i] = *(const v4u_t*)(src + PC_K + i * 64); }
            if (tid < 256) rv = *(const v4u_t*)(proj + (size_t)(t1 + (tid >> 2)) * NPROJ + PC_V + h * DH + v0 + (tid & 3) * 8); }
        __syncthreads();
        if (wave < 4) {
            const int rt = wave; LAS3 unsigned char* SWp = L + SW0 + rt * SWSZ;
            const f32x4 M4 = *(LAS3 f32x4*)(SMF(sb, 256) + rt * 16 + 4 * g) + 4.0f;
            float al4[4];
#pragma unroll
            for (int ct = 0; ct < 4; ++ct) al4[ct] = SMF(sb, 0)[ct * 16 + c16];
            bf16x8 qf[8], bk[4], cf[6], vf[6];
#pragma unroll
            for (int ks = 0; ks < 8; ++ks) qf[ks] = *(LAS3 bf16x8*)(L + QS + (rt * 16 + c16) * QST + (ks * 32 + g * 8) * 2);
#define MLSTM_LDK(ct_, hf_) do { _Pragma("unroll") for (int ks = 0; ks < 4; ++ks) bk[ks] = *(LAS3 bf16x8*)(L + KS + ((ct_) * 16 + c16) * QST + (((hf_) * 4 + ks) * 32 + g * 8) * 2); } while (0)
#define MLSTM_LDC(kp_) do { _Pragma("unroll") for (int j = 0; j < 2; ++j) _Pragma("unroll") for (int vt = 0; vt < 3; ++vt) cf[j * 3 + vt] = *(LAS3 bf16x8*)(CBc + (vt * 16 + c16) * QST + ((2 * (kp_) + j) * 32 + g * 8) * 2); } while (0)
            MLSTM_LDK(0, 0); MLSTM_LDC(0);
            asm volatile("" ::: "memory");
            f32x4 aI[3];
#pragma unroll
            for (int vt = 0; vt < 3; ++vt) aI[vt] = (f32x4){0.f, 0.f, 0.f, 0.f};
#pragma unroll
            for (int ct = 0; ct < 4; ++ct) { f32x4 acc = (f32x4){0.f, 0.f, 0.f, 0.f};
                if (ct <= rt) {
#pragma unroll
                    for (int ks = 0; ks < 4; ++ks) acc = __builtin_amdgcn_mfma_f32_16x16x32_bf16(qf[ks], bk[ks], acc, 0, 0, 0);
                    MLSTM_LDK(ct, 1); asm volatile("" ::: "memory"); }
#pragma unroll
                for (int j = 0; j < 2; ++j)
#pragma unroll
                    for (int vt = 0; vt < 3; ++vt) aI[vt] = __builtin_amdgcn_mfma_f32_16x16x32_bf16(qf[2 * ct + j], cf[j * 3 + vt], aI[vt], 0, 0, 0);
                if (ct <= rt) {
#pragma unroll
                    for (int ks = 0; ks < 4; ++ks) acc = __builtin_amdgcn_mfma_f32_16x16x32_bf16(qf[4 + ks], bk[ks], acc, 0, 0, 0); }
                if (ct < 3) { if (ct + 1 <= rt) MLSTM_LDK(ct + 1, 0); MLSTM_LDC(ct + 1); }
                else {
#pragma unroll
                    for (int ks = 0; ks < 2; ++ks)
#pragma unroll
                        for (int vt = 0; vt < 3; ++vt) { LAS3 unsigned char* vp = L + VA + (ks * 32 + g * 8 + q4) * VST + (vt * 16 + 4 * p4) * 2; vf[ks * 3 + vt] = tr8(vp, vp + 4 * VST); } }
                asm volatile("" ::: "memory");
                if (ct <= rt) { const float al = al4[ct]; float e[4];
#pragma unroll
                    for (int r = 0; r < 4; ++r) { e[r] = acc[r] * __builtin_amdgcn_exp2f(al - M4[r]); if (ct == rt && c16 > 4 * g + r) e[r] = 0.f; }
                    *(LAS3 v2u_t*)(SWp + (ct * 16 + c16) * SWT + (4 * g) * 2) = (v2u_t){pg8::cvt_pk_bf16(e[0], e[1]), pg8::cvt_pk_bf16(e[2], e[3])}; } }
#undef MLSTM_LDK
#undef MLSTM_LDC
            asm volatile("s_waitcnt lgkmcnt(0)" ::: "memory");
            f32x4 aX[3];
#pragma unroll
            for (int vt = 0; vt < 3; ++vt) aX[vt] = (f32x4){0.f, 0.f, 0.f, 0.f};
            { LAS3 unsigned char* sp0 = SWp + (g * 8 + q4) * SWT + (4 * p4) * 2; LAS3 unsigned char* sp1 = sp0 + 32 * SWT;
              const bf16x8 av0 = tr8(sp0, sp0 + 4 * SWT), av1 = tr8(sp1, sp1 + 4 * SWT);
#pragma unroll
              for (int vt = 0; vt < 3; ++vt) aX[vt] = __builtin_amdgcn_mfma_f32_16x16x32_bf16(av0, vf[vt], aX[vt], 0, 0, 0);
#pragma unroll
              for (int vt = 0; vt < 3; ++vt) aX[vt] = __builtin_amdgcn_mfma_f32_16x16x32_bf16(av1, vf[3 + vt], aX[vt], 0, 0, 0); }
            const f32x4 e4 = *(LAS3 f32x4*)(SMF(sb, 512) + rt * 16 + 4 * g), n4 = *(LAS3 f32x4*)(SMF(sb, 1024) + rt * 16 + 4 * g);
#pragma unroll
            for (int r = 0; r < 4; ++r) { const float den0 = __builtin_amdgcn_rcpf(fmaxf(fabsf(e4[r] * aI[2][r] + aX[2][r]), n4[r])); const float rden = __shfl(den0, g * 16);
                const size_t o = (size_t)(t0 + rt * 16 + 4 * g + r) * DML + h * DH + v0 + c16;
                const float h0_ = (e4[r] * aI[0][r] + aX[0][r]) * rden, h1_ = (e4[r] * aI[1][r] + aX[1][r]) * rden;
                hraw[o] = h0_; hraw[o + 16] = h1_; }
            if (wave == 0 && c + 1 < SEQ / LCH) {
                MLSTM_SMALLS(sb ^ 1, nic, nfc);
                const int c2 = (c + 2 < SEQ / LCH) ? c + 2 : SEQ / LCH - 1;
                nic = gi[(size_t)(b * SEQ + c2 * LCH + lane) * 4 + h]; nfc = gf[(size_t)(b * SEQ + c2 * LCH + lane) * 4 + h];
            }
        } else {
            const int wB = wave - 4; const float decay = SMF(sb, 1280)[1];
#pragma unroll
            for (int dt = 0; dt < 4; ++dt)
#pragma unroll
                for (int v3 = 0; v3 < 3; ++v3) accC[dt][v3] *= decay;
#pragma unroll
            for (int ks = 0; ks < 2; ++ks) { bf16x8 af[4], bfr[3];
#pragma unroll
                for (int dt = 0; dt < 4; ++dt) { LAS3 unsigned char* kp = L + KS + (ks * 32 + g * 8 + q4) * QST + ((4 * wB + dt) * 16 + 4 * p4) * 2; af[dt] = tr8(kp, kp + 4 * QST); }
#pragma unroll
                for (int v3 = 0; v3 < 3; ++v3) { LAS3 unsigned char* wp = L + WV + (ks * 32 + g * 8 + q4) * VST + (v3 * 16 + 4 * p4) * 2; bfr[v3] = tr8(wp, wp + 4 * VST); }
#pragma unroll
                for (int dt = 0; dt < 4; ++dt)
#pragma unroll
                    for (int v3 = 0; v3 < 3; ++v3) accC[dt][v3] = __builtin_amdgcn_mfma_f32_16x16x32_bf16(af[dt], bfr[v3], accC[dt][v3], 0, 0, 0); }
#pragma unroll
            for (int dt = 0; dt < 4; ++dt)
#pragma unroll
                for (int v3 = 0; v3 < 3; ++v3) { const int d = (4 * wB + dt) * 16 + 4 * g, vp = v3 * 16 + c16;
                    *(LAS3 v2u_t*)(CBn + vp * QST + d * 2) = (v2u_t){pg8::cvt_pk_bf16(accC[dt][v3][0], accC[dt][v3][1]), pg8::cvt_pk_bf16(accC[dt][v3][2], accC[dt][v3][3])}; }
        }
        __syncthreads();
    }
#undef MLSTM_SMALLS
#undef SMF
}

__device__ __forceinline__ void p3_finalize(const Params& P, int G, int bid) {
    const int lane = threadIdx.x & 63, wave = threadIdx.x >> 6;
    const float* hraw = (const float*)(P.ws + WS_HRAW); const bf16_t* proj = (const bf16_t*)(P.ws + WS_PROJ); bf16_t* mix = (bf16_t*)(P.ws + WS_MIXIN);
    for (int idx = bid * NWAVES + wave; idx < T * NH; idx += G * NWAVES) {
        const int t = idx >> 2, hh = idx & 3;
        const float4 hv = *(const float4*)(hraw + (size_t)t * DML + hh * DH + lane * 4);
        const float ss = wave_sum((hv.x * hv.x + hv.y * hv.y) + (hv.z * hv.z + hv.w * hv.w));
        const float r = rsqrtf(ss * (1.0f / DH) + EPS);
        const uint2 ow = *(const uint2*)(proj + (size_t)t * NPROJ + PC_O + hh * DH + lane * 4);
        const float4 g = *(const float4*)(P.gm + hh * DH + lane * 4);
        const float o0 = 1.0f / (1.0f + expf(-bflo(ow.x))), o1 = 1.0f / (1.0f + expf(-bfhi(ow.x))), o2 = 1.0f / (1.0f + expf(-bflo(ow.y))), o3 = 1.0f / (1.0f + expf(-bfhi(ow.y)));
        *(uint2*)(mix + (size_t)t * D + DML + hh * DH + lane * 4) = make_uint2(pk2(o0 * (hv.x * r * g.x), o1 * (hv.y * r * g.y)), pk2(o2 * (hv.z * r * g.z), o3 * (hv.w * r * g.w)));
    }
}

template <int CTRL> __device__ __forceinline__ float dppf(float v) { return __int_as_float(__builtin_amdgcn_update_dpp(0, __float_as_int(v), CTRL, 0xF, 0xF, true)); }
__device__ __forceinline__ float grp16_max(float v) { v = fmaxf(v, dppf<0xB1>(v)); v = fmaxf(v, dppf<0x4E>(v)); v = fmaxf(v, dppf<0x141>(v)); v = fmaxf(v, dppf<0x140>(v)); return v; }
__device__ __forceinline__ float grp16_sum(float v) { v += dppf<0xB1>(v); v += dppf<0x4E>(v); v += dppf<0x141>(v); v += dppf<0x140>(v); return v; }
#define CEX(a, b) do { const float hi_ = fmaxf(a, b), lo_ = fminf(a, b); a = hi_; b = lo_; } while (0)
static __device__ const unsigned char CAND_AB[16][4] = {
    {0x00, 0x01, 0x02, 0x03}, {0x04, 0x05, 0x06, 0x07}, {0x08, 0x09, 0x0A, 0x0B}, {0x0C, 0x0D, 0x0E, 0x0F}, {0x10, 0x11, 0x12, 0x13}, {0x14, 0x15, 0x16, 0x17}, {0x20, 0x21, 0x22, 0x23}, {0x24, 0, 0, 0},
    {0x30, 0x31, 0x32, 0x33}, {0x40, 0x41, 0x42, 0}, {0x50, 0x60, 0x70, 0x80}, {0x90, 0xA0, 0xB0, 0xC0}, {0xD0, 0xE0, 0xF0, 0}, {0x51, 0x61, 0x71, 0}, {0, 0, 0, 0}, {0, 0, 0, 0}};
static __device__ const unsigned char CAND_N[16] = {4, 4, 4, 4, 4, 4, 4, 1, 4, 3, 4, 4, 3, 3, 0, 0};
__device__ __forceinline__ void p6_topk(const Params& P, unsigned char* lds_, int G, int bid) {
    typedef pg8::bf16x8 bf16x8; typedef pg8::f32x4 f32x4;
    LAS3 unsigned char* L = (LAS3 unsigned char*)lds_;
    constexpr int KST = 272, KHALF = 128 * KST;
    const int tid = threadIdx.x, lane = tid & 63, wave = tid >> 6, g = lane >> 4, c16 = lane & 15;
    for (int i = tid; i < 2 * 2048; i += NTHREADS) { const int hf = i >> 11, n = (i >> 4) & 127, d8 = (i & 15) * 8; const float* src = (hf ? P.sk2 : P.sk1) + n * 128 + d8;
        const float4 a = *(const float4*)src, b = *(const float4*)(src + 4);
        *(LAS3 v4u_t*)(L + hf * KHALF + n * KST + d8 * 2) = (v4u_t){pk2(a.x, a.y), pk2(a.z, a.w), pk2(b.x, b.y), pk2(b.z, b.w)}; }
    __syncthreads();
    const bf16_t* qvb = (const bf16_t*)(P.ws + WS_QV);
    int* idxo = (int*)(P.ws + WS_IDX); float* gato = (float*)(P.ws + WS_GATE);
    const float NEGINF = -__builtin_inff();
    unsigned ctab = 0; { const unsigned char* tp = CAND_AB[c16]; ctab = (unsigned)tp[0] | ((unsigned)tp[1] << 8) | ((unsigned)tp[2] << 16) | ((unsigned)tp[3] << 24); }
    const int ccnt = CAND_N[c16];
#pragma unroll 1
    for (int it = bid * NWAVES + wave; it < (T / 16) * PEER_H; it += G * NWAVES) {
        const int t0 = (it >> 3) * 16, hh = it & 7;
        float keepH[2][4];
#pragma unroll
        for (int hf = 0; hf < 2; ++hf) {
            asm volatile("" ::: "memory");
            bf16x8 af[4];
#pragma unroll
            for (int ks = 0; ks < 4; ++ks) af[ks] = *(const bf16x8*)(qvb + (size_t)(t0 + c16) * D + hh * 256 + hf * 128 + ks * 32 + g * 8);
            f32x4 acc[8];
#pragma unroll
            for (int ct = 0; ct < 8; ++ct) { acc[ct] = (f32x4){0.f, 0.f, 0.f, 0.f};
#pragma unroll
                for (int ks = 0; ks < 4; ++ks) { const bf16x8 bv = *(LAS3 bf16x8*)(L + hf * KHALF + (ct * 16 + c16) * KST + (ks * 32 + g * 8) * 2);
                    acc[ct] = __builtin_amdgcn_mfma_f32_16x16x32_bf16(af[ks], bv, acc[ct], 0, 0, 0); } }
            float v[4][8];
#pragma unroll
            for (int r = 0; r < 4; ++r) {
#pragma unroll
                for (int ct = 0; ct < 8; ++ct) v[r][ct] = __uint_as_float((__float_as_uint(acc[ct][r]) & ~127u) | (unsigned)(127 - (ct * 16 + c16)));
                CEX(v[r][0], v[r][1]); CEX(v[r][2], v[r][3]); CEX(v[r][4], v[r][5]); CEX(v[r][6], v[r][7]);
                CEX(v[r][0], v[r][2]); CEX(v[r][1], v[r][3]); CEX(v[r][4], v[r][6]); CEX(v[r][5], v[r][7]);
                CEX(v[r][1], v[r][2]); CEX(v[r][5], v[r][6]); CEX(v[r][0], v[r][4]); CEX(v[r][3], v[r][7]);
                CEX(v[r][1], v[r][5]); CEX(v[r][2], v[r][6]);
                CEX(v[r][1], v[r][4]); CEX(v[r][3], v[r][6]);
                CEX(v[r][2], v[r][4]); CEX(v[r][3], v[r][5]);
                CEX(v[r][3], v[r][4]);
                keepH[hf][r] = 0.f;
            }
#pragma unroll
            for (int rd = 0; rd < TOPK; ++rd) {
#pragma unroll
                for (int r = 0; r < 4; ++r) {
                    const float W = grp16_max(v[r][0]); const bool win = (v[r][0] == W);
                    if (c16 == rd) keepH[hf][r] = W;
#pragma unroll
                    for (int k = 0; k < 7; ++k) v[r][k] = win ? v[r][k + 1] : v[r][k];
                    v[r][7] = win ? NEGINF : v[r][7];
                }
            }
        }
#pragma unroll
        for (int r = 0; r < 4; ++r) {
            const float V1 = keepH[0][r], V2 = keepH[1][r];
            float cv[4];
#pragma unroll
            for (int s4 = 0; s4 < 4; ++s4) { const unsigned code = (ctab >> (8 * s4)) & 255u;
                const float x1 = __shfl(V1, g * 16 + (int)(code >> 4)), x2 = __shfl(V2, g * 16 + (int)(code & 15u));
                const float sum = __uint_as_float(__float_as_uint(x1) & ~127u) + __uint_as_float(__float_as_uint(x2) & ~127u);
                cv[s4] = (s4 < ccnt) ? __uint_as_float((__float_as_uint(sum) & ~255u) | (255u - code)) : NEGINF; }
            float keepc = 0.f;
#pragma unroll
            for (int rd = 0; rd < TOPK; ++rd) {
                const float W = grp16_max(cv[0]); const bool win = (cv[0] == W);
                if (c16 == rd) keepc = W;
                cv[0] = win ? cv[1] : cv[0]; cv[1] = win ? cv[2] : cv[1]; cv[2] = win ? cv[3] : cv[2]; cv[3] = win ? NEGINF : cv[3];
            }
            const unsigned kb = __float_as_uint(keepc), code = 255u - (kb & 255u);
            const unsigned n1 = 127u - (__float_as_uint(__shfl(V1, g * 16 + (int)(code >> 4))) & 127u), n2 = 127u - (__float_as_uint(__shfl(V2, g * 16 + (int)(code & 15u))) & 127u);
            const float sval = __uint_as_float(kb & ~255u), smax = __shfl(sval, g * 16);
            const float ex = __expf(sval - smax), den = grp16_sum(ex);
            const size_t o = (size_t)(t0 + 4 * g + r) * 128 + hh * 16 + c16;
            idxo[o] = (int)(n1 * 128u + n2); gato[o] = ex / den;
        }
    }
    __syncthreads();
}

__device__ __forceinline__ float wave_sum_dpp(float v) {
    v += dppf<0xB1>(v); v += dppf<0x4E>(v); v += dppf<0x141>(v); v += dppf<0x140>(v);
    const int iv = __float_as_int(v);
    return (__int_as_float(__builtin_amdgcn_readlane(iv, 0)) + __int_as_float(__builtin_amdgcn_readlane(iv, 16))) + (__int_as_float(__builtin_amdgcn_readlane(iv, 32)) + __int_as_float(__builtin_amdgcn_readlane(iv, 48)));
}
__device__ __forceinline__ float dot16_fp8(const v4u_t w, const float (&x)[16]) {
    float s = 0.f;
#pragma unroll
    for (int k = 0; k < 4; ++k) { const f32x2_t lo = __builtin_amdgcn_cvt_pk_f32_fp8(w[k], false), hi = __builtin_amdgcn_cvt_pk_f32_fp8(w[k], true);
        s += (x[4 * k] * lo.x + x[4 * k + 1] * lo.y) + (x[4 * k + 2] * hi.x + x[4 * k + 3] * hi.y); }
    return s;
}
__device__ __forceinline__ void axpy16_fp8(const v4u_t w, const float cf, float (&y)[16]) {
#pragma unroll
    for (int k = 0; k < 4; ++k) { const f32x2_t lo = __builtin_amdgcn_cvt_pk_f32_fp8(w[k], false), hi = __builtin_amdgcn_cvt_pk_f32_fp8(w[k], true);
        y[4 * k] += cf * lo.x; y[4 * k + 1] += cf * lo.y; y[4 * k + 2] += cf * hi.x; y[4 * k + 3] += cf * hi.y; }
}
#define PIN16(a, o) asm volatile("" : "+v"(a[o + 0]), "+v"(a[o + 1]), "+v"(a[o + 2]), "+v"(a[o + 3]), "+v"(a[o + 4]), "+v"(a[o + 5]), "+v"(a[o + 6]), "+v"(a[o + 7]), "+v"(a[o + 8]), "+v"(a[o + 9]), "+v"(a[o + 10]), "+v"(a[o + 11]), "+v"(a[o + 12]), "+v"(a[o + 13]), "+v"(a[o + 14]), "+v"(a[o + 15]))
typedef __bf16 v2bf_t __attribute__((ext_vector_type(2)));
typedef __bf16 v32bf_t __attribute__((ext_vector_type(32)));
typedef unsigned v16u_t __attribute__((ext_vector_type(16)));
__device__ __forceinline__ float row16_sum(float v) { v += dppf<0xB1>(v); v += dppf<0x4E>(v); v += dppf<0x141>(v); v += dppf<0x140>(v); return v; }
__device__ __forceinline__ void p7_peer(const Params& P, unsigned char* lds_, int G, int bid) {
    const int lane = threadIdx.x & 63, wave = __builtin_amdgcn_readfirstlane(threadIdx.x >> 6);
    LAS3 unsigned char* W = (LAS3 unsigned char*)lds_ + wave * 8192;
    const bf16_t* x1b = (const bf16_t*)(P.ws + WS_X1B); const float* ssq = (const float*)(P.ws + WS_SSQ);
    const int* idxi = (const int*)(P.ws + WS_IDX); const float* gati = (const float*)(P.ws + WS_GATE);
    const unsigned char* ub = P.ws + WS_UB; const unsigned char* vb = P.ws + WS_VB; const float* esc = (const float*)(P.ws + WS_ESC);
#pragma unroll 1
    for (int qd = bid * NWAVES + wave; qd < T / 4; qd += G * NWAVES) {
        int ln = lane; asm volatile("" : "+v"(ln));
        const int tb = qd * 4, q = ln >> 4, l16 = ln & 15, t = tb + q;
        const unsigned loff = (unsigned)l16 * 24u;
#pragma unroll 1
        for (int s4 = 0; s4 < 4; ++s4) {
            LAS3 int* hist = (LAS3 int*)(W + 4096); LAS3 int* base = (LAS3 int*)(W + 4096 + 256); LAS3 v2u_t* list = (LAS3 v2u_t*)(W + s4 * 1024);
            const size_t o = (size_t)(tb + s4) * 128 + ln;
            const int i0 = idxi[o], i1 = idxi[o + 64]; const float g0 = gati[o], g1 = gati[o + 64];
            hist[ln] = 0; asm volatile("s_waitcnt lgkmcnt(0)" ::: "memory");
            const int t0_ = __hip_atomic_fetch_add((int*)(hist + (i0 >> 8)), 1, __ATOMIC_RELAXED, __HIP_MEMORY_SCOPE_WORKGROUP);
            const int t1_ = __hip_atomic_fetch_add((int*)(hist + (i1 >> 8)), 1, __ATOMIC_RELAXED, __HIP_MEMORY_SCOPE_WORKGROUP);
            asm volatile("s_waitcnt lgkmcnt(0)" ::: "memory");
            const int cnt = hist[ln]; int inc = cnt;
#pragma unroll
            for (int o2 = 1; o2 < 64; o2 <<= 1) { const int tv = __shfl_up(inc, o2); if (ln >= o2) inc += tv; }
            base[ln] = inc - cnt; asm volatile("s_waitcnt lgkmcnt(0)" ::: "memory");
            list[base[i0 >> 8] + t0_] = (v2u_t){(unsigned)i0, __float_as_uint(g0)}; list[base[i1 >> 8] + t1_] = (v2u_t){(unsigned)i1, __float_as_uint(g1)};
            asm volatile("s_waitcnt lgkmcnt(0)" ::: "memory");
        }
        LAS3 v2u_t* mylist = (LAS3 v2u_t*)(W + q * 1024); LAS3 float* mydot = (LAS3 float*)(W + 4096 + q * 512);
        const float rs2 = rsqrtf(row16_sum(ssq[(size_t)t * 32 + l16] + ssq[(size_t)t * 32 + 16 + l16]) * (1.0f / D) + EPS);
        {
            unsigned xp[4][16];
#pragma unroll
            for (int jj = 0; jj < 4; ++jj) { const v4u_t* xs = (const v4u_t*)(x1b + (size_t)t * D + jj * 512 + l16 * 32);
#pragma unroll
                for (int k = 0; k < 4; ++k) { const v4u_t a = xs[k]; xp[jj][4 * k] = a.x; xp[jj][4 * k + 1] = a.y; xp[jj][4 * k + 2] = a.z; xp[jj][4 * k + 3] = a.w; } }
            v6u_t rb[4][4]; float rsc[4];
#define P7_LD1(j, b) do { const unsigned e_ = mylist[j].x; const unsigned char* rp = ub + (size_t)e_ * EROW + loff; rsc[b] = esc[e_ * 2]; \
            _Pragma("unroll") for (int jj = 0; jj < 4; ++jj) { const v2u_t* cp = (const v2u_t*)(rp + jj * 384); const v2u_t c0 = cp[0], c1 = cp[1], c2 = cp[2]; rb[b][jj] = (v6u_t){c0.x, c0.y, c1.x, c1.y, c2.x, c2.y}; } } while (0)
#define P7_D2(k_) __builtin_amdgcn_fdot2_f32_bf16((v2bf_t){w[2 * (k_)], w[2 * (k_) + 1]}, __builtin_bit_cast(v2bf_t, xp[jj][k_]),
#define P7_DOT1(j, b) do { float s0 = 0.f, s1 = 0.f, s2 = 0.f, s3 = 0.f; _Pragma("unroll") for (int jj = 0; jj < 4; ++jj) { asm volatile("" : "+v"(rb[b][jj])); \
                const v32bf_t w = __builtin_amdgcn_cvt_scalef32_pk32_bf16_fp6(rb[b][jj], rsc[b]);     \
                _Pragma("unroll") for (int i = 0; i < 16; i += 4) { s0 = P7_D2(i) s0, false); s1 = P7_D2(i + 1) s1, false); s2 = P7_D2(i + 2) s2, false); s3 = P7_D2(i + 3) s3, false); } } \
            const float tot = row16_sum((s0 + s1) + (s2 + s3)); if (l16 == 0) mydot[j] = tot; } while (0)
#pragma unroll
            for (int b = 0; b < 4; ++b) P7_LD1(b, b);
#pragma unroll 1
            for (int j = 0; j < 124; j += 4) {
#pragma unroll
                for (int b = 0; b < 4; ++b) { P7_DOT1(j + b, b); P7_LD1(j + 4 + b, b); } }
#pragma unroll
            for (int b = 0; b < 4; ++b) P7_DOT1(124 + b, b);
#undef P7_DOT1
#undef P7_D2
#undef P7_LD1
        }
        asm volatile("s_waitcnt lgkmcnt(0)" ::: "memory");
        { const float r0 = __int_as_float(__builtin_amdgcn_readlane(__float_as_int(rs2), 0)), r1 = __int_as_float(__builtin_amdgcn_readlane(__float_as_int(rs2), 16)),
                      r2 = __int_as_float(__builtin_amdgcn_readlane(__float_as_int(rs2), 32)), r3 = __int_as_float(__builtin_amdgcn_readlane(__float_as_int(rs2), 48));
#pragma unroll
          for (int k = 0; k < 8; ++k) { const int n = k * 64 + ln; const v2u_t en = *(LAS3 v2u_t*)(W + n * 8); LAS3 float* dp = (LAS3 float*)(W + 4096 + n * 4);
              const float rr = (k >> 1) == 0 ? r0 : (k >> 1) == 1 ? r1 : (k >> 1) == 2 ? r2 : r3;
              *dp = __uint_as_float(en.y) * gelu_erf(*dp * rr); } }
        asm volatile("s_waitcnt lgkmcnt(0)" ::: "memory");
        float y[4][32];
#pragma unroll
        for (int jj = 0; jj < 4; ++jj)
#pragma unroll
            for (int k = 0; k < 4; ++k) { float a[8]; unpack8(*(const uint4*)(x1b + (size_t)t * D + jj * 512 + l16 * 32 + 8 * k), a);
#pragma unroll
                for (int i = 0; i < 8; ++i) y[jj][8 * k + i] = a[i]; }
        {
            v6u_t bA[4], bB[4]; float scA = 1.f, scB = 1.f;
#define P7_LOADQ(j, Bf, SC) do { const unsigned e_ = mylist[j].x; const unsigned char* rp = vb + (size_t)e_ * EROW + loff; SC = esc[e_ * 2 + 1]; \
            _Pragma("unroll") for (int jj = 0; jj < 4; ++jj) { const v2u_t* cp = (const v2u_t*)(rp + jj * 384); const v2u_t c0 = cp[0], c1 = cp[1], c2 = cp[2]; Bf[jj] = (v6u_t){c0.x, c0.y, c1.x, c1.y, c2.x, c2.y}; } } while (0)
#define P7_AXQ(j, Bf, SC) do { const float cf = mydot[j]; _Pragma("unroll") for (int jj = 0; jj < 4; ++jj) { asm volatile("" : "+v"(Bf[jj])); const v32f_t w = __builtin_amdgcn_cvt_scalef32_pk32_f32_fp6(Bf[jj], SC); \
            _Pragma("unroll") for (int i = 0; i < 32; ++i) y[jj][i] += cf * w[i]; PIN16(y[jj], 0); PIN16(y[jj], 16); } } while (0)
            P7_LOADQ(0, bA, scA);
#pragma unroll 1
            for (int j = 0; j < 126; j += 2) { P7_LOADQ(j + 1, bB, scB); P7_AXQ(j, bA, scA); P7_LOADQ(j + 2, bA, scA); P7_AXQ(j + 1, bB, scB); }
            P7_LOADQ(127, bB, scB); P7_AXQ(126, bA, scA); P7_AXQ(127, bB, scB);
#undef P7_AXQ
#undef P7_LOADQ
        }
        float ss = 0.f;
        const float* grow = P.gfin + l16 * 32; float* orow = P.out + (size_t)t * D + l16 * 32;
#pragma unroll
        for (int jj = 0; jj < 4; ++jj)
#pragma unroll
            for (int i = 0; i < 32; ++i) ss += y[jj][i] * y[jj][i];
        ss = row16_sum(ss);
        const float r = rsqrtf(ss * (1.0f / D) + EPS);
#pragma unroll
        for (int jj = 0; jj < 4; ++jj)
#pragma unroll
            for (int k = 0; k < 8; ++k) { const float4 gg = *(const float4*)(grow + jj * 512 + 4 * k);
                const float4 ov = make_float4(y[jj][4 * k] * r * gg.x, y[jj][4 * k + 1] * r * gg.y, y[jj][4 * k + 2] * r * gg.z, y[jj][4 * k + 3] * r * gg.w);
                *(float4*)(orow + jj * 512 + 4 * k) = ov; }
    }
}
#undef PIN16

#define XB_TMO      128
#define XB_XCNT(j)  (256  + 64 * (j))
#define XB_XSUB(j)  (1280 + 64 * (j))
#define XB_XGEN(j)  (2304 + 64 * (j))
#define XB_TOP      3328
#define XB_TOPGEN   3392
#define XCD_BAR_WORDS 3456
#define XB_SPIN_CAP (1u << 18)

__device__ __forceinline__ unsigned xb_ld(unsigned* p)              { return __hip_atomic_load(p, __ATOMIC_RELAXED, __HIP_MEMORY_SCOPE_AGENT); }
__device__ __forceinline__ unsigned xb_add(unsigned* p, unsigned v) { return __hip_atomic_fetch_add(p, v, __ATOMIC_RELAXED, __HIP_MEMORY_SCOPE_AGENT); }
__device__ __forceinline__ unsigned xb_xcc_id() { return (unsigned)__builtin_amdgcn_s_getreg((3 << 11) | 20) & 0xFu; }
#define XB_SPIN(cond, bar) do { unsigned _sp = 0; while (cond) { __builtin_amdgcn_s_sleep(1); \
    if ((++_sp & 255u) == 0u) { if (xb_ld(&(bar)[XB_TMO])) break; if (_sp > XB_SPIN_CAP) { atomicAdd(&(bar)[XB_TMO], 1u); break; } } } } while (0)

struct XcdBarrier {
    unsigned* bar; unsigned x;
    volatile LAS3 unsigned* st;
};

__device__ __forceinline__ XcdBarrier xcd_barrier_post(unsigned* bar, volatile LAS3 unsigned* st) {
    XcdBarrier b; b.bar = bar; b.x = xb_xcc_id(); b.st = st;
    if (threadIdx.x == 0) (void)xb_add(&bar[XB_XCNT(b.x)], 1u);
    return b;
}
__device__ __forceinline__ void xcd_barrier_complete(unsigned* bar, unsigned x, unsigned& nloc, unsigned& nx) {
    const unsigned G = gridDim.x * gridDim.y * gridDim.z;
    unsigned sum, cnt, mine, sp = 0u;
    for (;;) {
        sum = 0u; cnt = 0u; mine = 0u;
#pragma unroll
        for (unsigned j = 0; j < 16; ++j) { const unsigned c = xb_ld(&bar[XB_XCNT(j)]); sum += c; cnt += (c > 0u) ? 1u : 0u; mine = (j == x) ? c : mine; }
        if (sum == G) break;
        __builtin_amdgcn_s_sleep(1);
        if ((++sp & 255u) == 0u) { if (xb_ld(&bar[XB_TMO])) break; if (sp > XB_SPIN_CAP) { atomicAdd(&bar[XB_TMO], 1u); break; } }
    }
    nloc = mine > 0u ? mine : 1u; nx = cnt > 0u ? cnt : 1u;
}

__device__ __forceinline__ void xcd_barrier(const XcdBarrier& b) {
    asm volatile("s_waitcnt vmcnt(0)" ::: "memory");
    __syncthreads();
    if (threadIdx.x == 0) {
        unsigned* bar = b.bar;
        __builtin_amdgcn_s_waitcnt(0);
        unsigned nloc = b.st[0], nx = b.st[1];
        if (nloc == 0u) { xcd_barrier_complete(bar, b.x, nloc, nx); b.st[0] = nloc; b.st[1] = nx; }
        const unsigned old = xb_add(&bar[XB_XSUB(b.x)], 1u);
        const unsigned gen = old / nloc;
        if (old + 1u == (gen + 1u) * nloc) {
            __builtin_amdgcn_fence(__ATOMIC_RELEASE, "agent");
            asm volatile("s_waitcnt vmcnt(0)" ::: "memory");
            const unsigned og = xb_add(&bar[XB_TOP], 1u);
            const unsigned tg = og / nx;
            if (og + 1u == (tg + 1u) * nx) xb_add(&bar[XB_TOPGEN], 1u);
            else XB_SPIN(xb_ld(&bar[XB_TOPGEN]) == tg, bar);
            __builtin_amdgcn_fence(__ATOMIC_ACQUIRE, "agent");
            xb_add(&bar[XB_XGEN(b.x)], 1u);
            asm volatile("s_waitcnt vmcnt(0)" ::: "memory");
        } else {
            XB_SPIN(xb_ld(&bar[XB_XGEN(b.x)]) == gen, bar);
            __builtin_amdgcn_fence(__ATOMIC_ACQUIRE, "agent");
            asm volatile("s_waitcnt vmcnt(0)" ::: "memory");
        }
    }
    __syncthreads();
}

__device__ __forceinline__ void sub_barrier(unsigned* cnt, unsigned n) {
    asm volatile("s_waitcnt vmcnt(0)" ::: "memory"); __syncthreads();
    if (threadIdx.x == 0) {
        __builtin_amdgcn_fence(__ATOMIC_RELEASE, "agent"); asm volatile("s_waitcnt vmcnt(0)" ::: "memory");
        (void)xb_add(cnt, 1u);
        unsigned sp = 0u; while (xb_ld(cnt) < n) { __builtin_amdgcn_s_sleep(2); if (++sp > (1u << 22)) break; }
        __builtin_amdgcn_fence(__ATOMIC_ACQUIRE, "agent"); asm volatile("s_waitcnt vmcnt(0)" ::: "memory");
    }
    __syncthreads();
}

constexpr int N_PHASES = 8;
#ifndef MK_N_LAUNCHES
#define MK_N_LAUNCHES 1
#endif
__global__ void __launch_bounds__(NTHREADS, 2) layer_fwd(Params P) {
    extern __shared__ __attribute__((aligned(16))) unsigned char lds[];
    const int G = gridDim.x, bid = blockIdx.x;
    volatile LAS3 unsigned* bst = (volatile LAS3 unsigned*)((LAS3 unsigned char*)lds + (LDS_BYTES - 16));
    if (threadIdx.x < 4) bst[threadIdx.x] = 0u;
    __syncthreads();
    XcdBarrier xbar = xcd_barrier_post((unsigned*)(P.ws + WS_CTL) + CW_BAR, bst);
    const int lo = P.ph_lo, hi = P.ph_hi;
#define IN(k) (lo <= (k) && (k) < hi)
#define SEAM(k) do { if (IN(k) && IN((k) + 1)) xcd_barrier(xbar); } while (0)
    if (IN(0)) { p0_rows(P, lds, G, bid); p0_weights_in(P, lds, G, bid); }
    SEAM(0);
    if (IN(1)) {
        const int c0 = (G > 64) ? PC_Q : 0;
        pg8::Gemm g{(const pg8::bf16_t*)(P.ws + WS_XB), (const pg8::bf16_t*)(P.ws + WS_WINT) + (size_t)c0 * D, T, NPROJ - c0, D}; pg8::StaticOrder S; S.init(T, NPROJ - c0, G, bid);
        pg8::EpiProj E{(pg8::bf16_t*)(P.ws + WS_PROJ) + c0, NPROJ, (const float*)(P.ws + WS_RS1)};
        pg8::gemm_phase<pg8::EpiProj, pg8::StaticOrder, true, true>((PG8_LAS unsigned char*)lds, g, S, E);
    }
    SEAM(1);
    if (IN(2)) {
        for (int u = bid; u < 64; u += G) mlstm_unit(P, lds, u, (float*)(P.ws + WS_HRAW));
        if (G > 64) { if (bid >= 64) {
            { pg8::Gemm g{(const pg8::bf16_t*)(P.ws + WS_XB), (const pg8::bf16_t*)(P.ws + WS_WINT), T, PC_Q, D}; pg8::StaticOrder S; S.init(T, PC_Q, G - 64, bid - 64);
              pg8::EpiProj E{(pg8::bf16_t*)(P.ws + WS_PROJ), NPROJ, (const float*)(P.ws + WS_RS1)};
              pg8::gemm_phase<pg8::EpiProj, pg8::StaticOrder, true, true>((PG8_LAS unsigned char*)lds, g, S, E); }
            sub_barrier((unsigned*)(P.ws + WS_CTL) + 8192, (unsigned)(G - 64));
            p2_conv(P, G - 64, bid - 64); p2_weights_sq(P, lds, G - 64, bid - 64); p0_tables(P, G - 64, bid - 64); } }
        else { p2_conv(P, G, bid); p2_weights_sq(P, lds, G, bid); p0_tables(P, G, bid); }
    }
    SEAM(2);
    if (IN(3)) p3_finalize(P, G, bid);
    SEAM(3);
    if (IN(4)) {
        pg8::Gemm g{(const pg8::bf16_t*)(P.ws + WS_MIXIN), (const pg8::bf16_t*)(P.ws + WS_WOUTT), T, D, D}; pg8::StaticOrder S; S.init(T, D, G, bid);
        pg8::EpiOut E{P.x, (pg8::bf16_t*)(P.ws + WS_X1B), (float*)(P.ws + WS_SSQ), D};
        pg8::gemm_phase<pg8::EpiOut, pg8::StaticOrder, false, true>((PG8_LAS unsigned char*)lds, g, S, E);
    }
    SEAM(4);
    if (IN(5)) {
        pg8::Gemm g{(const pg8::bf16_t*)(P.ws + WS_X1B), (const pg8::bf16_t*)(P.ws + WS_WQT), T, D, D}; pg8::StaticOrder S; S.init(T, D, G, bid);
        pg8::EpiQb E{(pg8::bf16_t*)(P.ws + WS_QV), D, (const float*)(P.ws + WS_SSQ)};
        pg8::gemm_phase<pg8::EpiQb, pg8::StaticOrder, false, true>((PG8_LAS unsigned char*)lds, g, S, E);
    }
    SEAM(5);
    if (IN(6)) p6_topk(P, lds, G, bid);
    SEAM(6);
    if (IN(7)) p7_peer(P, lds, G, bid);
#undef IN
#undef SEAM
}

extern "C" void kernel_launch(void* const* d_in, const int* in_sizes, int n_in, void* d_out, int out_size, void* d_ws, size_t ws_size, hipStream_t stream) {
    static int grid = 0;
    if (grid == 0) {
        if (n_in != 15 || in_sizes[0] != T * D || out_size != T * D || ws_size < WS_END) { fprintf(stderr, "kernel_launch: unexpected shapes (n_in %d, in0 %d, out %d, ws %zu); nothing launched\n", n_in, n_in > 0 ? in_sizes[0] : -1, out_size, ws_size); grid = -1; return; }
        int dev = 0, cus = 0, per_cu = 0;
        if (hipGetDevice(&dev) != hipSuccess || hipDeviceGetAttribute(&cus, hipDeviceAttributeMultiprocessorCount, dev) != hipSuccess) { grid = -1; return; }
        if (hipFuncSetAttribute((const void*)layer_fwd, hipFuncAttributeMaxDynamicSharedMemorySize, LDS_BYTES) != hipSuccess) { fprintf(stderr, "kernel_launch: hipFuncSetAttribute failed\n"); grid = -1; return; }
        if (hipOccupancyMaxActiveBlocksPerMultiprocessor(&per_cu, (const void*)layer_fwd, NTHREADS, LDS_BYTES) != hipSuccess || per_cu < 1) { fprintf(stderr, "kernel_launch: occupancy query says %d blocks per CU\n", per_cu); (void)hipGetLastError(); grid = -1; return; }
        grid = cus;
    }
    if (grid < 0) return;
    Params p{};
    p.x = (const float*)d_in[0]; p.g1 = (const float*)d_in[1]; p.w_in = (const float*)d_in[2]; p.b_ig = (const float*)d_in[3]; p.b_fg = (const float*)d_in[4];
    p.conv_w = (const float*)d_in[5]; p.gm = (const float*)d_in[6]; p.w_out = (const float*)d_in[7]; p.g2 = (const float*)d_in[8]; p.w_q = (const float*)d_in[9];
    p.sk1 = (const float*)d_in[10]; p.sk2 = (const float*)d_in[11]; p.eu = (const float*)d_in[12]; p.ev = (const float*)d_in[13]; p.gfin = (const float*)d_in[14];
    p.out = (float*)d_out; p.ws = (unsigned char*)d_ws;
    if (hipMemsetAsync((char*)d_ws + WS_CTL, 0, CTL_ZERO_BYTES, stream) != hipSuccess) { fprintf(stderr, "kernel_launch: hipMemsetAsync failed\n"); return; }
    for (int li = 0; li < MK_N_LAUNCHES; ++li) {
        p.ph_lo = (MK_N_LAUNCHES == 1) ? 0 : li; p.ph_hi = (MK_N_LAUNCHES == 1) ? N_PHASES : li + 1;
        void* args[] = {&p};
        const hipError_t e = hipLaunchCooperativeKernel((const void*)layer_fwd, dim3(grid), dim3(NTHREADS), args, LDS_BYTES, stream);
        if (e != hipSuccess) { fprintf(stderr, "kernel_launch: cooperative launch %d failed: %s (grid %d)\n", li, hipGetErrorString(e), grid); break; }
    }
}
```

```cpp
#include <hip/hip_runtime.h>
#include <hip/hip_cooperative_groups.h>
#include <cstdio>
#include <cstdint>
namespace cg = cooperative_groups;
namespace pg8 {
#define PG8_LAS __attribute__((address_space(3)))
typedef unsigned short bf16_t;
typedef short bf16x8 __attribute__((ext_vector_type(8)));
typedef float f32x4 __attribute__((ext_vector_type(4)));
typedef unsigned u32x4 __attribute__((ext_vector_type(4)));
constexpr int BM = 256, BK = 64, HALF = 128, HTB = HALF * BK * 2  , STAGE_BYTES = 8 * HTB, NXCD = 8, WGM = 8;

__host__ __device__ __forceinline__ int lds_byte(int r, int c) { const int st = (r >> 4) * 2 + (c >> 5), rr = r & 15, cc = c & 31, ob = rr * 64 + cc * 2; return st * 1024 + (ob ^ (((ob >> 9) & 1) << 5)); }
__host__ __device__ __forceinline__ void stage_rc(int b, int& R, int& C) { const int st = b / 1024, sb = b % 1024, swz = sb ^ (((sb >> 9) & 1) << 5); R = (st >> 1) * 16 + swz / 64; C = (st & 1) * 32 + (swz % 64) / 2; }
__host__ __device__ __forceinline__ int perm32(int rho) { const int n = rho >> 4, i = rho & 15; return 8 * (i >> 2) + 4 * n + (i & 3); }

struct Unit { int pm, pn; };
struct Gemm { const bf16_t* A; const bf16_t* Bt; int M, N, K; };

struct StaticOrder {
    int nM, nN, nwg, G, c;
    __host__ __device__ void init(int M, int N, int G_, int c_) { nM = M / BM; nN = N / BM; nwg = nM * nN; G = G_; c = c_; }
    __host__ __device__ bool next(int i, Unit& u) const {
        const long L = (long)i * G + c; if (L >= nwg) return false;
        int wgid = (int)L; { const int q = nwg / NXCD, r = nwg % NXCD, xcd = wgid % NXCD, off = wgid / NXCD; wgid = (xcd < r ? xcd * (q + 1) : r * (q + 1) + (xcd - r) * q) + off; }
        const int nig = WGM * nN, gid = wgid / nig, fm = gid * WGM, gsz = (nM - fm) < WGM ? (nM - fm) : WGM;
        u.pm = fm + ((wgid % nig) % gsz); u.pn = (wgid % nig) / gsz; return true;
    }
    __device__ __forceinline__ void a_ready(const Unit&) const {}
    __device__ __forceinline__ void done(const Unit&) const {}
};

__device__ __forceinline__ unsigned cvt_pk_bf16(float lo, float hi) { unsigned r; asm volatile("v_cvt_pk_bf16_f32 %0, %1, %2" : "=v"(r) : "v"(lo), "v"(hi)); return r; }
struct EpiProj {
    static constexpr bool PERM = true, AFTER_DRAIN = false;
    bf16_t* O; int ldc; const float* rs;
    __device__ __forceinline__ void operator()(const f32x4 (&acc)[2][2][4][2], const Unit& u, int wr, int wc, int fr, int fq) const {
        const int row0 = u.pm * BM + wr * 64 + fr, col0 = u.pn * BM + wc * 32 + 8 * fq;
#pragma unroll
        for (int ai = 0; ai < 2; ++ai)
#pragma unroll
            for (int m = 0; m < 4; ++m) { const int row = row0 + ai * HALF + m * 16; const float s = rs[row]; bf16_t* rowp = O + (size_t)row * ldc + col0;
#pragma unroll
                for (int bj = 0; bj < 2; ++bj) { const f32x4 v0 = acc[ai][bj][m][0] * s, v1 = acc[ai][bj][m][1] * s; u32x4 w;
                    w.x = cvt_pk_bf16(v0[0], v0[1]); w.y = cvt_pk_bf16(v0[2], v0[3]); w.z = cvt_pk_bf16(v1[0], v1[1]); w.w = cvt_pk_bf16(v1[2], v1[3]);
                    *(u32x4*)(rowp + bj * HALF) = w; } }
    }
};
struct EpiProjT {
    static constexpr bool PERM = true, AFTER_DRAIN = false;
    bf16_t* O; bf16_t* Q; int pn0, trows; const float* rs;
    __device__ __forceinline__ void operator()(const f32x4 (&acc)[2][2][4][2], const Unit& u, int wr, int wc, int fr, int fq) const {
        const int pn = u.pn + pn0; bf16_t* base = (pn < 12) ? O + pn * BM : Q + (size_t)(pn - 12) * trows * BM; const int ld = (pn < 12) ? 3072 : BM;
        const int row0 = u.pm * BM + wr * 64 + fr, col0 = wc * 32 + 8 * fq;
#pragma unroll
        for (int ai = 0; ai < 2; ++ai)
#pragma unroll
            for (int m = 0; m < 4; ++m) { const int row = row0 + ai * HALF + m * 16; const float s = rs[row]; bf16_t* rowp = base + (size_t)row * ld + col0;
#pragma unroll
                for (int bj = 0; bj < 2; ++bj) { const f32x4 v0 = acc[ai][bj][m][0] * s, v1 = acc[ai][bj][m][1] * s; u32x4 w;
                    w.x = cvt_pk_bf16(v0[0], v0[1]); w.y = cvt_pk_bf16(v0[2], v0[3]); w.z = cvt_pk_bf16(v1[0], v1[1]); w.w = cvt_pk_bf16(v1[2], v1[3]);
                    *(u32x4*)(rowp + bj * HALF) = w; } }
    }
};
struct EpiOut {
    static constexpr bool PERM = false, AFTER_DRAIN = false;
    const float* X; bf16_t* X1B; float* SSQ; int ldc;
    __device__ __forceinline__ void operator()(const f32x4 (&acc)[2][2][4][2], const Unit& u, int wr, int wc, int fr, int fq) const {
        typedef unsigned u32x2 __attribute__((ext_vector_type(2)));
        const int row0 = u.pm * BM + wr * 64 + fr, col0 = u.pn * BM + wc * 32 + 4 * fq;
#pragma unroll
        for (int ai = 0; ai < 2; ++ai)
#pragma unroll
            for (int m = 0; m < 4; ++m) { const int row = row0 + ai * HALF + m * 16; const size_t off = (size_t)row * ldc + col0; float ss = 0.f;
#pragma unroll
                for (int bj = 0; bj < 2; ++bj)
#pragma unroll
                    for (int n = 0; n < 2; ++n) { const size_t c = off + bj * HALF + n * 16; const f32x4 xv = *(const f32x4*)(X + c); const f32x4 o = xv + acc[ai][bj][m][n];
                        ss += (o[0] * o[0] + o[1] * o[1]) + (o[2] * o[2] + o[3] * o[3]);
                        u32x2 pk; pk.x = cvt_pk_bf16(o[0], o[1]); pk.y = cvt_pk_bf16(o[2], o[3]); *(u32x2*)(X1B + c) = pk; }
                ss += __shfl_xor(ss, 16); ss += __shfl_xor(ss, 32);
                if (fq == 0) SSQ[(size_t)row * 32 + u.pn * 4 + wc] = ss; }
    }
};
struct EpiQ {
    static constexpr bool PERM = false, AFTER_DRAIN = false;
    float* O; int ldc;
    __device__ __forceinline__ void operator()(const f32x4 (&acc)[2][2][4][2], const Unit& u, int wr, int wc, int fr, int fq) const {
        const int row0 = u.pm * BM + wr * 64 + fr, col0 = u.pn * BM + wc * 32 + 4 * fq;
#pragma unroll
        for (int ai = 0; ai < 2; ++ai)
#pragma unroll
            for (int m = 0; m < 4; ++m) { const size_t off = (size_t)(row0 + ai * HALF + m * 16) * ldc + col0;
#pragma unroll
                for (int bj = 0; bj < 2; ++bj)
#pragma unroll
                    for (int n = 0; n < 2; ++n) *(f32x4*)(O + off + bj * HALF + n * 16) = acc[ai][bj][m][n]; }
    }
};
struct EpiQb {
    static constexpr bool PERM = true, AFTER_DRAIN = false;
    bf16_t* O; int ldc; const float* SSQ;
    __device__ __forceinline__ void operator()(const f32x4 (&acc)[2][2][4][2], const Unit& u, int wr, int wc, int fr, int fq) const {
        const int row0 = u.pm * BM + wr * 64 + fr, col0 = u.pn * BM + wc * 32 + 8 * fq;
#pragma unroll
        for (int ai = 0; ai < 2; ++ai)
#pragma unroll
            for (int m = 0; m < 4; ++m) { const int row = row0 + ai * HALF + m * 16; const f32x4* sp = (const f32x4*)(SSQ + (size_t)row * 32);
                f32x4 s4 = sp[0];
#pragma unroll
                for (int i = 1; i < 8; ++i) s4 += sp[i];
                const float s = rsqrtf(((s4[0] + s4[1]) + (s4[2] + s4[3])) * (1.0f / 2048.0f) + 1e-6f); bf16_t* rowp = O + (size_t)row * ldc + col0;
#pragma unroll
                for (int bj = 0; bj < 2; ++bj) { const f32x4 v0 = acc[ai][bj][m][0] * s, v1 = acc[ai][bj][m][1] * s; u32x4 w;
                    w.x = cvt_pk_bf16(v0[0], v0[1]); w.y = cvt_pk_bf16(v0[2], v0[3]); w.z = cvt_pk_bf16(v1[0], v1[1]); w.w = cvt_pk_bf16(v1[2], v1[3]);
                    *(u32x4*)(rowp + bj * HALF) = w; } }
    }
};
template <class Epi, class Sched, bool ALIGN_EPI = false, bool SP2 = false>
__device__ __forceinline__ void gemm_phase(PG8_LAS unsigned char* lds, const Gemm g, const Sched& S, const Epi& E) {
    const int tid = threadIdx.x, wid = __builtin_amdgcn_readfirstlane(tid >> 6), lane = tid & 63, wr = wid >> 2, wc = wid & 3, fr = lane & 15, fq = lane >> 4;
    const int K = g.K, nt = K / BK;
    unsigned voffA[2], voffB[2];
#pragma unroll
    for (int i = 0; i < 2; ++i) { int R, C; stage_rc(tid * 16 + i * 8192, R, C); const int Rb = Epi::PERM ? ((R & ~31) + perm32(R & 31)) : R;
        voffA[i] = (unsigned)(R * K + C) * 2u; voffB[i] = (unsigned)(Rb * K + C) * 2u; }
    const size_t kstep = (size_t)(BK * 2);
    const size_t hstep = (size_t)HALF * K * 2;
    const size_t tstep = 2 * hstep;
    const unsigned ldsw = (unsigned)wid * 1024u;
    const int aoff = lds_byte(wr * 64 + fr, fq * 8), boff = lds_byte(wc * 32 + fr, fq * 8);
#define PG8_SA(b, h) (((b) * 2 + (h)) * HTB)
#define PG8_SB(b, h) ((4 + (b) * 2 + (h)) * HTB)
#define PG8_STAGE(bufoff, gbase, voff) do { _Pragma("unroll") for (int _i = 0; _i < 2; ++_i) \
        __builtin_amdgcn_global_load_lds((const unsigned*)((const char*)(gbase) + (voff)[_i]), (PG8_LAS unsigned*)(lds + (bufoff) + ldsw + _i * 8192), 16, 0, 0); } while (0)
#define PG8_LDA(dst, b, h) do { _Pragma("unroll") for (int m = 0; m < 4; ++m) _Pragma("unroll") for (int k = 0; k < 2; ++k) dst[m][k] = *(const PG8_LAS bf16x8*)(lds + PG8_SA(b, h) + aoff + m * 2048 + k * 1024); } while (0)
#define PG8_LDB(dst, b, h) do { _Pragma("unroll") for (int n = 0; n < 2; ++n) _Pragma("unroll") for (int k = 0; k < 2; ++k) dst[n][k] = *(const PG8_LAS bf16x8*)(lds + PG8_SB(b, h) + boff + n * 2048 + k * 1024); } while (0)
#define PG8_MMA(ai, bj, At, Bt) do { __builtin_amdgcn_s_setprio(1); _Pragma("unroll") for (int m = 0; m < 4; ++m) _Pragma("unroll") for (int n = 0; n < 2; ++n) _Pragma("unroll") for (int k = 0; k < 2; ++k) \
        acc[ai][bj][m][n] = __builtin_amdgcn_mfma_f32_16x16x32_bf16(Bt[n][k], At[m][k], acc[ai][bj][m][n], 0, 0, 0); __builtin_amdgcn_s_setprio(0); } while (0)
#define PG8_WAIT_V(n) asm volatile("s_waitcnt vmcnt(" #n ")" ::: "memory")
#define PG8_WAIT_L(n) asm volatile("s_waitcnt lgkmcnt(" #n ")" ::: "memory")
#define PG8_BAR __builtin_amdgcn_s_barrier()
#define PG8_SCHED __builtin_amdgcn_sched_barrier(0)
    Unit cur, nxt; int ui = 0;
    if (!S.next(0, cur)) return;
    f32x4 acc[2][2][4][2];
#pragma unroll
    for (int a = 0; a < 2; ++a)
#pragma unroll
        for (int b = 0; b < 2; ++b)
#pragma unroll
            for (int m = 0; m < 4; ++m)
#pragma unroll
                for (int n = 0; n < 2; ++n) acc[a][b][m][n] = (f32x4){0.f, 0.f, 0.f, 0.f};
    bf16x8 At[4][2], B0[2][2], B1[2][2];
    const char* cA = (const char*)g.A + (size_t)cur.pm * tstep; const char* cB = (const char*)g.Bt + (size_t)cur.pn * tstep;
    S.a_ready(cur);
    if constexpr (SP2) {
        PG8_STAGE(PG8_SB(0, 0), cB, voffB); PG8_STAGE(PG8_SB(0, 1), cB + hstep, voffB); PG8_STAGE(PG8_SA(0, 0), cA, voffA); PG8_STAGE(PG8_SA(0, 1), cA + hstep, voffA);
        if (wr == 1) PG8_BAR;
        PG8_WAIT_V(2); PG8_BAR;
        PG8_STAGE(PG8_SB(1, 0), cB + kstep, voffB); PG8_STAGE(PG8_SA(1, 0), cA + kstep, voffA); PG8_STAGE(PG8_SB(1, 1), cB + hstep + kstep, voffB);
        PG8_WAIT_V(6); PG8_BAR;
    } else {
        PG8_STAGE(PG8_SB(0, 0), cB, voffB); PG8_STAGE(PG8_SA(0, 0), cA, voffA); PG8_STAGE(PG8_SB(0, 1), cB + hstep, voffB); PG8_STAGE(PG8_SA(0, 1), cA + hstep, voffA);
        if (wr == 1) PG8_BAR;
        PG8_WAIT_V(4); PG8_BAR;
        PG8_STAGE(PG8_SB(1, 0), cB + kstep, voffB); PG8_STAGE(PG8_SA(1, 0), cA + kstep, voffA); PG8_STAGE(PG8_SB(1, 1), cB + hstep + kstep, voffB);
        PG8_WAIT_V(6); PG8_BAR;
    }
    for (;;) {
        const bool has_next = S.next(ui + 1, nxt);
        const char* nA = has_next ? (const char*)g.A + (size_t)nxt.pm * tstep : cA; const char* nB = has_next ? (const char*)g.Bt + (size_t)nxt.pn * tstep : cB;
        for (int t = 0; t < nt; t += 2) {
            const bool last = (t == nt - 2);
            const char* a1 = cA + (size_t)(t + 1) * kstep;
            const char* a2 = last ? nA : cA + (size_t)(t + 2) * kstep; const char* b2 = last ? nB : cB + (size_t)(t + 2) * kstep;
            const char* a3 = a2 + kstep; const char* b3 = b2 + kstep;
            if (last && has_next) S.a_ready(nxt);
            if constexpr (SP2) {
            PG8_LDB(B0, 0, 0); PG8_LDB(B1, 0, 1); PG8_SCHED; PG8_LDA(At, 0, 0); PG8_STAGE(PG8_SA(1, 1), a1 + hstep, voffA);
            PG8_WAIT_V(8); PG8_WAIT_L(0); PG8_BAR; PG8_MMA(0, 0, At, B0); PG8_MMA(0, 1, At, B1); PG8_BAR; PG8_SCHED;
            PG8_LDA(At, 0, 1); PG8_STAGE(PG8_SB(0, 0), b2, voffB); PG8_STAGE(PG8_SB(0, 1), b2 + hstep, voffB); PG8_STAGE(PG8_SA(0, 0), a2, voffA);
            PG8_WAIT_V(8); PG8_WAIT_L(0); PG8_BAR; PG8_MMA(1, 0, At, B0); PG8_MMA(1, 1, At, B1); PG8_BAR; PG8_SCHED;
            PG8_LDB(B0, 1, 0); PG8_LDB(B1, 1, 1); PG8_SCHED; PG8_LDA(At, 1, 0); PG8_STAGE(PG8_SA(0, 1), a2 + hstep, voffA);
            PG8_WAIT_V(8); PG8_WAIT_L(0); PG8_BAR; PG8_MMA(0, 0, At, B0); PG8_MMA(0, 1, At, B1); PG8_BAR; PG8_SCHED;
            PG8_LDA(At, 1, 1); PG8_STAGE(PG8_SB(1, 0), b3, voffB); PG8_STAGE(PG8_SB(1, 1), b3 + hstep, voffB); PG8_STAGE(PG8_SA(1, 0), a3, voffA);
            PG8_WAIT_V(8); PG8_WAIT_L(0); PG8_BAR; PG8_MMA(1, 0, At, B0); PG8_MMA(1, 1, At, B1); PG8_BAR; PG8_SCHED;
            } else {
            PG8_LDB(B0, 0, 0); PG8_SCHED; PG8_LDA(At, 0, 0); PG8_STAGE(PG8_SA(1, 1), a1 + hstep, voffA);
            PG8_WAIT_L(8); PG8_BAR; PG8_WAIT_L(0); PG8_MMA(0, 0, At, B0); PG8_BAR; PG8_SCHED;
            PG8_LDB(B1, 0, 1); PG8_STAGE(PG8_SB(0, 0), b2, voffB);
            PG8_BAR; PG8_WAIT_L(0); PG8_MMA(0, 1, At, B1); PG8_BAR;
            PG8_LDA(At, 0, 1); PG8_STAGE(PG8_SA(0, 0), a2, voffA);
            PG8_BAR; PG8_WAIT_L(0); PG8_MMA(1, 0, At, B0); PG8_BAR; PG8_SCHED;
            PG8_STAGE(PG8_SB(0, 1), b2 + hstep, voffB);
            PG8_WAIT_V(6); PG8_BAR; PG8_MMA(1, 1, At, B1); PG8_BAR;
            PG8_LDB(B0, 1, 0); PG8_SCHED; PG8_LDA(At, 1, 0); PG8_STAGE(PG8_SA(0, 1), a2 + hstep, voffA);
            PG8_WAIT_L(8); PG8_BAR; PG8_WAIT_L(0); PG8_MMA(0, 0, At, B0); PG8_BAR; PG8_SCHED;
            PG8_LDB(B1, 1, 1); PG8_STAGE(PG8_SB(1, 0), b3, voffB);
            PG8_BAR; PG8_WAIT_L(0); PG8_MMA(0, 1, At, B1); PG8_BAR;
            PG8_LDA(At, 1, 1); PG8_STAGE(PG8_SA(1, 0), a3, voffA);
            PG8_BAR; PG8_WAIT_L(0); PG8_MMA(1, 0, At, B0); PG8_BAR; PG8_SCHED;
            PG8_STAGE(PG8_SB(1, 1), b3 + hstep, voffB);
            PG8_WAIT_V(6); PG8_BAR; PG8_MMA(1, 1, At, B1); PG8_BAR;
            }
        }
        if constexpr (ALIGN_EPI) { if (wr == 0) PG8_BAR; }
        if constexpr (!Epi::AFTER_DRAIN) { E(acc, cur, wr, wc, fr, fq); S.done(cur); }
        if (!has_next) break;
#pragma unroll
        for (int a = 0; a < 2; ++a)
#pragma unroll
            for (int b = 0; b < 2; ++b)
#pragma unroll
                for (int m = 0; m < 4; ++m)
#pragma unroll
                    for (int n = 0; n < 2; ++n) acc[a][b][m][n] = (f32x4){0.f, 0.f, 0.f, 0.f};
        cur = nxt; cA = nA; cB = nB; ++ui;
        if constexpr (ALIGN_EPI) { if (wr == 1) PG8_BAR; }
    }
    PG8_WAIT_V(0);
    if constexpr (!ALIGN_EPI) { if (wr == 0) PG8_BAR; }
    PG8_BAR;
    if constexpr (Epi::AFTER_DRAIN) { E.fused(acc, cur, wr, wc, fr, fq, lds, wid, lane); S.done(cur); }
#undef PG8_SA
#undef PG8_SB
#undef PG8_STAGE
#undef PG8_LDA
#undef PG8_LDB
#undef PG8_MMA
#undef PG8_WAIT_V
#undef PG8_WAIT_L
#undef PG8_BAR
#undef PG8_SCHED
}
}
constexpr int T = 8192, SEQ = 4096, D = 2048, NPROJ = 7168, NIN = 7176, NPC = 3072;
constexpr int NH = 4, DH = 256, LCH = 64, DML = 1024;
constexpr int NEXP = 16384, PEER_H = 8, TOPK = 16;
constexpr float EPS = 1e-6f;
constexpr int PC_CX = 0, PC_CB = 1024, PC_CC = 2048, PC_Q = 3072, PC_K = 4096, PC_V = 5120, PC_O = 6144;
constexpr int NTHREADS = 512, NWAVES = 8;
constexpr int LDS_BYTES = 147456;

constexpr size_t MiB = 1u << 20;
constexpr size_t WS_CTL = 0, CTL_ZERO_BYTES = 64 * 1024;
constexpr int CW_BAR = 1024;
constexpr size_t WS_RS1 = 1 * MiB, WS_GI = 1 * MiB + 64 * 1024, WS_GF = 1 * MiB + 256 * 1024, WS_SSQ = 3 * MiB, WS_ESC = 4 * MiB;
constexpr size_t WS_XB = 5 * MiB, WS_WINT = 37 * MiB, WS_WOUTT = 65 * MiB, WS_WQT = 73 * MiB;
constexpr size_t WS_PROJ = 81 * MiB, WS_QKVO = 129 * MiB;
constexpr size_t WS_X1 = 81 * MiB, WS_X1B = 145 * MiB;
constexpr size_t WS_HRAW = 193 * MiB, WS_MIXIN = 225 * MiB, WS_QV = 257 * MiB, WS_IDX = 321 * MiB, WS_GATE = 325 * MiB;
constexpr size_t WS_UB = 329 * MiB, WS_VB = 393 * MiB, WS_END = 457 * MiB;

struct Params {
    const float *x, *g1, *w_in, *b_ig, *b_fg, *conv_w, *gm, *w_out, *g2, *w_q, *sk1, *sk2, *eu, *ev, *gfin;
    float* out; unsigned char* ws;
    int ph_lo, ph_hi;
};

typedef unsigned short bf16_t;
typedef unsigned v4u_t __attribute__((ext_vector_type(4)));
typedef unsigned v2u_t __attribute__((ext_vector_type(2)));
__device__ __forceinline__ unsigned f2bf(float f) { unsigned u = __float_as_uint(f); return (u + 0x7fffu + ((u >> 16) & 1u)) >> 16; }
__device__ __forceinline__ unsigned pk2(float lo, float hi) { return f2bf(lo) | (f2bf(hi) << 16); }
__device__ __forceinline__ float bflo(unsigned w) { return __uint_as_float(w << 16); }
__device__ __forceinline__ float bfhi(unsigned w) { return __uint_as_float(w & 0xffff0000u); }
__device__ __forceinline__ float bf1(bf16_t h) { return __uint_as_float((unsigned)h << 16); }
__device__ __forceinline__ float wave_sum(float v) {
#pragma unroll
    for (int o = 32; o >= 1; o >>= 1) v += __shfl_xor(v, o);
    return v;
}
__device__ __forceinline__ void unpack8(const uint4 w, float (&f)[8]) {
    f[0] = bflo(w.x); f[1] = bfhi(w.x); f[2] = bflo(w.y); f[3] = bfhi(w.y); f[4] = bflo(w.z); f[5] = bfhi(w.z); f[6] = bflo(w.w); f[7] = bfhi(w.w);
}
__device__ __forceinline__ float log_sigmoid(float z) { return z >= 0.f ? -log1pf(expf(-z)) : z - log1pf(expf(z)); }
__device__ __forceinline__ float gelu_erf(float v) { return 0.5f * v * (1.0f + erff(v * 0.70710678118654752f)); }

__device__ __forceinline__ void p0_rows(const Params& P, unsigned char* lds, int G, int bid) {
    float* wg = (float*)lds;
    const int tid = threadIdx.x, lane = tid & 63, wave = tid >> 6;
    {
    for (int i = tid; i < 2 * D; i += NTHREADS) { const int k = i >> 1, hf = i & 1; const float4 w4 = *(const float4*)(P.w_in + (size_t)k * NIN + NPROJ + hf * 4); const float gk = P.g1[k];
        wg[(hf * 4 + 0) * D + k] = w4.x * gk; wg[(hf * 4 + 1) * D + k] = w4.y * gk; wg[(hf * 4 + 2) * D + k] = w4.z * gk; wg[(hf * 4 + 3) * D + k] = w4.w * gk; }
    __syncthreads(); }
    float* rs1 = (float*)(P.ws + WS_RS1); float* gi = (float*)(P.ws + WS_GI); float* gf = (float*)(P.ws + WS_GF); bf16_t* xb = (bf16_t*)(P.ws + WS_XB);
    for (int tp = bid * NWAVES + wave; tp < T / 2; tp += G * NWAVES) {
        const int t = tp * 2;
        const float4* xr = (const float4*)(P.x + (size_t)t * D);
        float ss[2] = {0.f, 0.f}, dg[2][8];
#pragma unroll
        for (int g = 0; g < 8; ++g) { dg[0][g] = 0.f; dg[1][g] = 0.f; }
        float4 v[2][8];
#pragma unroll
        for (int rr = 0; rr < 2; ++rr)
#pragma unroll
            for (int j = 0; j < 8; ++j) v[rr][j] = xr[rr * (D / 4) + j * 64 + lane];
#pragma unroll 1
        for (int j = 0; j < 8; ++j) {
            const int k0 = (j * 64 + lane) * 4;
#pragma unroll
            for (int rr = 0; rr < 2; ++rr) { const float4 vv = j == 0 ? v[rr][0] : j == 1 ? v[rr][1] : j == 2 ? v[rr][2] : j == 3 ? v[rr][3] : j == 4 ? v[rr][4] : j == 5 ? v[rr][5] : j == 6 ? v[rr][6] : v[rr][7];
                ss[rr] += (vv.x * vv.x + vv.y * vv.y) + (vv.z * vv.z + vv.w * vv.w);
#pragma unroll
                for (int g = 0; g < 8; ++g) { const float4 w = *(const float4*)(wg + g * D + k0); dg[rr][g] += (vv.x * w.x + vv.y * w.y) + (vv.z * w.z + vv.w * w.w); }
                ((uint2*)(xb + (size_t)(t + rr) * D))[j * 64 + lane] = make_uint2(pk2(vv.x, vv.y), pk2(vv.z, vv.w)); }
        }
#pragma unroll
        for (int rr = 0; rr < 2; ++rr) {
            const float s1 = wave_sum(ss[rr]);
#pragma unroll
            for (int g = 0; g < 8; ++g) dg[rr][g] = wave_sum(dg[rr][g]);
            const float rs = rsqrtf(s1 * (1.0f / D) + EPS);
            if (lane == 0) {
                rs1[t + rr] = rs;
#pragma unroll
                for (int h = 0; h < 4; ++h) { gi[(t + rr) * 4 + h] = rs * dg[rr][h] + P.b_ig[h]; gf[(t + rr) * 4 + h] = log_sigmoid(rs * dg[rr][4 + h] + P.b_fg[h]); }
            }
        }
    }
    __syncthreads();
}
__device__ __forceinline__ void transpose_tile(const float* W, int ldw, int K, const float* gain, bf16_t* WT, int k0, int n0, float* tile) {
    const int tid = threadIdx.x;
    float4 v[4];
#pragma unroll
    for (int r = 0; r < 4; ++r) v[r] = *(const float4*)(W + (size_t)(k0 + (tid >> 5) + 16 * r) * ldw + n0 + (tid & 31) * 4);
#pragma unroll
    for (int r = 0; r < 4; ++r) { const int kk = (tid >> 5) + 16 * r, n4 = (tid & 31) * 4; const float g = gain ? gain[k0 + kk] : 1.0f;
        tile[kk * 129 + n4 + 0] = v[r].x * g; tile[kk * 129 + n4 + 1] = v[r].y * g; tile[kk * 129 + n4 + 2] = v[r].z * g; tile[kk * 129 + n4 + 3] = v[r].w * g; }
    __syncthreads();
    { const int nn = tid >> 2, k16 = (tid & 3) * 16; float f[16];
#pragma unroll
      for (int i = 0; i < 16; ++i) f[i] = tile[(k16 + i) * 129 + nn];
      uint4* dst = (uint4*)(WT + (size_t)(n0 + nn) * K + k0 + k16);
      dst[0] = make_uint4(pk2(f[0], f[1]), pk2(f[2], f[3]), pk2(f[4], f[5]), pk2(f[6], f[7])); dst[1] = make_uint4(pk2(f[8], f[9]), pk2(f[10], f[11]), pk2(f[12], f[13]), pk2(f[14], f[15])); }
    __syncthreads();
}
__device__ __forceinline__ void p0_weights_in(const Params& P, unsigned char* lds, int G, int bid) {
    float* tile = (float*)lds;
    constexpr int N_IN = (D / 64) * (NPROJ / 128);
    for (int it = bid; it < N_IN; it += G) { const int kt = it / (NPROJ / 128), nt = it % (NPROJ / 128); transpose_tile(P.w_in, NIN, D, P.g1, (bf16_t*)(P.ws + WS_WINT), kt * 64, nt * 128, tile); }
}
__device__ __forceinline__ void p2_weights_sq(const Params& P, unsigned char* lds, int nworkers, int wid) {
    float* tile = (float*)lds;
    constexpr int N_SQ = (D / 64) * (D / 128);
    for (int it = wid; it < 2 * N_SQ; it += nworkers) {
        if (it < N_SQ) { const int kt = it / (D / 128), nt = it % (D / 128); transpose_tile(P.w_out, D, D, nullptr, (bf16_t*)(P.ws + WS_WOUTT), kt * 64, nt * 128, tile); }
        else { const int j = it - N_SQ, kt = j / (D / 128), nt = j % (D / 128); transpose_tile(P.w_q, D, D, P.g2, (bf16_t*)(P.ws + WS_WQT), kt * 64, nt * 128, tile); }
    }
}
typedef float f32x2_t __attribute__((ext_vector_type(2)));
typedef float v16f_t __attribute__((ext_vector_type(16)));
typedef float v32f_t __attribute__((ext_vector_type(32)));
typedef unsigned v6u_t __attribute__((ext_vector_type(6)));
constexpr int EROW = 1536;
__device__ __forceinline__ float wave_max(float v) {
#pragma unroll
    for (int o = 32; o >= 1; o >>= 1) v = fmaxf(v, __shfl_xor(v, o));
    return v;
}
__device__ __forceinline__ void p0_tables(const Params& P, int nworkers, int wid) {
    const int lane = threadIdx.x & 63, wave = threadIdx.x >> 6;
    float* esc = (float*)(P.ws + WS_ESC);
#pragma unroll 1
    for (int e = wid * NWAVES + wave; e < NEXP; e += nworkers * NWAVES) {
        float4 v[2][8];
#pragma unroll
        for (int isv = 0; isv < 2; ++isv) { const float4* src = (const float4*)((isv ? P.ev : P.eu) + (size_t)e * D) + lane * 8;
#pragma unroll
            for (int j = 0; j < 8; ++j) v[isv][j] = src[j]; }
#pragma unroll
        for (int isv = 0; isv < 2; ++isv) {
            float mx = 0.f;
#pragma unroll
            for (int j = 0; j < 8; ++j) { float4 w = v[isv][j];
                if (!isv) { const float4 gg = ((const float4*)P.g2)[lane * 8 + j]; w.x *= gg.x; w.y *= gg.y; w.z *= gg.z; w.w *= gg.w; v[isv][j] = w; }
                mx = fmaxf(mx, fmaxf(fmaxf(fabsf(w.x), fabsf(w.y)), fmaxf(fabsf(w.z), fabsf(w.w)))); }
            mx = wave_max(mx);
            int ex = 0; (void)frexpf(mx * (1.0f / 7.5f), &ex);
            const float sc = mx > 0.f ? ldexpf(1.0f, ex) : 1.0f;
            const v16f_t a = {v[isv][0].x, v[isv][0].z, v[isv][1].x, v[isv][1].z, v[isv][2].x, v[isv][2].z, v[isv][3].x, v[isv][3].z, v[isv][4].x, v[isv][4].z, v[isv][5].x, v[isv][5].z, v[isv][6].x, v[isv][6].z, v[isv][7].x, v[isv][7].z};
            const v16f_t b = {v[isv][0].y, v[isv][0].w, v[isv][1].y, v[isv][1].w, v[isv][2].y, v[isv][2].w, v[isv][3].y, v[isv][3].w, v[isv][4].y, v[isv][4].w, v[isv][5].y, v[isv][5].w, v[isv][6].y, v[isv][6].w, v[isv][7].y, v[isv][7].w};
            const v6u_t pk = __builtin_amdgcn_cvt_scalef32_2xpk16_fp6_f32(a, b, sc);
            v2u_t* dst = (v2u_t*)(P.ws + (isv ? WS_VB : WS_UB) + (size_t)e * EROW + lane * 24);
            dst[0] = (v2u_t){pk[0], pk[1]}; dst[1] = (v2u_t){pk[2], pk[3]}; dst[2] = (v2u_t){pk[4], pk[5]};
            if (lane == 0) esc[e * 2 + isv] = sc;
        }
    }
}

__device__ __forceinline__ void p2_conv(const Params& P, int nworkers, int wid) {
    const bf16_t* proj = (const bf16_t*)(P.ws + WS_PROJ); bf16_t* mix = (bf16_t*)(P.ws + WS_MIXIN);
    for (int idx = wid * NTHREADS + threadIdx.x; idx < T * 128; idx += nworkers * NTHREADS) {
        const int t = idx >> 7, c8 = (idx & 127) * 8, s = t & (SEQ - 1);
        float y[8];
#pragma unroll
        for (int i = 0; i < 8; ++i) y[i] = 0.f;
#pragma unroll
        for (int j = 0; j < 3; ++j) {
            const int dt = 2 - j;
            if (s >= dt) {
                const bf16_t* row = proj + (size_t)(t - dt) * NPC;
                float cx[8], cc[8]; unpack8(*(const uint4*)(row + PC_CX + c8), cx); unpack8(*(const uint4*)(row + PC_CC + c8), cc);
                const float4 w0 = *(const float4*)(P.conv_w + j * 1024 + c8), w1 = *(const float4*)(P.conv_w + j * 1024 + c8 + 4);
                y[0] += w0.x * (cc[0] * cx[0]); y[1] += w0.y * (cc[1] * cx[1]); y[2] += w0.z * (cc[2] * cx[2]); y[3] += w0.w * (cc[3] * cx[3]);
                y[4] += w1.x * (cc[4] * cx[4]); y[5] += w1.y * (cc[5] * cx[5]); y[6] += w1.z * (cc[6] * cx[6]); y[7] += w1.w * (cc[7] * cx[7]);
            }
        }
        float cb[8]; unpack8(*(const uint4*)(proj + (size_t)t * NPC + PC_CB + c8), cb);
        *(uint4*)(mix + (size_t)t * D + c8) = make_uint4(pk2(cb[0] * y[0], cb[1] * y[1]), pk2(cb[2] * y[2], cb[3] * y[3]), pk2(cb[4] * y[4], cb[5] * y[5]), pk2(cb[6] * y[6], cb[7] * y[7]));
    }
}
#define LAS3 __attribute__((address_space(3)))
typedef short s16x4_t __attribute__((ext_vector_type(4)));
__device__ __forceinline__ pg8::bf16x8 tr8(LAS3 unsigned char* p0, LAS3 unsigned char* p1) {
    const s16x4_t a = __builtin_amdgcn_ds_read_tr16_b64_v4i16((LAS3 s16x4_t*)p0), b = __builtin_amdgcn_ds_read_tr16_b64_v4i16((LAS3 s16x4_t*)p1);
    return __builtin_shufflevector(a, b, 0, 1, 2, 3, 4, 5, 6, 7);
}
template <int CTRL, int RMASK> __device__ __forceinline__ float dpp_keep(float oldv, float v) { return __int_as_float(__builtin_amdgcn_update_dpp(__float_as_int(oldv), __float_as_int(v), CTRL, RMASK, 0xF, false)); }
__device__ __forceinline__ float wave_incl_sum(float v) {
    v += dpp_keep<0x111, 0xF>(0.f, v); v += dpp_keep<0x112, 0xF>(0.f, v); v += dpp_keep<0x114, 0xF>(0.f, v); v += dpp_keep<0x118, 0xF>(0.f, v);
    v += dpp_keep<0x142, 0xA>(0.f, v); v += dpp_keep<0x143, 0xC>(0.f, v); return v;
}
__device__ __forceinline__ float wave_incl_max(float v) {
    const float NI = -__builtin_inff();
    v = fmaxf(v, dpp_keep<0x111, 0xF>(NI, v)); v = fmaxf(v, dpp_keep<0x112, 0xF>(NI, v)); v = fmaxf(v, dpp_keep<0x114, 0xF>(NI, v)); v = fmaxf(v, dpp_keep<0x118, 0xF>(NI, v));
    v = fmaxf(v, dpp_keep<0x142, 0xA>(NI, v)); v = fmaxf(v, dpp_keep<0x143, 0xC>(NI, v)); return v;
}
__device__ __forceinline__ void mlstm_unit(const Params& P, unsigned char* lds_, int unit, float* hraw) {
    typedef pg8::bf16x8 bf16x8; typedef pg8::f32x4 f32x4;
    LAS3 unsigned char* L = (LAS3 unsigned char*)lds_;
    constexpr int KS = 33792, VA = 67584, WV = 73728, CB0 = 79872, CBSZ = 25344, SW0 = CB0 + 2 * CBSZ, SWSZ = 2304, SM0 = SW0 + 4 * SWSZ, SMSZ = 1600;
    constexpr int QST = 528, VST = 96, SWT = 32;
    constexpr int NCH = SEQ / LCH;
    const int tid = threadIdx.x, wave = __builtin_amdgcn_readfirstlane(tid >> 6);
    const int bh = unit >> 3, sl = unit & 7, b = bh >> 2, h = bh & 3, v0 = sl * 32;
    const bf16_t* qT = (const bf16_t*)(P.ws + WS_QKVO) + (size_t)h * T * DH; const bf16_t* kT = qT + (size_t)4 * T * DH; const bf16_t* vT = qT + (size_t)8 * T * DH;
    const float* gi = (const float*)(P.ws + WS_GI); const float* gf = (const float*)(P.ws + WS_GF);
#define SMF(sb, off) ((LAS3 float*)(L + SM0 + (sb) * SMSZ + (off)))
    for (int i = tid; i < (2 * CBSZ) / 16; i += NTHREADS) *(LAS3 v4u_t*)(L + CB0 + i * 16) = (v4u_t){0u, 0u, 0u, 0u};
    for (int i = tid; i < 6144 / 16; i += NTHREADS) *(LAS3 v4u_t*)(L + WV + i * 16) = (v4u_t){0u, 0u, 0u, 0u};
    for (int i = tid; i < (4 * SWSZ) / 16; i += NTHREADS) *(LAS3 v4u_t*)(L + SW0 + i * 16) = (v4u_t){0u, 0u, 0u, 0u};
    if (tid < 64) { *(LAS3 v4u_t*)(L + VA + tid * VST + 64) = (v4u_t){0x00003F80u, 0u, 0u, 0u}; *(LAS3 v4u_t*)(L + VA + tid * VST + 80) = (v4u_t){0u, 0u, 0u, 0u}; }
    const int prow = (wave & 3) * 16;
    if (wave < 4) {
        const int rt = wave; LAS3 unsigned char* SWp = L + SW0 + rt * SWSZ;
        v4u_t r8[8], rv; float m = 0.f, nic = 0.f, nfc = 0.f;
#define MLSTM_SMALLS(sb, ic_, fc_) do { const float bc_ = wave_incl_sum(fc_); const float a_ = (ic_) - bc_; const float pm_ = wave_incl_max(a_); \
        const float M_ = fmaxf(m, pm_), M63_ = __shfl(M_, 63), b63_ = __shfl(bc_, 63); \
        SMF(sb, 0)[lane] = a_ * 1.4426950408889634f; SMF(sb, 256)[lane] = M_ * 1.4426950408889634f; SMF(sb, 512)[lane] = __expf(m - M_); SMF(sb, 768)[lane] = __expf(a_ - M63_) * 0.0625f; SMF(sb, 1024)[lane] = __expf(-bc_ - M_); \
        if (lane == 0) { SMF(sb, 1280)[0] = b63_ + M63_; SMF(sb, 1280)[1] = __expf(m - M63_); } m = b63_ + M63_; } while (0)
        { const int lane = tid & 63, g = lane >> 4, c16 = lane & 15; const int t0 = b * SEQ;
          const bf16_t* src8 = qT + (size_t)(t0 + prow + c16) * DH + g * 8;
#pragma unroll
          for (int i = 0; i < 8; ++i) r8[i] = *(const v4u_t*)(src8 + i * 32);
          rv = *(const v4u_t*)(vT + (size_t)(t0 + (tid >> 2)) * DH + v0 + (tid & 3) * 8);
          if (wave == 0) { const float ic0 = gi[(size_t)(t0 + lane) * 4 + h], fc0 = gf[(size_t)(t0 + lane) * 4 + h]; MLSTM_SMALLS(0, ic0, fc0);
              nic = gi[(size_t)(t0 + LCH + lane) * 4 + h]; nfc = gf[(size_t)(t0 + LCH + lane) * 4 + h]; } }
        __syncthreads();
#pragma unroll 1
        for (int c = 0; c < NCH; ++c) {
            const int t0 = b * SEQ + c * LCH, sb = c & 1;
            int tl = tid; asm volatile("" : "+v"(tl));
            const int lane = tl & 63, g = lane >> 4, c16 = lane & 15, q4 = c16 >> 2, p4 = lane & 3;
            LAS3 unsigned char* CBc = L + CB0 + sb * CBSZ;
            bf16x8 qf[8];
#pragma unroll
            for (int i = 0; i < 8; ++i) qf[i] = __builtin_bit_cast(bf16x8, r8[i]);
            { const int l = tl >> 2, part = tl & 3; const float wl = SMF(sb, 768)[l];
              *(LAS3 v4u_t*)(L + VA + l * VST + part * 16) = rv;
              *(LAS3 v4u_t*)(L + WV + l * VST + part * 16) = (v4u_t){pg8::cvt_pk_bf16(wl * bflo(rv.x), wl * bfhi(rv.x)), pg8::cvt_pk_bf16(wl * bflo(rv.y), wl * bfhi(rv.y)), pg8::cvt_pk_bf16(wl * bflo(rv.z), wl * bfhi(rv.z)), pg8::cvt_pk_bf16(wl * bflo(rv.w), wl * bfhi(rv.w))}; }
            { const int t1 = b * SEQ + ((c + 1 < NCH) ? c + 1 : c) * LCH;
              const bf16_t* src8 = qT + (size_t)(t1 + prow + c16) * DH + g * 8;
#pragma unroll
              for (int i = 0; i < 8; ++i) r8[i] = *(const v4u_t*)(src8 + i * 32);
              rv = *(const v4u_t*)(vT + (size_t)(t1 + (tl >> 2)) * DH + v0 + (tl & 3) * 8); }
            __syncthreads();
            const f32x4 M4 = *(LAS3 f32x4*)(SMF(sb, 256) + rt * 16 + 4 * g) + 4.0f;
            float al4[4];
#pragma unroll
            for (int ct = 0; ct < 4; ++ct) al4[ct] = SMF(sb, 0)[ct * 16 + c16];
            bf16x8 bk[4], cf[6], vf[6];
#define MLSTM_LDK(ct_, hf_) do { _Pragma("unroll") for (int ks = 0; ks < 4; ++ks) bk[ks] = *(LAS3 bf16x8*)(L + KS + ((ct_) * 16 + c16) * QST + (((hf_) * 4 + ks) * 32 + g * 8) * 2); } while (0)
#define MLSTM_LDC(kp_) do { _Pragma("unroll") for (int j = 0; j < 2; ++j) _Pragma("unroll") for (int vt = 0; vt < 3; ++vt) cf[j * 3 + vt] = *(LAS3 bf16x8*)(CBc + (vt * 16 + c16) * QST + ((2 * (kp_) + j) * 32 + g * 8) * 2); } while (0)
            MLSTM_LDK(0, 0); MLSTM_LDC(0);
            asm volatile("" ::: "memory");
            f32x4 aI[3];
#pragma unroll
            for (int vt = 0; vt < 3; ++vt) aI[vt] = (f32x4){0.f, 0.f, 0.f, 0.f};
#pragma unroll
            for (int ct = 0; ct < 4; ++ct) { f32x4 acc = (f32x4){0.f, 0.f, 0.f, 0.f};
                if (ct <= rt) {
#pragma unroll
                    for (int ks = 0; ks < 4; ++ks) acc = __builtin_amdgcn_mfma_f32_16x16x32_bf16(qf[ks], bk[ks], acc, 0, 0, 0);
                    MLSTM_LDK(ct, 1); asm volatile("" ::: "memory"); }
#pragma unroll
                for (int j = 0; j < 2; ++j)
#pragma unroll
                    for (int vt = 0; vt < 3; ++vt) aI[vt] = __builtin_amdgcn_mfma_f32_16x16x32_bf16(qf[2 * ct + j], cf[j * 3 + vt], aI[vt], 0, 0, 0);
                if (ct <= rt) {
#pragma unroll
                    for (int ks = 0; ks < 4; ++ks) acc = __builtin_amdgcn_mfma_f32_16x16x32_bf16(qf[4 + ks], bk[ks], acc, 0, 0, 0); }
                if (ct < 3) { if (ct + 1 <= rt) MLSTM_LDK(ct + 1, 0); MLSTM_LDC(ct + 1); }
                else {
#pragma unroll
                    for (int ks = 0; ks < 2; ++ks)
#pragma unroll
                        for (int vt = 0; vt < 3; ++vt) { LAS3 unsigned char* vp = L + VA + (ks * 32 + g * 8 + q4) * VST + (vt * 16 + 4 * p4) * 2; vf[ks * 3 + vt] = tr8(vp, vp + 4 * VST); } }
                asm volatile("" ::: "memory");
                if (ct <= rt) { const float al = al4[ct]; float e[4];
#pragma unroll
                    for (int r = 0; r < 4; ++r) { e[r] = acc[r] * __builtin_amdgcn_exp2f(al - M4[r]); if (ct == rt && c16 > 4 * g + r) e[r] = 0.f; }
                    *(LAS3 v2u_t*)(SWp + (ct * 16 + c16) * SWT + (4 * g) * 2) = (v2u_t){pg8::cvt_pk_bf16(e[0], e[1]), pg8::cvt_pk_bf16(e[2], e[3])}; } }
#undef MLSTM_LDK
#undef MLSTM_LDC
            asm volatile("s_waitcnt lgkmcnt(0)" ::: "memory");
            f32x4 aX[3];
#pragma unroll
            for (int vt = 0; vt < 3; ++vt) aX[vt] = (f32x4){0.f, 0.f, 0.f, 0.f};
            { LAS3 unsigned char* sp0 = SWp + (g * 8 + q4) * SWT + (4 * p4) * 2; LAS3 unsigned char* sp1 = sp0 + 32 * SWT;
              const bf16x8 av0 = tr8(sp0, sp0 + 4 * SWT), av1 = tr8(sp1, sp1 + 4 * SWT);
#pragma unroll
              for (int vt = 0; vt < 3; ++vt) aX[vt] = __builtin_amdgcn_mfma_f32_16x16x32_bf16(av0, vf[vt], aX[vt], 0, 0, 0);
#pragma unroll
              for (int vt = 0; vt < 3; ++vt) aX[vt] = __builtin_amdgcn_mfma_f32_16x16x32_bf16(av1, vf[3 + vt], aX[vt], 0, 0, 0); }
            const f32x4 e4 = *(LAS3 f32x4*)(SMF(sb, 512) + rt * 16 + 4 * g), n4 = *(LAS3 f32x4*)(SMF(sb, 1024) + rt * 16 + 4 * g);
#pragma unroll
            for (int r = 0; r < 4; ++r) { const float den0 = __builtin_amdgcn_rcpf(fmaxf(fabsf(e4[r] * aI[2][r] + aX[2][r]), n4[r])); const float rden = __shfl(den0, g * 16);
                const size_t o = (size_t)(t0 + rt * 16 + 4 * g + r) * DML + h * DH + v0 + c16;
                const float h0_ = (e4[r] * aI[0][r] + aX[0][r]) * rden, h1_ = (e4[r] * aI[1][r] + aX[1][r]) * rden;
                hraw[o] = h0_; hraw[o + 16] = h1_; }
            if (wave == 0 && c + 1 < NCH) {
                MLSTM_SMALLS(sb ^ 1, nic, nfc);
                const int c2 = (c + 2 < NCH) ? c + 2 : NCH - 1;
                nic = gi[(size_t)(b * SEQ + c2 * LCH + lane) * 4 + h]; nfc = gf[(size_t)(b * SEQ + c2 * LCH + lane) * 4 + h];
            }
            __syncthreads();
        }
#undef MLSTM_SMALLS
    } else {
        const int wB = wave - 4;
        f32x4 accC[4][3];
#pragma unroll
        for (int dt = 0; dt < 4; ++dt)
#pragma unroll
            for (int vt = 0; vt < 3; ++vt) accC[dt][vt] = (f32x4){0.f, 0.f, 0.f, 0.f};
        v4u_t r8[8];
        { const int lane = tid & 63, g = lane >> 4, c16 = lane & 15;
          const bf16_t* src8 = kT + (size_t)(b * SEQ + prow + c16) * DH + g * 8;
#pragma unroll
          for (int i = 0; i < 8; ++i) r8[i] = *(const v4u_t*)(src8 + i * 32); }
        __syncthreads();
#pragma unroll 1
        for (int c = 0; c < NCH; ++c) {
            const int sb = c & 1;
            int tl = tid; asm volatile("" : "+v"(tl));
            const int lane = tl & 63, g = lane >> 4, c16 = lane & 15, q4 = c16 >> 2, p4 = lane & 3;
            LAS3 unsigned char* CBn = L + CB0 + (sb ^ 1) * CBSZ;
#pragma unroll
            for (int i = 0; i < 8; ++i) *(LAS3 v4u_t*)(L + KS + (prow + c16) * QST + (g + 4 * i) * 16) = r8[i];
            if (wave == 4) *(LAS3 unsigned short*)(L + WV + lane * VST + 64) = (unsigned short)pg8::cvt_pk_bf16(SMF(sb, 768)[lane], 0.f);
            __syncthreads();
            { const int t1 = b * SEQ + ((c + 1 < NCH) ? c + 1 : c) * LCH;
              const bf16_t* src8 = kT + (size_t)(t1 + prow + c16) * DH + g * 8;
#pragma unroll
              for (int i = 0; i < 8; ++i) r8[i] = *(const v4u_t*)(src8 + i * 32); }
            const float decay = SMF(sb, 1280)[1];
#pragma unroll
            for (int dt = 0; dt < 4; ++dt)
#pragma unroll
                for (int v3 = 0; v3 < 3; ++v3) accC[dt][v3] *= decay;
#pragma unroll
            for (int ks = 0; ks < 2; ++ks) { bf16x8 af[4], bfr[3];
#pragma unroll
                for (int dt = 0; dt < 4; ++dt) { LAS3 unsigned char* kp = L + KS + (ks * 32 + g * 8 + q4) * QST + ((4 * wB + dt) * 16 + 4 * p4) * 2; af[dt] = tr8(kp, kp + 4 * QST); }
#pragma unroll
                for (int v3 = 0; v3 < 3; ++v3) { LAS3 unsigned char* wp = L + WV + (ks * 32 + g * 8 + q4) * VST + (v3 * 16 + 4 * p4) * 2; bfr[v3] = tr8(wp, wp + 4 * VST); }
#pragma unroll
                for (int dt = 0; dt < 4; ++dt)
#pragma unroll
                    for (int v3 = 0; v3 < 3; ++v3) accC[dt][v3] = __builtin_amdgcn_mfma_f32_16x16x32_bf16(af[dt], bfr[v3], accC[dt][v3], 0, 0, 0); }
#pragma unroll
            for (int dt = 0; dt < 4; ++dt)
#pragma unroll
                for (int v3 = 0; v3 < 3; ++v3) { const int d = (4 * wB + dt) * 16 + 4 * g, vp = v3 * 16 + c16;
                    *(LAS3 v2u_t*)(CBn + vp * QST + d * 2) = (v2u_t){pg8::cvt_pk_bf16(accC[dt][v3][0], accC[dt][v3][1]), pg8::cvt_pk_bf16(accC[dt][v3][2], accC[dt][v3][3])}; }
            __syncthreads();
        }
    }
#undef SMF
}

__device__ __forceinline__ void p3_finalize(const Params& P, int G, int bid) {
    const int lane = threadIdx.x & 63, wave = threadIdx.x >> 6;
    const float* hraw = (const float*)(P.ws + WS_HRAW); const bf16_t* oT = (const bf16_t*)(P.ws + WS_QKVO) + (size_t)12 * T * DH; bf16_t* mix = (bf16_t*)(P.ws + WS_MIXIN);
    for (int idx = bid * NWAVES + wave; idx < T * NH; idx += G * NWAVES) {
        const int t = idx >> 2, hh = idx & 3;
        const float4 hv = *(const float4*)(hraw + (size_t)t * DML + hh * DH + lane * 4);
        const float ss = wave_sum((hv.x * hv.x + hv.y * hv.y) + (hv.z * hv.z + hv.w * hv.w));
        const float r = rsqrtf(ss * (1.0f / DH) + EPS);
        const uint2 ow = *(const uint2*)(oT + ((size_t)hh * T + t) * DH + lane * 4);
        const float4 g = *(const float4*)(P.gm + hh * DH + lane * 4);
        const float o0 = 1.0f / (1.0f + expf(-bflo(ow.x))), o1 = 1.0f / (1.0f + expf(-bfhi(ow.x))), o2 = 1.0f / (1.0f + expf(-bflo(ow.y))), o3 = 1.0f / (1.0f + expf(-bfhi(ow.y)));
        *(uint2*)(mix + (size_t)t * D + DML + hh * DH + lane * 4) = make_uint2(pk2(o0 * (hv.x * r * g.x), o1 * (hv.y * r * g.y)), pk2(o2 * (hv.z * r * g.z), o3 * (hv.w * r * g.w)));
    }
}

template <int CTRL> __device__ __forceinline__ float dppf(float v) { return __int_as_float(__builtin_amdgcn_update_dpp(0, __float_as_int(v), CTRL, 0xF, 0xF, true)); }
__device__ __forceinline__ float grp16_max(float v) { v = fmaxf(v, dppf<0xB1>(v)); v = fmaxf(v, dppf<0x4E>(v)); v = fmaxf(v, dppf<0x141>(v)); v = fmaxf(v, dppf<0x140>(v)); return v; }
__device__ __forceinline__ float grp16_sum(float v) { v += dppf<0xB1>(v); v += dppf<0x4E>(v); v += dppf<0x141>(v); v += dppf<0x140>(v); return v; }
#define CEX(a, b) do { const float hi_ = fmaxf(a, b), lo_ = fminf(a, b); a = hi_; b = lo_; } while (0)
static __device__ const unsigned char CAND_AB[16][4] = {
    {0x00, 0x01, 0x02, 0x03}, {0x04, 0x05, 0x06, 0x07}, {0x08, 0x09, 0x0A, 0x0B}, {0x0C, 0x0D, 0x0E, 0x0F}, {0x10, 0x11, 0x12, 0x13}, {0x14, 0x15, 0x16, 0x17}, {0x20, 0x21, 0x22, 0x23}, {0x24, 0, 0, 0},
    {0x30, 0x31, 0x32, 0x33}, {0x40, 0x41, 0x42, 0}, {0x50, 0x60, 0x70, 0x80}, {0x90, 0xA0, 0xB0, 0xC0}, {0xD0, 0xE0, 0xF0, 0}, {0x51, 0x61, 0x71, 0}, {0, 0, 0, 0}, {0, 0, 0, 0}};
static __device__ const unsigned char CAND_N[16] = {4, 4, 4, 4, 4, 4, 4, 1, 4, 3, 4, 4, 3, 3, 0, 0};
__device__ __forceinline__ void p6_topk(const Params& P, unsigned char* lds_, int G, int bid) {
    typedef pg8::bf16x8 bf16x8; typedef pg8::f32x4 f32x4;
    LAS3 unsigned char* L = (LAS3 unsigned char*)lds_;
    constexpr int KST = 272, KHALF = 128 * KST;
    const int tid = threadIdx.x, lane = tid & 63, wave = tid >> 6, g = lane >> 4, c16 = lane & 15;
    for (int i = tid; i < 2 * 2048; i += NTHREADS) { const int hf = i >> 11, n = (i >> 4) & 127, d8 = (i & 15) * 8; const float* src = (hf ? P.sk2 : P.sk1) + n * 128 + d8;
        const float4 a = *(const float4*)src, b = *(const float4*)(src + 4);
        *(LAS3 v4u_t*)(L + hf * KHALF + n * KST + d8 * 2) = (v4u_t){pk2(a.x, a.y), pk2(a.z, a.w), pk2(b.x, b.y), pk2(b.z, b.w)}; }
    __syncthreads();
    const bf16_t* qvb = (const bf16_t*)(P.ws + WS_QV);
    int* idxo = (int*)(P.ws + WS_IDX); float* gato = (float*)(P.ws + WS_GATE);
    const float NEGINF = -__builtin_inff();
    unsigned ctab = 0; { const unsigned char* tp = CAND_AB[c16]; ctab = (unsigned)tp[0] | ((unsigned)tp[1] << 8) | ((unsigned)tp[2] << 16) | ((unsigned)tp[3] << 24); }
    const int ccnt = CAND_N[c16];
#pragma unroll 1
    for (int it = bid * NWAVES + wave; it < (T / 16) * PEER_H; it += G * NWAVES) {
        const int t0 = (it >> 3) * 16, hh = it & 7;
        float keepH[2][4];
#pragma unroll
        for (int hf = 0; hf < 2; ++hf) {
            asm volatile("" ::: "memory");
            bf16x8 af[4];
#pragma unroll
            for (int ks = 0; ks < 4; ++ks) af[ks] = *(const bf16x8*)(qvb + (size_t)(t0 + c16) * D + hh * 256 + hf * 128 + ks * 32 + g * 8);
            f32x4 acc[8];
#pragma unroll
            for (int ct = 0; ct < 8; ++ct) { acc[ct] = (f32x4){0.f, 0.f, 0.f, 0.f};
#pragma unroll
                for (int ks = 0; ks < 4; ++ks) { const bf16x8 bv = *(LAS3 bf16x8*)(L + hf * KHALF + (ct * 16 + c16) * KST + (ks * 32 + g * 8) * 2);
                    acc[ct] = __builtin_amdgcn_mfma_f32_16x16x32_bf16(af[ks], bv, acc[ct], 0, 0, 0); } }
            float v[4][8];
#pragma unroll
            for (int r = 0; r < 4; ++r) {
#pragma unroll
                for (int ct = 0; ct < 8; ++ct) v[r][ct] = __uint_as_float((__float_as_uint(acc[ct][r]) & ~127u) | (unsigned)(127 - (ct * 16 + c16)));
                CEX(v[r][0], v[r][1]); CEX(v[r][2], v[r][3]); CEX(v[r][4], v[r][5]); CEX(v[r][6], v[r][7]);
                CEX(v[r][0], v[r][2]); CEX(v[r][1], v[r][3]); CEX(v[r][4], v[r][6]); CEX(v[r][5], v[r][7]);
                CEX(v[r][1], v[r][2]); CEX(v[r][5], v[r][6]); CEX(v[r][0], v[r][4]); CEX(v[r][3], v[r][7]);
                CEX(v[r][1], v[r][5]); CEX(v[r][2], v[r][6]);
                CEX(v[r][1], v[r][4]); CEX(v[r][3], v[r][6]);
                CEX(v[r][2], v[r][4]); CEX(v[r][3], v[r][5]);
                CEX(v[r][3], v[r][4]);
                keepH[hf][r] = 0.f;
            }
#pragma unroll
            for (int rd = 0; rd < TOPK; ++rd) {
#pragma unroll
                for (int r = 0; r < 4; ++r) {
                    const float W = grp16_max(v[r][0]); const bool win = (v[r][0] == W);
                    if (c16 == rd) keepH[hf][r] = W;
#pragma unroll
                    for (int k = 0; k < 7; ++k) v[r][k] = win ? v[r][k + 1] : v[r][k];
                    v[r][7] = win ? NEGINF : v[r][7];
                }
            }
        }
#pragma unroll
        for (int r = 0; r < 4; ++r) {
            const float V1 = keepH[0][r], V2 = keepH[1][r];
            float cv[4];
#pragma unroll
            for (int s4 = 0; s4 < 4; ++s4) { const unsigned code = (ctab >> (8 * s4)) & 255u;
                const float x1 = __shfl(V1, g * 16 + (int)(code >> 4)), x2 = __shfl(V2, g * 16 + (int)(code & 15u));
                const float sum = __uint_as_float(__float_as_uint(x1) & ~127u) + __uint_as_float(__float_as_uint(x2) & ~127u);
                cv[s4] = (s4 < ccnt) ? __uint_as_float((__float_as_uint(sum) & ~255u) | (255u - code)) : NEGINF; }
            float keepc = 0.f;
#pragma unroll
            for (int rd = 0; rd < TOPK; ++rd) {
                const float W = grp16_max(cv[0]); const bool win = (cv[0] == W);
                if (c16 == rd) keepc = W;
                cv[0] = win ? cv[1] : cv[0]; cv[1] = win ? cv[2] : cv[1]; cv[2] = win ? cv[3] : cv[2]; cv[3] = win ? NEGINF : cv[3];
            }
            const unsigned kb = __float_as_uint(keepc), code = 255u - (kb & 255u);
            const unsigned n1 = 127u - (__float_as_uint(__shfl(V1, g * 16 + (int)(code >> 4))) & 127u), n2 = 127u - (__float_as_uint(__shfl(V2, g * 16 + (int)(code & 15u))) & 127u);
            const float sval = __uint_as_float(kb & ~255u), smax = __shfl(sval, g * 16);
            const float ex = __expf(sval - smax), den = grp16_sum(ex);
            const size_t o = (size_t)(t0 + 4 * g + r) * 128 + hh * 16 + c16;
            idxo[o] = (int)(n1 * 128u + n2); gato[o] = ex / den;
        }
    }
    __syncthreads();
}

__device__ __forceinline__ float wave_sum_dpp(float v) {
    v += dppf<0xB1>(v); v += dppf<0x4E>(v); v += dppf<0x141>(v); v += dppf<0x140>(v);
    const int iv = __float_as_int(v);
    return (__int_as_float(__builtin_amdgcn_readlane(iv, 0)) + __int_as_float(__builtin_amdgcn_readlane(iv, 16))) + (__int_as_float(__builtin_amdgcn_readlane(iv, 32)) + __int_as_float(__builtin_amdgcn_readlane(iv, 48)));
}
__device__ __forceinline__ float dot16_fp8(const v4u_t w, const float (&x)[16]) {
    float s = 0.f;
#pragma unroll
    for (int k = 0; k < 4; ++k) { const f32x2_t lo = __builtin_amdgcn_cvt_pk_f32_fp8(w[k], false), hi = __builtin_amdgcn_cvt_pk_f32_fp8(w[k], true);
        s += (x[4 * k] * lo.x + x[4 * k + 1] * lo.y) + (x[4 * k + 2] * hi.x + x[4 * k + 3] * hi.y); }
    return s;
}
__device__ __forceinline__ void axpy16_fp8(const v4u_t w, const float cf, float (&y)[16]) {
#pragma unroll
    for (int k = 0; k < 4; ++k) { const f32x2_t lo = __builtin_amdgcn_cvt_pk_f32_fp8(w[k], false), hi = __builtin_amdgcn_cvt_pk_f32_fp8(w[k], true);
        y[4 * k] += cf * lo.x; y[4 * k + 1] += cf * lo.y; y[4 * k + 2] += cf * hi.x; y[4 * k + 3] += cf * hi.y; }
}
#define PIN16(a, o) asm volatile("" : "+v"(a[o + 0]), "+v"(a[o + 1]), "+v"(a[o + 2]), "+v"(a[o + 3]), "+v"(a[o + 4]), "+v"(a[o + 5]), "+v"(a[o + 6]), "+v"(a[o + 7]), "+v"(a[o + 8]), "+v"(a[o + 9]), "+v"(a[o + 10]), "+v"(a[o + 11]), "+v"(a[o + 12]), "+v"(a[o + 13]), "+v"(a[o + 14]), "+v"(a[o + 15]))
typedef __bf16 v2bf_t __attribute__((ext_vector_type(2)));
typedef __bf16 v32bf_t __attribute__((ext_vector_type(32)));
typedef unsigned v16u_t __attribute__((ext_vector_type(16)));
__device__ __forceinline__ float row16_sum(float v) { v += dppf<0xB1>(v); v += dppf<0x4E>(v); v += dppf<0x141>(v); v += dppf<0x140>(v); return v; }
__device__ __forceinline__ void p7_peer(const Params& P, unsigned char* lds_, int G, int bid) {
    const int lane = threadIdx.x & 63, wave = __builtin_amdgcn_readfirstlane(threadIdx.x >> 6);
    LAS3 unsigned char* W = (LAS3 unsigned char*)lds_ + wave * 8192;
    const bf16_t* x1b = (const bf16_t*)(P.ws + WS_X1B); const float* ssq = (const float*)(P.ws + WS_SSQ);
    const int* idxi = (const int*)(P.ws + WS_IDX); const float* gati = (const float*)(P.ws + WS_GATE);
    const unsigned char* ub = P.ws + WS_UB; const unsigned char* vb = P.ws + WS_VB; const float* esc = (const float*)(P.ws + WS_ESC);
#pragma unroll 1
    for (int qd = bid * NWAVES + wave; qd < T / 4; qd += G * NWAVES) {
        int ln = lane; asm volatile("" : "+v"(ln));
        const int tb = qd * 4, q = ln >> 4, l16 = ln & 15, t = tb + q;
        const unsigned loff = (unsigned)l16 * 24u;
#pragma unroll 1
        for (int s4 = 0; s4 < 4; ++s4) {
            LAS3 int* hist = (LAS3 int*)(W + 4096); LAS3 int* base = (LAS3 int*)(W + 4096 + 256); LAS3 v2u_t* list = (LAS3 v2u_t*)(W + s4 * 1024);
            const size_t o = (size_t)(tb + s4) * 128 + ln;
            const int i0 = idxi[o], i1 = idxi[o + 64]; const float g0 = gati[o], g1 = gati[o + 64];
            hist[ln] = 0; asm volatile("s_waitcnt lgkmcnt(0)" ::: "memory");
            const int t0_ = __hip_atomic_fetch_add((int*)(hist + (i0 >> 8)), 1, __ATOMIC_RELAXED, __HIP_MEMORY_SCOPE_WORKGROUP);
            const int t1_ = __hip_atomic_fetch_add((int*)(hist + (i1 >> 8)), 1, __ATOMIC_RELAXED, __HIP_MEMORY_SCOPE_WORKGROUP);
            asm volatile("s_waitcnt lgkmcnt(0)" ::: "memory");
            const int cnt = hist[ln]; int inc = cnt;
#pragma unroll
            for (int o2 = 1; o2 < 64; o2 <<= 1) { const int tv = __shfl_up(inc, o2); if (ln >= o2) inc += tv; }
            base[ln] = inc - cnt; asm volatile("s_waitcnt lgkmcnt(0)" ::: "memory");
            list[base[i0 >> 8] + t0_] = (v2u_t){(unsigned)i0, __float_as_uint(g0)}; list[base[i1 >> 8] + t1_] = (v2u_t){(unsigned)i1, __float_as_uint(g1)};
            asm volatile("s_waitcnt lgkmcnt(0)" ::: "memory");
        }
        LAS3 v2u_t* mylist = (LAS3 v2u_t*)(W + q * 1024); LAS3 float* mydot = (LAS3 float*)(W + 4096 + q * 512);
        const float rs2 = rsqrtf(row16_sum(ssq[(size_t)t * 32 + l16] + ssq[(size_t)t * 32 + 16 + l16]) * (1.0f / D) + EPS);
        {
            unsigned xp[4][16];
#pragma unroll
            for (int jj = 0; jj < 4; ++jj) { const v4u_t* xs = (const v4u_t*)(x1b + (size_t)t * D + jj * 512 + l16 * 32);
#pragma unroll
                for (int k = 0; k < 4; ++k) { const v4u_t a = xs[k]; xp[jj][4 * k] = a.x; xp[jj][4 * k + 1] = a.y; xp[jj][4 * k + 2] = a.z; xp[jj][4 * k + 3] = a.w; } }
            v6u_t rb[4][4]; float rsc[4];
#define P7_LD1(j, b) do { const unsigned e_ = mylist[j].x; const unsigned char* rp = ub + (size_t)e_ * EROW + loff; rsc[b] = esc[e_ * 2]; \
            _Pragma("unroll") for (int jj = 0; jj < 4; ++jj) { const v2u_t* cp = (const v2u_t*)(rp + jj * 384); const v2u_t c0 = cp[0], c1 = cp[1], c2 = cp[2]; rb[b][jj] = (v6u_t){c0.x, c0.y, c1.x, c1.y, c2.x, c2.y}; } } while (0)
#define P7_D2(k_) __builtin_amdgcn_fdot2_f32_bf16((v2bf_t){w[2 * (k_)], w[2 * (k_) + 1]}, __builtin_bit_cast(v2bf_t, xp[jj][k_]),
#define P7_DOT1(j, b) do { float s0 = 0.f, s1 = 0.f, s2 = 0.f, s3 = 0.f; _Pragma("unroll") for (int jj = 0; jj < 4; ++jj) { asm volatile("" : "+v"(rb[b][jj])); \
                const v32bf_t w = __builtin_amdgcn_cvt_scalef32_pk32_bf16_fp6(rb[b][jj], rsc[b]);     \
                _Pragma("unroll") for (int i = 0; i < 16; i += 4) { s0 = P7_D2(i) s0, false); s1 = P7_D2(i + 1) s1, false); s2 = P7_D2(i + 2) s2, false); s3 = P7_D2(i + 3) s3, false); } } \
            const float tot = row16_sum((s0 + s1) + (s2 + s3)); if (l16 == 0) mydot[j] = tot; } while (0)
#pragma unroll
            for (int b = 0; b < 4; ++b) P7_LD1(b, b);
#pragma unroll 1
            for (int j = 0; j < 124; j += 4) {
#pragma unroll
                for (int b = 0; b < 4; ++b) { P7_DOT1(j + b, b); P7_LD1(j + 4 + b, b); } }
#pragma unroll
            for (int b = 0; b < 4; ++b) P7_DOT1(124 + b, b);
#undef P7_DOT1
#undef P7_D2
#undef P7_LD1
        }
        asm volatile("s_waitcnt lgkmcnt(0)" ::: "memory");
        { const float r0 = __int_as_float(__builtin_amdgcn_readlane(__float_as_int(rs2), 0)), r1 = __int_as_float(__builtin_amdgcn_readlane(__float_as_int(rs2), 16)),
                      r2 = __int_as_float(__builtin_amdgcn_readlane(__float_as_int(rs2), 32)), r3 = __int_as_float(__builtin_amdgcn_readlane(__float_as_int(rs2), 48));
#pragma unroll
          for (int k = 0; k < 8; ++k) { const int n = k * 64 + ln; const v2u_t en = *(LAS3 v2u_t*)(W + n * 8); LAS3 float* dp = (LAS3 float*)(W + 4096 + n * 4);
              const float rr = (k >> 1) == 0 ? r0 : (k >> 1) == 1 ? r1 : (k >> 1) == 2 ? r2 : r3;
              *dp = __uint_as_float(en.y) * gelu_erf(*dp * rr); } }
        asm volatile("s_waitcnt lgkmcnt(0)" ::: "memory");
        float y[4][32];
#pragma unroll
        for (int jj = 0; jj < 4; ++jj)
#pragma unroll
            for (int k = 0; k < 4; ++k) { float a[8]; unpack8(*(const uint4*)(x1b + (size_t)t * D + jj * 512 + l16 * 32 + 8 * k), a);
#pragma unroll
                for (int i = 0; i < 8; ++i) y[jj][8 * k + i] = a[i]; }
        {
            v6u_t bA[4], bB[4]; float scA = 1.f, scB = 1.f;
#define P7_LOADQ(j, Bf, SC) do { const unsigned e_ = mylist[j].x; const unsigned char* rp = vb + (size_t)e_ * EROW + loff; SC = esc[e_ * 2 + 1]; \
            _Pragma("unroll") for (int jj = 0; jj < 4; ++jj) { const v2u_t* cp = (const v2u_t*)(rp + jj * 384); const v2u_t c0 = cp[0], c1 = cp[1], c2 = cp[2]; Bf[jj] = (v6u_t){c0.x, c0.y, c1.x, c1.y, c2.x, c2.y}; } } while (0)
#define P7_AXQ(j, Bf, SC) do { const float cf = mydot[j]; _Pragma("unroll") for (int jj = 0; jj < 4; ++jj) { asm volatile("" : "+v"(Bf[jj])); const v32f_t w = __builtin_amdgcn_cvt_scalef32_pk32_f32_fp6(Bf[jj], SC); \
            _Pragma("unroll") for (int i = 0; i < 32; ++i) y[jj][i] += cf * w[i]; PIN16(y[jj], 0); PIN16(y[jj], 16); } } while (0)
            P7_LOADQ(0, bA, scA);
#pragma unroll 1
            for (int j = 0; j < 126; j += 2) { P7_LOADQ(j + 1, bB, scB); P7_AXQ(j, bA, scA); P7_LOADQ(j + 2, bA, scA); P7_AXQ(j + 1, bB, scB); }
            P7_LOADQ(127, bB, scB); P7_AXQ(126, bA, scA); P7_AXQ(127, bB, scB);
#undef P7_AXQ
#undef P7_LOADQ
        }
        float ss = 0.f;
        const float* grow = P.gfin + l16 * 32; float* orow = P.out + (size_t)t * D + l16 * 32;
#pragma unroll
        for (int jj = 0; jj < 4; ++jj)
#pragma unroll
            for (int i = 0; i < 32; ++i) ss += y[jj][i] * y[jj][i];
        ss = row16_sum(ss);
        const float r = rsqrtf(ss * (1.0f / D) + EPS);
#pragma unroll
        for (int jj = 0; jj < 4; ++jj)
#pragma unroll
            for (int k = 0; k < 8; ++k) { const float4 gg = *(const float4*)(grow + jj * 512 + 4 * k);
                const float4 ov = make_float4(y[jj][4 * k] * r * gg.x, y[jj][4 * k + 1] * r * gg.y, y[jj][4 * k + 2] * r * gg.z, y[jj][4 * k + 3] * r * gg.w);
                *(float4*)(orow + jj * 512 + 4 * k) = ov; }
    }
}
#undef PIN16

#define XB_TMO      128
#define XB_XCNT(j)  (256  + 64 * (j))
#define XB_XSUB(j)  (1280 + 64 * (j))
#define XB_XGEN(j)  (2304 + 64 * (j))
#define XB_TOP      3328
#define XB_TOPGEN   3392
#define XCD_BAR_WORDS 3456
#define XB_SPIN_CAP (1u << 18)

__device__ __forceinline__ unsigned xb_ld(unsigned* p)              { return __hip_atomic_load(p, __ATOMIC_RELAXED, __HIP_MEMORY_SCOPE_AGENT); }
__device__ __forceinline__ unsigned xb_add(unsigned* p, unsigned v) { return __hip_atomic_fetch_add(p, v, __ATOMIC_RELAXED, __HIP_MEMORY_SCOPE_AGENT); }
__device__ __forceinline__ unsigned xb_xcc_id() { return (unsigned)__builtin_amdgcn_s_getreg((3 << 11) | 20) & 0xFu; }
#define XB_SPIN(cond, bar) do { unsigned _sp = 0; while (cond) { __builtin_amdgcn_s_sleep(1); \
    if ((++_sp & 255u) == 0u) { if (xb_ld(&(bar)[XB_TMO])) break; if (_sp > XB_SPIN_CAP) { atomicAdd(&(bar)[XB_TMO], 1u); break; } } } } while (0)

struct XcdBarrier {
    unsigned* bar; unsigned x;
    volatile LAS3 unsigned* st;
};

__device__ __forceinline__ XcdBarrier xcd_barrier_post(unsigned* bar, volatile LAS3 unsigned* st) {
    XcdBarrier b; b.bar = bar; b.x = xb_xcc_id(); b.st = st;
    if (threadIdx.x == 0) (void)xb_add(&bar[XB_XCNT(b.x)], 1u);
    return b;
}
__device__ __forceinline__ void xcd_barrier_complete(unsigned* bar, unsigned x, unsigned& nloc, unsigned& nx) {
    const unsigned G = gridDim.x * gridDim.y * gridDim.z;
    unsigned sum, cnt, mine, sp = 0u;
    for (;;) {
        sum = 0u; cnt = 0u; mine = 0u;
#pragma unroll
        for (unsigned j = 0; j < 16; ++j) { const unsigned c = xb_ld(&bar[XB_XCNT(j)]); sum += c; cnt += (c > 0u) ? 1u : 0u; mine = (j == x) ? c : mine; }
        if (sum == G) break;
        __builtin_amdgcn_s_sleep(1);
        if ((++sp & 255u) == 0u) { if (xb_ld(&bar[XB_TMO])) break; if (sp > XB_SPIN_CAP) { atomicAdd(&bar[XB_TMO], 1u); break; } }
    }
    nloc = mine > 0u ? mine : 1u; nx = cnt > 0u ? cnt : 1u;
}

__device__ __forceinline__ void xcd_barrier(const XcdBarrier& b) {
    asm volatile("s_waitcnt vmcnt(0)" ::: "memory");
    __syncthreads();
    if (threadIdx.x == 0) {
        unsigned* bar = b.bar;
        __builtin_amdgcn_s_waitcnt(0);
        unsigned nloc = b.st[0], nx = b.st[1];
        if (nloc == 0u) { xcd_barrier_complete(bar, b.x, nloc, nx); b.st[0] = nloc; b.st[1] = nx; }
        const unsigned old = xb_add(&bar[XB_XSUB(b.x)], 1u);
        const unsigned gen = old / nloc;
        if (old + 1u == (gen + 1u) * nloc) {
            __builtin_amdgcn_fence(__ATOMIC_RELEASE, "agent");
            asm volatile("s_waitcnt vmcnt(0)" ::: "memory");
            const unsigned og = xb_add(&bar[XB_TOP], 1u);
            const unsigned tg = og / nx;
            if (og + 1u == (tg + 1u) * nx) xb_add(&bar[XB_TOPGEN], 1u);
            else XB_SPIN(xb_ld(&bar[XB_TOPGEN]) == tg, bar);
            __builtin_amdgcn_fence(__ATOMIC_ACQUIRE, "agent");
            xb_add(&bar[XB_XGEN(b.x)], 1u);
            asm volatile("s_waitcnt vmcnt(0)" ::: "memory");
        } else {
            XB_SPIN(xb_ld(&bar[XB_XGEN(b.x)]) == gen, bar);
            __builtin_amdgcn_fence(__ATOMIC_ACQUIRE, "agent");
            asm volatile("s_waitcnt vmcnt(0)" ::: "memory");
        }
    }
    __syncthreads();
}

__device__ __forceinline__ void sub_barrier(unsigned* cnt, unsigned n) {
    asm volatile("s_waitcnt vmcnt(0)" ::: "memory"); __syncthreads();
    if (threadIdx.x == 0) {
        __builtin_amdgcn_fence(__ATOMIC_RELEASE, "agent"); asm volatile("s_waitcnt vmcnt(0)" ::: "memory");
        (void)xb_add(cnt, 1u);
        unsigned sp = 0u; while (xb_ld(cnt) < n) { __builtin_amdgcn_s_sleep(2); if (++sp > (1u << 22)) break; }
        __builtin_amdgcn_fence(__ATOMIC_ACQUIRE, "agent"); asm volatile("s_waitcnt vmcnt(0)" ::: "memory");
    }
    __syncthreads();
}

constexpr int N_PHASES = 8;
#ifndef MK_N_LAUNCHES
#define MK_N_LAUNCHES 1
#endif
__global__ void __launch_bounds__(NTHREADS, 2) layer_fwd(Params P) {
    extern __shared__ __attribute__((aligned(16))) unsigned char lds[];
    const int G = gridDim.x, bid = blockIdx.x;
    volatile LAS3 unsigned* bst = (volatile LAS3 unsigned*)((LAS3 unsigned char*)lds + (LDS_BYTES - 16));
    if (threadIdx.x < 4) bst[threadIdx.x] = 0u;
    __syncthreads();
    XcdBarrier xbar = xcd_barrier_post((unsigned*)(P.ws + WS_CTL) + CW_BAR, bst);
    const int lo = P.ph_lo, hi = P.ph_hi;
#define IN(k) (lo <= (k) && (k) < hi)
#define SEAM(k) do { if (IN(k) && IN((k) + 1)) xcd_barrier(xbar); } while (0)
    if (IN(0)) { p0_rows(P, lds, G, bid); p0_weights_in(P, lds, G, bid); }
    SEAM(0);
    if (IN(1)) {
        const int c0 = (G > 64) ? PC_Q : 0;
        pg8::Gemm g{(const pg8::bf16_t*)(P.ws + WS_XB), (const pg8::bf16_t*)(P.ws + WS_WINT) + (size_t)c0 * D, T, NPROJ - c0, D}; pg8::StaticOrder S; S.init(T, NPROJ - c0, G, bid);
        pg8::EpiProjT E{(pg8::bf16_t*)(P.ws + WS_PROJ), (pg8::bf16_t*)(P.ws + WS_QKVO), c0 / 256, T, (const float*)(P.ws + WS_RS1)};
        pg8::gemm_phase<pg8::EpiProjT, pg8::StaticOrder, true, true>((PG8_LAS unsigned char*)lds, g, S, E);
    }
    SEAM(1);
    if (IN(2)) {
        for (int u = bid; u < 64; u += G) mlstm_unit(P, lds, u, (float*)(P.ws + WS_HRAW));
        if (G > 64) { if (bid >= 64) {
            { pg8::Gemm g{(const pg8::bf16_t*)(P.ws + WS_XB), (const pg8::bf16_t*)(P.ws + WS_WINT), T, PC_Q, D}; pg8::StaticOrder S; S.init(T, PC_Q, G - 64, bid - 64);
              pg8::EpiProjT E{(pg8::bf16_t*)(P.ws + WS_PROJ), (pg8::bf16_t*)(P.ws + WS_QKVO), 0, T, (const float*)(P.ws + WS_RS1)};
              pg8::gemm_phase<pg8::EpiProjT, pg8::StaticOrder, true, true>((PG8_LAS unsigned char*)lds, g, S, E); }
            sub_barrier((unsigned*)(P.ws + WS_CTL) + 8192, (unsigned)(G - 64));
            p2_conv(P, G - 64, bid - 64); p2_weights_sq(P, lds, G - 64, bid - 64); p0_tables(P, G - 64, bid - 64); } }
        else { p2_conv(P, G, bid); p2_weights_sq(P, lds, G, bid); p0_tables(P, G, bid); }
    }
    SEAM(2);
    if (IN(3)) p3_finalize(P, G, bid);
    SEAM(3);
    if (IN(4)) {
        pg8::Gemm g{(const pg8::bf16_t*)(P.ws + WS_MIXIN), (const pg8::bf16_t*)(P.ws + WS_WOUTT), T, D, D}; pg8::StaticOrder S; S.init(T, D, G, bid);
        pg8::EpiOut E{P.x, (pg8::bf16_t*)(P.ws + WS_X1B), (float*)(P.ws + WS_SSQ), D};
        pg8::gemm_phase<pg8::EpiOut, pg8::StaticOrder, false, true>((PG8_LAS unsigned char*)lds, g, S, E);
    }
    SEAM(4);
    if (IN(5)) {
        pg8::Gemm g{(const pg8::bf16_t*)(P.ws + WS_X1B), (const pg8::bf16_t*)(P.ws + WS_WQT), T, D, D}; pg8::StaticOrder S; S.init(T, D, G, bid);
        pg8::EpiQb E{(pg8::bf16_t*)(P.ws + WS_QV), D, (const float*)(P.ws + WS_SSQ)};
        pg8::gemm_phase<pg8::EpiQb, pg8::StaticOrder, false, true>((PG8_LAS unsigned char*)lds, g, S, E);
    }
    SEAM(5);
    if (IN(6)) p6_topk(P, lds, G, bid);
    SEAM(6);
    if (IN(7)) p7_peer(P, lds, G, bid);
#undef IN
#undef SEAM
}

extern "C" void kernel_launch(void* const* d_in, const int* in_sizes, int n_in, void* d_out, int out_size, void* d_ws, size_t ws_size, hipStream_t stream) {
    static int grid = 0;
    if (grid == 0) {
        if (n_in != 15 || in_sizes[0] != T * D || out_size != T * D || ws_size < WS_END) { fprintf(stderr, "kernel_launch: unexpected shapes (n_in %d, in0 %d, out %d, ws %zu); nothing launched\n", n_in, n_in > 0 ? in_sizes[0] : -1, out_size, ws_size); grid = -1; return; }
        int dev = 0, cus = 0, per_cu = 0;
        if (hipGetDevice(&dev) != hipSuccess || hipDeviceGetAttribute(&cus, hipDeviceAttributeMultiprocessorCount, dev) != hipSuccess) { grid = -1; return; }
        if (hipFuncSetAttribute((const void*)layer_fwd, hipFuncAttributeMaxDynamicSharedMemorySize, LDS_BYTES) != hipSuccess) { fprintf(stderr, "kernel_launch: hipFuncSetAttribute failed\n"); grid = -1; return; }
        if (hipOccupancyMaxActiveBlocksPerMultiprocessor(&per_cu, (const void*)layer_fwd, NTHREADS, LDS_BYTES) != hipSuccess || per_cu < 1) { fprintf(stderr, "kernel_launch: occupancy query says %d blocks per CU\n", per_cu); (void)hipGetLastError(); grid = -1; return; }
        grid = cus;
    }
    if (grid < 0) return;
    Params p{};
    p.x = (const float*)d_in[0]; p.g1 = (const float*)d_in[1]; p.w_in = (const float*)d_in[2]; p.b_ig = (const float*)d_in[3]; p.b_fg = (const float*)d_in[4];
    p.conv_w = (const float*)d_in[5]; p.gm = (const float*)d_in[6]; p.w_out = (const float*)d_in[7]; p.g2 = (const float*)d_in[8]; p.w_q = (const float*)d_in[9];
    p.sk1 = (const float*)d_in[10]; p.sk2 = (const float*)d_in[11]; p.eu = (const float*)d_in[12]; p.ev = (const float*)d_in[13]; p.gfin = (const float*)d_in[14];
    p.out = (float*)d_out; p.ws = (unsigned char*)d_ws;
    if (hipMemsetAsync((char*)d_ws + WS_CTL, 0, CTL_ZERO_BYTES, stream) != hipSuccess) { fprintf(stderr, "kernel_launch: hipMemsetAsync failed\n"); return; }
    for (int li = 0; li < MK_N_LAUNCHES; ++li) {
        p.ph_lo = (MK_N_LAUNCHES == 1) ? 0 : li; p.ph_hi = (MK_N_LAUNCHES == 1) ? N_PHASES : li + 1;
        void* args[] = {&p};
        const hipError_t e = hipLaunchCooperativeKernel((const void*)layer_fwd, dim3(grid), dim3(NTHREADS), args, LDS_BYTES, stream);
        if (e != hipSuccess) { fprintf(stderr, "kernel_launch: cooperative launch %d failed: %s (grid %d)\n", li, hipGetErrorString(e), grid); break; }
    }
}
```

```cpp
#include <hip/hip_runtime.h>
#include <hip/hip_cooperative_groups.h>
#include <cstdio>
#include <cstdint>
namespace cg = cooperative_groups;
namespace pg8 {
#define PG8_LAS __attribute__((address_space(3)))
typedef unsigned short bf16_t;
typedef short bf16x8 __attribute__((ext_vector_type(8)));
typedef float f32x4 __attribute__((ext_vector_type(4)));
typedef unsigned u32x4 __attribute__((ext_vector_type(4)));
constexpr int BM = 256, BK = 64, HALF = 128, HTB = HALF * BK * 2  , STAGE_BYTES = 8 * HTB, NXCD = 8, WGM = 8;

__host__ __device__ __forceinline__ int lds_byte(int r, int c) { const int st = (r >> 4) * 2 + (c >> 5), rr = r & 15, cc = c & 31, ob = rr * 64 + cc * 2; return st * 1024 + (ob ^ (((ob >> 9) & 1) << 5)); }
__host__ __device__ __forceinline__ void stage_rc(int b, int& R, int& C) { const int st = b / 1024, sb = b % 1024, swz = sb ^ (((sb >> 9) & 1) << 5); R = (st >> 1) * 16 + swz / 64; C = (st & 1) * 32 + (swz % 64) / 2; }
__host__ __device__ __forceinline__ int perm32(int rho) { const int n = rho >> 4, i = rho & 15; return 8 * (i >> 2) + 4 * n + (i & 3); }

struct Unit { int pm, pn; };
struct Gemm { const bf16_t* A; const bf16_t* Bt; int M, N, K; };

struct StaticOrder {
    int nM, nN, nwg, G, c;
    __host__ __device__ void init(int M, int N, int G_, int c_) { nM = M / BM; nN = N / BM; nwg = nM * nN; G = G_; c = c_; }
    __host__ __device__ bool next(int i, Unit& u) const {
        const long L = (long)i * G + c; if (L >= nwg) return false;
        int wgid = (int)L; { const int q = nwg / NXCD, r = nwg % NXCD, xcd = wgid % NXCD, off = wgid / NXCD; wgid = (xcd < r ? xcd * (q + 1) : r * (q + 1) + (xcd - r) * q) + off; }
        const int nig = WGM * nN, gid = wgid / nig, fm = gid * WGM, gsz = (nM - fm) < WGM ? (nM - fm) : WGM;
        u.pm = fm + ((wgid % nig) % gsz); u.pn = (wgid % nig) / gsz; return true;
    }
    __device__ __forceinline__ void a_ready(const Unit&) const {}
    __device__ __forceinline__ void done(const Unit&) const {}
};

__device__ __forceinline__ unsigned cvt_pk_bf16(float lo, float hi) { unsigned r; asm volatile("v_cvt_pk_bf16_f32 %0, %1, %2" : "=v"(r) : "v"(lo), "v"(hi)); return r; }
struct EpiProj {
    static constexpr bool PERM = true, AFTER_DRAIN = false;
    bf16_t* O; int ldc; const float* rs;
    __device__ __forceinline__ void operator()(const f32x4 (&acc)[2][2][4][2], const Unit& u, int wr, int wc, int fr, int fq) const {
        const int row0 = u.pm * BM + wr * 64 + fr, col0 = u.pn * BM + wc * 32 + 8 * fq;
#pragma unroll
        for (int ai = 0; ai < 2; ++ai)
#pragma unroll
            for (int m = 0; m < 4; ++m) { const int row = row0 + ai * HALF + m * 16; const float s = rs[row]; bf16_t* rowp = O + (size_t)row * ldc + col0;
#pragma unroll
                for (int bj = 0; bj < 2; ++bj) { const f32x4 v0 = acc[ai][bj][m][0] * s, v1 = acc[ai][bj][m][1] * s; u32x4 w;
                    w.x = cvt_pk_bf16(v0[0], v0[1]); w.y = cvt_pk_bf16(v0[2], v0[3]); w.z = cvt_pk_bf16(v1[0], v1[1]); w.w = cvt_pk_bf16(v1[2], v1[3]);
                    *(u32x4*)(rowp + bj * HALF) = w; } }
    }
};
struct EpiProjT {
    static constexpr bool PERM = true, AFTER_DRAIN = false;
    bf16_t* O; bf16_t* Q; int pn0, trows; const float* rs;
    __device__ __forceinline__ void operator()(const f32x4 (&acc)[2][2][4][2], const Unit& u, int wr, int wc, int fr, int fq) const {
        const int pn = u.pn + pn0; bf16_t* base = (pn < 12) ? O + pn * BM : Q + (size_t)(pn - 12) * trows * BM; const int ld = (pn < 12) ? 3072 : BM;
        const int row0 = u.pm * BM + wr * 64 + fr, col0 = wc * 32 + 8 * fq;
#pragma unroll
        for (int ai = 0; ai < 2; ++ai)
#pragma unroll
            for (int m = 0; m < 4; ++m) { const int row = row0 + ai * HALF + m * 16; const float s = rs[row]; bf16_t* rowp = base + (size_t)row * ld + col0;
#pragma unroll
                for (int bj = 0; bj < 2; ++bj) { const f32x4 v0 = acc[ai][bj][m][0] * s, v1 = acc[ai][bj][m][1] * s; u32x4 w;
                    w.x = cvt_pk_bf16(v0[0], v0[1]); w.y = cvt_pk_bf16(v0[2], v0[3]); w.z = cvt_pk_bf16(v1[0], v1[1]); w.w = cvt_pk_bf16(v1[2], v1[3]);
                    *(u32x4*)(rowp + bj * HALF) = w; } }
    }
};
struct EpiOut {
    static constexpr bool PERM = true, AFTER_DRAIN = false;
    const float* X; bf16_t* X1B; float* SSQ; int ldc;
    __device__ __forceinline__ void operator()(const f32x4 (&acc)[2][2][4][2], const Unit& u, int wr, int wc, int fr, int fq) const {
        const int row0 = u.pm * BM + wr * 64 + fr, col0 = u.pn * BM + wc * 32 + 8 * fq;
#pragma unroll
        for (int ai = 0; ai < 2; ++ai) {
            f32x4 xv[4][2][2];
#pragma unroll
            for (int m = 0; m < 4; ++m)
#pragma unroll
                for (int bj = 0; bj < 2; ++bj) { const size_t c = (size_t)(row0 + ai * HALF + m * 16) * ldc + col0 + bj * HALF; xv[m][bj][0] = *(const f32x4*)(X + c); xv[m][bj][1] = *(const f32x4*)(X + c + 4); }
            asm volatile("" ::: "memory");
#pragma unroll
            for (int m = 0; m < 4; ++m) { const int row = row0 + ai * HALF + m * 16; const size_t off = (size_t)row * ldc + col0; float ss = 0.f;
#pragma unroll
                for (int bj = 0; bj < 2; ++bj) { const size_t c = off + bj * HALF;
                    const f32x4 o0 = xv[m][bj][0] + acc[ai][bj][m][0], o1 = xv[m][bj][1] + acc[ai][bj][m][1];
                    ss += ((o0[0] * o0[0] + o0[1] * o0[1]) + (o0[2] * o0[2] + o0[3] * o0[3])) + ((o1[0] * o1[0] + o1[1] * o1[1]) + (o1[2] * o1[2] + o1[3] * o1[3]));
                    u32x4 w; w.x = cvt_pk_bf16(o0[0], o0[1]); w.y = cvt_pk_bf16(o0[2], o0[3]); w.z = cvt_pk_bf16(o1[0], o1[1]); w.w = cvt_pk_bf16(o1[2], o1[3]);
                    *(u32x4*)(X1B + c) = w; }
                ss += __shfl_xor(ss, 16); ss += __shfl_xor(ss, 32);
                if (fq == 0) SSQ[(size_t)row * 32 + u.pn * 4 + wc] = ss; }
        }
    }
};
struct EpiQ {
    static constexpr bool PERM = false, AFTER_DRAIN = false;
    float* O; int ldc;
    __device__ __forceinline__ void operator()(const f32x4 (&acc)[2][2][4][2], const Unit& u, int wr, int wc, int fr, int fq) const {
        const int row0 = u.pm * BM + wr * 64 + fr, col0 = u.pn * BM + wc * 32 + 4 * fq;
#pragma unroll
        for (int ai = 0; ai < 2; ++ai)
#pragma unroll
            for (int m = 0; m < 4; ++m) { const size_t off = (size_t)(row0 + ai * HALF + m * 16) * ldc + col0;
#pragma unroll
                for (int bj = 0; bj < 2; ++bj)
#pragma unroll
                    for (int n = 0; n < 2; ++n) *(f32x4*)(O + off + bj * HALF + n * 16) = acc[ai][bj][m][n]; }
    }
};
struct EpiQb {
    static constexpr bool PERM = true, AFTER_DRAIN = false;
    bf16_t* O; int ldc; const float* SSQ;
    __device__ __forceinline__ void operator()(const f32x4 (&acc)[2][2][4][2], const Unit& u, int wr, int wc, int fr, int fq) const {
        const int row0 = u.pm * BM + wr * 64 + fr, col0 = u.pn * BM + wc * 32 + 8 * fq;
#pragma unroll
        for (int ai = 0; ai < 2; ++ai)
#pragma unroll
            for (int m = 0; m < 4; ++m) { const int row = row0 + ai * HALF + m * 16; const f32x4* sp = (const f32x4*)(SSQ + (size_t)row * 32);
                f32x4 s4 = sp[0];
#pragma unroll
                for (int i = 1; i < 8; ++i) s4 += sp[i];
                const float s = rsqrtf(((s4[0] + s4[1]) + (s4[2] + s4[3])) * (1.0f / 2048.0f) + 1e-6f); bf16_t* rowp = O + (size_t)row * ldc + col0;
#pragma unroll
                for (int bj = 0; bj < 2; ++bj) { const f32x4 v0 = acc[ai][bj][m][0] * s, v1 = acc[ai][bj][m][1] * s; u32x4 w;
                    w.x = cvt_pk_bf16(v0[0], v0[1]); w.y = cvt_pk_bf16(v0[2], v0[3]); w.z = cvt_pk_bf16(v1[0], v1[1]); w.w = cvt_pk_bf16(v1[2], v1[3]);
                    *(u32x4*)(rowp + bj * HALF) = w; } }
    }
};
template <class Epi, class Sched, bool ALIGN_EPI = false, bool SP2 = false>
__device__ __forceinline__ void gemm_phase(PG8_LAS unsigned char* lds, const Gemm g, const Sched& S, const Epi& E) {
    const int tid = threadIdx.x, wid = __builtin_amdgcn_readfirstlane(tid >> 6), lane = tid & 63, wr = wid >> 2, wc = wid & 3, fr = lane & 15, fq = lane >> 4;
    const int K = g.K, nt = K / BK;
    unsigned voffA[2], voffB[2];
#pragma unroll
    for (int i = 0; i < 2; ++i) { int R, C; stage_rc(tid * 16 + i * 8192, R, C); const int Rb = Epi::PERM ? ((R & ~31) + perm32(R & 31)) : R;
        voffA[i] = (unsigned)(R * K + C) * 2u; voffB[i] = (unsigned)(Rb * K + C) * 2u; }
    const size_t kstep = (size_t)(BK * 2);
    const size_t hstep = (size_t)HALF * K * 2;
    const size_t tstep = 2 * hstep;
    const unsigned ldsw = (unsigned)wid * 1024u;
    const int aoff = lds_byte(wr * 64 + fr, fq * 8), boff = lds_byte(wc * 32 + fr, fq * 8);
#define PG8_SA(b, h) (((b) * 2 + (h)) * HTB)
#define PG8_SB(b, h) ((4 + (b) * 2 + (h)) * HTB)
#define PG8_STAGE(bufoff, gbase, voff) do { _Pragma("unroll") for (int _i = 0; _i < 2; ++_i) \
        __builtin_amdgcn_global_load_lds((const unsigned*)((const char*)(gbase) + (voff)[_i]), (PG8_LAS unsigned*)(lds + (bufoff) + ldsw + _i * 8192), 16, 0, 0); } while (0)
#define PG8_LDA(dst, b, h) do { _Pragma("unroll") for (int m = 0; m < 4; ++m) _Pragma("unroll") for (int k = 0; k < 2; ++k) dst[m][k] = *(const PG8_LAS bf16x8*)(lds + PG8_SA(b, h) + aoff + m * 2048 + k * 1024); } while (0)
#define PG8_LDB(dst, b, h) do { _Pragma("unroll") for (int n = 0; n < 2; ++n) _Pragma("unroll") for (int k = 0; k < 2; ++k) dst[n][k] = *(const PG8_LAS bf16x8*)(lds + PG8_SB(b, h) + boff + n * 2048 + k * 1024); } while (0)
#define PG8_MMA(ai, bj, At, Bt) do { __builtin_amdgcn_s_setprio(1); _Pragma("unroll") for (int m = 0; m < 4; ++m) _Pragma("unroll") for (int n = 0; n < 2; ++n) _Pragma("unroll") for (int k = 0; k < 2; ++k) \
        acc[ai][bj][m][n] = __builtin_amdgcn_mfma_f32_16x16x32_bf16(Bt[n][k], At[m][k], acc[ai][bj][m][n], 0, 0, 0); __builtin_amdgcn_s_setprio(0); } while (0)
#define PG8_WAIT_V(n) asm volatile("s_waitcnt vmcnt(" #n ")" ::: "memory")
#define PG8_WAIT_L(n) asm volatile("s_waitcnt lgkmcnt(" #n ")" ::: "memory")
#define PG8_BAR __builtin_amdgcn_s_barrier()
#define PG8_SCHED __builtin_amdgcn_sched_barrier(0)
    Unit cur, nxt; int ui = 0;
    if (!S.next(0, cur)) return;
    f32x4 acc[2][2][4][2];
#pragma unroll
    for (int a = 0; a < 2; ++a)
#pragma unroll
        for (int b = 0; b < 2; ++b)
#pragma unroll
            for (int m = 0; m < 4; ++m)
#pragma unroll
                for (int n = 0; n < 2; ++n) acc[a][b][m][n] = (f32x4){0.f, 0.f, 0.f, 0.f};
    bf16x8 At[4][2], B0[2][2], B1[2][2];
    const char* cA = (const char*)g.A + (size_t)cur.pm * tstep; const char* cB = (const char*)g.Bt + (size_t)cur.pn * tstep;
    S.a_ready(cur);
    if constexpr (SP2) {
        PG8_STAGE(PG8_SB(0, 0), cB, voffB); PG8_STAGE(PG8_SB(0, 1), cB + hstep, voffB); PG8_STAGE(PG8_SA(0, 0), cA, voffA); PG8_STAGE(PG8_SA(0, 1), cA + hstep, voffA);
        if (wr == 1) PG8_BAR;
        PG8_WAIT_V(2); PG8_BAR;
        PG8_STAGE(PG8_SB(1, 0), cB + kstep, voffB); PG8_STAGE(PG8_SA(1, 0), cA + kstep, voffA); PG8_STAGE(PG8_SB(1, 1), cB + hstep + kstep, voffB);
        PG8_WAIT_V(6); PG8_BAR;
    } else {
        PG8_STAGE(PG8_SB(0, 0), cB, voffB); PG8_STAGE(PG8_SA(0, 0), cA, voffA); PG8_STAGE(PG8_SB(0, 1), cB + hstep, voffB); PG8_STAGE(PG8_SA(0, 1), cA + hstep, voffA);
        if (wr == 1) PG8_BAR;
        PG8_WAIT_V(4); PG8_BAR;
        PG8_STAGE(PG8_SB(1, 0), cB + kstep, voffB); PG8_STAGE(PG8_SA(1, 0), cA + kstep, voffA); PG8_STAGE(PG8_SB(1, 1), cB + hstep + kstep, voffB);
        PG8_WAIT_V(6); PG8_BAR;
    }
    for (;;) {
        const bool has_next = S.next(ui + 1, nxt);
        const char* nA = has_next ? (const char*)g.A + (size_t)nxt.pm * tstep : cA; const char* nB = has_next ? (const char*)g.Bt + (size_t)nxt.pn * tstep : cB;
        for (int t = 0; t < nt; t += 2) {
            const bool last = (t == nt - 2);
            const char* a1 = cA + (size_t)(t + 1) * kstep;
            const char* a2 = last ? nA : cA + (size_t)(t + 2) * kstep; const char* b2 = last ? nB : cB + (size_t)(t + 2) * kstep;
            const char* a3 = a2 + kstep; const char* b3 = b2 + kstep;
            if (last && has_next) S.a_ready(nxt);
            if constexpr (SP2) {
            PG8_LDB(B0, 0, 0); PG8_LDB(B1, 0, 1); PG8_SCHED; PG8_LDA(At, 0, 0); PG8_STAGE(PG8_SA(1, 1), a1 + hstep, voffA);
            PG8_WAIT_V(8); PG8_WAIT_L(0); PG8_BAR; PG8_MMA(0, 0, At, B0); PG8_MMA(0, 1, At, B1); PG8_BAR; PG8_SCHED;
            PG8_LDA(At, 0, 1); PG8_STAGE(PG8_SB(0, 0), b2, voffB); PG8_STAGE(PG8_SB(0, 1), b2 + hstep, voffB); PG8_STAGE(PG8_SA(0, 0), a2, voffA);
            PG8_WAIT_V(8); PG8_WAIT_L(0); PG8_BAR; PG8_MMA(1, 0, At, B0); PG8_MMA(1, 1, At, B1); PG8_BAR; PG8_SCHED;
            PG8_LDB(B0, 1, 0); PG8_LDB(B1, 1, 1); PG8_SCHED; PG8_LDA(At, 1, 0); PG8_STAGE(PG8_SA(0, 1), a2 + hstep, voffA);
            PG8_WAIT_V(8); PG8_WAIT_L(0); PG8_BAR; PG8_MMA(0, 0, At, B0); PG8_MMA(0, 1, At, B1); PG8_BAR; PG8_SCHED;
            PG8_LDA(At, 1, 1); PG8_STAGE(PG8_SB(1, 0), b3, voffB); PG8_STAGE(PG8_SB(1, 1), b3 + hstep, voffB); PG8_STAGE(PG8_SA(1, 0), a3, voffA);
            PG8_WAIT_V(8); PG8_WAIT_L(0); PG8_BAR; PG8_MMA(1, 0, At, B0); PG8_MMA(1, 1, At, B1); PG8_BAR; PG8_SCHED;
            } else {
            PG8_LDB(B0, 0, 0); PG8_SCHED; PG8_LDA(At, 0, 0); PG8_STAGE(PG8_SA(1, 1), a1 + hstep, voffA);
            PG8_WAIT_L(8); PG8_BAR; PG8_WAIT_L(0); PG8_MMA(0, 0, At, B0); PG8_BAR; PG8_SCHED;
            PG8_LDB(B1, 0, 1); PG8_STAGE(PG8_SB(0, 0), b2, voffB);
            PG8_BAR; PG8_WAIT_L(0); PG8_MMA(0, 1, At, B1); PG8_BAR;
            PG8_LDA(At, 0, 1); PG8_STAGE(PG8_SA(0, 0), a2, voffA);
            PG8_BAR; PG8_WAIT_L(0); PG8_MMA(1, 0, At, B0); PG8_BAR; PG8_SCHED;
            PG8_STAGE(PG8_SB(0, 1), b2 + hstep, voffB);
            PG8_WAIT_V(6); PG8_BAR; PG8_MMA(1, 1, At, B1); PG8_BAR;
            PG8_LDB(B0, 1, 0); PG8_SCHED; PG8_LDA(At, 1, 0); PG8_STAGE(PG8_SA(0, 1), a2 + hstep, voffA);
            PG8_WAIT_L(8); PG8_BAR; PG8_WAIT_L(0); PG8_MMA(0, 0, At, B0); PG8_BAR; PG8_SCHED;
            PG8_LDB(B1, 1, 1); PG8_STAGE(PG8_SB(1, 0), b3, voffB);
            PG8_BAR; PG8_WAIT_L(0); PG8_MMA(0, 1, At, B1); PG8_BAR;
            PG8_LDA(At, 1, 1); PG8_STAGE(PG8_SA(1, 0), a3, voffA);
            PG8_BAR; PG8_WAIT_L(0); PG8_MMA(1, 0, At, B0); PG8_BAR; PG8_SCHED;
            PG8_STAGE(PG8_SB(1, 1), b3 + hstep, voffB);
            PG8_WAIT_V(6); PG8_BAR; PG8_MMA(1, 1, At, B1); PG8_BAR;
            }
        }
        if constexpr (ALIGN_EPI) { if (wr == 0) PG8_BAR; }
        if constexpr (!Epi::AFTER_DRAIN) { E(acc, cur, wr, wc, fr, fq); S.done(cur); }
        if (!has_next) break;
#pragma unroll
        for (int a = 0; a < 2; ++a)
#pragma unroll
            for (int b = 0; b < 2; ++b)
#pragma unroll
                for (int m = 0; m < 4; ++m)
#pragma unroll
                    for (int n = 0; n < 2; ++n) acc[a][b][m][n] = (f32x4){0.f, 0.f, 0.f, 0.f};
        cur = nxt; cA = nA; cB = nB; ++ui;
        if constexpr (ALIGN_EPI) { if (wr == 1) PG8_BAR; }
    }
    PG8_WAIT_V(0);
    if constexpr (!ALIGN_EPI) { if (wr == 0) PG8_BAR; }
    PG8_BAR;
    if constexpr (Epi::AFTER_DRAIN) { E.fused(acc, cur, wr, wc, fr, fq, lds, wid, lane); S.done(cur); }
#undef PG8_SA
#undef PG8_SB
#undef PG8_STAGE
#undef PG8_LDA
#undef PG8_LDB
#undef PG8_MMA
#undef PG8_WAIT_V
#undef PG8_WAIT_L
#undef PG8_BAR
#undef PG8_SCHED
}
}
constexpr int T = 8192, SEQ = 4096, D = 2048, NPROJ = 7168, NIN = 7176, NPC = 3072;
constexpr int NH = 4, DH = 256, LCH = 64, DML = 1024;
constexpr int NEXP = 16384, PEER_H = 8, TOPK = 16;
constexpr float EPS = 1e-6f;
constexpr int PC_CX = 0, PC_CB = 1024, PC_CC = 2048, PC_Q = 3072, PC_K = 4096, PC_V = 5120, PC_O = 6144;
constexpr int NTHREADS = 512, NWAVES = 8;
constexpr int LDS_BYTES = 147456;

constexpr size_t MiB = 1u << 20;
constexpr size_t WS_CTL = 0, CTL_ZERO_BYTES = 64 * 1024;
constexpr int CW_BAR = 1024;
constexpr size_t WS_RS1 = 1 * MiB, WS_GI = 1 * MiB + 64 * 1024, WS_GF = 1 * MiB + 256 * 1024, WS_SSQ = 3 * MiB, WS_ESC = 4 * MiB;
constexpr size_t WS_XB = 5 * MiB, WS_WINT = 37 * MiB, WS_WOUTT = 65 * MiB, WS_WQT = 73 * MiB;
constexpr size_t WS_PROJ = 81 * MiB, WS_QKVO = 129 * MiB;
constexpr size_t WS_X1 = 81 * MiB, WS_X1B = 145 * MiB;
constexpr size_t WS_HRAW = 193 * MiB, WS_MIXIN = 225 * MiB, WS_QV = 257 * MiB, WS_IDX = 321 * MiB, WS_GATE = 325 * MiB;
constexpr size_t WS_UB = 329 * MiB, WS_VB = 393 * MiB, WS_END = 457 * MiB;

struct Params {
    const float *x, *g1, *w_in, *b_ig, *b_fg, *conv_w, *gm, *w_out, *g2, *w_q, *sk1, *sk2, *eu, *ev, *gfin;
    float* out; unsigned char* ws;
    int ph_lo, ph_hi;
};

typedef unsigned short bf16_t;
typedef unsigned v4u_t __attribute__((ext_vector_type(4)));
typedef unsigned v2u_t __attribute__((ext_vector_type(2)));
__device__ __forceinline__ unsigned f2bf(float f) { unsigned u = __float_as_uint(f); return (u + 0x7fffu + ((u >> 16) & 1u)) >> 16; }
__device__ __forceinline__ unsigned pk2(float lo, float hi) { return f2bf(lo) | (f2bf(hi) << 16); }
__device__ __forceinline__ float bflo(unsigned w) { return __uint_as_float(w << 16); }
__device__ __forceinline__ float bfhi(unsigned w) { return __uint_as_float(w & 0xffff0000u); }
__device__ __forceinline__ float bf1(bf16_t h) { return __uint_as_float((unsigned)h << 16); }
__device__ __forceinline__ float wave_sum(float v) {
#pragma unroll
    for (int o = 32; o >= 1; o >>= 1) v += __shfl_xor(v, o);
    return v;
}
__device__ __forceinline__ void unpack8(const uint4 w, float (&f)[8]) {
    f[0] = bflo(w.x); f[1] = bfhi(w.x); f[2] = bflo(w.y); f[3] = bfhi(w.y); f[4] = bflo(w.z); f[5] = bfhi(w.z); f[6] = bflo(w.w); f[7] = bfhi(w.w);
}
__device__ __forceinline__ float log_sigmoid(float z) { return z >= 0.f ? -log1pf(expf(-z)) : z - log1pf(expf(z)); }
__device__ __forceinline__ float gelu_erf(float v) { return 0.5f * v * (1.0f + erff(v * 0.70710678118654752f)); }

__device__ __forceinline__ void p0_rows(const Params& P, unsigned char* lds, int G, int bid) {
    float* wg = (float*)lds;
    const int tid = threadIdx.x, lane = tid & 63, wave = tid >> 6;
    {
    for (int i = tid; i < 2 * D; i += NTHREADS) { const int k = i >> 1, hf = i & 1; const float4 w4 = *(const float4*)(P.w_in + (size_t)k * NIN + NPROJ + hf * 4); const float gk = P.g1[k];
        wg[(hf * 4 + 0) * D + k] = w4.x * gk; wg[(hf * 4 + 1) * D + k] = w4.y * gk; wg[(hf * 4 + 2) * D + k] = w4.z * gk; wg[(hf * 4 + 3) * D + k] = w4.w * gk; }
    __syncthreads(); }
    float* rs1 = (float*)(P.ws + WS_RS1); float* gi = (float*)(P.ws + WS_GI); float* gf = (float*)(P.ws + WS_GF); bf16_t* xb = (bf16_t*)(P.ws + WS_XB);
    float big[4], bfg[4];
#pragma unroll
    for (int h = 0; h < 4; ++h) { big[h] = P.b_ig[h]; bfg[h] = P.b_fg[h]; }
    for (int tp = bid * NWAVES + wave; tp < T / 2; tp += G * NWAVES) {
        const int t = tp * 2;
        const float4* xr = (const float4*)(P.x + (size_t)t * D);
        float ss[2] = {0.f, 0.f}, dg[2][8];
#pragma unroll
        for (int g = 0; g < 8; ++g) { dg[0][g] = 0.f; dg[1][g] = 0.f; }
        float4 v[2][8];
#pragma unroll
        for (int rr = 0; rr < 2; ++rr)
#pragma unroll
            for (int j = 0; j < 8; ++j) v[rr][j] = xr[rr * (D / 4) + j * 64 + lane];
#pragma unroll 1
        for (int j = 0; j < 8; ++j) {
            const int k0 = (j * 64 + lane) * 4;
#pragma unroll
            for (int rr = 0; rr < 2; ++rr) { const float4 vv = j == 0 ? v[rr][0] : j == 1 ? v[rr][1] : j == 2 ? v[rr][2] : j == 3 ? v[rr][3] : j == 4 ? v[rr][4] : j == 5 ? v[rr][5] : j == 6 ? v[rr][6] : v[rr][7];
                ss[rr] += (vv.x * vv.x + vv.y * vv.y) + (vv.z * vv.z + vv.w * vv.w);
#pragma unroll
                for (int g = 0; g < 8; ++g) { const float4 w = *(const float4*)(wg + g * D + k0); dg[rr][g] += (vv.x * w.x + vv.y * w.y) + (vv.z * w.z + vv.w * w.w); }
                ((uint2*)(xb + (size_t)(t + rr) * D))[j * 64 + lane] = make_uint2(pk2(vv.x, vv.y), pk2(vv.z, vv.w)); }
        }
#pragma unroll
        for (int rr = 0; rr < 2; ++rr) {
            const float s1 = wave_sum(ss[rr]);
#pragma unroll
            for (int g = 0; g < 8; ++g) dg[rr][g] = wave_sum(dg[rr][g]);
            const float rs = rsqrtf(s1 * (1.0f / D) + EPS);
            if (lane == 0) {
                rs1[t + rr] = rs;
#pragma unroll
                for (int h = 0; h < 4; ++h) { gi[(t + rr) * 4 + h] = rs * dg[rr][h] + big[h]; gf[(t + rr) * 4 + h] = log_sigmoid(rs * dg[rr][4 + h] + bfg[h]); }
            }
        }
    }
    __syncthreads();
}
__device__ __forceinline__ void transpose_tile(const float* W, int ldw, int K, const float* gain, bf16_t* WT, int k0, int n0, float* tile) {
    const int tid = threadIdx.x;
    float4 v[4];
#pragma unroll
    for (int r = 0; r < 4; ++r) v[r] = *(const float4*)(W + (size_t)(k0 + (tid >> 5) + 16 * r) * ldw + n0 + (tid & 31) * 4);
#pragma unroll
    for (int r = 0; r < 4; ++r) { const int kk = (tid >> 5) + 16 * r, n4 = (tid & 31) * 4; const float g = gain ? gain[k0 + kk] : 1.0f;
        tile[kk * 129 + n4 + 0] = v[r].x * g; tile[kk * 129 + n4 + 1] = v[r].y * g; tile[kk * 129 + n4 + 2] = v[r].z * g; tile[kk * 129 + n4 + 3] = v[r].w * g; }
    __syncthreads();
    { const int nn = tid >> 2, k16 = (tid & 3) * 16; float f[16];
#pragma unroll
      for (int i = 0; i < 16; ++i) f[i] = tile[(k16 + i) * 129 + nn];
      uint4* dst = (uint4*)(WT + (size_t)(n0 + nn) * K + k0 + k16);
      dst[0] = make_uint4(pk2(f[0], f[1]), pk2(f[2], f[3]), pk2(f[4], f[5]), pk2(f[6], f[7])); dst[1] = make_uint4(pk2(f[8], f[9]), pk2(f[10], f[11]), pk2(f[12], f[13]), pk2(f[14], f[15])); }
    __syncthreads();
}
__device__ __forceinline__ void p0_weights_in(const Params& P, unsigned char* lds, int G, int bid) {
    float* tile = (float*)lds;
    constexpr int N_IN = (D / 64) * (NPROJ / 128);
    for (int it = bid; it < N_IN; it += G) { const int kt = it / (NPROJ / 128), nt = it % (NPROJ / 128); transpose_tile(P.w_in, NIN, D, P.g1, (bf16_t*)(P.ws + WS_WINT), kt * 64, nt * 128, tile); }
}
__device__ __forceinline__ void p2_weights_sq(const Params& P, unsigned char* lds, int nworkers, int wid, int part = 2) {
    float* tile = (float*)lds;
    constexpr int N_SQ = (D / 64) * (D / 128);
    const int it_lo = part == 1 ? N_SQ : 0, it_hi = part == 0 ? N_SQ : 2 * N_SQ;
    for (int it = it_lo + wid; it < it_hi; it += nworkers) {
        if (it < N_SQ) { const int kt = it / (D / 128), nt = it % (D / 128); transpose_tile(P.w_out, D, D, nullptr, (bf16_t*)(P.ws + WS_WOUTT), kt * 64, nt * 128, tile); }
        else { const int j = it - N_SQ, kt = j / (D / 128), nt = j % (D / 128); transpose_tile(P.w_q, D, D, P.g2, (bf16_t*)(P.ws + WS_WQT), kt * 64, nt * 128, tile); }
    }
}
typedef float f32x2_t __attribute__((ext_vector_type(2)));
typedef float v16f_t __attribute__((ext_vector_type(16)));
typedef float v32f_t __attribute__((ext_vector_type(32)));
typedef unsigned v6u_t __attribute__((ext_vector_type(6)));
#define LAS3 __attribute__((address_space(3)))
__device__ __forceinline__ void store16_wt(void* p, v4u_t v) { asm volatile("global_store_dwordx4 %0, %1, off sc1\n\ts_nop 1" :: "v"(p), "v"(v) : "memory"); }
constexpr int EROW = 1536;
__device__ __forceinline__ float wave_max(float v) {
#pragma unroll
    for (int o = 32; o >= 1; o >>= 1) v = fmaxf(v, __shfl_xor(v, o));
    return v;
}
__device__ __forceinline__ void p0_tables(const Params& P, unsigned char* lds_, int nworkers, int wid, int e_begin = 0, int e_end = NEXP) {
    const int lane = threadIdx.x & 63, wave = threadIdx.x >> 6;
    LAS3 unsigned char* W = (LAS3 unsigned char*)lds_ + wave * 3072;
    __syncthreads();
    float* esc = (float*)(P.ws + WS_ESC);
#define TB_LOAD(V, e_) do { _Pragma("unroll") for (int isv = 0; isv < 2; ++isv) { const float4* src = (const float4*)((isv ? P.ev : P.eu) + (size_t)(e_) * D) + lane * 8; \
        _Pragma("unroll") for (int j = 0; j < 8; ++j) V[isv][j] = src[j]; } } while (0)
#define TB_PACK(V, e_) do { _Pragma("unroll") for (int isv = 0; isv < 2; ++isv) { \
        float mx = 0.f; \
        _Pragma("unroll") for (int j = 0; j < 8; ++j) { float4 w = V[isv][j]; \
            if (!isv) { const float4 gg = ((const float4*)P.g2)[lane * 8 + j]; w.x *= gg.x; w.y *= gg.y; w.z *= gg.z; w.w *= gg.w; V[isv][j] = w; } \
            mx = fmaxf(mx, fmaxf(fmaxf(fabsf(w.x), fabsf(w.y)), fmaxf(fabsf(w.z), fabsf(w.w)))); } \
        mx = wave_max(mx); \
        int ex = 0; (void)frexpf(mx * (1.0f / 7.5f), &ex); \
        const float sc = mx > 0.f ? ldexpf(1.0f, ex) : 1.0f; \
          \
        const v16f_t a = {V[isv][0].x, V[isv][0].z, V[isv][1].x, V[isv][1].z, V[isv][2].x, V[isv][2].z, V[isv][3].x, V[isv][3].z, V[isv][4].x, V[isv][4].z, V[isv][5].x, V[isv][5].z, V[isv][6].x, V[isv][6].z, V[isv][7].x, V[isv][7].z}; \
        const v16f_t b = {V[isv][0].y, V[isv][0].w, V[isv][1].y, V[isv][1].w, V[isv][2].y, V[isv][2].w, V[isv][3].y, V[isv][3].w, V[isv][4].y, V[isv][4].w, V[isv][5].y, V[isv][5].w, V[isv][6].y, V[isv][6].w, V[isv][7].y, V[isv][7].w}; \
        const v6u_t pk = __builtin_amdgcn_cvt_scalef32_2xpk16_fp6_f32(a, b, sc); \
        LAS3 v2u_t* wl = (LAS3 v2u_t*)(W + isv * EROW + lane * 24); \
        wl[0] = (v2u_t){pk[0], pk[1]}; wl[1] = (v2u_t){pk[2], pk[3]}; wl[2] = (v2u_t){pk[4], pk[5]}; \
        const v4u_t o0 = *(LAS3 v4u_t*)(W + isv * EROW + lane * 16), o1 = *(LAS3 v4u_t*)(W + isv * EROW + 1024 + (lane & 31) * 16);     \
        unsigned char* dst = P.ws + (isv ? WS_VB : WS_UB) + (size_t)(e_) * EROW; \
        store16_wt(dst + lane * 16, o0); if (lane < 32) store16_wt(dst + 1024 + lane * 16, o1); \
        if (lane == 0) esc[(e_) * 2 + isv] = sc; } } while (0)
    const int step = nworkers * NWAVES;
    int e = e_begin + wid * NWAVES + wave;
    float4 va[2][8], vb[2][8];
    if (e < e_end) TB_LOAD(va, e);
#pragma unroll 1
    while (e < e_end) {
        { const int en = e + step; const int ec = en < e_end ? en : e; TB_LOAD(vb, ec); }
        TB_PACK(va, e);
        e += step; if (e >= e_end) break;
        { const int en = e + step; const int ec = en < e_end ? en : e; TB_LOAD(va, ec); }
        TB_PACK(vb, e);
        e += step;
    }
#undef TB_LOAD
#undef TB_PACK
}

__device__ __forceinline__ void p2_conv(const Params& P, unsigned char* lds_, int nworkers, int wid) {
    const bf16_t* proj = (const bf16_t*)(P.ws + WS_PROJ); bf16_t* mix = (bf16_t*)(P.ws + WS_MIXIN);
    LAS3 float* CW = (LAS3 float*)lds_;
    __syncthreads();
    for (int i = threadIdx.x; i < 3 * 1024 / 4; i += NTHREADS) *(LAS3 pg8::f32x4*)(CW + i * 4) = *(const pg8::f32x4*)(P.conv_w + i * 4);
    __syncthreads();
    constexpr int NI = 2;
    const int stride = nworkers * NTHREADS;
#pragma unroll 1
    for (int idx0 = wid * NTHREADS + threadIdx.x; idx0 < T * 128; idx0 += NI * stride) {
        uint4 ux[NI][3], uc[NI][3], ub_[NI];
#pragma unroll
        for (int q = 0; q < NI; ++q) { int idx = idx0 + q * stride; idx = idx < T * 128 ? idx : idx0; const int t = idx >> 7, c8 = (idx & 127) * 8, s = t & (SEQ - 1);
#pragma unroll
            for (int j = 0; j < 3; ++j) { const int dt = 2 - j; const int tt = s >= dt ? t - dt : t; const bf16_t* row = proj + (size_t)tt * NPC;
                ux[q][j] = *(const uint4*)(row + PC_CX + c8); uc[q][j] = *(const uint4*)(row + PC_CC + c8); }
            ub_[q] = *(const uint4*)(proj + (size_t)t * NPC + PC_CB + c8); }
        asm volatile("" ::: "memory");
#pragma unroll
        for (int q = 0; q < NI; ++q) { const int idx = idx0 + q * stride; if (idx < T * 128) { const int t = idx >> 7, c8 = (idx & 127) * 8, s = t & (SEQ - 1);
            float y[8];
#pragma unroll
            for (int i = 0; i < 8; ++i) y[i] = 0.f;
#pragma unroll
            for (int j = 0; j < 3; ++j) {
                const int dt = 2 - j;
                if (s >= dt) {
                    float cx[8], cc[8]; unpack8(ux[q][j], cx); unpack8(uc[q][j], cc);
                    const pg8::f32x4 w0 = *(LAS3 pg8::f32x4*)(CW + j * 1024 + c8), w1 = *(LAS3 pg8::f32x4*)(CW + j * 1024 + c8 + 4);
                    y[0] += w0[0] * (cc[0] * cx[0]); y[1] += w0[1] * (cc[1] * cx[1]); y[2] += w0[2] * (cc[2] * cx[2]); y[3] += w0[3] * (cc[3] * cx[3]);
                    y[4] += w1[0] * (cc[4] * cx[4]); y[5] += w1[1] * (cc[5] * cx[5]); y[6] += w1[2] * (cc[6] * cx[6]); y[7] += w1[3] * (cc[7] * cx[7]);
                }
            }
            float cb[8]; unpack8(ub_[q], cb);
            *(uint4*)(mix + (size_t)t * D + c8) = make_uint4(pk2(cb[0] * y[0], cb[1] * y[1]), pk2(cb[2] * y[2], cb[3] * y[3]), pk2(cb[4] * y[4], cb[5] * y[5]), pk2(cb[6] * y[6], cb[7] * y[7])); } }
    }
    __syncthreads();
}
typedef short s16x4_t __attribute__((ext_vector_type(4)));
__device__ __forceinline__ pg8::bf16x8 tr8(LAS3 unsigned char* p0, LAS3 unsigned char* p1) {
    const s16x4_t a = __builtin_amdgcn_ds_read_tr16_b64_v4i16((LAS3 s16x4_t*)p0), b = __builtin_amdgcn_ds_read_tr16_b64_v4i16((LAS3 s16x4_t*)p1);
    return __builtin_shufflevector(a, b, 0, 1, 2, 3, 4, 5, 6, 7);
}
template <int CTRL, int RMASK> __device__ __forceinline__ float dpp_keep(float oldv, float v) { return __int_as_float(__builtin_amdgcn_update_dpp(__float_as_int(oldv), __float_as_int(v), CTRL, RMASK, 0xF, false)); }
__device__ __forceinline__ float wave_incl_sum(float v) {
    v += dpp_keep<0x111, 0xF>(0.f, v); v += dpp_keep<0x112, 0xF>(0.f, v); v += dpp_keep<0x114, 0xF>(0.f, v); v += dpp_keep<0x118, 0xF>(0.f, v);
    v += dpp_keep<0x142, 0xA>(0.f, v); v += dpp_keep<0x143, 0xC>(0.f, v); return v;
}
template <int CTRL, int RMASK> __device__ __forceinline__ int dpp_keep_i(int v) { return __builtin_amdgcn_update_dpp(0, v, CTRL, RMASK, 0xF, false); }
__device__ __forceinline__ int wave_incl_sum_i(int v) {
    v += dpp_keep_i<0x111, 0xF>(v); v += dpp_keep_i<0x112, 0xF>(v); v += dpp_keep_i<0x114, 0xF>(v); v += dpp_keep_i<0x118, 0xF>(v);
    v += dpp_keep_i<0x142, 0xA>(v); v += dpp_keep_i<0x143, 0xC>(v); return v;
}
__device__ __forceinline__ float wave_incl_max(float v) {
    const float NI = -__builtin_inff();
    v = fmaxf(v, dpp_keep<0x111, 0xF>(NI, v)); v = fmaxf(v, dpp_keep<0x112, 0xF>(NI, v)); v = fmaxf(v, dpp_keep<0x114, 0xF>(NI, v)); v = fmaxf(v, dpp_keep<0x118, 0xF>(NI, v));
    v = fmaxf(v, dpp_keep<0x142, 0xA>(NI, v)); v = fmaxf(v, dpp_keep<0x143, 0xC>(NI, v)); return v;
}
__device__ __forceinline__ void mlstm_unit(const Params& P, unsigned char* lds_, int unit, float* hraw) {
    typedef pg8::bf16x8 bf16x8; typedef pg8::f32x4 f32x4;
    LAS3 unsigned char* L = (LAS3 unsigned char*)lds_;
    constexpr int KS = 33792, VA = 67584, WV = 73728, CB0 = 79872, CBSZ = 25344, SW0 = CB0 + 2 * CBSZ, SWSZ = 2304, SM0 = SW0 + 4 * SWSZ, SMSZ = 1600;
    constexpr int QST = 528, VST = 96, SWT = 32;
    constexpr int NCH = SEQ / LCH;
    const int tid = threadIdx.x, wave = __builtin_amdgcn_readfirstlane(tid >> 6);
    const int bh = unit >> 3, sl = unit & 7, b = bh >> 2, h = bh & 3, v0 = sl * 32;
    const bf16_t* qT = (const bf16_t*)(P.ws + WS_QKVO) + (size_t)h * T * DH; const bf16_t* kT = qT + (size_t)4 * T * DH; const bf16_t* vT = qT + (size_t)8 * T * DH;
    const float* gi = (const float*)(P.ws + WS_GI); const float* gf = (const float*)(P.ws + WS_GF);
#define SMF(sb, off) ((LAS3 float*)(L + SM0 + (sb) * SMSZ + (off)))
    for (int i = tid; i < (2 * CBSZ) / 16; i += NTHREADS) *(LAS3 v4u_t*)(L + CB0 + i * 16) = (v4u_t){0u, 0u, 0u, 0u};
    for (int i = tid; i < 6144 / 16; i += NTHREADS) *(LAS3 v4u_t*)(L + WV + i * 16) = (v4u_t){0u, 0u, 0u, 0u};
    for (int i = tid; i < (4 * SWSZ) / 16; i += NTHREADS) *(LAS3 v4u_t*)(L + SW0 + i * 16) = (v4u_t){0u, 0u, 0u, 0u};
    if (tid < 64) { *(LAS3 v4u_t*)(L + VA + tid * VST + 64) = (v4u_t){0x00003F80u, 0u, 0u, 0u}; *(LAS3 v4u_t*)(L + VA + tid * VST + 80) = (v4u_t){0u, 0u, 0u, 0u}; }
    const int prow = (wave & 3) * 16;
    if (wave < 4) {
        const int rt = wave; LAS3 unsigned char* SWp = L + SW0 + rt * SWSZ;
        v4u_t r8[8], rv; float m = 0.f, nic = 0.f, nfc = 0.f;
#define MLSTM_SMALLS(sb, ic_, fc_) do { const float bc_ = wave_incl_sum(fc_); const float a_ = (ic_) - bc_; const float pm_ = wave_incl_max(a_); \
        const float M_ = fmaxf(m, pm_), M63_ = __shfl(M_, 63), b63_ = __shfl(bc_, 63); \
        SMF(sb, 0)[lane] = a_ * 1.4426950408889634f; SMF(sb, 256)[lane] = M_ * 1.4426950408889634f; SMF(sb, 512)[lane] = __expf(m - M_); SMF(sb, 768)[lane] = __expf(a_ - M63_) * 0.0625f; SMF(sb, 1024)[lane] = __expf(-bc_ - M_); \
        if (lane == 0) { SMF(sb, 1280)[0] = b63_ + M63_; SMF(sb, 1280)[1] = __expf(m - M63_); } m = b63_ + M63_; } while (0)
        { const int lane = tid & 63, g = lane >> 4, c16 = lane & 15; const int t0 = b * SEQ;
          const bf16_t* src8 = qT + (size_t)(t0 + prow + c16) * DH + g * 8;
#pragma unroll
          for (int i = 0; i < 8; ++i) r8[i] = *(const v4u_t*)(src8 + i * 32);
          rv = *(const v4u_t*)(vT + (size_t)(t0 + (tid >> 2)) * DH + v0 + (tid & 3) * 8);
          if (wave == 0) { const float ic0 = gi[(size_t)(t0 + lane) * 4 + h], fc0 = gf[(size_t)(t0 + lane) * 4 + h]; MLSTM_SMALLS(0, ic0, fc0);
              nic = gi[(size_t)(t0 + LCH + lane) * 4 + h]; nfc = gf[(size_t)(t0 + LCH + lane) * 4 + h]; } }
        __syncthreads();
#pragma unroll 1
        for (int c = 0; c < NCH; ++c) {
            const int t0 = b * SEQ + c * LCH, sb = c & 1;
            int tl = tid; asm volatile("" : "+v"(tl));
            const int lane = tl & 63, g = lane >> 4, c16 = lane & 15, q4 = c16 >> 2, p4 = lane & 3;
            LAS3 unsigned char* CBc = L + CB0 + sb * CBSZ;
            bf16x8 qf[8];
#pragma unroll
            for (int i = 0; i < 8; ++i) qf[i] = __builtin_bit_cast(bf16x8, r8[i]);
            { const int l = tl >> 2, part = tl & 3; const float wl = SMF(sb, 768)[l];
              *(LAS3 v4u_t*)(L + VA + l * VST + part * 16) = rv;
              *(LAS3 v4u_t*)(L + WV + l * VST + part * 16) = (v4u_t){pg8::cvt_pk_bf16(wl * bflo(rv.x), wl * bfhi(rv.x)), pg8::cvt_pk_bf16(wl * bflo(rv.y), wl * bfhi(rv.y)), pg8::cvt_pk_bf16(wl * bflo(rv.z), wl * bfhi(rv.z)), pg8::cvt_pk_bf16(wl * bflo(rv.w), wl * bfhi(rv.w))}; }
            { const int t1 = b * SEQ + ((c + 1 < NCH) ? c + 1 : c) * LCH;
              const bf16_t* src8 = qT + (size_t)(t1 + prow + c16) * DH + g * 8;
#pragma unroll
              for (int i = 0; i < 8; ++i) r8[i] = *(const v4u_t*)(src8 + i * 32);
              rv = *(const v4u_t*)(vT + (size_t)(t1 + (tl >> 2)) * DH + v0 + (tl & 3) * 8); }
            __syncthreads();
            const f32x4 M4 = *(LAS3 f32x4*)(SMF(sb, 256) + rt * 16 + 4 * g) + 4.0f;
            float al4[4];
#pragma unroll
            for (int ct = 0; ct < 4; ++ct) al4[ct] = SMF(sb, 0)[ct * 16 + c16];
            bf16x8 bk[4], cf[6], vf[6];
#define MLSTM_LDK(ct_, hf_) do { _Pragma("unroll") for (int ks = 0; ks < 4; ++ks) bk[ks] = *(LAS3 bf16x8*)(L + KS + ((ct_) * 16 + c16) * QST + (((hf_) * 4 + ks) * 32 + g * 8) * 2); } while (0)
#define MLSTM_LDC(kp_) do { _Pragma("unroll") for (int j = 0; j < 2; ++j) _Pragma("unroll") for (int vt = 0; vt < 3; ++vt) cf[j * 3 + vt] = *(LAS3 bf16x8*)(CBc + (vt * 16 + c16) * QST + ((2 * (kp_) + j) * 32 + g * 8) * 2); } while (0)
            MLSTM_LDK(0, 0); MLSTM_LDC(0);
            asm volatile("" ::: "memory");
            f32x4 aI[3];
#pragma unroll
            for (int vt = 0; vt < 3; ++vt) aI[vt] = (f32x4){0.f, 0.f, 0.f, 0.f};
#pragma unroll
            for (int ct = 0; ct < 4; ++ct) { f32x4 acc = (f32x4){0.f, 0.f, 0.f, 0.f};
                if (ct <= rt) {
#pragma unroll
                    for (int ks = 0; ks < 4; ++ks) acc = __builtin_amdgcn_mfma_f32_16x16x32_bf16(qf[ks], bk[ks], acc, 0, 0, 0);
                    MLSTM_LDK(ct, 1); asm volatile("" ::: "memory"); }
#pragma unroll
                for (int j = 0; j < 2; ++j)
#pragma unroll
                    for (int vt = 0; vt < 3; ++vt) aI[vt] = __builtin_amdgcn_mfma_f32_16x16x32_bf16(qf[2 * ct + j], cf[j * 3 + vt], aI[vt], 0, 0, 0);
                if (ct <= rt) {
#pragma unroll
                    for (int ks = 0; ks < 4; ++ks) acc = __builtin_amdgcn_mfma_f32_16x16x32_bf16(qf[4 + ks], bk[ks], acc, 0, 0, 0); }
                if (ct < 3) { if (ct + 1 <= rt) MLSTM_LDK(ct + 1, 0); MLSTM_LDC(ct + 1); }
                else {
#pragma unroll
                    for (int ks = 0; ks < 2; ++ks)
#pragma unroll
                        for (int vt = 0; vt < 3; ++vt) { LAS3 unsigned char* vp = L + VA + (ks * 32 + g * 8 + q4) * VST + (vt * 16 + 4 * p4) * 2; vf[ks * 3 + vt] = tr8(vp, vp + 4 * VST); } }
                asm volatile("" ::: "memory");
                if (ct <= rt) { const float al = al4[ct]; float e[4];
#pragma unroll
                    for (int r = 0; r < 4; ++r) { e[r] = acc[r] * __builtin_amdgcn_exp2f(al - M4[r]); if (ct == rt && c16 > 4 * g + r) e[r] = 0.f; }
                    *(LAS3 v2u_t*)(SWp + (ct * 16 + c16) * SWT + (4 * g) * 2) = (v2u_t){pg8::cvt_pk_bf16(e[0], e[1]), pg8::cvt_pk_bf16(e[2], e[3])}; } }
#undef MLSTM_LDK
#undef MLSTM_LDC
            asm volatile("s_waitcnt lgkmcnt(0)" ::: "memory");
            f32x4 aX[3];
#pragma unroll
            for (int vt = 0; vt < 3; ++vt) aX[vt] = (f32x4){0.f, 0.f, 0.f, 0.f};
            { LAS3 unsigned char* sp0 = SWp + (g * 8 + q4) * SWT + (4 * p4) * 2; LAS3 unsigned char* sp1 = sp0 + 32 * SWT;
              const bf16x8 av0 = tr8(sp0, sp0 + 4 * SWT), av1 = tr8(sp1, sp1 + 4 * SWT);
#pragma unroll
              for (int vt = 0; vt < 3; ++vt) aX[vt] = __builtin_amdgcn_mfma_f32_16x16x32_bf16(av0, vf[vt], aX[vt], 0, 0, 0);
#pragma unroll
              for (int vt = 0; vt < 3; ++vt) aX[vt] = __builtin_amdgcn_mfma_f32_16x16x32_bf16(av1, vf[3 + vt], aX[vt], 0, 0, 0); }
            const f32x4 e4 = *(LAS3 f32x4*)(SMF(sb, 512) + rt * 16 + 4 * g), n4 = *(LAS3 f32x4*)(SMF(sb, 1024) + rt * 16 + 4 * g);
#pragma unroll
            for (int r = 0; r < 4; ++r) { const float den0 = __builtin_amdgcn_rcpf(fmaxf(fabsf(e4[r] * aI[2][r] + aX[2][r]), n4[r])); const float rden = __shfl(den0, g * 16);
                const size_t o = (size_t)(t0 + rt * 16 + 4 * g + r) * DML + h * DH + v0 + c16;
                const float h0_ = (e4[r] * aI[0][r] + aX[0][r]) * rden, h1_ = (e4[r] * aI[1][r] + aX[1][r]) * rden;
                hraw[o] = h0_; hraw[o + 16] = h1_; }
            if (wave == 0 && c + 1 < NCH) {
                MLSTM_SMALLS(sb ^ 1, nic, nfc);
                const int c2 = (c + 2 < NCH) ? c + 2 : NCH - 1;
                nic = gi[(size_t)(b * SEQ + c2 * LCH + lane) * 4 + h]; nfc = gf[(size_t)(b * SEQ + c2 * LCH + lane) * 4 + h];
            }
            __syncthreads();
        }
#undef MLSTM_SMALLS
    } else {
        const int wB = wave - 4;
        f32x4 accC[4][3];
#pragma unroll
        for (int dt = 0; dt < 4; ++dt)
#pragma unroll
            for (int vt = 0; vt < 3; ++vt) accC[dt][vt] = (f32x4){0.f, 0.f, 0.f, 0.f};
        v4u_t r8[8];
        { const int lane = tid & 63, g = lane >> 4, c16 = lane & 15;
          const bf16_t* src8 = kT + (size_t)(b * SEQ + prow + c16) * DH + g * 8;
#pragma unroll
          for (int i = 0; i < 8; ++i) r8[i] = *(const v4u_t*)(src8 + i * 32); }
        __syncthreads();
#pragma unroll 1
        for (int c = 0; c < NCH; ++c) {
            const int sb = c & 1;
            int tl = tid; asm volatile("" : "+v"(tl));
            const int lane = tl & 63, g = lane >> 4, c16 = lane & 15, q4 = c16 >> 2, p4 = lane & 3;
            LAS3 unsigned char* CBn = L + CB0 + (sb ^ 1) * CBSZ;
#pragma unroll
            for (int i = 0; i < 8; ++i) *(LAS3 v4u_t*)(L + KS + (prow + c16) * QST + (g + 4 * i) * 16) = r8[i];
            if (wave == 4) *(LAS3 unsigned short*)(L + WV + lane * VST + 64) = (unsigned short)pg8::cvt_pk_bf16(SMF(sb, 768)[lane], 0.f);
            __syncthreads();
            { const int t1 = b * SEQ + ((c + 1 < NCH) ? c + 1 : c) * LCH;
              const bf16_t* src8 = kT + (size_t)(t1 + prow + c16) * DH + g * 8;
#pragma unroll
              for (int i = 0; i < 8; ++i) r8[i] = *(const v4u_t*)(src8 + i * 32); }
            const float decay = SMF(sb, 1280)[1];
#pragma unroll
            for (int dt = 0; dt < 4; ++dt)
#pragma unroll
                for (int v3 = 0; v3 < 3; ++v3) accC[dt][v3] *= decay;
#pragma unroll
            for (int ks = 0; ks < 2; ++ks) { bf16x8 af[4], bfr[3];
#pragma unroll
                for (int dt = 0; dt < 4; ++dt) { LAS3 unsigned char* kp = L + KS + (ks * 32 + g * 8 + q4) * QST + ((4 * wB + dt) * 16 + 4 * p4) * 2; af[dt] = tr8(kp, kp + 4 * QST); }
#pragma unroll
                for (int v3 = 0; v3 < 3; ++v3) { LAS3 unsigned char* wp = L + WV + (ks * 32 + g * 8 + q4) * VST + (v3 * 16 + 4 * p4) * 2; bfr[v3] = tr8(wp, wp + 4 * VST); }
#pragma unroll
                for (int dt = 0; dt < 4; ++dt)
#pragma unroll
                    for (int v3 = 0; v3 < 3; ++v3) accC[dt][v3] = __builtin_amdgcn_mfma_f32_16x16x32_bf16(af[dt], bfr[v3], accC[dt][v3], 0, 0, 0); }
#pragma unroll
            for (int dt = 0; dt < 4; ++dt)
#pragma unroll
                for (int v3 = 0; v3 < 3; ++v3) { const int d = (4 * wB + dt) * 16 + 4 * g, vp = v3 * 16 + c16;
                    *(LAS3 v2u_t*)(CBn + vp * QST + d * 2) = (v2u_t){pg8::cvt_pk_bf16(accC[dt][v3][0], accC[dt][v3][1]), pg8::cvt_pk_bf16(accC[dt][v3][2], accC[dt][v3][3])}; }
            __syncthreads();
        }
    }
#undef SMF
}

__device__ __forceinline__ void p3_finalize(const Params& P, int G, int bid) {
    const int lane = threadIdx.x & 63, wave = threadIdx.x >> 6;
    const float* hraw = (const float*)(P.ws + WS_HRAW); const bf16_t* oT = (const bf16_t*)(P.ws + WS_QKVO) + (size_t)12 * T * DH; bf16_t* mix = (bf16_t*)(P.ws + WS_MIXIN);
    for (int idx = bid * NWAVES + wave; idx < T * NH; idx += G * NWAVES) {
        const int t = idx >> 2, hh = idx & 3;
        const float4 hv = *(const float4*)(hraw + (size_t)t * DML + hh * DH + lane * 4);
        const float ss = wave_sum((hv.x * hv.x + hv.y * hv.y) + (hv.z * hv.z + hv.w * hv.w));
        const float r = rsqrtf(ss * (1.0f / DH) + EPS);
        const uint2 ow = *(const uint2*)(oT + ((size_t)hh * T + t) * DH + lane * 4);
        const float4 g = *(const float4*)(P.gm + hh * DH + lane * 4);
        const float o0 = 1.0f / (1.0f + expf(-bflo(ow.x))), o1 = 1.0f / (1.0f + expf(-bfhi(ow.x))), o2 = 1.0f / (1.0f + expf(-bflo(ow.y))), o3 = 1.0f / (1.0f + expf(-bfhi(ow.y)));
        *(uint2*)(mix + (size_t)t * D + DML + hh * DH + lane * 4) = make_uint2(pk2(o0 * (hv.x * r * g.x), o1 * (hv.y * r * g.y)), pk2(o2 * (hv.z * r * g.z), o3 * (hv.w * r * g.w)));
    }
}

template <int CTRL> __device__ __forceinline__ float dppf(float v) { return __int_as_float(__builtin_amdgcn_update_dpp(0, __float_as_int(v), CTRL, 0xF, 0xF, true)); }
__device__ __forceinline__ float grp16_max(float v) { v = fmaxf(v, dppf<0xB1>(v)); v = fmaxf(v, dppf<0x4E>(v)); v = fmaxf(v, dppf<0x141>(v)); v = fmaxf(v, dppf<0x140>(v)); return v; }
__device__ __forceinline__ float grp16_sum(float v) { v += dppf<0xB1>(v); v += dppf<0x4E>(v); v += dppf<0x141>(v); v += dppf<0x140>(v); return v; }
#define CEX(a, b) do { const float hi_ = fmaxf(a, b), lo_ = fminf(a, b); a = hi_; b = lo_; } while (0)
static __device__ const unsigned char CAND_AB[16][4] = {
    {0x00, 0x01, 0x02, 0x03}, {0x04, 0x05, 0x06, 0x07}, {0x08, 0x09, 0x0A, 0x0B}, {0x0C, 0x0D, 0x0E, 0x0F}, {0x10, 0x11, 0x12, 0x13}, {0x14, 0x15, 0x16, 0x17}, {0x20, 0x21, 0x22, 0x23}, {0x24, 0, 0, 0},
    {0x30, 0x31, 0x32, 0x33}, {0x40, 0x41, 0x42, 0}, {0x50, 0x60, 0x70, 0x80}, {0x90, 0xA0, 0xB0, 0xC0}, {0xD0, 0xE0, 0xF0, 0}, {0x51, 0x61, 0x71, 0}, {0, 0, 0, 0}, {0, 0, 0, 0}};
static __device__ const unsigned char CAND_N[16] = {4, 4, 4, 4, 4, 4, 4, 1, 4, 3, 4, 4, 3, 3, 0, 0};
__device__ __forceinline__ void p6_topk(const Params& P, unsigned char* lds_, int G, int bid) {
    typedef pg8::bf16x8 bf16x8; typedef pg8::f32x4 f32x4;
    LAS3 unsigned char* L = (LAS3 unsigned char*)lds_;
    constexpr int KST = 272, KHALF = 128 * KST;
    const int tid = threadIdx.x, lane = tid & 63, wave = tid >> 6, g = lane >> 4, c16 = lane & 15;
    for (int i = tid; i < 2 * 2048; i += NTHREADS) { const int hf = i >> 11, n = (i >> 4) & 127, d8 = (i & 15) * 8; const float* src = (hf ? P.sk2 : P.sk1) + n * 128 + d8;
        const float4 a = *(const float4*)src, b = *(const float4*)(src + 4);
        *(LAS3 v4u_t*)(L + hf * KHALF + n * KST + d8 * 2) = (v4u_t){pk2(a.x, a.y), pk2(a.z, a.w), pk2(b.x, b.y), pk2(b.z, b.w)}; }
    __syncthreads();
    const bf16_t* qvb = (const bf16_t*)(P.ws + WS_QV);
    int* idxo = (int*)(P.ws + WS_IDX); float* gato = (float*)(P.ws + WS_GATE);
    const float NEGINF = -__builtin_inff();
    unsigned ctab = 0; { const unsigned char* tp = CAND_AB[c16]; ctab = (unsigned)tp[0] | ((unsigned)tp[1] << 8) | ((unsigned)tp[2] << 16) | ((unsigned)tp[3] << 24); }
    const int ccnt = CAND_N[c16];
#pragma unroll 1
    for (int it = bid * NWAVES + wave; it < (T / 16) * PEER_H; it += G * NWAVES) {
        const int t0 = (it >> 3) * 16, hh = it & 7;
        float keepH[2][4];
#pragma unroll
        for (int hf = 0; hf < 2; ++hf) {
            asm volatile("" ::: "memory");
            bf16x8 af[4];
#pragma unroll
            for (int ks = 0; ks < 4; ++ks) af[ks] = *(const bf16x8*)(qvb + (size_t)(t0 + c16) * D + hh * 256 + hf * 128 + ks * 32 + g * 8);
            f32x4 acc[8];
#pragma unroll
            for (int ct = 0; ct < 8; ++ct) { acc[ct] = (f32x4){0.f, 0.f, 0.f, 0.f};
#pragma unroll
                for (int ks = 0; ks < 4; ++ks) { const bf16x8 bv = *(LAS3 bf16x8*)(L + hf * KHALF + (ct * 16 + c16) * KST + (ks * 32 + g * 8) * 2);
                    acc[ct] = __builtin_amdgcn_mfma_f32_16x16x32_bf16(af[ks], bv, acc[ct], 0, 0, 0); } }
            float v[4][8];
#pragma unroll
            for (int r = 0; r < 4; ++r) {
#pragma unroll
                for (int ct = 0; ct < 8; ++ct) v[r][ct] = __uint_as_float((__float_as_uint(acc[ct][r]) & ~127u) | (unsigned)(127 - (ct * 16 + c16)));
                CEX(v[r][0], v[r][1]); CEX(v[r][2], v[r][3]); CEX(v[r][4], v[r][5]); CEX(v[r][6], v[r][7]);
                CEX(v[r][0], v[r][2]); CEX(v[r][1], v[r][3]); CEX(v[r][4], v[r][6]); CEX(v[r][5], v[r][7]);
                CEX(v[r][1], v[r][2]); CEX(v[r][5], v[r][6]); CEX(v[r][0], v[r][4]); CEX(v[r][3], v[r][7]);
                CEX(v[r][1], v[r][5]); CEX(v[r][2], v[r][6]);
                CEX(v[r][1], v[r][4]); CEX(v[r][3], v[r][6]);
                CEX(v[r][2], v[r][4]); CEX(v[r][3], v[r][5]);
                CEX(v[r][3], v[r][4]);
                keepH[hf][r] = 0.f;
            }
#pragma unroll
            for (int rd = 0; rd < TOPK; ++rd) {
#pragma unroll
                for (int r = 0; r < 4; ++r) {
                    const float W = grp16_max(v[r][0]); const bool win = (v[r][0] == W);
                    if (c16 == rd) keepH[hf][r] = W;
#pragma unroll
                    for (int k = 0; k < 7; ++k) v[r][k] = win ? v[r][k + 1] : v[r][k];
                    v[r][7] = win ? NEGINF : v[r][7];
                }
            }
        }
#pragma unroll
        for (int r = 0; r < 4; ++r) {
            const float V1 = keepH[0][r], V2 = keepH[1][r];
            float cv[4];
#pragma unroll
            for (int s4 = 0; s4 < 4; ++s4) { const unsigned code = (ctab >> (8 * s4)) & 255u;
                const float x1 = __shfl(V1, g * 16 + (int)(code >> 4)), x2 = __shfl(V2, g * 16 + (int)(code & 15u));
                const float sum = __uint_as_float(__float_as_uint(x1) & ~127u) + __uint_as_float(__float_as_uint(x2) & ~127u);
                cv[s4] = (s4 < ccnt) ? __uint_as_float((__float_as_uint(sum) & ~255u) | (255u - code)) : NEGINF; }
            float keepc = 0.f;
#pragma unroll
            for (int rd = 0; rd < TOPK; ++rd) {
                const float W = grp16_max(cv[0]); const bool win = (cv[0] == W);
                if (c16 == rd) keepc = W;
                cv[0] = win ? cv[1] : cv[0]; cv[1] = win ? cv[2] : cv[1]; cv[2] = win ? cv[3] : cv[2]; cv[3] = win ? NEGINF : cv[3];
            }
            const unsigned kb = __float_as_uint(keepc), code = 255u - (kb & 255u);
            const unsigned n1 = 127u - (__float_as_uint(__shfl(V1, g * 16 + (int)(code >> 4))) & 127u), n2 = 127u - (__float_as_uint(__shfl(V2, g * 16 + (int)(code & 15u))) & 127u);
            const float sval = __uint_as_float(kb & ~255u), smax = __shfl(sval, g * 16);
            const float ex = __expf(sval - smax), den = grp16_sum(ex);
            const size_t o = (size_t)(t0 + 4 * g + r) * 128 + hh * 16 + c16;
            idxo[o] = (int)(n1 * 128u + n2); gato[o] = ex / den;
        }
    }
    __syncthreads();
}

__device__ __forceinline__ float wave_sum_dpp(float v) {
    v += dppf<0xB1>(v); v += dppf<0x4E>(v); v += dppf<0x141>(v); v += dppf<0x140>(v);
    const int iv = __float_as_int(v);
    return (__int_as_float(__builtin_amdgcn_readlane(iv, 0)) + __int_as_float(__builtin_amdgcn_readlane(iv, 16))) + (__int_as_float(__builtin_amdgcn_readlane(iv, 32)) + __int_as_float(__builtin_amdgcn_readlane(iv, 48)));
}
__device__ __forceinline__ float dot16_fp8(const v4u_t w, const float (&x)[16]) {
    float s = 0.f;
#pragma unroll
    for (int k = 0; k < 4; ++k) { const f32x2_t lo = __builtin_amdgcn_cvt_pk_f32_fp8(w[k], false), hi = __builtin_amdgcn_cvt_pk_f32_fp8(w[k], true);
        s += (x[4 * k] * lo.x + x[4 * k + 1] * lo.y) + (x[4 * k + 2] * hi.x + x[4 * k + 3] * hi.y); }
    return s;
}
__device__ __forceinline__ void axpy16_fp8(const v4u_t w, const float cf, float (&y)[16]) {
#pragma unroll
    for (int k = 0; k < 4; ++k) { const f32x2_t lo = __builtin_amdgcn_cvt_pk_f32_fp8(w[k], false), hi = __builtin_amdgcn_cvt_pk_f32_fp8(w[k], true);
        y[4 * k] += cf * lo.x; y[4 * k + 1] += cf * lo.y; y[4 * k + 2] += cf * hi.x; y[4 * k + 3] += cf * hi.y; }
}
#define PIN16(a, o) asm volatile("" : "+v"(a[o + 0]), "+v"(a[o + 1]), "+v"(a[o + 2]), "+v"(a[o + 3]), "+v"(a[o + 4]), "+v"(a[o + 5]), "+v"(a[o + 6]), "+v"(a[o + 7]), "+v"(a[o + 8]), "+v"(a[o + 9]), "+v"(a[o + 10]), "+v"(a[o + 11]), "+v"(a[o + 12]), "+v"(a[o + 13]), "+v"(a[o + 14]), "+v"(a[o + 15]))
typedef __bf16 v2bf_t __attribute__((ext_vector_type(2)));
typedef __bf16 v32bf_t __attribute__((ext_vector_type(32)));
typedef unsigned v16u_t __attribute__((ext_vector_type(16)));
__device__ __forceinline__ float row16_sum(float v) { v += dppf<0xB1>(v); v += dppf<0x4E>(v); v += dppf<0x141>(v); v += dppf<0x140>(v); return v; }
#ifndef RING1
#define RING1 2
#endif
__device__ __forceinline__ int p7_lane_id() { unsigned z = 0u; asm volatile("" : "+v"(z)); return (int)__builtin_amdgcn_mbcnt_hi(~0u, __builtin_amdgcn_mbcnt_lo(~0u, z)); }
__device__ __forceinline__ void p7_peer(const Params& P, unsigned char* lds_, int G, int bid) {
    const int lane = threadIdx.x & 63, wave = __builtin_amdgcn_readfirstlane(threadIdx.x >> 6);
    LAS3 unsigned char* W = (LAS3 unsigned char*)lds_ + wave * 8192;
    const bf16_t* x1b = (const bf16_t*)(P.ws + WS_X1B); const float* ssq = (const float*)(P.ws + WS_SSQ);
    LAS3 float* GFL = (LAS3 float*)((LAS3 unsigned char*)lds_ + 8 * 8192);
    for (int i = threadIdx.x; i < D / 4; i += NTHREADS) *(LAS3 pg8::f32x4*)(GFL + i * 4) = *(const pg8::f32x4*)(P.gfin + i * 4);
    __syncthreads();
    const int* idxi = (const int*)(P.ws + WS_IDX); const float* gati = (const float*)(P.ws + WS_GATE);
    const unsigned char* ub = P.ws + WS_UB; const unsigned char* vb = P.ws + WS_VB; const float* esc = (const float*)(P.ws + WS_ESC);
#pragma unroll 1
    for (int qd = bid * NWAVES + wave; qd < T / 4; qd += G * NWAVES) {
        int ln = p7_lane_id(); asm volatile("" : "+v"(ln));
        const int tb = qd * 4, q = ln >> 4, l16 = ln & 15, t = tb + q;
        const unsigned loff = (unsigned)l16 * 24u;
        int pi0[4], pi1[4]; float pg0[4], pg1[4];
#pragma unroll
        for (int s4 = 0; s4 < 4; ++s4) { const size_t o = (size_t)(tb + s4) * 128 + ln; pi0[s4] = idxi[o]; pi1[s4] = idxi[o + 64]; pg0[s4] = gati[o]; pg1[s4] = gati[o + 64]; }
#pragma unroll
        for (int s4 = 0; s4 < 4; ++s4) {
            LAS3 int* hist = (LAS3 int*)(W + 4096); LAS3 int* base = (LAS3 int*)(W + 4096 + 256); LAS3 v2u_t* list = (LAS3 v2u_t*)(W + s4 * 1024);
            const int i0 = pi0[s4], i1 = pi1[s4]; const float g0 = pg0[s4], g1 = pg1[s4];
            hist[ln] = 0; asm volatile("s_waitcnt lgkmcnt(0)" ::: "memory");
            const int t0_ = __hip_atomic_fetch_add((int*)(hist + (i0 >> 8)), 1, __ATOMIC_RELAXED, __HIP_MEMORY_SCOPE_WORKGROUP);
            const int t1_ = __hip_atomic_fetch_add((int*)(hist + (i1 >> 8)), 1, __ATOMIC_RELAXED, __HIP_MEMORY_SCOPE_WORKGROUP);
            asm volatile("s_waitcnt lgkmcnt(0)" ::: "memory");
            const int cnt = hist[ln]; const int inc = wave_incl_sum_i(cnt);
            base[ln] = inc - cnt; asm volatile("s_waitcnt lgkmcnt(0)" ::: "memory");
            list[base[i0 >> 8] + t0_] = (v2u_t){(unsigned)i0, __float_as_uint(g0)}; list[base[i1 >> 8] + t1_] = (v2u_t){(unsigned)i1, __float_as_uint(g1)};
            asm volatile("s_waitcnt lgkmcnt(0)" ::: "memory");
        }
        LAS3 v2u_t* mylist = (LAS3 v2u_t*)(W + q * 1024); LAS3 float* mydot = (LAS3 float*)(W + 4096 + q * 512);
        const float rs2 = rsqrtf(row16_sum(ssq[(size_t)t * 32 + l16] + ssq[(size_t)t * 32 + 16 + l16]) * (1.0f / D) + EPS);
        unsigned xp[4][16];
        {
#pragma unroll
            for (int jj = 0; jj < 4; ++jj) { const v4u_t* xs = (const v4u_t*)(x1b + (size_t)t * D + jj * 512 + l16 * 32);
#pragma unroll
                for (int k = 0; k < 4; ++k) { const v4u_t a = xs[k]; xp[jj][4 * k] = a.x; xp[jj][4 * k + 1] = a.y; xp[jj][4 * k + 2] = a.z; xp[jj][4 * k + 3] = a.w; } }
            v6u_t rb[RING1][4]; float rsc[RING1];
#define P7_LD1(j, b) do { __builtin_amdgcn_s_setprio(3); const unsigned e_ = mylist[j].x; const unsigned char* rp = ub + (size_t)(e_ * (unsigned)EROW + loff); rsc[b] = esc[e_ * 2]; \
            _Pragma("unroll") for (int jj = 0; jj < 4; ++jj) { const v2u_t* cp = (const v2u_t*)(rp + jj * 384); const v2u_t c0 = cp[0], c1 = cp[1], c2 = cp[2]; rb[b][jj] = (v6u_t){c0.x, c0.y, c1.x, c1.y, c2.x, c2.y}; } __builtin_amdgcn_s_setprio(0); } while (0)
#define P7_D2(k_) __builtin_amdgcn_fdot2_f32_bf16((v2bf_t){w[2 * (k_)], w[2 * (k_) + 1]}, __builtin_bit_cast(v2bf_t, xp[jj][k_]),
#define P7_DOT1(j, b) do { float s0 = 0.f, s1 = 0.f, s2 = 0.f, s3 = 0.f; _Pragma("unroll") for (int jj = 0; jj < 4; ++jj) { asm volatile("" : "+v"(rb[b][jj])); \
                const v32bf_t w = __builtin_amdgcn_cvt_scalef32_pk32_bf16_fp6(rb[b][jj], rsc[b]);     \
                _Pragma("unroll") for (int i = 0; i < 16; i += 4) { s0 = P7_D2(i) s0, false); s1 = P7_D2(i + 1) s1, false); s2 = P7_D2(i + 2) s2, false); s3 = P7_D2(i + 3) s3, false); } } \
            const float tot = row16_sum((s0 + s1) + (s2 + s3)); if (l16 == 0) mydot[j] = tot; } while (0)
#pragma unroll
            for (int b = 0; b < RING1; ++b) P7_LD1(b, b);
#pragma unroll 1
            for (int j = 0; j < 128 - RING1; j += RING1) {
#pragma unroll
                for (int b = 0; b < RING1; ++b) { P7_DOT1(j + b, b); P7_LD1(j + RING1 + b, b); } }
#pragma unroll
            for (int b = 0; b < RING1; ++b) P7_DOT1(128 - RING1 + b, b);
#undef P7_DOT1
#undef P7_D2
#undef P7_LD1
        }
        asm volatile("s_waitcnt lgkmcnt(0)" ::: "memory");
        { const float r0 = __int_as_float(__builtin_amdgcn_readlane(__float_as_int(rs2), 0)), r1 = __int_as_float(__builtin_amdgcn_readlane(__float_as_int(rs2), 16)),
                      r2 = __int_as_float(__builtin_amdgcn_readlane(__float_as_int(rs2), 32)), r3 = __int_as_float(__builtin_amdgcn_readlane(__float_as_int(rs2), 48));
#pragma unroll
          for (int k = 0; k < 8; ++k) { const int n = k * 64 + ln; const v2u_t en = *(LAS3 v2u_t*)(W + n * 8); LAS3 float* dp = (LAS3 float*)(W + 4096 + n * 4);
              const float rr = (k >> 1) == 0 ? r0 : (k >> 1) == 1 ? r1 : (k >> 1) == 2 ? r2 : r3;
              *dp = __uint_as_float(en.y) * gelu_erf(*dp * rr); } }
        asm volatile("s_waitcnt lgkmcnt(0)" ::: "memory");
        typedef float f32x2_t __attribute__((ext_vector_type(2)));
        int ln2 = p7_lane_id(); asm volatile("" : "+v"(ln2));
        const int t2 = tb + (ln2 >> 4), l16b = ln2 & 15;
        f32x2_t y[4][16];
#pragma unroll
        for (int jj = 0; jj < 4; ++jj)
#pragma unroll
            for (int i = 0; i < 16; ++i) y[jj][i] = (f32x2_t){__uint_as_float(xp[jj][i] << 16), __uint_as_float(xp[jj][i] & 0xffff0000u)};
#define PIN8P(a, o) asm volatile("" : "+v"(a[o + 0]), "+v"(a[o + 1]), "+v"(a[o + 2]), "+v"(a[o + 3]), "+v"(a[o + 4]), "+v"(a[o + 5]), "+v"(a[o + 6]), "+v"(a[o + 7]))
        {
            v6u_t bA[4], bB[4]; float scA = 1.f, scB = 1.f;
#define P7_LOADQ(j, Bf, SC) do { __builtin_amdgcn_s_setprio(3); const unsigned e_ = mylist[j].x; const unsigned char* rp = vb + (size_t)(e_ * (unsigned)EROW + loff); SC = esc[e_ * 2 + 1]; \
            _Pragma("unroll") for (int jj = 0; jj < 4; ++jj) { const v2u_t* cp = (const v2u_t*)(rp + jj * 384); const v2u_t c0 = cp[0], c1 = cp[1], c2 = cp[2]; Bf[jj] = (v6u_t){c0.x, c0.y, c1.x, c1.y, c2.x, c2.y}; } __builtin_amdgcn_s_setprio(0); } while (0)
#define P7_AXQ(j, Bf, SC) do { const float cf = mydot[j]; const f32x2_t cf2 = {cf, cf}; _Pragma("unroll") for (int jj = 0; jj < 4; ++jj) { asm volatile("" : "+v"(Bf[jj])); const v32f_t w = __builtin_amdgcn_cvt_scalef32_pk32_f32_fp6(Bf[jj], SC); \
            _Pragma("unroll") for (int i = 0; i < 16; ++i) y[jj][i] = cf2 * (f32x2_t){w[2 * i], w[2 * i + 1]} + y[jj][i]; } } while (0)
            P7_LOADQ(0, bA, scA);
#pragma unroll 1
            for (int j = 0; j < 126; j += 2) { P7_LOADQ(j + 1, bB, scB); P7_AXQ(j, bA, scA); P7_LOADQ(j + 2, bA, scA); P7_AXQ(j + 1, bB, scB); }
            P7_LOADQ(127, bB, scB); P7_AXQ(126, bA, scA); P7_AXQ(127, bB, scB);
#undef P7_AXQ
#undef P7_LOADQ
        }
        float ss = 0.f;
        int ln3 = p7_lane_id(); asm volatile("" : "+v"(ln3));
        LAS3 float* grow = GFL + (ln3 & 15) * 32; float* orow = P.out + (size_t)(tb + (ln3 >> 4)) * D + (ln3 & 15) * 32;
#pragma unroll
        for (int jj = 0; jj < 4; ++jj)
#pragma unroll
            for (int i = 0; i < 16; ++i) ss += y[jj][i].x * y[jj][i].x + y[jj][i].y * y[jj][i].y;
        ss = row16_sum(ss);
        const float r = rsqrtf(ss * (1.0f / D) + EPS);
#pragma unroll
        for (int jj = 0; jj < 4; ++jj)
#pragma unroll
            for (int k = 0; k < 8; ++k) { const pg8::f32x4 gv = *(LAS3 pg8::f32x4*)(grow + jj * 512 + 4 * k); const float4 gg = make_float4(gv[0], gv[1], gv[2], gv[3]);
                const float4 ov = make_float4(y[jj][2 * k].x * r * gg.x, y[jj][2 * k].y * r * gg.y, y[jj][2 * k + 1].x * r * gg.z, y[jj][2 * k + 1].y * r * gg.w);
                *(float4*)(orow + jj * 512 + 4 * k) = ov; }
    }
}
#undef PIN16

#define XB_TMO      128
#define XB_XCNT(j)  (256  + 64 * (j))
#define XB_XSUB(j)  (1280 + 64 * (j))
#define XB_XGEN(j)  (2304 + 64 * (j))
#define XB_TOP      3328
#define XB_TOPGEN   3392
#define XCD_BAR_WORDS 3456
#define XB_SPIN_CAP (1u << 18)

__device__ __forceinline__ unsigned xb_ld(unsigned* p)              { return __hip_atomic_load(p, __ATOMIC_RELAXED, __HIP_MEMORY_SCOPE_AGENT); }
__device__ __forceinline__ unsigned xb_add(unsigned* p, unsigned v) { return __hip_atomic_fetch_add(p, v, __ATOMIC_RELAXED, __HIP_MEMORY_SCOPE_AGENT); }
__device__ __forceinline__ unsigned xb_xcc_id() { return (unsigned)__builtin_amdgcn_s_getreg((3 << 11) | 20) & 0xFu; }
#define XB_SPIN(cond, bar) do { unsigned _sp = 0; while (cond) { __builtin_amdgcn_s_sleep(1); \
    if ((++_sp & 255u) == 0u) { if (xb_ld(&(bar)[XB_TMO])) break; if (_sp > XB_SPIN_CAP) { atomicAdd(&(bar)[XB_TMO], 1u); break; } } } } while (0)

struct XcdBarrier {
    unsigned* bar; unsigned x;
    volatile LAS3 unsigned* st;
};

__device__ __forceinline__ XcdBarrier xcd_barrier_post(unsigned* bar, volatile LAS3 unsigned* st) {
    XcdBarrier b; b.bar = bar; b.x = xb_xcc_id(); b.st = st;
    if (threadIdx.x == 0) (void)xb_add(&bar[XB_XCNT(b.x)], 1u);
    return b;
}
__device__ __forceinline__ void xcd_barrier_complete(unsigned* bar, unsigned x, unsigned& nloc, unsigned& nx) {
    const unsigned G = gridDim.x * gridDim.y * gridDim.z;
    unsigned sum, cnt, mine, sp = 0u;
    for (;;) {
        sum = 0u; cnt = 0u; mine = 0u;
#pragma unroll
        for (unsigned j = 0; j < 16; ++j) { const unsigned c = xb_ld(&bar[XB_XCNT(j)]); sum += c; cnt += (c > 0u) ? 1u : 0u; mine = (j == x) ? c : mine; }
        if (sum == G) break;
        __builtin_amdgcn_s_sleep(1);
        if ((++sp & 255u) == 0u) { if (xb_ld(&bar[XB_TMO])) break; if (sp > XB_SPIN_CAP) { atomicAdd(&bar[XB_TMO], 1u); break; } }
    }
    nloc = mine > 0u ? mine : 1u; nx = cnt > 0u ? cnt : 1u;
}

__device__ __forceinline__ void xcd_barrier(const XcdBarrier& b) {
    asm volatile("s_waitcnt vmcnt(0)" ::: "memory");
    __syncthreads();
    if (threadIdx.x == 0) {
        unsigned* bar = b.bar;
        __builtin_amdgcn_s_waitcnt(0);
        unsigned nloc = b.st[0], nx = b.st[1];
        if (nloc == 0u) { xcd_barrier_complete(bar, b.x, nloc, nx); b.st[0] = nloc; b.st[1] = nx; }
        const unsigned old = xb_add(&bar[XB_XSUB(b.x)], 1u);
        const unsigned gen = old / nloc;
        if (old + 1u == (gen + 1u) * nloc) {
            __builtin_amdgcn_fence(__ATOMIC_RELEASE, "agent");
            asm volatile("s_waitcnt vmcnt(0)" ::: "memory");
            const unsigned og = xb_add(&bar[XB_TOP], 1u);
            const unsigned tg = og / nx;
            if (og + 1u == (tg + 1u) * nx) xb_add(&bar[XB_TOPGEN], 1u);
            else XB_SPIN(xb_ld(&bar[XB_TOPGEN]) == tg, bar);
            __builtin_amdgcn_fence(__ATOMIC_ACQUIRE, "agent");
            xb_add(&bar[XB_XGEN(b.x)], 1u);
            asm volatile("s_waitcnt vmcnt(0)" ::: "memory");
        } else {
            XB_SPIN(xb_ld(&bar[XB_XGEN(b.x)]) == gen, bar);
            __builtin_amdgcn_fence(__ATOMIC_ACQUIRE, "agent");
            asm volatile("s_waitcnt vmcnt(0)" ::: "memory");
        }
    }
    __syncthreads();
}

__device__ __forceinline__ void sub_barrier(unsigned* cnt, unsigned n) {
    asm volatile("s_waitcnt vmcnt(0)" ::: "memory"); __syncthreads();
    if (threadIdx.x == 0) {
        __builtin_amdgcn_fence(__ATOMIC_RELEASE, "agent"); asm volatile("s_waitcnt vmcnt(0)" ::: "memory");
        (void)xb_add(cnt, 1u);
        unsigned sp = 0u; while (xb_ld(cnt) < n) { __builtin_amdgcn_s_sleep(2); if (++sp > (1u << 22)) break; }
        __builtin_amdgcn_fence(__ATOMIC_ACQUIRE, "agent"); asm volatile("s_waitcnt vmcnt(0)" ::: "memory");
    }
    __syncthreads();
}

constexpr int N_PHASES = 8;
#ifndef MK_N_LAUNCHES
#define MK_N_LAUNCHES 1
#endif
__global__ void __launch_bounds__(NTHREADS, 2) layer_fwd(Params P) {
    extern __shared__ __attribute__((aligned(16))) unsigned char lds[];
    const int G = gridDim.x, bid = blockIdx.x;
    volatile LAS3 unsigned* bst = (volatile LAS3 unsigned*)((LAS3 unsigned char*)lds + (LDS_BYTES - 16));
    if (threadIdx.x < 4) bst[threadIdx.x] = 0u;
    __syncthreads();
    XcdBarrier xbar = xcd_barrier_post((unsigned*)(P.ws + WS_CTL) + CW_BAR, bst);
    const int lo = P.ph_lo, hi = P.ph_hi;
#define IN(k) (lo <= (k) && (k) < hi)
#define SEAM(k) do { if (IN(k) && IN((k) + 1)) xcd_barrier(xbar); } while (0)
    if (IN(0)) { p0_rows(P, lds, G, bid); p0_weights_in(P, lds, G, bid); }
    SEAM(0);
    if (IN(1)) {
        const int c0 = (G > 64) ? PC_Q : 0;
        pg8::Gemm g{(const pg8::bf16_t*)(P.ws + WS_XB), (const pg8::bf16_t*)(P.ws + WS_WINT) + (size_t)c0 * D, T, NPROJ - c0, D}; pg8::StaticOrder S; S.init(T, NPROJ - c0, G, bid);
        pg8::EpiProjT E{(pg8::bf16_t*)(P.ws + WS_PROJ), (pg8::bf16_t*)(P.ws + WS_QKVO), c0 / 256, T, (const float*)(P.ws + WS_RS1)};
        pg8::gemm_phase<pg8::EpiProjT, pg8::StaticOrder, true, true>((PG8_LAS unsigned char*)lds, g, S, E);
    }
    SEAM(1);
    if (IN(2)) {
        for (int u = bid; u < 64; u += G) mlstm_unit(P, lds, u, (float*)(P.ws + WS_HRAW));
        if (G > 64) { if (bid < 64) { __syncthreads(); p0_tables(P, lds, 64, bid, NEXP - 1024, NEXP); }
          if (bid >= 64) {
            { pg8::Gemm g{(const pg8::bf16_t*)(P.ws + WS_XB), (const pg8::bf16_t*)(P.ws + WS_WINT), T, PC_Q, D}; pg8::StaticOrder S; S.init(T, PC_Q, G - 64, bid - 64);
              pg8::EpiProjT E{(pg8::bf16_t*)(P.ws + WS_PROJ), (pg8::bf16_t*)(P.ws + WS_QKVO), 0, T, (const float*)(P.ws + WS_RS1)};
              pg8::gemm_phase<pg8::EpiProjT, pg8::StaticOrder, true, true>((PG8_LAS unsigned char*)lds, g, S, E); }
            sub_barrier((unsigned*)(P.ws + WS_CTL) + 8192, (unsigned)(G - 64));
            p2_conv(P, lds, G - 64, bid - 64); p2_weights_sq(P, lds, G - 64, bid - 64, 2); p0_tables(P, lds, G - 64, bid - 64, 0, NEXP - 1024); } }
        else { p2_conv(P, lds, G, bid); p2_weights_sq(P, lds, G, bid); p0_tables(P, lds, G, bid); }
    }
    SEAM(2);
    if (IN(3)) p3_finalize(P, G, bid);
    SEAM(3);
    if (IN(4)) {
        pg8::Gemm g{(const pg8::bf16_t*)(P.ws + WS_MIXIN), (const pg8::bf16_t*)(P.ws + WS_WOUTT), T, D, D}; pg8::StaticOrder S; S.init(T, D, G, bid);
        pg8::EpiOut E{P.x, (pg8::bf16_t*)(P.ws + WS_X1B), (float*)(P.ws + WS_SSQ), D};
        pg8::gemm_phase<pg8::EpiOut, pg8::StaticOrder, true, true>((PG8_LAS unsigned char*)lds, g, S, E);
    }
    SEAM(4);
    if (IN(5)) {
        pg8::Gemm g{(const pg8::bf16_t*)(P.ws + WS_X1B), (const pg8::bf16_t*)(P.ws + WS_WQT), T, D, D}; pg8::StaticOrder S; S.init(T, D, G, bid);
        float* rs2 = (float*)(P.ws + WS_RS1) + T;
        { pg8::Unit u; for (int i = 0; S.next(i, u); ++i) { const int row = u.pm * 256 + (threadIdx.x >> 1); const pg8::f32x4* sp = (const pg8::f32x4*)((const float*)(P.ws + WS_SSQ) + (size_t)row * 32 + (threadIdx.x & 1) * 16);
              const pg8::f32x4 s4 = (sp[0] + sp[1]) + (sp[2] + sp[3]); float sm = (s4[0] + s4[1]) + (s4[2] + s4[3]); sm += __shfl_xor(sm, 1);
              if (!(threadIdx.x & 1)) rs2[row] = rsqrtf(sm * (1.0f / 2048.0f) + 1e-6f); }
          asm volatile("s_waitcnt vmcnt(0)" ::: "memory"); __syncthreads(); }
        pg8::EpiProj E{(pg8::bf16_t*)(P.ws + WS_QV), D, rs2};
        pg8::gemm_phase<pg8::EpiProj, pg8::StaticOrder, true, true>((PG8_LAS unsigned char*)lds, g, S, E);
    }
    SEAM(5);
    if (IN(6)) p6_topk(P, lds, G, bid);
    SEAM(6);
    if (IN(7)) p7_peer(P, lds, G, bid);
#undef IN
#undef SEAM
}

extern "C" void kernel_launch(void* const* d_in, const int* in_sizes, int n_in, void* d_out, int out_size, void* d_ws, size_t ws_size, hipStream_t stream) {
    static int grid = 0;
    if (grid == 0) {
        if (n_in != 15 || in_sizes[0] != T * D || out_size != T * D || ws_size < WS_END) { fprintf(stderr, "kernel_launch: unexpected shapes (n_in %d, in0 %d, out %d, ws %zu); nothing launched\n", n_in, n_in > 0 ? in_sizes[0] : -1, out_size, ws_size); grid = -1; return; }
        int dev = 0, cus = 0, per_cu = 0;
        if (hipGetDevice(&dev) != hipSuccess || hipDeviceGetAttribute(&cus, hipDeviceAttributeMultiprocessorCount, dev) != hipSuccess) { grid = -1; return; }
        if (hipFuncSetAttribute((const void*)layer_fwd, hipFuncAttributeMaxDynamicSharedMemorySize, LDS_BYTES) != hipSuccess) { fprintf(stderr, "kernel_launch: hipFuncSetAttribute failed\n"); grid = -1; return; }
        if (hipOccupancyMaxActiveBlocksPerMultiprocessor(&per_cu, (const void*)layer_fwd, NTHREADS, LDS_BYTES) != hipSuccess || per_cu < 1) { fprintf(stderr, "kernel_launch: occupancy query says %d blocks per CU\n", per_cu); (void)hipGetLastError(); grid = -1; return; }
        grid = cus;
    }
    if (grid < 0) return;
    Params p{};
    p.x = (const float*)d_in[0]; p.g1 = (const float*)d_in[1]; p.w_in = (const float*)d_in[2]; p.b_ig = (const float*)d_in[3]; p.b_fg = (const float*)d_in[4];
    p.conv_w = (const float*)d_in[5]; p.gm = (const float*)d_in[6]; p.w_out = (const float*)d_in[7]; p.g2 = (const float*)d_in[8]; p.w_q = (const float*)d_in[9];
    p.sk1 = (const float*)d_in[10]; p.sk2 = (const float*)d_in[11]; p.eu = (const float*)d_in[12]; p.ev = (const float*)d_in[13]; p.gfin = (const float*)d_in[14];
    p.out = (float*)d_out; p.ws = (unsigned char*)d_ws;
    if (hipMemsetAsync((char*)d_ws + WS_CTL, 0, CTL_ZERO_BYTES, stream) != hipSuccess) { fprintf(stderr, "kernel_launch: hipMemsetAsync failed\n"); return; }
    for (int li = 0; li < MK_N_LAUNCHES; ++li) {
        p.ph_lo = (MK_N_LAUNCHES == 1) ? 0 : li; p.ph_hi = (MK_N_LAUNCHES == 1) ? N_PHASES : li + 1;
        void* args[] = {&p};
        const hipError_t e = hipLaunchCooperativeKernel((const void*)layer_fwd, dim3(grid), dim3(NTHREADS), args, LDS_BYTES, stream);
        if (e != hipSuccess) { fprintf(stderr, "kernel_launch: cooperative launch %d failed: %s (grid %d)\n", li, hipGetErrorString(e), grid); break; }
    }
}
```
